# Optimizing an MI355X kernel written in HIP

```python
import math
import jax, jax.numpy as jnp
from jax import lax
import numpy as np

D_MODEL = 1024
BATCH = 2
SEQ = 8192
DEPTH = 2

CHUNK = 64
Q_BLOCK = 128
ROPE_THETA = 500000.0
EPS = 1e-6

GLA_HEADS = 4
GLA_KEY_DIM = D_MODEL // 2
GLA_VAL_DIM = D_MODEL
GLA_DK = GLA_KEY_DIM // GLA_HEADS
GLA_DV = GLA_VAL_DIM // GLA_HEADS
GLA_LOW_RANK = 16
GLA_GATE_NORMALIZER = 16.0

SSM_D_INNER = 2 * D_MODEL
SSM_HEAD_DIM = 64
SSM_HEADS = SSM_D_INNER // SSM_HEAD_DIM
SSM_GROUPS = 4
SSM_HEADS_PER_GROUP = SSM_HEADS // SSM_GROUPS
SSM_STATE = 128
SSM_CONV_W = 4
SSM_BC_WIDTH = SSM_GROUPS * SSM_STATE
SSM_CONV_DIM = SSM_D_INNER + 2 * SSM_BC_WIDTH

DIFF_HEADS = 8
DIFF_HEAD_DIM = 64
DIFF_V_DIM = 2 * DIFF_HEAD_DIM
DIFF_QK_WIDTH = DIFF_HEADS * 2 * DIFF_HEAD_DIM
DIFF_V_WIDTH = DIFF_HEADS * DIFF_V_DIM
ROT_DIM = DIFF_HEAD_DIM // 4
DIFF_SUBLN_EPS = 1e-5

N_BRANCHES = 3
D_FF = 4 * D_MODEL

IN_SPLITS = (GLA_KEY_DIM, GLA_KEY_DIM, GLA_VAL_DIM, GLA_LOW_RANK, GLA_VAL_DIM,
             SSM_D_INNER, SSM_CONV_DIM, SSM_HEADS,
             DIFF_QK_WIDTH, DIFF_QK_WIDTH, DIFF_V_WIDTH,
             N_BRANCHES * D_MODEL)
IN_COLS = (GLA_KEY_DIM + GLA_KEY_DIM + GLA_VAL_DIM + GLA_LOW_RANK + GLA_VAL_DIM
           + SSM_D_INNER + SSM_CONV_DIM + SSM_HEADS
           + DIFF_QK_WIDTH + DIFF_QK_WIDTH + DIFF_V_WIDTH + N_BRANCHES * D_MODEL)

kernel_name = 'hybrid_gated_gla_ssd_diffattn_trunk'

F32 = jnp.float32


def _rms(x, eps=EPS):
    xf = x.astype(F32)
    return xf * lax.rsqrt(jnp.mean(xf * xf, axis=-1, keepdims=True) + eps)


def rmsnorm(x, g):
    return (_rms(x) * g.astype(F32)).astype(x.dtype)


def _split_points():
    pts = []
    acc = 0
    for s in IN_SPLITS[:-1]:
        acc += s
        pts.append(acc)
    return pts


def segsum(t):
    T = t.shape[-1]
    tr = jnp.broadcast_to(t[..., :, None], t.shape + (T,))
    strict = jnp.tril(jnp.ones((T, T), bool), -1)
    cs = jnp.cumsum(jnp.where(strict, tr, 0.0), axis=-2)
    return jnp.where(jnp.tril(jnp.ones((T, T), bool)), cs, -jnp.inf)


def gla_mixer(q, k, v, gk_low, g_out, w_gk2, b_gk, norm_g):
    bsz, s_len, _ = q.shape
    nc = s_len // CHUNK
    gk = jax.nn.log_sigmoid(gk_low.astype(F32) @ w_gk2.astype(F32) + b_gk.astype(F32)) / GLA_GATE_NORMALIZER

    def to_chunks(t, d):
        return t.astype(F32).reshape(bsz, nc, CHUNK, GLA_HEADS, d).transpose(1, 0, 3, 2, 4)

    qc = to_chunks(q, GLA_DK) * (GLA_DK ** -0.5)
    kc = to_chunks(k, GLA_DK)
    vc = to_chunks(v, GLA_DV)
    bc = jnp.cumsum(to_chunks(gk, GLA_DK), axis=-2)
    causal = jnp.tril(jnp.ones((CHUNK, CHUNK), bool))

    def step(state, inp):
        qi, ki, vi, bi = inp
        o_inter = jnp.einsum('bhcd,bhde->bhce', qi * jnp.exp(bi), state)
        rel = bi[:, :, :, None, :] - bi[:, :, None, :, :]
        decay = jnp.exp(jnp.where(causal[:, :, None], rel, -jnp.inf))
        scores = jnp.einsum('bhid,bhjd,bhijd->bhij', qi, ki, decay)
        o = o_inter + jnp.einsum('bhij,bhje->bhie', scores, vi)
        b_last = bi[:, :, -1:, :]
        state = state * jnp.exp(b_last)[:, :, 0, :, None] + jnp.einsum(
            'bhcd,bhce->bhde', ki * jnp.exp(b_last - bi), vi)
        return state, o

    s0 = jnp.zeros((bsz, GLA_HEADS, GLA_DK, GLA_DV), F32)
    _, o = lax.scan(step, s0, (qc, kc, vc, bc))
    o = o.transpose(1, 0, 3, 2, 4).reshape(bsz, s_len, GLA_HEADS, GLA_DV)
    g = g_out.astype(F32).reshape(bsz, s_len, GLA_HEADS, GLA_DV)
    o = _rms(o) * norm_g.astype(F32) * jax.nn.silu(g)
    return o.reshape(bsz, s_len, GLA_VAL_DIM).astype(q.dtype)


def ssd_mixer(z, xbc, dt_raw, conv_w, conv_b, dt_bias, a_log, d_skip, norm_g):
    bsz, s_len, _ = z.shape
    nc = s_len // CHUNK
    G, R, P, N = SSM_GROUPS, SSM_HEADS_PER_GROUP, SSM_HEAD_DIM, SSM_STATE
    xp = jnp.pad(xbc.astype(F32), ((0, 0), (SSM_CONV_W - 1, 0), (0, 0)))
    conv = conv_b.astype(F32)
    for i in range(SSM_CONV_W):
        conv = conv + xp[:, i:i + s_len, :] * conv_w[i].astype(F32)
    xbc = jax.nn.silu(conv)
    xs = xbc[..., :SSM_D_INNER]
    bm = xbc[..., SSM_D_INNER:SSM_D_INNER + SSM_BC_WIDTH]
    cm = xbc[..., SSM_D_INNER + SSM_BC_WIDTH:]
    dt = jax.nn.softplus(dt_raw.astype(F32) + dt_bias.astype(F32))
    a = -jnp.exp(a_log.astype(F32))

    x_c = xs.reshape(bsz, nc, CHUNK, G, R, P)
    dtc = dt.reshape(bsz, nc, CHUNK, G, R)
    xdt = x_c * dtc[..., None]
    bc = bm.reshape(bsz, nc, CHUNK, G, N)
    cc = cm.reshape(bsz, nc, CHUNK, G, N)
    da = (dtc * a.reshape(G, R)).transpose(0, 3, 4, 1, 2)
    a_cum = jnp.cumsum(da, axis=-1)

    lmat = jnp.exp(segsum(da))
    y_diag = jnp.einsum('bclgn,bcsgn,bgrcls,bcsgrp->bclgrp', cc, bc, lmat, xdt)
    decay_states = jnp.exp(a_cum[..., -1:] - a_cum)
    states = jnp.einsum('bclgn,bgrcl,bclgrp->bcgrpn', bc, decay_states, xdt)
    states = jnp.concatenate([jnp.zeros_like(states[:, :1]), states], axis=1)
    chunk_decay = jnp.exp(segsum(jnp.pad(a_cum[..., -1], ((0, 0), (0, 0), (0, 0), (1, 0)))))
    states = jnp.einsum('bgrzc,bcgrpn->bzgrpn', chunk_decay, states)[:, :-1]
    y_off = jnp.einsum('bclgn,bcgrpn,bgrcl->bclgrp', cc, states, jnp.exp(a_cum))
    y = y_diag + y_off + x_c * d_skip.astype(F32).reshape(G, R)[:, :, None]
    y = y.reshape(bsz, s_len, SSM_D_INNER) * jax.nn.silu(z.astype(F32))
    y = _rms(y.reshape(bsz, s_len, G, SSM_D_INNER // G)).reshape(bsz, s_len, SSM_D_INNER)
    return (y * norm_g.astype(F32)).astype(z.dtype)


def partial_rope(t, cos, sin):
    half = ROT_DIM // 2
    t1 = t[..., :half]
    t2 = t[..., half:ROT_DIM]
    return jnp.concatenate([t1 * cos - t2 * sin, t2 * cos + t1 * sin, t[..., ROT_DIM:]], axis=-1)


def diff_mixer(q, k, v, positions, lq1, lk1, lq2, lk2, norm_g, lambda_init):
    bsz, s_len, _ = q.shape
    nb = s_len // Q_BLOCK
    q = q.astype(F32).reshape(bsz, s_len, DIFF_HEADS, 2, DIFF_HEAD_DIM)
    k = k.astype(F32).reshape(bsz, s_len, DIFF_HEADS, 2, DIFF_HEAD_DIM)
    v = v.astype(F32).reshape(bsz, s_len, DIFF_HEADS, DIFF_V_DIM)
    inv_freq = ROPE_THETA ** (-jnp.arange(0, ROT_DIM, 2, dtype=F32) / ROT_DIM)
    ang = positions.astype(F32)[..., None] * inv_freq
    cos = jnp.cos(ang)[:, :, None, None, :]
    sin = jnp.sin(ang)[:, :, None, None, :]
    q = partial_rope(q, cos, sin)
    k = partial_rope(k, cos, sin)
    lam = (jnp.exp(jnp.sum(lq1.astype(F32) * lk1.astype(F32)))
           - jnp.exp(jnp.sum(lq2.astype(F32) * lk2.astype(F32))) + lambda_init)

    qb = q.reshape(bsz, nb, Q_BLOCK, DIFF_HEADS, 2, DIFF_HEAD_DIM).transpose(1, 0, 3, 4, 2, 5)
    kt = k.transpose(0, 2, 3, 1, 4)
    vt = v.transpose(0, 2, 1, 3)
    key_chunk = jnp.arange(s_len) // CHUNK
    scale = DIFF_HEAD_DIM ** -0.5

    def attend(args):
        q_blk, blk = args
        q_chunk = (blk * Q_BLOCK + jnp.arange(Q_BLOCK)) // CHUNK
        allowed = key_chunk[None, :] <= q_chunk[:, None]
        s = jnp.einsum('bhtqd,bhtkd->bhtqk', q_blk, kt) * scale
        p = jax.nn.softmax(jnp.where(allowed, s, -jnp.inf), axis=-1)
        w = p[:, :, 0] - lam * p[:, :, 1]
        return jnp.einsum('bhqk,bhkd->bhqd', w, vt)

    o = lax.map(attend, (qb, jnp.arange(nb)))
    o = o.transpose(1, 0, 3, 2, 4).reshape(bsz, s_len, DIFF_HEADS, DIFF_V_DIM)
    o = _rms(o, DIFF_SUBLN_EPS) * norm_g.astype(F32) * (1.0 - lambda_init)
    return o.reshape(bsz, s_len, DIFF_V_WIDTH).astype(positions.dtype if False else jnp.result_type(norm_g))


def setup_inputs(seed: int = 0) -> dict:
    key = jax.random.key(seed)
    ks = jax.random.split(key, 32)

    def nrm(k, shape, scale):
        return jax.random.normal(k, shape, F32) * scale

    x = jax.random.normal(ks[0], (BATCH, SEQ, D_MODEL), F32)
    offset = jax.random.randint(ks[1], (BATCH,), 0, 4096, dtype=jnp.int32)
    positions = offset[:, None] + jnp.arange(SEQ, dtype=jnp.int32)[None, :]
    dt = jnp.exp(jax.random.uniform(ks[10], (DEPTH, SSM_HEADS), F32, math.log(1e-3), math.log(1e-1)))
    return {
        'x': x,
        'positions': positions,
        'norm_mix_g': 1.0 + nrm(ks[2], (DEPTH, D_MODEL), 0.01),
        'w_in': nrm(ks[3], (DEPTH, D_MODEL, IN_COLS), D_MODEL ** -0.5),
        'b_gate': nrm(ks[4], (DEPTH, N_BRANCHES * D_MODEL), 0.01),
        'gla_w_gk2': nrm(ks[5], (DEPTH, GLA_LOW_RANK, GLA_KEY_DIM), GLA_LOW_RANK ** -0.5),
        'gla_b_gk': nrm(ks[6], (DEPTH, GLA_KEY_DIM), 0.01),
        'gla_norm_g': 1.0 + nrm(ks[7], (DEPTH, GLA_DV), 0.01),
        'ssm_conv_w': nrm(ks[8], (DEPTH, SSM_CONV_W, SSM_CONV_DIM), SSM_CONV_W ** -0.5),
        'ssm_conv_b': nrm(ks[9], (DEPTH, SSM_CONV_DIM), 0.01),
        'ssm_dt_bias': dt + jnp.log(-jnp.expm1(-dt)),
        'ssm_a_log': jnp.log(jax.random.uniform(ks[11], (DEPTH, SSM_HEADS), F32, 1.0, 16.0)),
        'ssm_d': 1.0 + nrm(ks[12], (DEPTH, SSM_HEADS), 0.01),
        'ssm_norm_g': 1.0 + nrm(ks[13], (DEPTH, SSM_D_INNER), 0.01),
        'diff_lq1': nrm(ks[14], (DEPTH, DIFF_HEAD_DIM), 0.1),
        'diff_lk1': nrm(ks[15], (DEPTH, DIFF_HEAD_DIM), 0.1),
        'diff_lq2': nrm(ks[16], (DEPTH, DIFF_HEAD_DIM), 0.1),
        'diff_lk2': nrm(ks[17], (DEPTH, DIFF_HEAD_DIM), 0.1),
        'diff_norm_g': 1.0 + nrm(ks[18], (DEPTH, DIFF_V_DIM), 0.01),
        'w_br_gla': nrm(ks[19], (DEPTH, GLA_VAL_DIM, D_MODEL), GLA_VAL_DIM ** -0.5),
        'w_br_ssm': nrm(ks[20], (DEPTH, SSM_D_INNER, D_MODEL), SSM_D_INNER ** -0.5),
        'w_br_diff': nrm(ks[21], (DEPTH, DIFF_V_WIDTH, D_MODEL), DIFF_V_WIDTH ** -0.5),
        'w_out': nrm(ks[22], (DEPTH, D_MODEL, D_MODEL), D_MODEL ** -0.5),
        'norm_mlp_g': 1.0 + nrm(ks[23], (DEPTH, D_MODEL), 0.01),
        'w_mlp_up': nrm(ks[24], (DEPTH, D_MODEL, D_FF), D_MODEL ** -0.5),
        'w_mlp_down': nrm(ks[25], (DEPTH, D_FF, D_MODEL), D_FF ** -0.5),
        'norm_final_g': 1.0 + nrm(ks[26], (D_MODEL,), 0.01),
    }


def reference(x, positions, norm_mix_g, w_in, b_gate, gla_w_gk2, gla_b_gk, gla_norm_g,
              ssm_conv_w, ssm_conv_b, ssm_dt_bias, ssm_a_log, ssm_d, ssm_norm_g,
              diff_lq1, diff_lk1, diff_lq2, diff_lk2, diff_norm_g,
              w_br_gla, w_br_ssm, w_br_diff, w_out, norm_mlp_g, w_mlp_up, w_mlp_down,
              norm_final_g):
    bsz, s_len, _ = x.shape
    pts = _split_points()
    for l in range(DEPTH):
        h = rmsnorm(x, norm_mix_g[l])
        proj = h @ w_in[l]
        (a_q, a_k, a_v, a_gk, a_g, b_z, b_xbc, b_dt,
         c_q, c_k, c_v, gate_logits) = jnp.split(proj, pts, axis=-1)
        y_gla = gla_mixer(a_q, a_k, a_v, a_gk, a_g, gla_w_gk2[l], gla_b_gk[l], gla_norm_g[l])
        y_ssm = ssd_mixer(b_z, b_xbc, b_dt, ssm_conv_w[l], ssm_conv_b[l], ssm_dt_bias[l],
                          ssm_a_log[l], ssm_d[l], ssm_norm_g[l])
        lambda_init = 0.8 - 0.6 * math.exp(-0.3 * l)
        y_diff = diff_mixer(c_q, c_k, c_v, positions, diff_lq1[l], diff_lk1[l], diff_lq2[l],
                            diff_lk2[l], diff_norm_g[l], lambda_init)
        gates = jax.nn.sigmoid((gate_logits + b_gate[l]).astype(F32))
        gates = gates.reshape(bsz, s_len, N_BRANCHES, D_MODEL).astype(x.dtype)
        mixed = (gates[:, :, 0] * (y_gla @ w_br_gla[l])
                 + gates[:, :, 1] * (y_ssm @ w_br_ssm[l])
                 + gates[:, :, 2] * (y_diff.astype(x.dtype) @ w_br_diff[l]))
        x = x + mixed @ w_out[l]
        h = rmsnorm(x, norm_mlp_g[l])
        x = x + jnp.square(jax.nn.relu(h @ w_mlp_up[l])) @ w_mlp_down[l]
    return rmsnorm(x, norm_final_g)
```

```cpp
#include <hip/hip_runtime.h>
#include <hip/hip_cooperative_groups.h>
#include <cstdio>
#include <cstdint>
namespace cg = cooperative_groups;

#define LAS __attribute__((address_space(3)))
#define DI __device__ __forceinline__
typedef unsigned short bf16_t;
typedef short bf16x8 __attribute__((ext_vector_type(8)));
typedef short s16x4 __attribute__((ext_vector_type(4)));
typedef float f32x4 __attribute__((ext_vector_type(4)));
typedef float f32x16 __attribute__((ext_vector_type(16)));
typedef unsigned u32x4 __attribute__((ext_vector_type(4)));
typedef unsigned u32x2 __attribute__((ext_vector_type(2)));
typedef float f32x2_t __attribute__((ext_vector_type(2)));
typedef __bf16 bf16x2_t __attribute__((ext_vector_type(2)));

DI unsigned pk2(float lo, float hi) { f32x2_t v = {lo, hi}; bf16x2_t b = __builtin_convertvector(v, bf16x2_t); return __builtin_bit_cast(unsigned, b); }
DI bf16_t f2bf(float f) { return (bf16_t)(pk2(f, 0.f) & 0xffffu); }
DI float bf2f(unsigned b) { return __uint_as_float(b << 16); }
DI float bflo(unsigned w) { return __uint_as_float(w << 16); }
DI float bfhi(unsigned w) { return __uint_as_float(w & 0xffff0000u); }
DI f32x4 mfma16(bf16x8 a, bf16x8 b, f32x4 c) { return __builtin_amdgcn_mfma_f32_16x16x32_bf16(a, b, c, 0, 0, 0); }
DI f32x16 mfma32(bf16x8 a, bf16x8 b, f32x16 c) { return __builtin_amdgcn_mfma_f32_32x32x16_bf16(a, b, c, 0, 0, 0); }
DI float sigmoidf_(float x) { return 1.f / (1.f + __expf(-x)); }
DI float siluf_(float x) { return x / (1.f + __expf(-x)); }
DI int opaque_tid() { int t = threadIdx.x; asm volatile("" : "+v"(t)); return t; }
DI int crow(int r, int hi) { return (r & 3) + 8 * (r >> 2) + 4 * hi; }

constexpr int T = 16384, SEQ = 8192, DM = 1024, DFF = 4096, INC = 14384;
constexpr float EPS = 1e-6f;
constexpr size_t MiB = 1u << 20;
constexpr size_t WS_ROWSQ = 0;
constexpr size_t WS_DECG = 512 * 1024;
constexpr size_t WS_DECS = 768 * 1024;
constexpr size_t WS_SSQ = 1 * MiB;
constexpr size_t WS_SMALL = 2 * MiB;
constexpr size_t WS_XB = 6 * MiB;
constexpr size_t WS_MIXB = 38 * MiB;
constexpr size_t WS_WT = 70 * MiB;
constexpr size_t WT_GD = 0, WT_S = WT_GD + (size_t)8448 * 1024 * 2, WT_GLA = WT_S + (size_t)6144 * 1024 * 2, WT_SSM = WT_GLA + 2 * MiB,
                 WT_DIFF = WT_SSM + 4 * MiB, WT_OUT = WT_DIFF + 2 * MiB, WT_UP = WT_OUT + 2 * MiB, WT_DOWN = WT_UP + 8 * MiB, WT_END = WT_DOWN + 8 * MiB;
static_assert(WT_END <= 56 * MiB, "wt");
constexpr size_t WS_R = 126 * MiB;
constexpr size_t BLK = 32 * MiB;
constexpr size_t WS_STG = WS_R + 8 * BLK;
constexpr size_t WS_STS = WS_R + 6 * BLK;
constexpr size_t WS_SIDE = WS_R + 9 * BLK;
constexpr size_t SB_HN = WS_SIDE, SB_PROJ = SB_HN + 512 * 1024, SB_KV = SB_PROJ + 128 * 1024, SB_Y = SB_KV + 1024 * 1024, SB_GATE = SB_Y + 32 * 1024,
                 SB_BR = SB_GATE + 32 * 1024, SB_MIX = SB_BR + 32 * 1024, SB_XM = SB_MIX + 8192, SB_H2 = SB_XM + 8192, SB_UP = SB_H2 + 8192,
                 SB_HH = SB_UP + 32768, SB_X1 = SB_HH + 32768, SB_HN1 = SB_X1 + 8192, SB_QK1 = SB_HN1 + 8192, SB_END = SB_QK1 + 8192;
constexpr size_t WS_END = WS_SIDE + 2 * MiB;
static_assert(SB_END <= WS_END, "side");

struct Params {
    const float* in[27];
    float* out; unsigned char* ws;
    int ph_lo, ph_hi;
};

namespace pg8 {
constexpr int BM = 256, BK = 64, HALF = 128, HTB = HALF * BK * 2, STAGE_BYTES = 8 * HTB, NXCD = 8, WGM = 8;
__host__ __device__ __forceinline__ int lds_byte(int r, int c) { const int st = (r >> 4) * 2 + (c >> 5), rr = r & 15, cc = c & 31, ob = rr * 64 + cc * 2; return st * 1024 + (ob ^ (((ob >> 9) & 1) << 5)); }
__host__ __device__ __forceinline__ void stage_rc(int b, int& R, int& C) { const int st = b / 1024, sb = b % 1024, swz = sb ^ (((sb >> 9) & 1) << 5); R = (st >> 1) * 16 + swz / 64; C = (st & 1) * 32 + (swz % 64) / 2; }
struct Unit { int pm, pn; };
struct Gemm { const bf16_t* A; const bf16_t* Bt; int M, N, K, lda, ldb; };
struct StaticOrder {
    int nM, nN, nwg, G, c;
    __host__ __device__ void init(int M, int N, int G_, int c_) { nM = M / BM; nN = N / BM; nwg = nM * nN; G = G_; c = c_; }
    __host__ __device__ bool next(int i, Unit& u) const {
        const long L = (long)i * G + c; if (L >= nwg) return false;
        int wgid = (int)L; { const int q = nwg / NXCD, r = nwg % NXCD, xcd = wgid % NXCD, off = wgid / NXCD; wgid = (xcd < r ? xcd * (q + 1) : r * (q + 1) + (xcd - r) * q) + off; }
        const int nig = WGM * nN, gid = wgid / nig, fm = gid * WGM, gsz = (nM - fm) < WGM ? (nM - fm) : WGM;
        u.pm = fm + ((wgid % nig) % gsz); u.pn = (wgid % nig) / gsz; return true;
    }
};
template <class Epi, class Sched>
__device__ __forceinline__ void gemm_phase(LAS unsigned char* lds, const Gemm g, const Sched& S, const Epi& E) {
    const int tid = opaque_tid(), wid = __builtin_amdgcn_readfirstlane(tid >> 6), lane = tid & 63, wr = wid >> 2, wc = wid & 3, fr = lane & 15, fq = lane >> 4;
    const int K = g.K, nt = K / BK;
    unsigned voffA[2], voffB[2];
#pragma unroll
    for (int i = 0; i < 2; ++i) { int R, C; stage_rc(tid * 16 + i * 8192, R, C);
        voffA[i] = (unsigned)(R * g.lda + C) * 2u; voffB[i] = (unsigned)(R * g.ldb + C) * 2u; }
    const size_t kstep = (size_t)(BK * 2);
    const size_t hstepA = (size_t)HALF * g.lda * 2, hstepB = (size_t)HALF * g.ldb * 2;
    const size_t tstepA = 2 * hstepA, tstepB = 2 * hstepB;
    const unsigned ldsw = (unsigned)wid * 1024u;
    const int aoff = lds_byte(wr * 64 + fr, fq * 8), boff = lds_byte(wc * 32 + fr, fq * 8);
#define PG8_SA(b, h) (((b) * 2 + (h)) * HTB)
#define PG8_SB(b, h) ((4 + (b) * 2 + (h)) * HTB)
#define PG8_STAGE(bufoff, gbase, voff) do { _Pragma("unroll") for (int _i = 0; _i < 2; ++_i) \
        __builtin_amdgcn_global_load_lds((const unsigned*)((const char*)(gbase) + (voff)[_i]), (LAS unsigned*)(lds + (bufoff) + ldsw + _i * 8192), 16, 0, 0); } while (0)
#define PG8_LDA(dst, b, h) do { _Pragma("unroll") for (int m = 0; m < 4; ++m) _Pragma("unroll") for (int k = 0; k < 2; ++k) dst[m][k] = *(const LAS bf16x8*)(lds + PG8_SA(b, h) + aoff + m * 2048 + k * 1024); } while (0)
#define PG8_LDB(dst, b, h) do { _Pragma("unroll") for (int n = 0; n < 2; ++n) _Pragma("unroll") for (int k = 0; k < 2; ++k) dst[n][k] = *(const LAS bf16x8*)(lds + PG8_SB(b, h) + boff + n * 2048 + k * 1024); } while (0)
#define PG8_MMA(ai, bj, At, Bt) do { __builtin_amdgcn_s_setprio(1); _Pragma("unroll") for (int m = 0; m < 4; ++m) _Pragma("unroll") for (int n = 0; n < 2; ++n) _Pragma("unroll") for (int k = 0; k < 2; ++k) \
        acc[ai][bj][m][n] = __builtin_amdgcn_mfma_f32_16x16x32_bf16(Bt[n][k], At[m][k], acc[ai][bj][m][n], 0, 0, 0); __builtin_amdgcn_s_setprio(0); } while (0)
#define PG8_WAIT_V(n) asm volatile("s_waitcnt vmcnt(" #n ")" ::: "memory")
#define PG8_WAIT_L(n) asm volatile("s_waitcnt lgkmcnt(" #n ")" ::: "memory")
#define PG8_BAR __builtin_amdgcn_s_barrier()
#define PG8_SCHED __builtin_amdgcn_sched_barrier(0)
    Unit cur, nxt; int ui = 0;
    if (!S.next(0, cur)) return;
    f32x4 acc[2][2][4][2];
#pragma unroll
    for (int a = 0; a < 2; ++a)
#pragma unroll
        for (int b = 0; b < 2; ++b)
#pragma unroll
            for (int m = 0; m < 4; ++m)
#pragma unroll
                for (int n = 0; n < 2; ++n) acc[a][b][m][n] = (f32x4){0.f, 0.f, 0.f, 0.f};
    bf16x8 At[4][2], B0[2][2], B1[2][2];
    const char* cA = (const char*)g.A + (size_t)cur.pm * tstepA; const char* cB = (const char*)g.Bt + (size_t)cur.pn * tstepB;
    PG8_STAGE(PG8_SB(0, 0), cB, voffB); PG8_STAGE(PG8_SB(0, 1), cB + hstepB, voffB); PG8_STAGE(PG8_SA(0, 0), cA, voffA); PG8_STAGE(PG8_SA(0, 1), cA + hstepA, voffA);
    if (wr == 1) PG8_BAR;
    PG8_WAIT_V(2); PG8_BAR;
    PG8_STAGE(PG8_SB(1, 0), cB + kstep, voffB); PG8_STAGE(PG8_SA(1, 0), cA + kstep, voffA); PG8_STAGE(PG8_SB(1, 1), cB + hstepB + kstep, voffB);
    PG8_WAIT_V(6); PG8_BAR;
    for (;;) {
        const bool has_next = S.next(ui + 1, nxt);
        const char* nA = has_next ? (const char*)g.A + (size_t)nxt.pm * tstepA : cA; const char* nB = has_next ? (const char*)g.Bt + (size_t)nxt.pn * tstepB : cB;
        for (int t = 0; t < nt; t += 2) {
            const bool last = (t == nt - 2);
            const char* a1 = cA + (size_t)(t + 1) * kstep;
            const char* a2 = last ? nA : cA + (size_t)(t + 2) * kstep; const char* b2 = last ? nB : cB + (size_t)(t + 2) * kstep;
            const char* a3 = a2 + kstep; const char* b3 = b2 + kstep;
            PG8_LDB(B0, 0, 0); PG8_LDB(B1, 0, 1); PG8_SCHED; PG8_LDA(At, 0, 0); PG8_STAGE(PG8_SA(1, 1), a1 + hstepA, voffA);
            PG8_WAIT_V(8); PG8_WAIT_L(0); PG8_BAR; PG8_MMA(0, 0, At, B0); PG8_MMA(0, 1, At, B1); PG8_BAR; PG8_SCHED;
            PG8_LDA(At, 0, 1); PG8_STAGE(PG8_SB(0, 0), b2, voffB); PG8_STAGE(PG8_SB(0, 1), b2 + hstepB, voffB); PG8_STAGE(PG8_SA(0, 0), a2, voffA);
            PG8_WAIT_V(8); PG8_WAIT_L(0); PG8_BAR; PG8_MMA(1, 0, At, B0); PG8_MMA(1, 1, At, B1); PG8_BAR; PG8_SCHED;
            PG8_LDB(B0, 1, 0); PG8_LDB(B1, 1, 1); PG8_SCHED; PG8_LDA(At, 1, 0); PG8_STAGE(PG8_SA(0, 1), a2 + hstepA, voffA);
            PG8_WAIT_V(8); PG8_WAIT_L(0); PG8_BAR; PG8_MMA(0, 0, At, B0); PG8_MMA(0, 1, At, B1); PG8_BAR; PG8_SCHED;
            PG8_LDA(At, 1, 1); PG8_STAGE(PG8_SB(1, 0), b3, voffB); PG8_STAGE(PG8_SB(1, 1), b3 + hstepB, voffB); PG8_STAGE(PG8_SA(1, 0), a3, voffA);
            PG8_WAIT_V(8); PG8_WAIT_L(0); PG8_BAR; PG8_MMA(1, 0, At, B0); PG8_MMA(1, 1, At, B1); PG8_BAR; PG8_SCHED;
        }
        if (wr == 0) PG8_BAR;
        E(acc, cur, wr, wc, fr, fq);
        if (!has_next) break;
#pragma unroll
        for (int a = 0; a < 2; ++a)
#pragma unroll
            for (int b = 0; b < 2; ++b)
#pragma unroll
                for (int m = 0; m < 4; ++m)
#pragma unroll
                    for (int n = 0; n < 2; ++n) acc[a][b][m][n] = (f32x4){0.f, 0.f, 0.f, 0.f};
        cur = nxt; cA = nA; cB = nB; ++ui;
        if (wr == 1) PG8_BAR;
    }
    PG8_WAIT_V(0);
    PG8_BAR;
#undef PG8_SA
#undef PG8_SB
#undef PG8_STAGE
#undef PG8_LDA
#undef PG8_LDB
#undef PG8_MMA
#undef PG8_WAIT_V
#undef PG8_WAIT_L
#undef PG8_BAR
#undef PG8_SCHED
}
}

typedef f32x4 Acc[2][2][4][2];
#define EPI_LOOP(body) \
    _Pragma("unroll") for (int ai = 0; ai < 2; ++ai) _Pragma("unroll") for (int m = 0; m < 4; ++m) { const int row = u.pm * 256 + ai * 128 + wr * 64 + m * 16 + fr; \
    _Pragma("unroll") for (int bj = 0; bj < 2; ++bj) _Pragma("unroll") for (int n = 0; n < 2; ++n) { const int ct = bj * 128 + wc * 32 + n * 16 + fq * 4; f32x4 v = acc[ai][bj][m][n]; body } }

struct EpiIn {
    bf16_t* R; const float* rowsq; float* small; int small_tile; int gblkA, gblkB; const float* biasA; const float* biasB;
    DI void operator()(const Acc& acc, const pg8::Unit& u, int wr, int wc, int fr, int fq) const {
        const int blk = u.pn >> 2, cb = (u.pn & 3) * 256;
        if (u.pn == small_tile) {
            EPI_LOOP( if (ct < 64) { const float rs = rsqrtf(rowsq[row] * (1.f / 1024.f) + EPS); *(f32x4*)(small + (size_t)row * 64 + ct) = v * rs; } )
            return;
        }
        bf16_t* dst = R + (size_t)blk * (BLK / 2);
        const float* bias = (blk == gblkA) ? biasA : ((blk == gblkB) ? biasB : nullptr);
        if (bias) {
            EPI_LOOP( const float rs = rsqrtf(rowsq[row] * (1.f / 1024.f) + EPS); const f32x4 bv = *(const f32x4*)(bias + cb + ct); v = v * rs + bv;
                u32x2 w; w.x = pk2(sigmoidf_(v[0]), sigmoidf_(v[1])); w.y = pk2(sigmoidf_(v[2]), sigmoidf_(v[3])); *(u32x2*)(dst + (size_t)row * 1024 + cb + ct) = w; )
        } else {
            EPI_LOOP( const float rs = rsqrtf(rowsq[row] * (1.f / 1024.f) + EPS); v = v * rs;
                u32x2 w; w.x = pk2(v[0], v[1]); w.y = pk2(v[2], v[3]); *(u32x2*)(dst + (size_t)row * 1024 + cb + ct) = w; )
        }
    }
};
struct EpiMix {
    bf16_t* mixb; const bf16_t* gate; const float* ssq; int grp; int first;
    DI void operator()(const Acc& acc, const pg8::Unit& u, int wr, int wc, int fr, int fq) const {
        EPI_LOOP( const int col = u.pn * 256 + ct; const size_t o = (size_t)row * 1024 + col;
            float rs = 1.f; if (ssq) rs = rsqrtf(ssq[(size_t)row * 4 + grp] * (1.f / 512.f) + EPS);
            const u32x2 gw = *(const u32x2*)(gate + o);
            f32x4 r; r[0] = bflo(gw.x) * v[0] * rs; r[1] = bfhi(gw.x) * v[1] * rs; r[2] = bflo(gw.y) * v[2] * rs; r[3] = bfhi(gw.y) * v[3] * rs;
            if (!first) { const u32x2 mw = *(const u32x2*)(mixb + o); r[0] += bflo(mw.x); r[1] += bfhi(mw.x); r[2] += bflo(mw.y); r[3] += bfhi(mw.y); }
            u32x2 w; w.x = pk2(r[0], r[1]); w.y = pk2(r[2], r[3]); *(u32x2*)(mixb + o) = w; )
    }
};
struct EpiRes {
    const float* xold; float* xnew; bf16_t* xb; float* rowsq;
    DI void operator()(const Acc& acc, const pg8::Unit& u, int wr, int wc, int fr, int fq) const {
#pragma unroll
        for (int ai = 0; ai < 2; ++ai)
#pragma unroll
            for (int m = 0; m < 4; ++m) { const int row = u.pm * 256 + ai * 128 + wr * 64 + m * 16 + fr; float ss = 0.f;
#pragma unroll
                for (int bj = 0; bj < 2; ++bj)
#pragma unroll
                    for (int n = 0; n < 2; ++n) { const int col = u.pn * 256 + bj * 128 + wc * 32 + n * 16 + fq * 4; const size_t o = (size_t)row * 1024 + col;
                        f32x4 v = acc[ai][bj][m][n] + *(const f32x4*)(xold + o); *(f32x4*)(xnew + o) = v;
                        u32x2 w; w.x = pk2(v[0], v[1]); w.y = pk2(v[2], v[3]); *(u32x2*)(xb + o) = w;
                        ss += v[0] * v[0] + v[1] * v[1] + v[2] * v[2] + v[3] * v[3]; }
                ss += __shfl_xor(ss, 16); ss += __shfl_xor(ss, 32);
                if (fq == 0) atomicAdd(rowsq + row, ss); }
    }
};
struct EpiUp {
    bf16_t* h; const float* rowsq;
    DI void operator()(const Acc& acc, const pg8::Unit& u, int wr, int wc, int fr, int fq) const {
        EPI_LOOP( const float rs = rsqrtf(rowsq[row] * (1.f / 1024.f) + EPS); v = v * rs;
            f32x4 r; r[0] = fmaxf(v[0], 0.f); r[1] = fmaxf(v[1], 0.f); r[2] = fmaxf(v[2], 0.f); r[3] = fmaxf(v[3], 0.f); r = r * r;
            u32x2 w; w.x = pk2(r[0], r[1]); w.y = pk2(r[2], r[3]); *(u32x2*)(h + (size_t)row * 4096 + u.pn * 256 + ct) = w; )
    }
};

DI int colmap(int kind, int n) {
    if (kind == 1) {
        if (n < 2048) return n;
        if (n < 3072) return 2064 + (n - 2048);
        if (n < 4096) return 11312 + (n - 3072);
        if (n < 5120) return 8240 + (n - 4096);
        if (n < 6144) return 9264 + (n - 5120);
        if (n < 7168) return 10288 + (n - 6144);
        if (n < 8192) return 13360 + (n - 7168);
        const int i = n - 8192; if (i < 16) return 2048 + i; if (i < 48) return 8208 + (i - 16); return -1;
    }
    if (kind == 2) {
        if (n < 2048) return 3088 + n;
        if (n < 5120) return 5136 + (n - 2048);
        return 12336 + (n - 5120);
    }
    return n;
}
DI void tr_item(const float* W, int ldw, int K, bf16_t* WT, const float* kscale, int kind, int kb, int nb, LAS float* scr, int lane) {
    const int k0 = 64 * kb, n0 = 32 * nb; const int sc = colmap(kind, n0 + (lane & 31));
#pragma unroll 8
    for (int i = 0; i < 32; ++i) { const int kk = 2 * i + (lane >> 5); float v = 0.f; if (sc >= 0) { v = W[(size_t)(k0 + kk) * ldw + sc]; if (kscale) v *= kscale[k0 + kk]; } scr[kk * 33 + (lane & 31)] = v; }
    asm volatile("s_waitcnt lgkmcnt(0)" ::: "memory");
    const int c = lane & 7;
#pragma unroll
    for (int j = 0; j < 4; ++j) { const int n = (lane >> 3) + 8 * j; const LAS float* s = scr + (8 * c) * 33 + n;
        u32x4 o; o.x = pk2(s[0 * 33], s[1 * 33]); o.y = pk2(s[2 * 33], s[3 * 33]); o.z = pk2(s[4 * 33], s[5 * 33]); o.w = pk2(s[6 * 33], s[7 * 33]);
        *(u32x4*)(WT + (size_t)(n0 + n) * K + k0 + 8 * c) = o; }
    asm volatile("s_waitcnt lgkmcnt(0)" ::: "memory");
}
DI float wave_sum(float v) {
#pragma unroll
    for (int o = 1; o < 64; o <<= 1) v += __shfl_xor(v, o);
    return v;
}
DI void phase_prep(const Params& p, int l, LAS unsigned char* lds) {
    const int tid = opaque_tid(), lane = tid & 63, wave = __builtin_amdgcn_readfirstlane(tid >> 6);
    const int gw = blockIdx.x * 8 + wave, NGW = gridDim.x * 8;
    LAS float* scr = (LAS float*)(lds + wave * 8704);
    unsigned char* ws = p.ws; bf16_t* wt = (bf16_t*)(ws + WS_WT);
    const float* w_in = p.in[3] + (size_t)l * 1024 * INC;
    constexpr int I0 = 16 * 264, I1 = 16 * 192, I2 = 16 * 32, I3 = 32 * 32, I4 = 16 * 32, I5 = 16 * 32, I6 = 16 * 128, I7 = 64 * 32;
    constexpr int NIT = I0 + I1 + I2 + I3 + I4 + I5 + I6 + I7;
    for (int it = gw; it < NIT; it += NGW) {
        int r = it;
        if (r < I0) { tr_item(w_in, INC, 1024, (bf16_t*)((char*)wt + WT_GD), p.in[2] + l * 1024, 1, r / 264, r % 264, scr, lane); continue; } r -= I0;
        if (r < I1) { tr_item(w_in, INC, 1024, (bf16_t*)((char*)wt + WT_S), p.in[2] + l * 1024, 2, r / 192, r % 192, scr, lane); continue; } r -= I1;
        if (r < I2) { tr_item(p.in[19] + (size_t)l * 1024 * 1024, 1024, 1024, (bf16_t*)((char*)wt + WT_GLA), nullptr, 0, r / 32, r % 32, scr, lane); continue; } r -= I2;
        if (r < I3) { tr_item(p.in[20] + (size_t)l * 2048 * 1024, 1024, 2048, (bf16_t*)((char*)wt + WT_SSM), p.in[13] + l * 2048, 0, r / 32, r % 32, scr, lane); continue; } r -= I3;
        if (r < I4) { tr_item(p.in[21] + (size_t)l * 1024 * 1024, 1024, 1024, (bf16_t*)((char*)wt + WT_DIFF), nullptr, 0, r / 32, r % 32, scr, lane); continue; } r -= I4;
        if (r < I5) { tr_item(p.in[22] + (size_t)l * 1024 * 1024, 1024, 1024, (bf16_t*)((char*)wt + WT_OUT), nullptr, 0, r / 32, r % 32, scr, lane); continue; } r -= I5;
        if (r < I6) { tr_item(p.in[24] + (size_t)l * 1024 * 4096, 4096, 1024, (bf16_t*)((char*)wt + WT_UP), p.in[23] + l * 1024, 0, r / 128, r % 128, scr, lane); continue; } r -= I6;
        tr_item(p.in[25] + (size_t)l * 4096 * 1024, 1024, 4096, (bf16_t*)((char*)wt + WT_DOWN), nullptr, 0, r / 32, r % 32, scr, lane);
    }
    const int gt = blockIdx.x * 512 + tid, NT_ = gridDim.x * 512;
    float* ssq = (float*)(ws + WS_SSQ);
    for (int i = gt; i < T * 4; i += NT_) ssq[i] = 0.f;
    if (l == 0) {
        float* rowsq = (float*)(ws + WS_ROWSQ);
        for (int i = gt; i < 4 * T; i += NT_) rowsq[T + i] = 0.f;
        bf16_t* xb = (bf16_t*)(ws + WS_XB); const float* x = p.in[0];
        for (int m = gw; m < T; m += NGW) {
            const f32x4* xr = (const f32x4*)(x + (size_t)m * 1024) + lane; float s = 0.f;
            u32x2* o = (u32x2*)(xb + (size_t)m * 1024) + lane;
#pragma unroll
            for (int j = 0; j < 4; ++j) { const f32x4 v = xr[64 * j]; s += v[0] * v[0] + v[1] * v[1] + v[2] * v[2] + v[3] * v[3]; u32x2 w; w.x = pk2(v[0], v[1]); w.y = pk2(v[2], v[3]); o[64 * j] = w; }
            s = wave_sum(s); if (lane == 0) rowsq[m] = s;
        }
    }
}

DI void rope_pass(const Params& p) {
    const int* pos = (const int*)p.in[1];
    bf16_t* Qd = (bf16_t*)(p.ws + WS_R + 4 * BLK); bf16_t* Kd = (bf16_t*)(p.ws + WS_R + 5 * BLK);
    const double cf[8] = {0.15915494309189535, 0.03086376340470123, 0.005985185712713705, 0.001160663641240061, 0.00022507907903927653, 4.364795279280289e-05, 8.464330808241401e-06, 1.6414262627950345e-06};
    const int gt = blockIdx.x * 512 + opaque_tid(), NTH = gridDim.x * 512;
    for (int it = gt; it < T * 32; it += NTH) {
        const int t = it >> 5, w = it & 31; bf16_t* base = ((w & 16) ? Kd : Qd) + (size_t)t * 1024 + (w & 15) * 64;
        const double ps = (double)pos[t];
        u32x4 a = *(u32x4*)base, b = *(u32x4*)(base + 8);
        float t1[8], t2[8];
#pragma unroll
        for (int i = 0; i < 4; ++i) { t1[2 * i] = bflo(a[i]); t1[2 * i + 1] = bfhi(a[i]); t2[2 * i] = bflo(b[i]); t2[2 * i + 1] = bfhi(b[i]); }
        float o1[8], o2[8];
#pragma unroll
        for (int i = 0; i < 8; ++i) { double rv = ps * cf[i]; rv -= floor(rv); const float fr = (float)rv; const float sn = __builtin_amdgcn_sinf(fr), cs = __builtin_amdgcn_cosf(fr);
            o1[i] = t1[i] * cs - t2[i] * sn; o2[i] = t2[i] * cs + t1[i] * sn; }
#pragma unroll
        for (int i = 0; i < 4; ++i) { a[i] = pk2(o1[2 * i], o1[2 * i + 1]); b[i] = pk2(o2[2 * i], o2[2 * i + 1]); }
        *(u32x4*)base = a; *(u32x4*)(base + 8) = b;
    }
}

template <int KS> DI f32x4 mm16(f32x4 acc, const LAS unsigned char* A, int lda_b, const LAS unsigned char* B, int ldb_b, int lane) {
    const int r = lane & 15, q = lane >> 4;
    const LAS unsigned char* ap = A + r * lda_b + q * 16; const LAS unsigned char* bp = B + r * ldb_b + q * 16;
#pragma unroll
    for (int s = 0; s < KS; ++s) acc = mfma16(*(const LAS bf16x8*)(ap + s * 64), *(const LAS bf16x8*)(bp + s * 64), acc);
    return acc;
}
DI float logsigmoidf_(float x) { return fminf(x, 0.f) - log1pf(__expf(-fabsf(x))); }

constexpr int G_GKL = 0, G_QTOT = 4096, G_BLAST = 6144, G_PART = 6656, G_QT = 8704, G_KT = 26112, G_KHT = 43520, G_VT = 61952, G_P = 98816;
template <int MODE> DI void gla_unit(const Params& p, int l, int un, LAS unsigned char* lds) {
    const int tid = opaque_tid(), lane = tid & 63, w = __builtin_amdgcn_readfirstlane(tid >> 6), r16 = lane & 15, quad = lane >> 4;
    const int sc = un >> 2, h = un & 3, tok0 = sc * 256;
    unsigned char* ws = p.ws;
    const bf16_t* QK = (const bf16_t*)(ws + WS_R); const bf16_t* Vg = (const bf16_t*)(ws + WS_R + BLK); bf16_t* Gg = (bf16_t*)(ws + WS_R + 2 * BLK);
    const float* small = (const float*)(ws + WS_SMALL);
    float* states = (float*)(ws + WS_STG) + (size_t)un * 32768;
    const int d = tid & 127, qr = tid >> 7;
    float wk[16];
#pragma unroll
    for (int r = 0; r < 16; ++r) wk[r] = p.in[5][(size_t)l * 16 * 512 + r * 512 + h * 128 + d];
    const float bk = p.in[6][l * 512 + h * 128 + d];
    f32x4 S[8][2];
    if (MODE == 3) {
#pragma unroll
        for (int mb = 0; mb < 8; ++mb)
#pragma unroll
            for (int nb = 0; nb < 2; ++nb) S[mb][nb] = *(const f32x4*)(states + ((size_t)(w * 16 + mb * 2 + nb) * 64 + lane) * 4);
    } else {
#pragma unroll
        for (int mb = 0; mb < 8; ++mb)
#pragma unroll
            for (int nb = 0; nb < 2; ++nb) S[mb][nb] = (f32x4){0.f, 0.f, 0.f, 0.f};
    }
    float ng[2] = {0.f, 0.f};
    if (MODE == 3) { ng[0] = p.in[7][l * 256 + 32 * w + r16]; ng[1] = p.in[7][l * 256 + 32 * w + 16 + r16]; }
    float dtot = 1.f;
    for (int j = 0; j < 4; ++j) {
        const int t0 = tok0 + 64 * j;
        if (tid < 256) { const int row = tid >> 2, c4 = (tid & 3) * 4; *(LAS f32x4*)(lds + G_GKL + (row * 16 + c4) * 4) = *(const f32x4*)(small + (size_t)(t0 + row) * 64 + c4); }
        if (tid < 64) ((LAS float*)(lds + G_PART))[tid] = 0.f;
        __syncthreads();
        float c[16]; float run = 0.f;
#pragma unroll
        for (int i = 0; i < 16; ++i) { const LAS float* gr = (const LAS float*)(lds + G_GKL) + (qr * 16 + i) * 16; float x = bk;
#pragma unroll
            for (int r = 0; r < 16; ++r) x += gr[r] * wk[r];
            run += logsigmoidf_(x) * (1.f / 16.f); c[i] = run; }
        ((LAS float*)(lds + G_QTOT))[qr * 128 + d] = run;
        __syncthreads();
        {
            float off = 0.f, bl = 0.f;
#pragma unroll
            for (int q2 = 0; q2 < 4; ++q2) { const float v = ((const LAS float*)(lds + G_QTOT))[q2 * 128 + d]; bl += v; if (q2 < qr) off += v; }
            unsigned khp[8];
#pragma unroll
            for (int i = 0; i < 16; i += 2) {
                float kh2[2];
#pragma unroll
                for (int e = 0; e < 2; ++e) { const int t = qr * 16 + i + e; const float b = off + c[i + e];
                    const float k = bf2f(QK[(size_t)(t0 + t) * 1024 + 512 + h * 128 + d]);
                    kh2[e] = k * __expf(bl - b);
                    if (MODE == 3) { const float q = bf2f(QK[(size_t)(t0 + t) * 1024 + h * 128 + d]);
                        ((LAS bf16_t*)(lds + G_QT))[t * 136 + d] = f2bf(q * 0.08838834764831845f * __expf(b));
                        ((LAS bf16_t*)(lds + G_KT))[t * 136 + d] = f2bf(k * __expf(-b)); } }
                khp[i >> 1] = pk2(kh2[0], kh2[1]);
            }
            *(LAS u32x4*)(lds + G_KHT + d * 144 + qr * 32) = (u32x4){khp[0], khp[1], khp[2], khp[3]};
            *(LAS u32x4*)(lds + G_KHT + d * 144 + qr * 32 + 16) = (u32x4){khp[4], khp[5], khp[6], khp[7]};
            if (qr == 0) { ((LAS float*)(lds + G_BLAST))[d] = bl; dtot *= __expf(bl); }
#pragma unroll
            for (int i = 0; i < 4; ++i) { const int pid = tid + 512 * i, g8 = pid >> 6, t = pid & 63;
                const u32x4 v = *(const u32x4*)(Vg + (size_t)(t0 + t) * 1024 + h * 256 + g8 * 8);
                LAS bf16_t* vt = (LAS bf16_t*)(lds + G_VT) + (g8 * 8) * 72 + t;
#pragma unroll
                for (int e = 0; e < 4; ++e) { vt[(2 * e) * 72] = (bf16_t)(v[e] & 0xffffu); vt[(2 * e + 1) * 72] = (bf16_t)(v[e] >> 16); } }
        }
        __syncthreads();
        if (MODE == 3) {
#pragma unroll
            for (int e = 0; e < 2; ++e) { const int x = 2 * w + e, tb = x >> 2, sb = x & 3;
                f32x4 a = (f32x4){0.f, 0.f, 0.f, 0.f};
                if (sb <= tb) a = mm16<4>(a, lds + G_KT + sb * 16 * 272, 272, lds + G_QT + tb * 16 * 272, 272, lane);
                const int t = 16 * tb + r16, s0 = 16 * sb + quad * 4;
                float v[4];
#pragma unroll
                for (int jj = 0; jj < 4; ++jj) v[jj] = (s0 + jj <= t) ? a[jj] : 0.f;
                if (x == 0 && lane == 0 && j == 0 && (tok0 & (SEQ - 1)) == 0) { const float* qk_ = (l == 0) ? (const float*)(ws + SB_PROJ) + (tok0 >> 13) * 14384 : (const float*)(ws + SB_QK1) + (tok0 >> 13) * 1024;
                    float acc_ = 0.f; for (int d_ = 0; d_ < 128; ++d_) acc_ += qk_[h * 128 + d_] * qk_[512 + h * 128 + d_]; v[0] = acc_ * 0.08838834764831845f; }
                *(LAS u32x2*)(lds + G_P + t * 144 + s0 * 2) = (u32x2){pk2(v[0], v[1]), pk2(v[2], v[3])}; }
            f32x4 o[4][2];
#pragma unroll
            for (int mb = 0; mb < 4; ++mb) { o[mb][0] = (f32x4){0.f, 0.f, 0.f, 0.f}; o[mb][1] = (f32x4){0.f, 0.f, 0.f, 0.f}; }
#pragma unroll
            for (int ks = 0; ks < 4; ++ks) {
                bf16x8 bf[2];
#pragma unroll
                for (int nb = 0; nb < 2; ++nb) { const f32x4 s0v = S[2 * ks][nb], s1v = S[2 * ks + 1][nb];
                    u32x4 pk; pk.x = pk2(s0v[0], s0v[1]); pk.y = pk2(s0v[2], s0v[3]); pk.z = pk2(s1v[0], s1v[1]); pk.w = pk2(s1v[2], s1v[3]); bf[nb] = __builtin_bit_cast(bf16x8, pk); }
#pragma unroll
                for (int mb = 0; mb < 4; ++mb) { const LAS unsigned char* ap = lds + G_QT + (16 * mb + r16) * 272 + (32 * ks + quad * 4) * 2;
                    const u32x2 lo = *(const LAS u32x2*)ap, hi = *(const LAS u32x2*)(ap + 32);
                    const bf16x8 af = __builtin_bit_cast(bf16x8, (u32x4){lo.x, lo.y, hi.x, hi.y});
                    o[mb][0] = mfma16(af, bf[0], o[mb][0]); o[mb][1] = mfma16(af, bf[1], o[mb][1]); }
            }
            __syncthreads();
#pragma unroll
            for (int mb = 0; mb < 4; ++mb)
#pragma unroll
                for (int nb = 0; nb < 2; ++nb) o[mb][nb] = mm16<2>(o[mb][nb], lds + G_P + mb * 16 * 144, 144, lds + G_VT + (32 * w + 16 * nb) * 144, 144, lane);
#pragma unroll
            for (int mb = 0; mb < 4; ++mb)
#pragma unroll
                for (int jj = 0; jj < 4; ++jj) { float ss = o[mb][0][jj] * o[mb][0][jj] + o[mb][1][jj] * o[mb][1][jj];
                    ss += __shfl_xor(ss, 1); ss += __shfl_xor(ss, 2); ss += __shfl_xor(ss, 4); ss += __shfl_xor(ss, 8);
                    if (r16 == 0) __hip_atomic_fetch_add((LAS float*)(lds + G_PART) + 16 * mb + quad * 4 + jj, ss, __ATOMIC_RELAXED, __HIP_MEMORY_SCOPE_WORKGROUP); }
            __syncthreads();
#pragma unroll
            for (int mb = 0; mb < 4; ++mb)
#pragma unroll
                for (int jj = 0; jj < 4; ++jj) { const int t = 16 * mb + quad * 4 + jj; const float rs = rsqrtf(((const LAS float*)(lds + G_PART))[t] * (1.f / 256.f) + EPS);
#pragma unroll
                    for (int nb = 0; nb < 2; ++nb) { bf16_t* gp = Gg + (size_t)(t0 + t) * 1024 + h * 256 + 32 * w + 16 * nb + r16;
                        const float gv = bf2f(*gp); *gp = f2bf(o[mb][nb][jj] * rs * ng[nb] * siluf_(gv)); } }
        }
#pragma unroll
        for (int mb = 0; mb < 8; ++mb) { const f32x4 bl4 = *(const LAS f32x4*)(lds + G_BLAST + (16 * mb + quad * 4) * 4);
            const f32x4 dc = (f32x4){__expf(bl4[0]), __expf(bl4[1]), __expf(bl4[2]), __expf(bl4[3])};
#pragma unroll
            for (int nb = 0; nb < 2; ++nb) { S[mb][nb] = S[mb][nb] * dc;
                S[mb][nb] = mm16<2>(S[mb][nb], lds + G_KHT + mb * 16 * 144, 144, lds + G_VT + (32 * w + 16 * nb) * 144, 144, lane); } }
        __syncthreads();
    }
    if (MODE == 1) {
#pragma unroll
        for (int mb = 0; mb < 8; ++mb)
#pragma unroll
            for (int nb = 0; nb < 2; ++nb) *(f32x4*)(states + ((size_t)(w * 16 + mb * 2 + nb) * 64 + lane) * 4) = S[mb][nb];
        if (tid < 128) ((float*)(ws + WS_DECG))[un * 128 + tid] = dtot;
    }
}
DI void gla_scan(const Params& p) {
    const int gid = blockIdx.x * 512 + opaque_tid();
    for (int it = gid; it < 65536; it += gridDim.x * 512) {
        const int chain = it >> 13, e = it & 8191, b = chain >> 2, h = chain & 3;
        const int tile = (e >> 6) & 15, lane = e & 63, d0 = 16 * (tile >> 1) + (lane >> 4) * 4;
        f32x4* st = (f32x4*)(p.ws + WS_STG); const float* dec = (const float*)(p.ws + WS_DECG);
        f32x4 u[32];
#pragma unroll
        for (int s = 0; s < 32; ++s) u[s] = st[(size_t)((b * 32 + s) * 4 + h) * 8192 + e];
        f32x4 run = (f32x4){0.f, 0.f, 0.f, 0.f};
#pragma unroll
        for (int s = 0; s < 32; ++s) { const int un = (b * 32 + s) * 4 + h; const f32x4 dc = *(const f32x4*)(dec + un * 128 + d0);
            st[(size_t)un * 8192 + e] = run; run = run * dc + u[s]; }
    }
}

constexpr int S_ACUM = 0, S_DTV = 256, S_MISC = 512, S_XDT = 1024, S_XD2 = 10240, S_BN = 19456, S_BT = 36864, S_CN = 55296, S_GL = 72704, S_SB = 81920;
DI float softplusf_(float x) { return x > 20.f ? x : log1pf(__expf(x)); }
template <int MODE> DI void ssd_unit(const Params& p, int l, int un, LAS unsigned char* lds) {
    const int tid = opaque_tid(), lane = tid & 63, w = __builtin_amdgcn_readfirstlane(tid >> 6), r16 = lane & 15, quad = lane >> 4;
    const int sc = un >> 5, head = un & 31, g = head >> 3, tok0 = sc * 256;
    unsigned char* ws = p.ws;
    bf16_t* Zb = (bf16_t*)(ws + WS_R + (size_t)(head >> 4) * BLK) + (head & 15) * 64;
    const bf16_t* Xb = (const bf16_t*)(ws + WS_R + (size_t)(2 + (head >> 4)) * BLK) + (head & 15) * 64;
    const bf16_t* BCb = (const bf16_t*)(ws + WS_R + 4 * BLK);
    const float* small = (const float*)(ws + WS_SMALL);
    float* ssq = (float*)(ws + WS_SSQ);
    float* states = (float*)(ws + WS_STS) + (size_t)un * 8192;
    const float* cw = p.in[8] + (size_t)l * 4 * 3072; const float* cbias = p.in[9] + l * 3072;
    const float dtb = p.in[10][l * 32 + head], aneg = -__expf(p.in[11][l * 32 + head]), Dh = p.in[12][l * 32 + head];
    f32x4 st[4];
    if (MODE == 3) {
#pragma unroll
        for (int pb = 0; pb < 4; ++pb) { st[pb] = *(const f32x4*)(states + ((size_t)(w * 4 + pb) * 64 + lane) * 4);
            *(LAS u32x2*)(lds + S_SB + (16 * pb + r16) * 272 + (16 * w + quad * 4) * 2) = (u32x2){pk2(st[pb][0], st[pb][1]), pk2(st[pb][2], st[pb][3])}; }
    } else {
#pragma unroll
        for (int pb = 0; pb < 4; ++pb) st[pb] = (f32x4){0.f, 0.f, 0.f, 0.f};
    }
    const int px = tid & 63, tq = tid >> 6;
    const int nn = tid & 127, tq2 = tid >> 7;
    float wx[4], wb[4], wcc[4];
#pragma unroll
    for (int i = 0; i < 4; ++i) { wx[i] = cw[i * 3072 + head * 64 + px]; wb[i] = cw[i * 3072 + 2048 + g * 128 + nn]; wcc[i] = cw[i * 3072 + 2560 + g * 128 + nn]; }
    const float bx = cbias[head * 64 + px], bb = cbias[2048 + g * 128 + nn], bc = cbias[2560 + g * 128 + nn];
    float atot = 0.f;
    for (int j = 0; j < 4; ++j) {
        const int t0 = tok0 + 64 * j, s0 = t0 & (SEQ - 1);
        if (w == 0) {
            const float dt = softplusf_(small[(size_t)(t0 + lane) * 64 + 16 + head] + dtb);
            float cs = dt * aneg;
#pragma unroll
            for (int o = 1; o < 64; o <<= 1) { const float v = __shfl_up(cs, o); if (lane >= o) cs += v; }
            ((LAS float*)(lds + S_ACUM))[lane] = cs; ((LAS float*)(lds + S_DTV))[lane] = dt;
            if (lane == 63) ((LAS float*)(lds + S_MISC))[0] = cs;
        }
        __syncthreads();
        const float alast = ((const LAS float*)(lds + S_MISC))[0];
        atot += alast;
        {
            float xv[11];
#pragma unroll
            for (int k = 0; k < 11; ++k) { const int tt = tq * 8 - 3 + k; xv[k] = (s0 + tt >= 0) ? bf2f(Xb[(size_t)(t0 + tt) * 1024 + px]) : 0.f; }
            unsigned a1[4], a2[4]; float e1[2], e2[2];
#pragma unroll
            for (int i = 0; i < 8; ++i) { const int t = tq * 8 + i;
                const float cv = bx + xv[i] * wx[0] + xv[i + 1] * wx[1] + xv[i + 2] * wx[2] + xv[i + 3] * wx[3];
                const float xd = siluf_(cv) * ((const LAS float*)(lds + S_DTV))[t];
                e1[i & 1] = xd; e2[i & 1] = xd * __expf(alast - ((const LAS float*)(lds + S_ACUM))[t]);
                if (i & 1) { a1[i >> 1] = pk2(e1[0], e1[1]); a2[i >> 1] = pk2(e2[0], e2[1]); } }
            *(LAS u32x4*)(lds + S_XDT + px * 144 + tq * 16) = (u32x4){a1[0], a1[1], a1[2], a1[3]};
            *(LAS u32x4*)(lds + S_XD2 + px * 144 + tq * 16) = (u32x4){a2[0], a2[1], a2[2], a2[3]};
        }
        {
            float bv[19];
#pragma unroll
            for (int k = 0; k < 19; ++k) { const int tt = tq2 * 16 - 3 + k; bv[k] = (s0 + tt >= 0) ? bf2f(BCb[(size_t)(t0 + tt) * 1024 + g * 128 + nn]) : 0.f; }
            unsigned bp[8]; float e1[2];
#pragma unroll
            for (int i = 0; i < 16; ++i) { const float cv = bb + bv[i] * wb[0] + bv[i + 1] * wb[1] + bv[i + 2] * wb[2] + bv[i + 3] * wb[3]; const float sv = siluf_(cv);
                if (MODE == 3) ((LAS bf16_t*)(lds + S_BN))[(tq2 * 16 + i) * 136 + nn] = f2bf(sv);
                e1[i & 1] = sv; if (i & 1) bp[i >> 1] = pk2(e1[0], e1[1]); }
            *(LAS u32x4*)(lds + S_BT + nn * 144 + tq2 * 32) = (u32x4){bp[0], bp[1], bp[2], bp[3]};
            *(LAS u32x4*)(lds + S_BT + nn * 144 + tq2 * 32 + 16) = (u32x4){bp[4], bp[5], bp[6], bp[7]};
            if (MODE == 3) {
#pragma unroll
                for (int k = 0; k < 19; ++k) { const int tt = tq2 * 16 - 3 + k; bv[k] = (s0 + tt >= 0) ? bf2f(BCb[(size_t)(t0 + tt) * 1024 + 512 + g * 128 + nn]) : 0.f; }
#pragma unroll
                for (int i = 0; i < 16; ++i) { const float cv = bc + bv[i] * wcc[0] + bv[i + 1] * wcc[1] + bv[i + 2] * wcc[2] + bv[i + 3] * wcc[3];
                    ((LAS bf16_t*)(lds + S_CN))[(tq2 * 16 + i) * 136 + nn] = f2bf(siluf_(cv)); }
            }
        }
        __syncthreads();
        if (MODE == 3) {
            f32x4 y[2];
#pragma unroll
            for (int e = 0; e < 2; ++e) { const int x = 2 * w + e, tb = x >> 2, sb = x & 3;
                f32x4 a = (f32x4){0.f, 0.f, 0.f, 0.f};
                if (sb <= tb) a = mm16<4>(a, lds + S_BN + sb * 16 * 272, 272, lds + S_CN + tb * 16 * 272, 272, lane);
                const int t = 16 * tb + r16, sb0 = 16 * sb + quad * 4;
                const float act = ((const LAS float*)(lds + S_ACUM))[t], dtt = ((const LAS float*)(lds + S_DTV))[t];
                float v[4];
#pragma unroll
                for (int jj = 0; jj < 4; ++jj) { const int s = sb0 + jj; float val = 0.f;
                    if (s <= t) val = a[jj] * __expf(act - ((const LAS float*)(lds + S_ACUM))[s]);
                    if (s == t) val += Dh / dtt;
                    v[jj] = val; }
                *(LAS u32x2*)(lds + S_GL + t * 144 + sb0 * 2) = (u32x2){pk2(v[0], v[1]), pk2(v[2], v[3])};
                const int pb = sb;
                y[e] = mm16<4>((f32x4){0.f, 0.f, 0.f, 0.f}, lds + S_SB + pb * 16 * 272, 272, lds + S_CN + tb * 16 * 272, 272, lane);
                y[e] = y[e] * __expf(act);
            }
            __syncthreads();
#pragma unroll
            for (int e = 0; e < 2; ++e) { const int x = 2 * w + e, tb = x >> 2, pb = x & 3;
                y[e] = mm16<2>(y[e], lds + S_XDT + pb * 16 * 144, 144, lds + S_GL + tb * 16 * 144, 144, lane);
                const int t = 16 * tb + r16; bf16_t* zp = Zb + (size_t)(t0 + t) * 1024 + 16 * pb + quad * 4;
                const u32x2 zw = *(const u32x2*)zp;
                f32x4 r; r[0] = y[e][0] * siluf_(bflo(zw.x)); r[1] = y[e][1] * siluf_(bfhi(zw.x)); r[2] = y[e][2] * siluf_(bflo(zw.y)); r[3] = y[e][3] * siluf_(bfhi(zw.y));
                float ss = r[0] * r[0] + r[1] * r[1] + r[2] * r[2] + r[3] * r[3];
                ss += __shfl_xor(ss, 16); ss += __shfl_xor(ss, 32);
                if (quad == 0) atomicAdd(ssq + (size_t)(t0 + t) * 4 + g, ss);
                *(u32x2*)zp = (u32x2){pk2(r[0], r[1]), pk2(r[2], r[3])}; }
        }
        {
            const float da = __expf(alast);
#pragma unroll
            for (int pb = 0; pb < 4; ++pb) { st[pb] = st[pb] * da;
                st[pb] = mm16<2>(st[pb], lds + S_BT + w * 16 * 144, 144, lds + S_XD2 + pb * 16 * 144, 144, lane);
                if (MODE == 3) *(LAS u32x2*)(lds + S_SB + (16 * pb + r16) * 272 + (16 * w + quad * 4) * 2) = (u32x2){pk2(st[pb][0], st[pb][1]), pk2(st[pb][2], st[pb][3])}; }
        }
        __syncthreads();
    }
    if (MODE == 1) {
#pragma unroll
        for (int pb = 0; pb < 4; ++pb) *(f32x4*)(states + ((size_t)(w * 4 + pb) * 64 + lane) * 4) = st[pb];
        if (tid == 0) ((float*)(ws + WS_DECS))[un] = __expf(atot);
    }
}
DI void ssd_scan(const Params& p) {
    const int gid = blockIdx.x * 512 + opaque_tid();
    for (int it = gid; it < 131072; it += gridDim.x * 512) {
        const int chain = it >> 11, e = it & 2047, b = chain >> 5, head = chain & 31;
        f32x4* st = (f32x4*)(p.ws + WS_STS); const float* dec = (const float*)(p.ws + WS_DECS);
        f32x4 u[32];
#pragma unroll
        for (int s = 0; s < 32; ++s) u[s] = st[(size_t)((b * 32 + s) * 32 + head) * 2048 + e];
        f32x4 run = (f32x4){0.f, 0.f, 0.f, 0.f};
#pragma unroll
        for (int s = 0; s < 32; ++s) { const int un = (b * 32 + s) * 32 + head; const float dc = dec[un];
            st[(size_t)un * 2048 + e] = run; run = run * dc + u[s]; }
    }
}

typedef short v4i16_t __attribute__((ext_vector_type(4)));
DI s16x4 vtr(const LAS unsigned char* p) { return __builtin_bit_cast(s16x4, __builtin_amdgcn_ds_read_tr16_b64_v4i16((LAS v4i16_t*)p)); }
constexpr int A_K = 0, A_V = 34816, A_X = 0, A_Y = 65536, A_NG = 100352;
DI void attn_unit(const Params& p, int b, int h, int qb, float lam, float oscale, LAS unsigned char* lds) {
    const int tid = opaque_tid(), lane = tid & 63, w = __builtin_amdgcn_readfirstlane(tid >> 6), rg = w & 3, sub = w >> 2, q = lane & 31, hh = lane >> 5;
    bf16_t* Qd = (bf16_t*)(p.ws + WS_R + 4 * BLK); const bf16_t* Kd = (const bf16_t*)(p.ws + WS_R + 5 * BLK); const bf16_t* Vd = (const bf16_t*)(p.ws + WS_R + 6 * BLK);
    const int tok0 = b * SEQ + qb * 128;
    bf16x8 qf[4];
    { const bf16_t* qp = Qd + (size_t)(tok0 + rg * 32 + q) * 1024 + h * 128 + sub * 64 + hh * 8;
#pragma unroll
      for (int ks = 0; ks < 4; ++ks) qf[ks] = *(const bf16x8*)(qp + ks * 16); }
    const int NT = 2 * qb + 2;
    u32x4 kr[2], vr[2];
    const int prow = tid >> 4, pc16 = tid & 15;
#define ATT_LOAD(t) do { _Pragma("unroll") for (int i_ = 0; i_ < 2; ++i_) { const size_t off_ = (size_t)(b * SEQ + (t) * 64 + prow + 32 * i_) * 1024 + h * 128 + pc16 * 8; \
        kr[i_] = *(const u32x4*)(Kd + off_); vr[i_] = *(const u32x4*)(Vd + off_); } } while (0)
#define ATT_STORE(buf) do { _Pragma("unroll") for (int i_ = 0; i_ < 2; ++i_) { const int o_ = (buf) * 17408 + (prow + 32 * i_) * 272 + pc16 * 16; \
        *(LAS u32x4*)(lds + A_K + o_) = kr[i_]; *(LAS u32x4*)(lds + A_V + o_) = vr[i_]; } } while (0)
    f32x16 o[4];
#pragma unroll
    for (int db = 0; db < 4; ++db)
#pragma unroll
        for (int i = 0; i < 16; ++i) o[db][i] = 0.f;
    float m_run = -1e30f, l_run = 0.f;
    const float C2 = 0.18033688011112042f;
    ATT_LOAD(0); ATT_STORE(0); ATT_LOAD(1);
    __syncthreads();
    const int i16 = lane & 15, blk = (lane >> 4) & 1;
    for (int t = 0; t < NT; ++t) {
        if (t + 1 < NT) ATT_STORE((t + 1) & 1);
        if (t + 2 < NT) ATT_LOAD(t + 2);
        if (t <= 2 * qb + (rg >> 1)) {
            const LAS unsigned char* Kb = lds + A_K + (t & 1) * 17408; const LAS unsigned char* Vb = lds + A_V + (t & 1) * 17408;
            f32x16 s0, s1;
#pragma unroll
            for (int i = 0; i < 16; ++i) { s0[i] = 0.f; s1[i] = 0.f; }
#pragma unroll
            for (int ks = 0; ks < 4; ++ks) { const LAS unsigned char* kp = Kb + q * 272 + (sub * 64 + ks * 16 + hh * 8) * 2;
                s0 = mfma32(*(const LAS bf16x8*)kp, qf[ks], s0); s1 = mfma32(*(const LAS bf16x8*)(kp + 32 * 272), qf[ks], s1); }
            float mx = fmaxf(s0[0], s1[0]);
#pragma unroll
            for (int i = 1; i < 16; ++i) mx = fmaxf(mx, fmaxf(s0[i], s1[i]));
            mx = fmaxf(mx, __shfl_xor(mx, 32));
            const float m_new = fmaxf(m_run, mx), alpha = __builtin_amdgcn_exp2f((m_run - m_new) * C2), negm = -m_new * C2;
            float sum = 0.f;
#pragma unroll
            for (int i = 0; i < 16; ++i) { s0[i] = __builtin_amdgcn_exp2f(fmaf(s0[i], C2, negm)); s1[i] = __builtin_amdgcn_exp2f(fmaf(s1[i], C2, negm)); sum += s0[i] + s1[i]; }
            l_run = l_run * alpha + sum; m_run = m_new;
#pragma unroll
            for (int db = 0; db < 4; ++db)
#pragma unroll
                for (int i = 0; i < 16; ++i) o[db][i] *= alpha;
            bf16x8 pf[2][2];
#pragma unroll
            for (int s = 0; s < 2; ++s) {
                pf[0][s] = __builtin_bit_cast(bf16x8, (u32x4){pk2(s0[8 * s], s0[8 * s + 1]), pk2(s0[8 * s + 2], s0[8 * s + 3]), pk2(s0[8 * s + 4], s0[8 * s + 5]), pk2(s0[8 * s + 6], s0[8 * s + 7])});
                pf[1][s] = __builtin_bit_cast(bf16x8, (u32x4){pk2(s1[8 * s], s1[8 * s + 1]), pk2(s1[8 * s + 2], s1[8 * s + 3]), pk2(s1[8 * s + 4], s1[8 * s + 5]), pk2(s1[8 * s + 6], s1[8 * s + 7])}); }
#pragma unroll
            for (int kb = 0; kb < 2; ++kb)
#pragma unroll
                for (int s = 0; s < 2; ++s) { const LAS unsigned char* vp = Vb + (32 * kb + 16 * s + 4 * hh + (i16 >> 2)) * 272 + blk * 32 + (i16 & 3) * 8;
#pragma unroll
                    for (int db = 0; db < 4; ++db) { const s16x4 lo = vtr(vp + db * 64), hi = vtr(vp + db * 64 + 8 * 272);
                        const bf16x8 vf = (bf16x8){lo[0], lo[1], lo[2], lo[3], hi[0], hi[1], hi[2], hi[3]};
                        o[db] = mfma32(vf, pf[kb][s], o[db]); } }
        }
        __syncthreads();
    }
#undef ATT_LOAD
#undef ATT_STORE
    const float l_tot = l_run + __shfl_xor(l_run, 32);
    LAS float* X = (LAS float*)(lds + A_X) + rg * 4096;
    if (sub == 1) { const float inv = lam / l_tot;
#pragma unroll
        for (int db = 0; db < 4; ++db)
#pragma unroll
            for (int i = 0; i < 16; ++i) X[(db * 16 + i) * 64 + lane] = o[db][i] * inv; }
    __syncthreads();
    if (sub == 0) { const float inv = 1.f / l_tot; float ss = 0.f;
#pragma unroll
        for (int db = 0; db < 4; ++db)
#pragma unroll
            for (int i = 0; i < 16; ++i) { const float v = o[db][i] * inv - X[(db * 16 + i) * 64 + lane]; o[db][i] = v; ss += v * v; }
        ss += __shfl_xor(ss, 32);
        const float rs = rsqrtf(ss * (1.f / 128.f) + 1e-5f) * oscale;
        LAS bf16_t* Y = (LAS bf16_t*)(lds + A_Y) + rg * (32 * 136);
        const LAS float* ngl = (const LAS float*)(lds + A_NG);
#pragma unroll
        for (int db = 0; db < 4; ++db)
#pragma unroll
            for (int i = 0; i < 16; ++i) { const int dv = 32 * db + crow(i, hh); Y[q * 136 + dv] = f2bf(o[db][i] * rs * ngl[dv]); }
        asm volatile("s_waitcnt lgkmcnt(0)" ::: "memory");
#pragma unroll
        for (int k = 0; k < 8; ++k) { const int piece = lane + 64 * k, row = piece >> 4, c16 = piece & 15;
            const u32x4 v = *(const LAS u32x4*)((const LAS unsigned char*)Y + row * 272 + c16 * 16);
            *(u32x4*)(Qd + (size_t)(tok0 + rg * 32 + row) * 1024 + h * 128 + c16 * 8) = v; }
    }
    __syncthreads();
}
DI void attn_phase(const Params& p, int l, LAS unsigned char* lds) {
    const int tid = opaque_tid();
    float d1 = 0.f, d2 = 0.f;
    for (int i = 0; i < 64; ++i) { d1 += p.in[14][l * 64 + i] * p.in[15][l * 64 + i]; d2 += p.in[16][l * 64 + i] * p.in[17][l * 64 + i]; }
    const float lambda_init = (l == 0) ? 0.2f : 0.35550906759096934f;
    const float lam = expf(d1) - expf(d2) + lambda_init;
    if (tid < 128) ((LAS float*)(lds + A_NG))[tid] = p.in[18][l * 128 + tid];
    __syncthreads();
    for (int i = 0; i < 4; ++i)
        for (int vc = blockIdx.x; vc < 256; vc += gridDim.x) {
            const int bh = vc >> 4, s = vc & 15; const int qb = (i == 0) ? s : (i == 1) ? 31 - s : (i == 2) ? 32 + s : 63 - s;
            attn_unit(p, bh >> 3, bh & 7, qb, lam, 1.f - lambda_init, lds);
        }
}

DI void final_norm(const Params& p) {
    const float* rowsq = (const float*)(p.ws + WS_ROWSQ) + 4 * T; const float* g = p.in[26];
    const int gt = blockIdx.x * 512 + opaque_tid();
    for (int i = gt; i < T * 256; i += gridDim.x * 512) { const int row = i >> 8, c = (i & 255) * 4;
        const float rs = rsqrtf(rowsq[row] * (1.f / 1024.f) + EPS);
        f32x4 v = *(f32x4*)(p.out + (size_t)row * 1024 + c); const f32x4 gv = *(const f32x4*)(g + c);
        *(f32x4*)(p.out + (size_t)row * 1024 + c) = v * rs * gv; }
}


DI void gemv2(float* out, int ldo, const float* in, int ldi, const float* W, int ldw, int K, int N, int kchunk) {
    const int tid = opaque_tid(), lane = tid & 63, wave = __builtin_amdgcn_readfirstlane(tid >> 6);
    const int gw = blockIdx.x * 8 + wave, NGW = gridDim.x * 8, nstrip = (N + 63) / 64, nk = K / kchunk;
    for (int job = gw; job < nstrip * nk; job += NGW) {
        const int strip = job % nstrip, kq = job / nstrip, col = strip * 64 + lane; const bool ok = col < N;
        const float* wp = W + (size_t)(kq * kchunk) * ldw + (ok ? col : 0);
        const float* i0 = in + kq * kchunk; const float* i1 = in + ldi + kq * kchunk;
        float a0 = 0.f, a1 = 0.f;
#pragma unroll 8
        for (int k = 0; k < kchunk; ++k) { const float wv = wp[(size_t)k * ldw]; a0 += i0[k] * wv; a1 += i1[k] * wv; }
        if (ok) { atomicAdd(out + col, a0); atomicAdd(out + ldo + col, a1); }
    }
}
DI void side_init(const Params& p) {
    const int tid = opaque_tid(), lane = tid & 63, wave = __builtin_amdgcn_readfirstlane(tid >> 6);
    const int gt = blockIdx.x * 512 + tid, NTH = gridDim.x * 512, gw = blockIdx.x * 8 + wave, NGW = gridDim.x * 8;
    float* z = (float*)(p.ws + SB_PROJ);
    for (int i = gt; i < (int)((SB_END - SB_PROJ) / 4); i += NTH) z[i] = 0.f;
    float* hn = (float*)(p.ws + SB_HN);
    for (int r = gw; r < 128; r += NGW) { const int row = (r >> 6) * SEQ + (r & 63);
        const f32x4* xr = (const f32x4*)(p.in[0] + (size_t)row * 1024) + lane; f32x4 v[4]; float s2 = 0.f;
#pragma unroll
        for (int j = 0; j < 4; ++j) { v[j] = xr[64 * j]; s2 += v[j][0] * v[j][0] + v[j][1] * v[j][1] + v[j][2] * v[j][2] + v[j][3] * v[j][3]; }
        const float rs = rsqrtf(wave_sum(s2) * (1.f / 1024.f) + EPS);
#pragma unroll
        for (int j = 0; j < 4; ++j) { const f32x4 g = *((const f32x4*)p.in[2] + lane + 64 * j); *((f32x4*)(hn + (size_t)r * 1024) + lane + 64 * j) = v[j] * rs * g; } }
}
DI void side_kv(const Params& p) {
    const int tid = opaque_tid(), lane = tid & 63, wave = __builtin_amdgcn_readfirstlane(tid >> 6);
    const int gw = blockIdx.x * 8 + wave, NGW = gridDim.x * 8;
    const float* hn = (const float*)(p.ws + SB_HN); float* kv = (float*)(p.ws + SB_KV);
    for (int job = gw; job < 2048; job += NGW) {
        const int strip = job & 31, grp = (job >> 5) & 15, kq = job >> 9, col = strip * 64 + lane;
        const float* wp = p.in[3] + (size_t)(kq * 256) * INC + 9264 + col; const float* hp = hn + (size_t)(grp * 8) * 1024 + kq * 256;
        float a[8];
#pragma unroll
        for (int t = 0; t < 8; ++t) a[t] = 0.f;
#pragma unroll 4
        for (int k = 0; k < 256; ++k) { const float wv = wp[(size_t)k * INC];
#pragma unroll
            for (int t = 0; t < 8; ++t) a[t] += hp[t * 1024 + k] * wv; }
#pragma unroll
        for (int t = 0; t < 8; ++t) atomicAdd(kv + (size_t)(grp * 8 + t) * 2048 + col, a[t]);
    }
}
DI void rope_cs(int pos, int i, float& cs, float& sn) {
    const double cf[8] = {0.15915494309189535, 0.03086376340470123, 0.005985185712713705, 0.001160663641240061, 0.00022507907903927653, 4.364795279280289e-05, 8.464330808241401e-06, 1.6414262627950345e-06};
    double c = cf[0];
#pragma unroll
    for (int q = 1; q < 8; ++q) c = (i == q) ? cf[q] : c;
    double rv = (double)pos * c; rv -= floor(rv); const float fr = (float)rv; sn = __builtin_amdgcn_sinf(fr); cs = __builtin_amdgcn_cosf(fr);
}
DI void side_mixers(const Params& p, int b, LAS unsigned char* lds) {
    const int tid = opaque_tid();
    const float* P = (const float*)(p.ws + SB_PROJ) + b * 14384; float* Y = (float*)(p.ws + SB_Y) + b * 4096; float* KV = (float*)(p.ws + SB_KV) + (size_t)b * 64 * 2048;
    LAS float* cx = (LAS float*)lds; LAS float* ypre = cx + 3072; LAS float* lg = ypre + 2048; LAS float* pr = lg + 1024; LAS float* red = pr + 1024; LAS float* qr = red + 64;
    const int* pos = (const int*)p.in[1] + b * SEQ;
    __syncthreads();
    if (tid < 4) { float qk = 0.f, vv = 0.f; for (int d = 0; d < 128; ++d) qk += P[tid * 128 + d] * P[512 + tid * 128 + d]; for (int d = 0; d < 256; ++d) { const float v = P[1024 + tid * 256 + d]; vv += v * v; }
        red[tid] = qk * 0.08838834764831845f; red[4 + tid] = vv * (1.f / 256.f); }
    for (int c = tid; c < 3072; c += 512) cx[c] = siluf_(p.in[9][c] + p.in[8][3 * 3072 + c] * P[5136 + c]);
    if (tid < 32) red[8 + tid] = softplusf_(P[8208 + tid] + p.in[10][tid]);
    __syncthreads();
    for (int i = tid; i < 1024; i += 512) { const int h = i >> 8; const float p00 = red[h], o = p00 * P[1024 + i];
        Y[i] = o * rsqrtf(p00 * p00 * red[4 + h] + EPS) * p.in[7][i & 255] * siluf_(P[2064 + i]); }
    if (tid < 4) { float cb = 0.f; for (int n = 0; n < 128; ++n) cb += cx[2560 + tid * 128 + n] * cx[2048 + tid * 128 + n]; red[40 + tid] = cb; }
    __syncthreads();
    for (int i = tid; i < 2048; i += 512) { const int head = i >> 6; ypre[i] = (red[40 + (head >> 3)] * red[8 + head] + p.in[12][head]) * cx[i] * siluf_(P[3088 + i]); }
    __syncthreads();
    if (tid < 4) { float ss = 0.f; for (int i = 0; i < 512; ++i) ss += ypre[tid * 512 + i] * ypre[tid * 512 + i]; red[44 + tid] = rsqrtf(ss * (1.f / 512.f) + EPS); }
    __syncthreads();
    for (int i = tid; i < 2048; i += 512) Y[1024 + i] = ypre[i] * red[44 + (i >> 9)] * p.in[13][i];
    for (int i = tid; i < 1024; i += 512) { const int d = i & 63; float v = P[8240 + i];
        if (d < 16) { float cs, sn; rope_cs(pos[0], d & 7, cs, sn); const float o = (d < 8) ? P[8240 + i + 8] : P[8240 + i - 8]; v = (d < 8) ? v * cs - o * sn : v * cs + o * sn; }
        qr[i] = v; }
    for (int it = tid; it < 8192; it += 512) { const int j = it >> 7, hs = (it >> 3) & 15, d = it & 7; float cs, sn; rope_cs(pos[j], d, cs, sn);
        float* kp = KV + (size_t)j * 2048 + hs * 64 + d; const float k1 = kp[0], k2 = kp[8]; kp[0] = k1 * cs - k2 * sn; kp[8] = k2 * cs + k1 * sn; }
    __threadfence_block();
    __syncthreads();
    for (int i = tid; i < 1024; i += 512) { const int hs = i >> 6, j = i & 63; const float* kp = KV + (size_t)j * 2048 + hs * 64; float sacc = 0.f;
        for (int d = 0; d < 64; ++d) sacc += qr[hs * 64 + d] * kp[d];
        lg[i] = sacc * 0.125f; }
    __syncthreads();
    if (tid < 16) { float m = -1e30f; for (int j = 0; j < 64; ++j) m = fmaxf(m, lg[tid * 64 + j]); float sum = 0.f; for (int j = 0; j < 64; ++j) { const float e = expf(lg[tid * 64 + j] - m); pr[tid * 64 + j] = e; sum += e; }
        const float inv = 1.f / sum; for (int j = 0; j < 64; ++j) pr[tid * 64 + j] *= inv; }
    __syncthreads();
    float d1 = 0.f, d2 = 0.f;
    for (int i = 0; i < 64; ++i) { d1 += p.in[14][i] * p.in[15][i]; d2 += p.in[16][i] * p.in[17][i]; }
    const float lam = expf(d1) - expf(d2) + 0.2f;
    for (int i = tid; i < 1024; i += 512) { const int h = i >> 7; float o = 0.f;
        for (int j = 0; j < 64; ++j) o += (pr[(2 * h) * 64 + j] - lam * pr[(2 * h + 1) * 64 + j]) * KV[(size_t)j * 2048 + 1024 + i];
        ypre[i] = o; }
    __syncthreads();
    if (tid < 8) { float ss = 0.f; for (int i = 0; i < 128; ++i) ss += ypre[tid * 128 + i] * ypre[tid * 128 + i]; red[48 + tid] = rsqrtf(ss * (1.f / 128.f) + 1e-5f) * 0.8f; }
    __syncthreads();
    for (int i = tid; i < 1024; i += 512) Y[3072 + i] = ypre[i] * red[48 + (i >> 7)] * p.in[18][i & 127];
    float* G = (float*)(p.ws + SB_GATE) + b * 3072;
    for (int i = tid; i < 3072; i += 512) G[i] = sigmoidf_(P[11312 + i] + p.in[4][i]);
    __syncthreads();
}
DI void side_glue(const Params& p, int step, int b, LAS unsigned char* lds) {
    const int tid = opaque_tid(); unsigned char* ws = p.ws; LAS float* red = (LAS float*)lds;
    if (step == 4) {
        const float* G = (const float*)(ws + SB_GATE) + b * 3072; const float* BR = (const float*)(ws + SB_BR) + b * 3072;
        for (int c = tid; c < 1024; c += 512) { ((float*)(ws + SB_MIX))[b * 1024 + c] = G[c] * BR[c] + G[1024 + c] * BR[1024 + c] + G[2048 + c] * BR[2048 + c];
            ((float*)(ws + SB_XM))[b * 1024 + c] = p.in[0][(size_t)b * SEQ * 1024 + c]; }
    } else if (step == 6 || step == 100) {
        const float* src = (const float*)(ws + (step == 6 ? SB_XM : SB_X1)) + b * 1024; float* dst = (float*)(ws + (step == 6 ? SB_H2 : SB_HN1)) + b * 1024;
        const float* g = step == 6 ? p.in[23] : p.in[2] + 1024;
        __syncthreads();
        float s2 = 0.f; for (int c = tid; c < 1024; c += 512) s2 += src[c] * src[c];
        s2 = wave_sum(s2); if ((tid & 63) == 0) red[tid >> 6] = s2;
        __syncthreads();
        float tot = 0.f; for (int w = 0; w < 8; ++w) tot += red[w];
        const float rs = rsqrtf(tot * (1.f / 1024.f) + EPS);
        for (int c = tid; c < 1024; c += 512) dst[c] = src[c] * rs * g[c];
        if (step == 100) { const size_t row = (size_t)b * SEQ; bf16_t* xb = (bf16_t*)(ws + WS_XB);
            for (int c = tid; c < 1024; c += 512) { p.out[row * 1024 + c] = src[c]; xb[row * 1024 + c] = f2bf(src[c]); }
            if (tid == 0) ((float*)(ws + WS_ROWSQ))[2 * T + row] = tot; }
        __syncthreads();
    } else if (step == 8) {
        const float* up = (const float*)(ws + SB_UP) + b * 4096; float* hh = (float*)(ws + SB_HH) + b * 4096;
        for (int c = tid; c < 4096; c += 512) { const float r = fmaxf(up[c], 0.f); hh[c] = r * r; }
        for (int c = tid; c < 1024; c += 512) ((float*)(ws + SB_X1))[b * 1024 + c] = ((const float*)(ws + SB_XM))[b * 1024 + c];
    }
}
DI void side_phase(const Params& p, int l, int k, LAS unsigned char* lds) {
    unsigned char* ws = p.ws; const int bid = blockIdx.x;
    if (l == 0) {
        if (k == 0) side_init(p);
        else if (k == 1) { gemv2((float*)(ws + SB_PROJ), 14384, (const float*)(ws + SB_HN), 64 * 1024, p.in[3], INC, 1024, INC, 128); side_kv(p); }
        else if (k == 2) { if (bid < 2) side_mixers(p, bid, lds); }
        else if (k == 3) { float* br = (float*)(ws + SB_BR); const float* y = (const float*)(ws + SB_Y);
            gemv2(br, 3072, y, 4096, p.in[19], 1024, 1024, 1024, 128); gemv2(br + 1024, 3072, y + 1024, 4096, p.in[20], 1024, 2048, 1024, 128); gemv2(br + 2048, 3072, y + 3072, 4096, p.in[21], 1024, 1024, 1024, 128); }
        else if (k == 4) { if (bid < 2) side_glue(p, 4, bid, lds); }
        else if (k == 5) gemv2((float*)(ws + SB_XM), 1024, (const float*)(ws + SB_MIX), 1024, p.in[22], 1024, 1024, 1024, 128);
        else if (k == 6) { if (bid < 2) side_glue(p, 6, bid, lds); }
        else if (k == 7) gemv2((float*)(ws + SB_UP), 4096, (const float*)(ws + SB_H2), 1024, p.in[24], 4096, 1024, 4096, 128);
        else if (k == 8) { if (bid < 2) side_glue(p, 8, bid, lds); }
        else if (k == 9) gemv2((float*)(ws + SB_X1), 1024, (const float*)(ws + SB_HH), 4096, p.in[25], 1024, 4096, 1024, 128);
    } else {
        if (k == 0) { if (bid < 2) side_glue(p, 100, bid, lds); }
        else if (k == 1) gemv2((float*)(ws + SB_QK1), 1024, (const float*)(ws + SB_HN1), 1024, p.in[3] + (size_t)1024 * INC, INC, 1024, 1024, 128);
    }
}

constexpr int NPHASE = 29;
#ifndef PH_MASK
#define PH_MASK 0xFFFFFFFFu
#endif
#define EN(k_) ((PH_MASK >> (k_)) & 1u)
constexpr int LDS_BYTES = 147456;
template <bool COOP> __global__ void __launch_bounds__(512, 2) mk(Params p) {
    extern __shared__ __attribute__((aligned(16))) unsigned char lds_raw[];
    LAS unsigned char* lds = (LAS unsigned char*)lds_raw;
    unsigned char* ws = p.ws;
    float* rowsq = (float*)(ws + WS_ROWSQ);
    bf16_t* xb = (bf16_t*)(ws + WS_XB); bf16_t* mixb = (bf16_t*)(ws + WS_MIXB); bf16_t* R = (bf16_t*)(ws + WS_R);
    const unsigned char* wt = ws + WS_WT;
    const int G = gridDim.x, bid = blockIdx.x;
    for (int ph = p.ph_lo; ph < p.ph_hi; ++ph) {
        if (ph == 28) { if (EN(14)) final_norm(p); }
        else {
            const int l = ph / 14, k = ph % 14;
            if (EN(0) && k == 0) phase_prep(p, l, lds);
            else if (EN(1) && (k == 1 || k == 6)) {
                const bool gd = (k == 1);
                pg8::Gemm g{xb, (const bf16_t*)(wt + (gd ? WT_GD : WT_S)), T, gd ? 8448 : 6144, 1024, 1024, 1024};
                pg8::StaticOrder S; S.init(T, g.N, G, bid);
                EpiIn E{R, rowsq + (2 * l) * T, (float*)(ws + WS_SMALL), gd ? 32 : -1, gd ? 3 : 5, gd ? 7 : -1,
                        p.in[4] + l * 3072 + (gd ? 0 : 1024), p.in[4] + l * 3072 + 2048};
                pg8::gemm_phase(lds, g, S, E);
            }
            else if (EN(2) && k == 2) { rope_pass(p); for (int un = bid; un < 256; un += G) gla_unit<1>(p, l, un, lds); }
            else if (EN(3) && k == 3) { gla_scan(p); attn_phase(p, l, lds); }
            else if (EN(4) && k == 4) { for (int un = bid; un < 256; un += G) gla_unit<3>(p, l, un, lds); }
            else if (EN(5) && (k == 5 || k == 10)) {
                const int nrun = (k == 5) ? 2 : 4;
                for (int r = 0; r < nrun; ++r) {
                    pg8::Gemm g; EpiMix E;
                    if (k == 5) {
                        g = pg8::Gemm{R + (size_t)(r == 0 ? 2 : 4) * (BLK / 2), (const bf16_t*)(wt + (r == 0 ? WT_GLA : WT_DIFF)), T, 1024, 1024, 1024, 1024};
                        E = EpiMix{mixb, R + (size_t)(r == 0 ? 3 : 7) * (BLK / 2), nullptr, 0, r == 0 ? 1 : 0};
                    } else {
                        g = pg8::Gemm{R + (size_t)(r >> 1) * (BLK / 2) + (r & 1) * 512, (const bf16_t*)(wt + WT_SSM) + r * 512, T, 1024, 512, 1024, 2048};
                        E = EpiMix{mixb, R + (size_t)5 * (BLK / 2), (const float*)(ws + WS_SSQ), r, 0};
                    }
                    pg8::StaticOrder S; S.init(T, 1024, G, bid);
                    pg8::gemm_phase(lds, g, S, E);
                }
            }
            else if (EN(7) && k == 7) { for (int un = bid; un < 2048; un += G) ssd_unit<1>(p, l, un, lds); }
            else if (EN(8) && k == 8) { ssd_scan(p); }
            else if (EN(9) && k == 9) { for (int un = bid; un < 2048; un += G) ssd_unit<3>(p, l, un, lds); }
            else if (EN(11) && (k == 11 || k == 13)) {
                const bool dn = (k == 13);
                pg8::Gemm g{dn ? R : mixb, (const bf16_t*)(wt + (dn ? WT_DOWN : WT_OUT)), T, 1024, dn ? 4096 : 1024, dn ? 4096 : 1024, dn ? 4096 : 1024};
                pg8::StaticOrder S; S.init(T, 1024, G, bid);
                EpiRes E{(l == 0 && !dn) ? p.in[0] : p.out, p.out, xb, rowsq + (2 * l + (dn ? 2 : 1)) * T};
                pg8::gemm_phase(lds, g, S, E);
            }
            else if (EN(12) && k == 12) {
                pg8::Gemm g{xb, (const bf16_t*)(wt + WT_UP), T, 4096, 1024, 1024, 1024};
                pg8::StaticOrder S; S.init(T, 4096, G, bid);
                EpiUp E{R, rowsq + (2 * l + 1) * T};
                pg8::gemm_phase(lds, g, S, E);
            }
        }
        if (ph < 28) side_phase(p, ph / 14, ph % 14, lds);
        if (COOP) { if (ph + 1 < p.ph_hi) cg::this_grid().sync(); }
    }
}

extern "C" void kernel_launch(void* const* d_in, const int* in_sizes, int n_in, void* d_out, int out_size, void* d_ws, size_t ws_size, hipStream_t stream) {
    static int grid = 0;
    if (grid == 0) {
        if (n_in != 27 || out_size != T * 1024 || ws_size < WS_END) { fprintf(stderr, "kernel_launch: unexpected shapes/ws (n_in %d out %d ws %zu need %zu)\n", n_in, out_size, ws_size, (size_t)WS_END); grid = -1; return; }
        int dev = 0, cus = 0, per_cu = 0;
        (void)hipGetDevice(&dev); (void)hipDeviceGetAttribute(&cus, hipDeviceAttributeMultiprocessorCount, dev);
        (void)hipFuncSetAttribute((const void*)mk<true>, hipFuncAttributeMaxDynamicSharedMemorySize, LDS_BYTES);
        (void)hipOccupancyMaxActiveBlocksPerMultiprocessor(&per_cu, (const void*)mk<true>, 512, LDS_BYTES);
        if (per_cu < 1) fprintf(stderr, "kernel_launch: occupancy query says %d blocks/CU\n", per_cu);
        (void)hipGetLastError();
        grid = cus;
    }
    if (grid < 0) return;
    Params p{};
    for (int i = 0; i < 27; ++i) p.in[i] = (const float*)d_in[i];
    p.out = (float*)d_out; p.ws = (unsigned char*)d_ws;
    p.ph_lo = 0; p.ph_hi = NPHASE;
    void* args[] = {&p};
    hipError_t e = hipLaunchCooperativeKernel((const void*)mk<true>, dim3(grid), dim3(512), args, LDS_BYTES, stream);
    if (e != hipSuccess) fprintf(stderr, "cooperative launch failed: %s (grid %d)\n", hipGetErrorString(e), grid);
}
```

```cpp
#include <hip/hip_runtime.h>
#include <hip/hip_cooperative_groups.h>
#include <cstdio>
#include <cstdint>
namespace cg = cooperative_groups;

#define LAS __attribute__((address_space(3)))
#define DI __device__ __forceinline__
typedef unsigned short bf16_t;
typedef short bf16x8 __attribute__((ext_vector_type(8)));
typedef short s16x4 __attribute__((ext_vector_type(4)));
typedef float f32x4 __attribute__((ext_vector_type(4)));
typedef float f32x16 __attribute__((ext_vector_type(16)));
typedef unsigned u32x4 __attribute__((ext_vector_type(4)));
typedef unsigned u32x2 __attribute__((ext_vector_type(2)));
typedef float f32x2_t __attribute__((ext_vector_type(2)));
typedef __bf16 bf16x2_t __attribute__((ext_vector_type(2)));

DI unsigned pk2(float lo, float hi) { f32x2_t v = {lo, hi}; bf16x2_t b = __builtin_convertvector(v, bf16x2_t); return __builtin_bit_cast(unsigned, b); }
DI bf16_t f2bf(float f) { return (bf16_t)(pk2(f, 0.f) & 0xffffu); }
DI float bf2f(unsigned b) { return __uint_as_float(b << 16); }
DI float bflo(unsigned w) { return __uint_as_float(w << 16); }
DI float bfhi(unsigned w) { return __uint_as_float(w & 0xffff0000u); }
DI f32x4 mfma16(bf16x8 a, bf16x8 b, f32x4 c) { return __builtin_amdgcn_mfma_f32_16x16x32_bf16(a, b, c, 0, 0, 0); }
DI f32x16 mfma32(bf16x8 a, bf16x8 b, f32x16 c) { return __builtin_amdgcn_mfma_f32_32x32x16_bf16(a, b, c, 0, 0, 0); }
DI float sigmoidf_(float x) { return 1.f / (1.f + __expf(-x)); }
DI float siluf_(float x) { return x / (1.f + __expf(-x)); }
DI int opaque_tid() { int t = threadIdx.x; asm volatile("" : "+v"(t)); return t; }
DI int crow(int r, int hi) { return (r & 3) + 8 * (r >> 2) + 4 * hi; }

constexpr int T = 16384, SEQ = 8192, DM = 1024, DFF = 4096, INC = 14384;
constexpr float EPS = 1e-6f;
constexpr size_t MiB = 1u << 20;
constexpr size_t WS_ROWSQ = 0;
constexpr size_t WS_BAR = 448 * 1024;
constexpr size_t WS_DECG = 512 * 1024;
constexpr size_t WS_DECS = 768 * 1024;
constexpr size_t WS_SSQ = 1 * MiB;
constexpr size_t WS_SMALL = 2 * MiB;
constexpr size_t WS_XB = 6 * MiB;
constexpr size_t WS_MIXB = 38 * MiB;
constexpr size_t WS_WT = 70 * MiB;
constexpr size_t WT_GD = 0, WT_S = WT_GD + (size_t)8448 * 1024 * 2, WT_GLA = WT_S + (size_t)6144 * 1024 * 2, WT_SSM = WT_GLA + 2 * MiB,
                 WT_DIFF = WT_SSM + 4 * MiB, WT_OUT = WT_DIFF + 2 * MiB, WT_UP = WT_OUT + 2 * MiB, WT_DOWN = WT_UP + 8 * MiB, WT_END = WT_DOWN + 8 * MiB;
static_assert(WT_END <= 56 * MiB, "wt");
constexpr size_t WS_R = 126 * MiB;
constexpr size_t BLK = 32 * MiB;
constexpr size_t WS_STG = WS_R + 8 * BLK;
constexpr size_t WS_STS = WS_R + 6 * BLK;
constexpr size_t WS_SIDE = WS_R + 9 * BLK;
constexpr size_t SB_HN = WS_SIDE, SB_PROJ = SB_HN + 512 * 1024, SB_KV = SB_PROJ + 128 * 1024, SB_Y = SB_KV + 1024 * 1024, SB_GATE = SB_Y + 32 * 1024,
                 SB_BR = SB_GATE + 32 * 1024, SB_MIX = SB_BR + 32 * 1024, SB_XM = SB_MIX + 8192, SB_H2 = SB_XM + 8192, SB_UP = SB_H2 + 8192,
                 SB_HH = SB_UP + 32768, SB_X1 = SB_HH + 32768, SB_HN1 = SB_X1 + 8192, SB_QK1 = SB_HN1 + 8192, SB_END = SB_QK1 + 8192;
constexpr size_t WS_END = WS_SIDE + 2 * MiB;
static_assert(SB_END <= WS_END, "side");

struct Params {
    const float* in[27];
    float* out; unsigned char* ws;
    int ph_lo, ph_hi;
};

namespace pg8 {
constexpr int BM = 256, BK = 64, HALF = 128, HTB = HALF * BK * 2, STAGE_BYTES = 8 * HTB, NXCD = 8, WGM = 8;
__host__ __device__ __forceinline__ int lds_byte(int r, int c) { const int st = (r >> 4) * 2 + (c >> 5), rr = r & 15, cc = c & 31, ob = rr * 64 + cc * 2; return st * 1024 + (ob ^ (((ob >> 9) & 1) << 5)); }
__host__ __device__ __forceinline__ void stage_rc(int b, int& R, int& C) { const int st = b / 1024, sb = b % 1024, swz = sb ^ (((sb >> 9) & 1) << 5); R = (st >> 1) * 16 + swz / 64; C = (st & 1) * 32 + (swz % 64) / 2; }
struct Unit { int pm, pn; };
struct Gemm { const bf16_t* A; const bf16_t* Bt; int M, N, K, lda, ldb; };
struct StaticOrder {
    int nM, nN, nwg, G, c;
    __host__ __device__ void init(int M, int N, int G_, int c_) { nM = M / BM; nN = N / BM; nwg = nM * nN; G = G_; c = c_; }
    __host__ __device__ bool next(int i, Unit& u) const {
        const long L = (long)i * G + c; if (L >= nwg) return false;
        int wgid = (int)L; { const int q = nwg / NXCD, r = nwg % NXCD, xcd = wgid % NXCD, off = wgid / NXCD; wgid = (xcd < r ? xcd * (q + 1) : r * (q + 1) + (xcd - r) * q) + off; }
        const int nig = WGM * nN, gid = wgid / nig, fm = gid * WGM, gsz = (nM - fm) < WGM ? (nM - fm) : WGM;
        u.pm = fm + ((wgid % nig) % gsz); u.pn = (wgid % nig) / gsz; return true;
    }
};
template <class Epi, class Sched>
__device__ __forceinline__ void gemm_phase(LAS unsigned char* lds, const Gemm g, const Sched& S, const Epi& E) {
    const int tid = opaque_tid(), wid = __builtin_amdgcn_readfirstlane(tid >> 6), lane = tid & 63, wr = wid >> 2, wc = wid & 3, fr = lane & 15, fq = lane >> 4;
    const int K = g.K, nt = K / BK;
    unsigned voffA[2], voffB[2];
#pragma unroll
    for (int i = 0; i < 2; ++i) { int R, C; stage_rc(tid * 16 + i * 8192, R, C);
        voffA[i] = (unsigned)(R * g.lda + C) * 2u; voffB[i] = (unsigned)(R * g.ldb + C) * 2u; }
    const size_t kstep = (size_t)(BK * 2);
    const size_t hstepA = (size_t)HALF * g.lda * 2, hstepB = (size_t)HALF * g.ldb * 2;
    const size_t tstepA = 2 * hstepA, tstepB = 2 * hstepB;
    const unsigned ldsw = (unsigned)wid * 1024u;
    const int aoff = lds_byte(wr * 64 + fr, fq * 8), boff = lds_byte(wc * 32 + fr, fq * 8);
#define PG8_SA(b, h) (((b) * 2 + (h)) * HTB)
#define PG8_SB(b, h) ((4 + (b) * 2 + (h)) * HTB)
#define PG8_STAGE(bufoff, gbase, voff) do { _Pragma("unroll") for (int _i = 0; _i < 2; ++_i) \
        __builtin_amdgcn_global_load_lds((const unsigned*)((const char*)(gbase) + (voff)[_i]), (LAS unsigned*)(lds + (bufoff) + ldsw + _i * 8192), 16, 0, 0); } while (0)
#define PG8_LDA(dst, b, h) do { _Pragma("unroll") for (int m = 0; m < 4; ++m) _Pragma("unroll") for (int k = 0; k < 2; ++k) dst[m][k] = *(const LAS bf16x8*)(lds + PG8_SA(b, h) + aoff + m * 2048 + k * 1024); } while (0)
#define PG8_LDB(dst, b, h) do { _Pragma("unroll") for (int n = 0; n < 2; ++n) _Pragma("unroll") for (int k = 0; k < 2; ++k) dst[n][k] = *(const LAS bf16x8*)(lds + PG8_SB(b, h) + boff + n * 2048 + k * 1024); } while (0)
#define PG8_MMA(ai, bj, At, Bt) do { __builtin_amdgcn_s_setprio(1); _Pragma("unroll") for (int m = 0; m < 4; ++m) _Pragma("unroll") for (int n = 0; n < 2; ++n) _Pragma("unroll") for (int k = 0; k < 2; ++k) \
        acc[ai][bj][m][n] = __builtin_amdgcn_mfma_f32_16x16x32_bf16(Bt[n][k], At[m][k], acc[ai][bj][m][n], 0, 0, 0); __builtin_amdgcn_s_setprio(0); } while (0)
#define PG8_WAIT_V(n) asm volatile("s_waitcnt vmcnt(" #n ")" ::: "memory")
#define PG8_WAIT_L(n) asm volatile("s_waitcnt lgkmcnt(" #n ")" ::: "memory")
#define PG8_BAR __builtin_amdgcn_s_barrier()
#define PG8_SCHED __builtin_amdgcn_sched_barrier(0)
    Unit cur, nxt; int ui = 0;
    if (!S.next(0, cur)) return;
    f32x4 acc[2][2][4][2];
#pragma unroll
    for (int a = 0; a < 2; ++a)
#pragma unroll
        for (int b = 0; b < 2; ++b)
#pragma unroll
            for (int m = 0; m < 4; ++m)
#pragma unroll
                for (int n = 0; n < 2; ++n) acc[a][b][m][n] = (f32x4){0.f, 0.f, 0.f, 0.f};
    bf16x8 At[4][2], B0[2][2], B1[2][2];
    const char* cA = (const char*)g.A + (size_t)cur.pm * tstepA; const char* cB = (const char*)g.Bt + (size_t)cur.pn * tstepB;
    PG8_STAGE(PG8_SB(0, 0), cB, voffB); PG8_STAGE(PG8_SB(0, 1), cB + hstepB, voffB); PG8_STAGE(PG8_SA(0, 0), cA, voffA); PG8_STAGE(PG8_SA(0, 1), cA + hstepA, voffA);
    if (wr == 1) PG8_BAR;
    PG8_WAIT_V(2); PG8_BAR;
    PG8_STAGE(PG8_SB(1, 0), cB + kstep, voffB); PG8_STAGE(PG8_SA(1, 0), cA + kstep, voffA); PG8_STAGE(PG8_SB(1, 1), cB + hstepB + kstep, voffB);
    PG8_WAIT_V(6); PG8_BAR;
    for (;;) {
        const bool has_next = S.next(ui + 1, nxt);
        const char* nA = has_next ? (const char*)g.A + (size_t)nxt.pm * tstepA : cA; const char* nB = has_next ? (const char*)g.Bt + (size_t)nxt.pn * tstepB : cB;
        for (int t = 0; t < nt; t += 2) {
            const bool last = (t == nt - 2);
            const char* a1 = cA + (size_t)(t + 1) * kstep;
            const char* a2 = last ? nA : cA + (size_t)(t + 2) * kstep; const char* b2 = last ? nB : cB + (size_t)(t + 2) * kstep;
            const char* a3 = a2 + kstep; const char* b3 = b2 + kstep;
            PG8_LDB(B0, 0, 0); PG8_LDB(B1, 0, 1); PG8_SCHED; PG8_LDA(At, 0, 0); PG8_STAGE(PG8_SA(1, 1), a1 + hstepA, voffA);
            PG8_WAIT_V(8); PG8_WAIT_L(0); PG8_BAR; PG8_MMA(0, 0, At, B0); PG8_MMA(0, 1, At, B1); PG8_BAR; PG8_SCHED;
            PG8_LDA(At, 0, 1); PG8_STAGE(PG8_SB(0, 0), b2, voffB); PG8_STAGE(PG8_SB(0, 1), b2 + hstepB, voffB); PG8_STAGE(PG8_SA(0, 0), a2, voffA);
            PG8_WAIT_V(8); PG8_WAIT_L(0); PG8_BAR; PG8_MMA(1, 0, At, B0); PG8_MMA(1, 1, At, B1); PG8_BAR; PG8_SCHED;
            PG8_LDB(B0, 1, 0); PG8_LDB(B1, 1, 1); PG8_SCHED; PG8_LDA(At, 1, 0); PG8_STAGE(PG8_SA(0, 1), a2 + hstepA, voffA);
            PG8_WAIT_V(8); PG8_WAIT_L(0); PG8_BAR; PG8_MMA(0, 0, At, B0); PG8_MMA(0, 1, At, B1); PG8_BAR; PG8_SCHED;
            PG8_LDA(At, 1, 1); PG8_STAGE(PG8_SB(1, 0), b3, voffB); PG8_STAGE(PG8_SB(1, 1), b3 + hstepB, voffB); PG8_STAGE(PG8_SA(1, 0), a3, voffA);
            PG8_WAIT_V(8); PG8_WAIT_L(0); PG8_BAR; PG8_MMA(1, 0, At, B0); PG8_MMA(1, 1, At, B1); PG8_BAR; PG8_SCHED;
        }
        if (wr == 0) PG8_BAR;
        E(acc, cur, wr, wc, fr, fq);
        if (!has_next) break;
#pragma unroll
        for (int a = 0; a < 2; ++a)
#pragma unroll
            for (int b = 0; b < 2; ++b)
#pragma unroll
                for (int m = 0; m < 4; ++m)
#pragma unroll
                    for (int n = 0; n < 2; ++n) acc[a][b][m][n] = (f32x4){0.f, 0.f, 0.f, 0.f};
        cur = nxt; cA = nA; cB = nB; ++ui;
        if (wr == 1) PG8_BAR;
    }
    PG8_WAIT_V(0);
    PG8_BAR;
#undef PG8_SA
#undef PG8_SB
#undef PG8_STAGE
#undef PG8_LDA
#undef PG8_LDB
#undef PG8_MMA
#undef PG8_WAIT_V
#undef PG8_WAIT_L
#undef PG8_BAR
#undef PG8_SCHED
}
}

typedef f32x4 Acc[2][2][4][2];
#define EPI_LOOP(body) \
    _Pragma("unroll") for (int ai = 0; ai < 2; ++ai) _Pragma("unroll") for (int m = 0; m < 4; ++m) { const int row = u.pm * 256 + ai * 128 + wr * 64 + m * 16 + fr; \
    _Pragma("unroll") for (int bj = 0; bj < 2; ++bj) _Pragma("unroll") for (int n = 0; n < 2; ++n) { const int ct = bj * 128 + wc * 32 + n * 16 + fq * 4; f32x4 v = acc[ai][bj][m][n]; body } }

struct EpiIn {
    bf16_t* R; const float* rowsq; float* small; int small_tile; int gblkA, gblkB; const float* biasA; const float* biasB;
    DI void operator()(const Acc& acc, const pg8::Unit& u, int wr, int wc, int fr, int fq) const {
        const int blk = u.pn >> 2, cb = (u.pn & 3) * 256;
        if (u.pn == small_tile) {
            EPI_LOOP( if (ct < 64) { const float rs = rsqrtf(rowsq[row] * (1.f / 1024.f) + EPS); *(f32x4*)(small + (size_t)row * 64 + ct) = v * rs; } )
            return;
        }
        bf16_t* dst = R + (size_t)blk * (BLK / 2);
        const float* bias = (blk == gblkA) ? biasA : ((blk == gblkB) ? biasB : nullptr);
        if (bias) {
            EPI_LOOP( const float rs = rsqrtf(rowsq[row] * (1.f / 1024.f) + EPS); const f32x4 bv = *(const f32x4*)(bias + cb + ct); v = v * rs + bv;
                u32x2 w; w.x = pk2(sigmoidf_(v[0]), sigmoidf_(v[1])); w.y = pk2(sigmoidf_(v[2]), sigmoidf_(v[3])); *(u32x2*)(dst + (size_t)row * 1024 + cb + ct) = w; )
        } else {
            EPI_LOOP( const float rs = rsqrtf(rowsq[row] * (1.f / 1024.f) + EPS); v = v * rs;
                u32x2 w; w.x = pk2(v[0], v[1]); w.y = pk2(v[2], v[3]); *(u32x2*)(dst + (size_t)row * 1024 + cb + ct) = w; )
        }
    }
};
struct EpiMix {
    bf16_t* mixb; const bf16_t* gate; const float* ssq; int grp; int first;
    DI void operator()(const Acc& acc, const pg8::Unit& u, int wr, int wc, int fr, int fq) const {
        EPI_LOOP( const int col = u.pn * 256 + ct; const size_t o = (size_t)row * 1024 + col;
            float rs = 1.f; if (ssq) rs = rsqrtf(ssq[(size_t)row * 4 + grp] * (1.f / 512.f) + EPS);
            const u32x2 gw = *(const u32x2*)(gate + o);
            f32x4 r; r[0] = bflo(gw.x) * v[0] * rs; r[1] = bfhi(gw.x) * v[1] * rs; r[2] = bflo(gw.y) * v[2] * rs; r[3] = bfhi(gw.y) * v[3] * rs;
            if (!first) { const u32x2 mw = *(const u32x2*)(mixb + o); r[0] += bflo(mw.x); r[1] += bfhi(mw.x); r[2] += bflo(mw.y); r[3] += bfhi(mw.y); }
            u32x2 w; w.x = pk2(r[0], r[1]); w.y = pk2(r[2], r[3]); *(u32x2*)(mixb + o) = w; )
    }
};
struct EpiRes {
    const float* xold; float* xnew; bf16_t* xb; float* rowsq;
    DI void operator()(const Acc& acc, const pg8::Unit& u, int wr, int wc, int fr, int fq) const {
#pragma unroll
        for (int ai = 0; ai < 2; ++ai)
#pragma unroll
            for (int m = 0; m < 4; ++m) { const int row = u.pm * 256 + ai * 128 + wr * 64 + m * 16 + fr; float ss = 0.f;
#pragma unroll
                for (int bj = 0; bj < 2; ++bj)
#pragma unroll
                    for (int n = 0; n < 2; ++n) { const int col = u.pn * 256 + bj * 128 + wc * 32 + n * 16 + fq * 4; const size_t o = (size_t)row * 1024 + col;
                        f32x4 v = acc[ai][bj][m][n] + *(const f32x4*)(xold + o); *(f32x4*)(xnew + o) = v;
                        u32x2 w; w.x = pk2(v[0], v[1]); w.y = pk2(v[2], v[3]); *(u32x2*)(xb + o) = w;
                        ss += v[0] * v[0] + v[1] * v[1] + v[2] * v[2] + v[3] * v[3]; }
                ss += __shfl_xor(ss, 16); ss += __shfl_xor(ss, 32);
                if (fq == 0) atomicAdd(rowsq + row, ss); }
    }
};
struct EpiUp {
    bf16_t* h; const float* rowsq;
    DI void operator()(const Acc& acc, const pg8::Unit& u, int wr, int wc, int fr, int fq) const {
        EPI_LOOP( const float rs = rsqrtf(rowsq[row] * (1.f / 1024.f) + EPS); v = v * rs;
            f32x4 r; r[0] = fmaxf(v[0], 0.f); r[1] = fmaxf(v[1], 0.f); r[2] = fmaxf(v[2], 0.f); r[3] = fmaxf(v[3], 0.f); r = r * r;
            u32x2 w; w.x = pk2(r[0], r[1]); w.y = pk2(r[2], r[3]); *(u32x2*)(h + (size_t)row * 4096 + u.pn * 256 + ct) = w; )
    }
};

DI int colmap(int kind, int n) {
    if (kind == 1) {
        if (n < 2048) return n;
        if (n < 3072) return 2064 + (n - 2048);
        if (n < 4096) return 11312 + (n - 3072);
        if (n < 5120) return 8240 + (n - 4096);
        if (n < 6144) return 9264 + (n - 5120);
        if (n < 7168) return 10288 + (n - 6144);
        if (n < 8192) return 13360 + (n - 7168);
        const int i = n - 8192; if (i < 16) return 2048 + i; if (i < 48) return 8208 + (i - 16); return -1;
    }
    if (kind == 2) {
        if (n < 2048) return 3088 + n;
        if (n < 5120) return 5136 + (n - 2048);
        return 12336 + (n - 5120);
    }
    return n;
}
DI void tr_item(const float* W, int ldw, int K, bf16_t* WT, const float* kscale, int kind, int kb, int nb, LAS float* scr, int lane) {
    const int k0 = 64 * kb, n0 = 32 * nb; const int sc = colmap(kind, n0 + (lane & 31));
#pragma unroll 8
    for (int i = 0; i < 32; ++i) { const int kk = 2 * i + (lane >> 5); float v = 0.f; if (sc >= 0) { v = W[(size_t)(k0 + kk) * ldw + sc]; if (kscale) v *= kscale[k0 + kk]; } scr[kk * 33 + (lane & 31)] = v; }
    asm volatile("s_waitcnt lgkmcnt(0)" ::: "memory");
    const int c = lane & 7;
#pragma unroll
    for (int j = 0; j < 4; ++j) { const int n = (lane >> 3) + 8 * j; const LAS float* s = scr + (8 * c) * 33 + n;
        u32x4 o; o.x = pk2(s[0 * 33], s[1 * 33]); o.y = pk2(s[2 * 33], s[3 * 33]); o.z = pk2(s[4 * 33], s[5 * 33]); o.w = pk2(s[6 * 33], s[7 * 33]);
        *(u32x4*)(WT + (size_t)(n0 + n) * K + k0 + 8 * c) = o; }
    asm volatile("s_waitcnt lgkmcnt(0)" ::: "memory");
}
DI float wave_sum(float v) {
#pragma unroll
    for (int o = 1; o < 64; o <<= 1) v += __shfl_xor(v, o);
    return v;
}
DI void phase_prep(const Params& p, int l, LAS unsigned char* lds) {
    const int tid = opaque_tid(), lane = tid & 63, wave = __builtin_amdgcn_readfirstlane(tid >> 6);
    const int gw = blockIdx.x * 8 + wave, NGW = gridDim.x * 8;
    LAS float* scr = (LAS float*)(lds + wave * 8704);
    unsigned char* ws = p.ws; bf16_t* wt = (bf16_t*)(ws + WS_WT);
    const float* w_in = p.in[3] + (size_t)l * 1024 * INC;
    constexpr int I0 = 16 * 264, I1 = 16 * 192, I2 = 16 * 32, I3 = 32 * 32, I4 = 16 * 32, I5 = 16 * 32, I6 = 16 * 128, I7 = 64 * 32;
    constexpr int NIT = I0 + I1 + I2 + I3 + I4 + I5 + I6 + I7;
    for (int it = gw; it < NIT; it += NGW) {
        int r = it;
        if (r < I0) { tr_item(w_in, INC, 1024, (bf16_t*)((char*)wt + WT_GD), p.in[2] + l * 1024, 1, r / 264, r % 264, scr, lane); continue; } r -= I0;
        if (r < I1) { tr_item(w_in, INC, 1024, (bf16_t*)((char*)wt + WT_S), p.in[2] + l * 1024, 2, r / 192, r % 192, scr, lane); continue; } r -= I1;
        if (r < I2) { tr_item(p.in[19] + (size_t)l * 1024 * 1024, 1024, 1024, (bf16_t*)((char*)wt + WT_GLA), nullptr, 0, r / 32, r % 32, scr, lane); continue; } r -= I2;
        if (r < I3) { tr_item(p.in[20] + (size_t)l * 2048 * 1024, 1024, 2048, (bf16_t*)((char*)wt + WT_SSM), p.in[13] + l * 2048, 0, r / 32, r % 32, scr, lane); continue; } r -= I3;
        if (r < I4) { tr_item(p.in[21] + (size_t)l * 1024 * 1024, 1024, 1024, (bf16_t*)((char*)wt + WT_DIFF), nullptr, 0, r / 32, r % 32, scr, lane); continue; } r -= I4;
        if (r < I5) { tr_item(p.in[22] + (size_t)l * 1024 * 1024, 1024, 1024, (bf16_t*)((char*)wt + WT_OUT), nullptr, 0, r / 32, r % 32, scr, lane); continue; } r -= I5;
        if (r < I6) { tr_item(p.in[24] + (size_t)l * 1024 * 4096, 4096, 1024, (bf16_t*)((char*)wt + WT_UP), p.in[23] + l * 1024, 0, r / 128, r % 128, scr, lane); continue; } r -= I6;
        tr_item(p.in[25] + (size_t)l * 4096 * 1024, 1024, 4096, (bf16_t*)((char*)wt + WT_DOWN), nullptr, 0, r / 32, r % 32, scr, lane);
    }
    const int gt = blockIdx.x * 512 + tid, NT_ = gridDim.x * 512;
    float* ssq = (float*)(ws + WS_SSQ);
    for (int i = gt; i < T * 4; i += NT_) ssq[i] = 0.f;
    if (l == 0) {
        float* rowsq = (float*)(ws + WS_ROWSQ);
        for (int i = gt; i < 4 * T; i += NT_) rowsq[T + i] = 0.f;
        bf16_t* xb = (bf16_t*)(ws + WS_XB); const float* x = p.in[0];
        for (int m = gw; m < T; m += NGW) {
            const f32x4* xr = (const f32x4*)(x + (size_t)m * 1024) + lane; float s = 0.f;
            u32x2* o = (u32x2*)(xb + (size_t)m * 1024) + lane;
#pragma unroll
            for (int j = 0; j < 4; ++j) { const f32x4 v = xr[64 * j]; s += v[0] * v[0] + v[1] * v[1] + v[2] * v[2] + v[3] * v[3]; u32x2 w; w.x = pk2(v[0], v[1]); w.y = pk2(v[2], v[3]); o[64 * j] = w; }
            s = wave_sum(s); if (lane == 0) rowsq[m] = s;
        }
    }
}

DI void rope_pass(const Params& p) {
    const int* pos = (const int*)p.in[1];
    bf16_t* Qd = (bf16_t*)(p.ws + WS_R + 4 * BLK); bf16_t* Kd = (bf16_t*)(p.ws + WS_R + 5 * BLK);
    const double cf[8] = {0.15915494309189535, 0.03086376340470123, 0.005985185712713705, 0.001160663641240061, 0.00022507907903927653, 4.364795279280289e-05, 8.464330808241401e-06, 1.6414262627950345e-06};
    const int gt = blockIdx.x * 512 + opaque_tid(), NTH = gridDim.x * 512;
    for (int it = gt; it < T * 32; it += NTH) {
        const int t = it >> 5, w = it & 31; bf16_t* base = ((w & 16) ? Kd : Qd) + (size_t)t * 1024 + (w & 15) * 64;
        const double ps = (double)pos[t];
        u32x4 a = *(u32x4*)base, b = *(u32x4*)(base + 8);
        float t1[8], t2[8];
#pragma unroll
        for (int i = 0; i < 4; ++i) { t1[2 * i] = bflo(a[i]); t1[2 * i + 1] = bfhi(a[i]); t2[2 * i] = bflo(b[i]); t2[2 * i + 1] = bfhi(b[i]); }
        float o1[8], o2[8];
#pragma unroll
        for (int i = 0; i < 8; ++i) { double rv = ps * cf[i]; rv -= floor(rv); const float fr = (float)rv; const float sn = __builtin_amdgcn_sinf(fr), cs = __builtin_amdgcn_cosf(fr);
            o1[i] = t1[i] * cs - t2[i] * sn; o2[i] = t2[i] * cs + t1[i] * sn; }
#pragma unroll
        for (int i = 0; i < 4; ++i) { a[i] = pk2(o1[2 * i], o1[2 * i + 1]); b[i] = pk2(o2[2 * i], o2[2 * i + 1]); }
        *(u32x4*)base = a; *(u32x4*)(base + 8) = b;
    }
}

template <int KS> DI f32x4 mm16(f32x4 acc, const LAS unsigned char* A, int lda_b, const LAS unsigned char* B, int ldb_b, int lane) {
    const int r = lane & 15, q = lane >> 4;
    const LAS unsigned char* ap = A + r * lda_b + q * 16; const LAS unsigned char* bp = B + r * ldb_b + q * 16;
#pragma unroll
    for (int s = 0; s < KS; ++s) acc = mfma16(*(const LAS bf16x8*)(ap + s * 64), *(const LAS bf16x8*)(bp + s * 64), acc);
    return acc;
}
DI float logsigmoidf_(float x) { return fminf(x, 0.f) - log1pf(__expf(-fabsf(x))); }

constexpr int G_GKL = 0, G_QTOT = 4096, G_BLAST = 6144, G_PART = 6656, G_QT = 8704, G_KT = 26112, G_KHT = 43520, G_VT = 61952, G_P = 98816;
template <int MODE> DI void gla_unit(const Params& p, int l, int un, LAS unsigned char* lds) {
    const int tid = opaque_tid(), lane = tid & 63, w = __builtin_amdgcn_readfirstlane(tid >> 6), r16 = lane & 15, quad = lane >> 4;
    const int sc = un >> 2, h = un & 3, tok0 = sc * 256;
    unsigned char* ws = p.ws;
    const bf16_t* QK = (const bf16_t*)(ws + WS_R); const bf16_t* Vg = (const bf16_t*)(ws + WS_R + BLK); bf16_t* Gg = (bf16_t*)(ws + WS_R + 2 * BLK);
    const float* small = (const float*)(ws + WS_SMALL);
    float* states = (float*)(ws + WS_STG) + (size_t)un * 32768;
    const int d = tid & 127, qr = tid >> 7;
    float wk[16];
#pragma unroll
    for (int r = 0; r < 16; ++r) wk[r] = p.in[5][(size_t)l * 16 * 512 + r * 512 + h * 128 + d];
    const float bk = p.in[6][l * 512 + h * 128 + d];
    f32x4 S[8][2];
    if (MODE == 3) {
#pragma unroll
        for (int mb = 0; mb < 8; ++mb)
#pragma unroll
            for (int nb = 0; nb < 2; ++nb) S[mb][nb] = *(const f32x4*)(states + ((size_t)(w * 16 + mb * 2 + nb) * 64 + lane) * 4);
    } else {
#pragma unroll
        for (int mb = 0; mb < 8; ++mb)
#pragma unroll
            for (int nb = 0; nb < 2; ++nb) S[mb][nb] = (f32x4){0.f, 0.f, 0.f, 0.f};
    }
    float ng[2] = {0.f, 0.f};
    if (MODE == 3) { ng[0] = p.in[7][l * 256 + 32 * w + r16]; ng[1] = p.in[7][l * 256 + 32 * w + 16 + r16]; }
    float dtot = 1.f;
    for (int j = 0; j < 4; ++j) {
        const int t0 = tok0 + 64 * j;
        if (tid < 256) { const int row = tid >> 2, c4 = (tid & 3) * 4; *(LAS f32x4*)(lds + G_GKL + (row * 16 + c4) * 4) = *(const f32x4*)(small + (size_t)(t0 + row) * 64 + c4); }
        if (tid < 64) ((LAS float*)(lds + G_PART))[tid] = 0.f;
        __syncthreads();
        float c[16]; float run = 0.f;
#pragma unroll
        for (int i = 0; i < 16; ++i) { const LAS float* gr = (const LAS float*)(lds + G_GKL) + (qr * 16 + i) * 16; float x = bk;
#pragma unroll
            for (int r = 0; r < 16; ++r) x += gr[r] * wk[r];
            run += logsigmoidf_(x) * (1.f / 16.f); c[i] = run; }
        ((LAS float*)(lds + G_QTOT))[qr * 128 + d] = run;
        __syncthreads();
        {
            float off = 0.f, bl = 0.f;
#pragma unroll
            for (int q2 = 0; q2 < 4; ++q2) { const float v = ((const LAS float*)(lds + G_QTOT))[q2 * 128 + d]; bl += v; if (q2 < qr) off += v; }
            unsigned khp[8];
#pragma unroll
            for (int i = 0; i < 16; i += 2) {
                float kh2[2];
#pragma unroll
                for (int e = 0; e < 2; ++e) { const int t = qr * 16 + i + e; const float b = off + c[i + e];
                    const float k = bf2f(QK[(size_t)(t0 + t) * 1024 + 512 + h * 128 + d]);
                    kh2[e] = k * __expf(bl - b);
                    if (MODE == 3) { const float q = bf2f(QK[(size_t)(t0 + t) * 1024 + h * 128 + d]);
                        ((LAS bf16_t*)(lds + G_QT))[t * 136 + d] = f2bf(q * 0.08838834764831845f * __expf(b));
                        ((LAS bf16_t*)(lds + G_KT))[t * 136 + d] = f2bf(k * __expf(-b)); } }
                khp[i >> 1] = pk2(kh2[0], kh2[1]);
            }
            *(LAS u32x4*)(lds + G_KHT + d * 144 + qr * 32) = (u32x4){khp[0], khp[1], khp[2], khp[3]};
            *(LAS u32x4*)(lds + G_KHT + d * 144 + qr * 32 + 16) = (u32x4){khp[4], khp[5], khp[6], khp[7]};
            if (qr == 0) { ((LAS float*)(lds + G_BLAST))[d] = bl; dtot *= __expf(bl); }
#pragma unroll
            for (int i = 0; i < 4; ++i) { const int pid = tid + 512 * i, g8 = pid >> 6, t = pid & 63;
                const u32x4 v = *(const u32x4*)(Vg + (size_t)(t0 + t) * 1024 + h * 256 + g8 * 8);
                LAS bf16_t* vt = (LAS bf16_t*)(lds + G_VT) + (g8 * 8) * 72 + t;
#pragma unroll
                for (int e = 0; e < 4; ++e) { vt[(2 * e) * 72] = (bf16_t)(v[e] & 0xffffu); vt[(2 * e + 1) * 72] = (bf16_t)(v[e] >> 16); } }
        }
        __syncthreads();
        if (MODE == 3) {
#pragma unroll
            for (int e = 0; e < 2; ++e) { const int x = 2 * w + e, tb = x >> 2, sb = x & 3;
                f32x4 a = (f32x4){0.f, 0.f, 0.f, 0.f};
                if (sb <= tb) a = mm16<4>(a, lds + G_KT + sb * 16 * 272, 272, lds + G_QT + tb * 16 * 272, 272, lane);
                const int t = 16 * tb + r16, s0 = 16 * sb + quad * 4;
                float v[4];
#pragma unroll
                for (int jj = 0; jj < 4; ++jj) v[jj] = (s0 + jj <= t) ? a[jj] : 0.f;
                if (x == 0 && lane == 0 && j == 0 && (tok0 & (SEQ - 1)) == 0) { const float* qk_ = (l == 0) ? (const float*)(ws + SB_PROJ) + (tok0 >> 13) * 14384 : (const float*)(ws + SB_QK1) + (tok0 >> 13) * 1024;
                    float acc_ = 0.f; for (int d_ = 0; d_ < 128; ++d_) acc_ += qk_[h * 128 + d_] * qk_[512 + h * 128 + d_]; v[0] = acc_ * 0.08838834764831845f; }
                *(LAS u32x2*)(lds + G_P + t * 144 + s0 * 2) = (u32x2){pk2(v[0], v[1]), pk2(v[2], v[3])}; }
            f32x4 o[4][2];
#pragma unroll
            for (int mb = 0; mb < 4; ++mb) { o[mb][0] = (f32x4){0.f, 0.f, 0.f, 0.f}; o[mb][1] = (f32x4){0.f, 0.f, 0.f, 0.f}; }
#pragma unroll
            for (int ks = 0; ks < 4; ++ks) {
                bf16x8 bf[2];
#pragma unroll
                for (int nb = 0; nb < 2; ++nb) { const f32x4 s0v = S[2 * ks][nb], s1v = S[2 * ks + 1][nb];
                    u32x4 pk; pk.x = pk2(s0v[0], s0v[1]); pk.y = pk2(s0v[2], s0v[3]); pk.z = pk2(s1v[0], s1v[1]); pk.w = pk2(s1v[2], s1v[3]); bf[nb] = __builtin_bit_cast(bf16x8, pk); }
#pragma unroll
                for (int mb = 0; mb < 4; ++mb) { const LAS unsigned char* ap = lds + G_QT + (16 * mb + r16) * 272 + (32 * ks + quad * 4) * 2;
                    const u32x2 lo = *(const LAS u32x2*)ap, hi = *(const LAS u32x2*)(ap + 32);
                    const bf16x8 af = __builtin_bit_cast(bf16x8, (u32x4){lo.x, lo.y, hi.x, hi.y});
                    o[mb][0] = mfma16(af, bf[0], o[mb][0]); o[mb][1] = mfma16(af, bf[1], o[mb][1]); }
            }
            __syncthreads();
#pragma unroll
            for (int mb = 0; mb < 4; ++mb)
#pragma unroll
                for (int nb = 0; nb < 2; ++nb) o[mb][nb] = mm16<2>(o[mb][nb], lds + G_P + mb * 16 * 144, 144, lds + G_VT + (32 * w + 16 * nb) * 144, 144, lane);
#pragma unroll
            for (int mb = 0; mb < 4; ++mb)
#pragma unroll
                for (int jj = 0; jj < 4; ++jj) { float ss = o[mb][0][jj] * o[mb][0][jj] + o[mb][1][jj] * o[mb][1][jj];
                    ss += __shfl_xor(ss, 1); ss += __shfl_xor(ss, 2); ss += __shfl_xor(ss, 4); ss += __shfl_xor(ss, 8);
                    if (r16 == 0) __hip_atomic_fetch_add((LAS float*)(lds + G_PART) + 16 * mb + quad * 4 + jj, ss, __ATOMIC_RELAXED, __HIP_MEMORY_SCOPE_WORKGROUP); }
            __syncthreads();
#pragma unroll
            for (int mb = 0; mb < 4; ++mb)
#pragma unroll
                for (int jj = 0; jj < 4; ++jj) { const int t = 16 * mb + quad * 4 + jj; const float rs = rsqrtf(((const LAS float*)(lds + G_PART))[t] * (1.f / 256.f) + EPS);
#pragma unroll
                    for (int nb = 0; nb < 2; ++nb) { bf16_t* gp = Gg + (size_t)(t0 + t) * 1024 + h * 256 + 32 * w + 16 * nb + r16;
                        const float gv = bf2f(*gp); *gp = f2bf(o[mb][nb][jj] * rs * ng[nb] * siluf_(gv)); } }
        }
#pragma unroll
        for (int mb = 0; mb < 8; ++mb) { const f32x4 bl4 = *(const LAS f32x4*)(lds + G_BLAST + (16 * mb + quad * 4) * 4);
            const f32x4 dc = (f32x4){__expf(bl4[0]), __expf(bl4[1]), __expf(bl4[2]), __expf(bl4[3])};
#pragma unroll
            for (int nb = 0; nb < 2; ++nb) { S[mb][nb] = S[mb][nb] * dc;
                S[mb][nb] = mm16<2>(S[mb][nb], lds + G_KHT + mb * 16 * 144, 144, lds + G_VT + (32 * w + 16 * nb) * 144, 144, lane); } }
        __syncthreads();
    }
    if (MODE == 1) {
#pragma unroll
        for (int mb = 0; mb < 8; ++mb)
#pragma unroll
            for (int nb = 0; nb < 2; ++nb) *(f32x4*)(states + ((size_t)(w * 16 + mb * 2 + nb) * 64 + lane) * 4) = S[mb][nb];
        if (tid < 128) ((float*)(ws + WS_DECG))[un * 128 + tid] = dtot;
    }
}
DI void gla_scan(const Params& p) {
    const int gid = blockIdx.x * 512 + opaque_tid();
    for (int it = gid; it < 65536; it += gridDim.x * 512) {
        const int chain = it >> 13, e = it & 8191, b = chain >> 2, h = chain & 3;
        const int tile = (e >> 6) & 15, lane = e & 63, d0 = 16 * (tile >> 1) + (lane >> 4) * 4;
        f32x4* st = (f32x4*)(p.ws + WS_STG); const float* dec = (const float*)(p.ws + WS_DECG);
        f32x4 u[32];
#pragma unroll
        for (int s = 0; s < 32; ++s) u[s] = st[(size_t)((b * 32 + s) * 4 + h) * 8192 + e];
        f32x4 run = (f32x4){0.f, 0.f, 0.f, 0.f};
#pragma unroll
        for (int s = 0; s < 32; ++s) { const int un = (b * 32 + s) * 4 + h; const f32x4 dc = *(const f32x4*)(dec + un * 128 + d0);
            st[(size_t)un * 8192 + e] = run; run = run * dc + u[s]; }
    }
}

constexpr int S_ACUM = 0, S_DTV = 256, S_MISC = 512, S_XDT = 1024, S_XD2 = 10240, S_BN = 19456, S_BT = 36864, S_CN = 55296, S_GL = 72704, S_SB = 81920;
DI float softplusf_(float x) { return x > 20.f ? x : log1pf(__expf(x)); }
template <int MODE> DI void ssd_unit(const Params& p, int l, int un, LAS unsigned char* lds) {
    const int tid = opaque_tid(), lane = tid & 63, w = __builtin_amdgcn_readfirstlane(tid >> 6), r16 = lane & 15, quad = lane >> 4;
    const int sc = un >> 5, head = un & 31, g = head >> 3, tok0 = sc * 256;
    unsigned char* ws = p.ws;
    bf16_t* Zb = (bf16_t*)(ws + WS_R + (size_t)(head >> 4) * BLK) + (head & 15) * 64;
    const bf16_t* Xb = (const bf16_t*)(ws + WS_R + (size_t)(2 + (head >> 4)) * BLK) + (head & 15) * 64;
    const bf16_t* BCb = (const bf16_t*)(ws + WS_R + 4 * BLK);
    const float* small = (const float*)(ws + WS_SMALL);
    float* ssq = (float*)(ws + WS_SSQ);
    float* states = (float*)(ws + WS_STS) + (size_t)un * 8192;
    const float* cw = p.in[8] + (size_t)l * 4 * 3072; const float* cbias = p.in[9] + l * 3072;
    const float dtb = p.in[10][l * 32 + head], aneg = -__expf(p.in[11][l * 32 + head]), Dh = p.in[12][l * 32 + head];
    f32x4 st[4];
    if (MODE == 3) {
#pragma unroll
        for (int pb = 0; pb < 4; ++pb) { st[pb] = *(const f32x4*)(states + ((size_t)(w * 4 + pb) * 64 + lane) * 4);
            *(LAS u32x2*)(lds + S_SB + (16 * pb + r16) * 272 + (16 * w + quad * 4) * 2) = (u32x2){pk2(st[pb][0], st[pb][1]), pk2(st[pb][2], st[pb][3])}; }
    } else {
#pragma unroll
        for (int pb = 0; pb < 4; ++pb) st[pb] = (f32x4){0.f, 0.f, 0.f, 0.f};
    }
    const int px = tid & 63, tq = tid >> 6;
    float wx[4];
#pragma unroll
    for (int i = 0; i < 4; ++i) wx[i] = cw[i * 3072 + head * 64 + px];
    const float bx = cbias[head * 64 + px];
    float atot = 0.f;
    for (int j = 0; j < 4; ++j) {
        const int t0 = tok0 + 64 * j, s0 = t0 & (SEQ - 1);
        if (w == 0) {
            const float dt = softplusf_(small[(size_t)(t0 + lane) * 64 + 16 + head] + dtb);
            float cs = dt * aneg;
#pragma unroll
            for (int o = 1; o < 64; o <<= 1) { const float v = __shfl_up(cs, o); if (lane >= o) cs += v; }
            ((LAS float*)(lds + S_ACUM))[lane] = cs; ((LAS float*)(lds + S_DTV))[lane] = dt;
            if (lane == 63) ((LAS float*)(lds + S_MISC))[0] = cs;
        }
        __syncthreads();
        const float alast = ((const LAS float*)(lds + S_MISC))[0];
        atot += alast;
        {
            float xv[11];
#pragma unroll
            for (int k = 0; k < 11; ++k) { const int tt = tq * 8 - 3 + k; xv[k] = (s0 + tt >= 0) ? bf2f(Xb[(size_t)(t0 + tt) * 1024 + px]) : 0.f; }
            unsigned a1[4], a2[4]; float e1[2], e2[2];
#pragma unroll
            for (int i = 0; i < 8; ++i) { const int t = tq * 8 + i;
                const float cv = bx + xv[i] * wx[0] + xv[i + 1] * wx[1] + xv[i + 2] * wx[2] + xv[i + 3] * wx[3];
                const float xd = siluf_(cv) * ((const LAS float*)(lds + S_DTV))[t];
                e1[i & 1] = xd; e2[i & 1] = xd * __expf(alast - ((const LAS float*)(lds + S_ACUM))[t]);
                if (i & 1) { a1[i >> 1] = pk2(e1[0], e1[1]); a2[i >> 1] = pk2(e2[0], e2[1]); } }
            *(LAS u32x4*)(lds + S_XDT + px * 144 + tq * 16) = (u32x4){a1[0], a1[1], a1[2], a1[3]};
            *(LAS u32x4*)(lds + S_XD2 + px * 144 + tq * 16) = (u32x4){a2[0], a2[1], a2[2], a2[3]};
        }
        {
            const bf16_t* BCc = (const bf16_t*)(ws + WS_STG);
#pragma unroll
            for (int i = 0; i < 2; ++i) { const int pid = tid + 512 * i, c8 = pid >> 6, t = pid & 63;
                const u32x4 v = *(const u32x4*)(BCc + (size_t)(t0 + t) * 1024 + g * 128 + c8 * 8);
                if (MODE == 3) *(LAS u32x4*)(lds + S_BN + t * 272 + c8 * 16) = v;
                LAS bf16_t* bt = (LAS bf16_t*)(lds + S_BT) + (c8 * 8) * 72 + t;
#pragma unroll
                for (int e = 0; e < 4; ++e) { bt[(2 * e) * 72] = (bf16_t)(v[e] & 0xffffu); bt[(2 * e + 1) * 72] = (bf16_t)(v[e] >> 16); }
                if (MODE == 3) { const u32x4 cv = *(const u32x4*)(BCc + (size_t)(t0 + t) * 1024 + 512 + g * 128 + c8 * 8); *(LAS u32x4*)(lds + S_CN + t * 272 + c8 * 16) = cv; } }
        }
        __syncthreads();
        if (MODE == 3) {
            f32x4 y[2];
#pragma unroll
            for (int e = 0; e < 2; ++e) { const int x = 2 * w + e, tb = x >> 2, sb = x & 3;
                f32x4 a = (f32x4){0.f, 0.f, 0.f, 0.f};
                if (sb <= tb) a = mm16<4>(a, lds + S_BN + sb * 16 * 272, 272, lds + S_CN + tb * 16 * 272, 272, lane);
                const int t = 16 * tb + r16, sb0 = 16 * sb + quad * 4;
                const float act = ((const LAS float*)(lds + S_ACUM))[t], dtt = ((const LAS float*)(lds + S_DTV))[t];
                float v[4];
#pragma unroll
                for (int jj = 0; jj < 4; ++jj) { const int s = sb0 + jj; float val = 0.f;
                    if (s <= t) val = a[jj] * __expf(act - ((const LAS float*)(lds + S_ACUM))[s]);
                    if (s == t) val += Dh / dtt;
                    v[jj] = val; }
                *(LAS u32x2*)(lds + S_GL + t * 144 + sb0 * 2) = (u32x2){pk2(v[0], v[1]), pk2(v[2], v[3])};
                const int pb = sb;
                y[e] = mm16<4>((f32x4){0.f, 0.f, 0.f, 0.f}, lds + S_SB + pb * 16 * 272, 272, lds + S_CN + tb * 16 * 272, 272, lane);
                y[e] = y[e] * __expf(act);
            }
            __syncthreads();
#pragma unroll
            for (int e = 0; e < 2; ++e) { const int x = 2 * w + e, tb = x >> 2, pb = x & 3;
                y[e] = mm16<2>(y[e], lds + S_XDT + pb * 16 * 144, 144, lds + S_GL + tb * 16 * 144, 144, lane);
                const int t = 16 * tb + r16; bf16_t* zp = Zb + (size_t)(t0 + t) * 1024 + 16 * pb + quad * 4;
                const u32x2 zw = *(const u32x2*)zp;
                f32x4 r; r[0] = y[e][0] * siluf_(bflo(zw.x)); r[1] = y[e][1] * siluf_(bfhi(zw.x)); r[2] = y[e][2] * siluf_(bflo(zw.y)); r[3] = y[e][3] * siluf_(bfhi(zw.y));
                float ss = r[0] * r[0] + r[1] * r[1] + r[2] * r[2] + r[3] * r[3];
                ss += __shfl_xor(ss, 16); ss += __shfl_xor(ss, 32);
                if (quad == 0) atomicAdd(ssq + (size_t)(t0 + t) * 4 + g, ss);
                *(u32x2*)zp = (u32x2){pk2(r[0], r[1]), pk2(r[2], r[3])}; }
        }
        {
            const float da = __expf(alast);
#pragma unroll
            for (int pb = 0; pb < 4; ++pb) { st[pb] = st[pb] * da;
                st[pb] = mm16<2>(st[pb], lds + S_BT + w * 16 * 144, 144, lds + S_XD2 + pb * 16 * 144, 144, lane);
                if (MODE == 3) *(LAS u32x2*)(lds + S_SB + (16 * pb + r16) * 272 + (16 * w + quad * 4) * 2) = (u32x2){pk2(st[pb][0], st[pb][1]), pk2(st[pb][2], st[pb][3])}; }
        }
        __syncthreads();
    }
    if (MODE == 1) {
#pragma unroll
        for (int pb = 0; pb < 4; ++pb) *(f32x4*)(states + ((size_t)(w * 4 + pb) * 64 + lane) * 4) = st[pb];
        if (tid == 0) ((float*)(ws + WS_DECS))[un] = __expf(atot);
    }
}

DI void conv_bc(const Params& p, int l) {
    const bf16_t* BC = (const bf16_t*)(p.ws + WS_R + 4 * BLK); bf16_t* O = (bf16_t*)(p.ws + WS_STG);
    const float* cw = p.in[8] + (size_t)l * 4 * 3072 + 2048; const float* cb = p.in[9] + l * 3072 + 2048;
    const int gt = blockIdx.x * 512 + opaque_tid();
    for (int it = gt; it < 1024 * 256; it += gridDim.x * 512) {
        const int c = it & 1023, r0 = (it >> 10) * 64;
        const float w0 = cw[c], w1 = cw[3072 + c], w2 = cw[2 * 3072 + c], w3 = cw[3 * 3072 + c], b = cb[c];
        float x0 = 0.f, x1 = 0.f, x2 = 0.f;
        if ((r0 & (SEQ - 1)) != 0) { x0 = bf2f(BC[(size_t)(r0 - 3) * 1024 + c]); x1 = bf2f(BC[(size_t)(r0 - 2) * 1024 + c]); x2 = bf2f(BC[(size_t)(r0 - 1) * 1024 + c]); }
#pragma unroll 8
        for (int i = 0; i < 64; ++i) { const float x3 = bf2f(BC[(size_t)(r0 + i) * 1024 + c]); const float cv = b + x0 * w0 + x1 * w1 + x2 * w2 + x3 * w3;
            O[(size_t)(r0 + i) * 1024 + c] = f2bf(siluf_(cv)); x0 = x1; x1 = x2; x2 = x3; }
    }
}
DI void ssd_scan(const Params& p) {
    const int gid = blockIdx.x * 512 + opaque_tid();
    for (int it = gid; it < 131072; it += gridDim.x * 512) {
        const int chain = it >> 11, e = it & 2047, b = chain >> 5, head = chain & 31;
        f32x4* st = (f32x4*)(p.ws + WS_STS); const float* dec = (const float*)(p.ws + WS_DECS);
        f32x4 u[32];
#pragma unroll
        for (int s = 0; s < 32; ++s) u[s] = st[(size_t)((b * 32 + s) * 32 + head) * 2048 + e];
        f32x4 run = (f32x4){0.f, 0.f, 0.f, 0.f};
#pragma unroll
        for (int s = 0; s < 32; ++s) { const int un = (b * 32 + s) * 32 + head; const float dc = dec[un];
            st[(size_t)un * 2048 + e] = run; run = run * dc + u[s]; }
    }
}

typedef short v4i16_t __attribute__((ext_vector_type(4)));
DI s16x4 vtr(const LAS unsigned char* p) { return __builtin_bit_cast(s16x4, __builtin_amdgcn_ds_read_tr16_b64_v4i16((LAS v4i16_t*)p)); }
constexpr int A_K = 0, A_V = 34816, A_X = 0, A_Y = 65536, A_NG = 100352;
DI void attn_unit(const Params& p, int b, int h, int qb, float lam, float oscale, LAS unsigned char* lds) {
    const int tid = opaque_tid(), lane = tid & 63, w = __builtin_amdgcn_readfirstlane(tid >> 6), rg = w & 3, sub = w >> 2, q = lane & 31, hh = lane >> 5;
    bf16_t* Qd = (bf16_t*)(p.ws + WS_R + 4 * BLK); const bf16_t* Kd = (const bf16_t*)(p.ws + WS_R + 5 * BLK); const bf16_t* Vd = (const bf16_t*)(p.ws + WS_R + 6 * BLK);
    const int tok0 = b * SEQ + qb * 128;
    bf16x8 qf[4];
    { const bf16_t* qp = Qd + (size_t)(tok0 + rg * 32 + q) * 1024 + h * 128 + sub * 64 + hh * 8;
#pragma unroll
      for (int ks = 0; ks < 4; ++ks) qf[ks] = *(const bf16x8*)(qp + ks * 16); }
    const int NT = 2 * qb + 2;
    u32x4 kr[2], vr[2];
    const int prow = tid >> 4, pc16 = tid & 15;
#define ATT_LOAD(t) do { _Pragma("unroll") for (int i_ = 0; i_ < 2; ++i_) { const size_t off_ = (size_t)(b * SEQ + (t) * 64 + prow + 32 * i_) * 1024 + h * 128 + pc16 * 8; \
        kr[i_] = *(const u32x4*)(Kd + off_); vr[i_] = *(const u32x4*)(Vd + off_); } } while (0)
#define ATT_STORE(buf) do { _Pragma("unroll") for (int i_ = 0; i_ < 2; ++i_) { const int o_ = (buf) * 17408 + (prow + 32 * i_) * 272 + pc16 * 16; \
        *(LAS u32x4*)(lds + A_K + o_) = kr[i_]; *(LAS u32x4*)(lds + A_V + o_) = vr[i_]; } } while (0)
    f32x16 o[4];
#pragma unroll
    for (int db = 0; db < 4; ++db)
#pragma unroll
        for (int i = 0; i < 16; ++i) o[db][i] = 0.f;
    float m_run = -1e30f, l_run = 0.f;
    const float C2 = 0.18033688011112042f;
    ATT_LOAD(0); ATT_STORE(0); ATT_LOAD(1);
    __syncthreads();
    const int i16 = lane & 15, blk = (lane >> 4) & 1;
    for (int t = 0; t < NT; ++t) {
        if (t + 1 < NT) ATT_STORE((t + 1) & 1);
        if (t + 2 < NT) ATT_LOAD(t + 2);
        if (t <= 2 * qb + (rg >> 1)) {
            const LAS unsigned char* Kb = lds + A_K + (t & 1) * 17408; const LAS unsigned char* Vb = lds + A_V + (t & 1) * 17408;
            f32x16 s0, s1;
#pragma unroll
            for (int i = 0; i < 16; ++i) { s0[i] = 0.f; s1[i] = 0.f; }
#pragma unroll
            for (int ks = 0; ks < 4; ++ks) { const LAS unsigned char* kp = Kb + q * 272 + (sub * 64 + ks * 16 + hh * 8) * 2;
                s0 = mfma32(*(const LAS bf16x8*)kp, qf[ks], s0); s1 = mfma32(*(const LAS bf16x8*)(kp + 32 * 272), qf[ks], s1); }
            float mx = fmaxf(s0[0], s1[0]);
#pragma unroll
            for (int i = 1; i < 16; ++i) mx = fmaxf(mx, fmaxf(s0[i], s1[i]));
            mx = fmaxf(mx, __shfl_xor(mx, 32));
            const float m_new = fmaxf(m_run, mx), alpha = __builtin_amdgcn_exp2f((m_run - m_new) * C2), negm = -m_new * C2;
            float sum = 0.f;
#pragma unroll
            for (int i = 0; i < 16; ++i) { s0[i] = __builtin_amdgcn_exp2f(fmaf(s0[i], C2, negm)); s1[i] = __builtin_amdgcn_exp2f(fmaf(s1[i], C2, negm)); sum += s0[i] + s1[i]; }
            l_run = l_run * alpha + sum; m_run = m_new;
#pragma unroll
            for (int db = 0; db < 4; ++db)
#pragma unroll
                for (int i = 0; i < 16; ++i) o[db][i] *= alpha;
            bf16x8 pf[2][2];
#pragma unroll
            for (int s = 0; s < 2; ++s) {
                pf[0][s] = __builtin_bit_cast(bf16x8, (u32x4){pk2(s0[8 * s], s0[8 * s + 1]), pk2(s0[8 * s + 2], s0[8 * s + 3]), pk2(s0[8 * s + 4], s0[8 * s + 5]), pk2(s0[8 * s + 6], s0[8 * s + 7])});
                pf[1][s] = __builtin_bit_cast(bf16x8, (u32x4){pk2(s1[8 * s], s1[8 * s + 1]), pk2(s1[8 * s + 2], s1[8 * s + 3]), pk2(s1[8 * s + 4], s1[8 * s + 5]), pk2(s1[8 * s + 6], s1[8 * s + 7])}); }
#pragma unroll
            for (int kb = 0; kb < 2; ++kb)
#pragma unroll
                for (int s = 0; s < 2; ++s) { const LAS unsigned char* vp = Vb + (32 * kb + 16 * s + 4 * hh + (i16 >> 2)) * 272 + blk * 32 + (i16 & 3) * 8;
#pragma unroll
                    for (int db = 0; db < 4; ++db) { const s16x4 lo = vtr(vp + db * 64), hi = vtr(vp + db * 64 + 8 * 272);
                        const bf16x8 vf = (bf16x8){lo[0], lo[1], lo[2], lo[3], hi[0], hi[1], hi[2], hi[3]};
                        o[db] = mfma32(vf, pf[kb][s], o[db]); } }
        }
        __syncthreads();
    }
#undef ATT_LOAD
#undef ATT_STORE
    const float l_tot = l_run + __shfl_xor(l_run, 32);
    LAS float* X = (LAS float*)(lds + A_X) + rg * 4096;
    if (sub == 1) { const float inv = lam / l_tot;
#pragma unroll
        for (int db = 0; db < 4; ++db)
#pragma unroll
            for (int i = 0; i < 16; ++i) X[(db * 16 + i) * 64 + lane] = o[db][i] * inv; }
    __syncthreads();
    if (sub == 0) { const float inv = 1.f / l_tot; float ss = 0.f;
#pragma unroll
        for (int db = 0; db < 4; ++db)
#pragma unroll
            for (int i = 0; i < 16; ++i) { const float v = o[db][i] * inv - X[(db * 16 + i) * 64 + lane]; o[db][i] = v; ss += v * v; }
        ss += __shfl_xor(ss, 32);
        const float rs = rsqrtf(ss * (1.f / 128.f) + 1e-5f) * oscale;
        LAS bf16_t* Y = (LAS bf16_t*)(lds + A_Y) + rg * (32 * 136);
        const LAS float* ngl = (const LAS float*)(lds + A_NG);
#pragma unroll
        for (int db = 0; db < 4; ++db)
#pragma unroll
            for (int i = 0; i < 16; ++i) { const int dv = 32 * db + crow(i, hh); Y[q * 136 + dv] = f2bf(o[db][i] * rs * ngl[dv]); }
        asm volatile("s_waitcnt lgkmcnt(0)" ::: "memory");
#pragma unroll
        for (int k = 0; k < 8; ++k) { const int piece = lane + 64 * k, row = piece >> 4, c16 = piece & 15;
            const u32x4 v = *(const LAS u32x4*)((const LAS unsigned char*)Y + row * 272 + c16 * 16);
            *(u32x4*)(Qd + (size_t)(tok0 + rg * 32 + row) * 1024 + h * 128 + c16 * 8) = v; }
    }
    __syncthreads();
}
DI void attn_phase(const Params& p, int l, LAS unsigned char* lds) {
    const int tid = opaque_tid();
    float d1 = 0.f, d2 = 0.f;
    for (int i = 0; i < 64; ++i) { d1 += p.in[14][l * 64 + i] * p.in[15][l * 64 + i]; d2 += p.in[16][l * 64 + i] * p.in[17][l * 64 + i]; }
    const float lambda_init = (l == 0) ? 0.2f : 0.35550906759096934f;
    const float lam = expf(d1) - expf(d2) + lambda_init;
    if (tid < 128) ((LAS float*)(lds + A_NG))[tid] = p.in[18][l * 128 + tid];
    __syncthreads();
    for (int i = 0; i < 4; ++i)
        for (int vc = blockIdx.x; vc < 256; vc += gridDim.x) {
            const int bh = vc >> 4, s = vc & 15; const int qb = (i == 0) ? s : (i == 1) ? 31 - s : (i == 2) ? 32 + s : 63 - s;
            attn_unit(p, bh >> 3, bh & 7, qb, lam, 1.f - lambda_init, lds);
        }
}

DI void final_norm(const Params& p) {
    const float* rowsq = (const float*)(p.ws + WS_ROWSQ) + 4 * T; const float* g = p.in[26];
    const int gt = blockIdx.x * 512 + opaque_tid();
    for (int i = gt; i < T * 256; i += gridDim.x * 512) { const int row = i >> 8, c = (i & 255) * 4;
        const float rs = rsqrtf(rowsq[row] * (1.f / 1024.f) + EPS);
        f32x4 v = *(f32x4*)(p.out + (size_t)row * 1024 + c); const f32x4 gv = *(const f32x4*)(g + c);
        *(f32x4*)(p.out + (size_t)row * 1024 + c) = v * rs * gv; }
}


DI void gemv2(float* out, int ldo, const float* in, int ldi, const float* W, int ldw, int K, int N, int kchunk) {
    const int tid = opaque_tid(), lane = tid & 63, wave = __builtin_amdgcn_readfirstlane(tid >> 6);
    const int gw = blockIdx.x * 8 + wave, NGW = gridDim.x * 8, nstrip = (N + 63) / 64, nk = K / kchunk;
    for (int job = gw; job < nstrip * nk; job += NGW) {
        const int strip = job % nstrip, kq = job / nstrip, col = strip * 64 + lane; const bool ok = col < N;
        const float* wp = W + (size_t)(kq * kchunk) * ldw + (ok ? col : 0);
        const float* i0 = in + kq * kchunk; const float* i1 = in + ldi + kq * kchunk;
        float a0 = 0.f, a1 = 0.f;
#pragma unroll 8
        for (int k = 0; k < kchunk; ++k) { const float wv = wp[(size_t)k * ldw]; a0 += i0[k] * wv; a1 += i1[k] * wv; }
        if (ok) { atomicAdd(out + col, a0); atomicAdd(out + ldo + col, a1); }
    }
}
DI void side_init(const Params& p) {
    const int tid = opaque_tid(), lane = tid & 63, wave = __builtin_amdgcn_readfirstlane(tid >> 6);
    const int gt = blockIdx.x * 512 + tid, NTH = gridDim.x * 512, gw = blockIdx.x * 8 + wave, NGW = gridDim.x * 8;
    float* z = (float*)(p.ws + SB_PROJ);
    for (int i = gt; i < (int)((SB_END - SB_PROJ) / 4); i += NTH) z[i] = 0.f;
    float* hn = (float*)(p.ws + SB_HN);
    for (int r = gw; r < 128; r += NGW) { const int row = (r >> 6) * SEQ + (r & 63);
        const f32x4* xr = (const f32x4*)(p.in[0] + (size_t)row * 1024) + lane; f32x4 v[4]; float s2 = 0.f;
#pragma unroll
        for (int j = 0; j < 4; ++j) { v[j] = xr[64 * j]; s2 += v[j][0] * v[j][0] + v[j][1] * v[j][1] + v[j][2] * v[j][2] + v[j][3] * v[j][3]; }
        const float rs = rsqrtf(wave_sum(s2) * (1.f / 1024.f) + EPS);
#pragma unroll
        for (int j = 0; j < 4; ++j) { const f32x4 g = *((const f32x4*)p.in[2] + lane + 64 * j); *((f32x4*)(hn + (size_t)r * 1024) + lane + 64 * j) = v[j] * rs * g; } }
}
DI void side_kv(const Params& p) {
    const int tid = opaque_tid(), lane = tid & 63, wave = __builtin_amdgcn_readfirstlane(tid >> 6);
    const int gw = blockIdx.x * 8 + wave, NGW = gridDim.x * 8;
    const float* hn = (const float*)(p.ws + SB_HN); float* kv = (float*)(p.ws + SB_KV);
    for (int job = gw; job < 2048; job += NGW) {
        const int strip = job & 31, grp = (job >> 5) & 15, kq = job >> 9, col = strip * 64 + lane;
        const float* wp = p.in[3] + (size_t)(kq * 256) * INC + 9264 + col; const float* hp = hn + (size_t)(grp * 8) * 1024 + kq * 256;
        float a[8];
#pragma unroll
        for (int t = 0; t < 8; ++t) a[t] = 0.f;
#pragma unroll 4
        for (int k = 0; k < 256; ++k) { const float wv = wp[(size_t)k * INC];
#pragma unroll
            for (int t = 0; t < 8; ++t) a[t] += hp[t * 1024 + k] * wv; }
#pragma unroll
        for (int t = 0; t < 8; ++t) atomicAdd(kv + (size_t)(grp * 8 + t) * 2048 + col, a[t]);
    }
}
DI void rope_cs(int pos, int i, float& cs, float& sn) {
    const double cf[8] = {0.15915494309189535, 0.03086376340470123, 0.005985185712713705, 0.001160663641240061, 0.00022507907903927653, 4.364795279280289e-05, 8.464330808241401e-06, 1.6414262627950345e-06};
    double c = cf[0];
#pragma unroll
    for (int q = 1; q < 8; ++q) c = (i == q) ? cf[q] : c;
    double rv = (double)pos * c; rv -= floor(rv); const float fr = (float)rv; sn = __builtin_amdgcn_sinf(fr); cs = __builtin_amdgcn_cosf(fr);
}
DI void side_mixers(const Params& p, int b, LAS unsigned char* lds) {
    const int tid = opaque_tid();
    const float* P = (const float*)(p.ws + SB_PROJ) + b * 14384; float* Y = (float*)(p.ws + SB_Y) + b * 4096; float* KV = (float*)(p.ws + SB_KV) + (size_t)b * 64 * 2048;
    LAS float* cx = (LAS float*)lds; LAS float* ypre = cx + 3072; LAS float* lg = ypre + 2048; LAS float* pr = lg + 1024; LAS float* red = pr + 1024; LAS float* qr = red + 64;
    const int* pos = (const int*)p.in[1] + b * SEQ;
    __syncthreads();
    if (tid < 4) { float qk = 0.f, vv = 0.f; for (int d = 0; d < 128; ++d) qk += P[tid * 128 + d] * P[512 + tid * 128 + d]; for (int d = 0; d < 256; ++d) { const float v = P[1024 + tid * 256 + d]; vv += v * v; }
        red[tid] = qk * 0.08838834764831845f; red[4 + tid] = vv * (1.f / 256.f); }
    for (int c = tid; c < 3072; c += 512) cx[c] = siluf_(p.in[9][c] + p.in[8][3 * 3072 + c] * P[5136 + c]);
    if (tid < 32) red[8 + tid] = softplusf_(P[8208 + tid] + p.in[10][tid]);
    __syncthreads();
    for (int i = tid; i < 1024; i += 512) { const int h = i >> 8; const float p00 = red[h], o = p00 * P[1024 + i];
        Y[i] = o * rsqrtf(p00 * p00 * red[4 + h] + EPS) * p.in[7][i & 255] * siluf_(P[2064 + i]); }
    if (tid < 4) { float cb = 0.f; for (int n = 0; n < 128; ++n) cb += cx[2560 + tid * 128 + n] * cx[2048 + tid * 128 + n]; red[40 + tid] = cb; }
    __syncthreads();
    for (int i = tid; i < 2048; i += 512) { const int head = i >> 6; ypre[i] = (red[40 + (head >> 3)] * red[8 + head] + p.in[12][head]) * cx[i] * siluf_(P[3088 + i]); }
    __syncthreads();
    if (tid < 4) { float ss = 0.f; for (int i = 0; i < 512; ++i) ss += ypre[tid * 512 + i] * ypre[tid * 512 + i]; red[44 + tid] = rsqrtf(ss * (1.f / 512.f) + EPS); }
    __syncthreads();
    for (int i = tid; i < 2048; i += 512) Y[1024 + i] = ypre[i] * red[44 + (i >> 9)] * p.in[13][i];
    for (int i = tid; i < 1024; i += 512) { const int d = i & 63; float v = P[8240 + i];
        if (d < 16) { float cs, sn; rope_cs(pos[0], d & 7, cs, sn); const float o = (d < 8) ? P[8240 + i + 8] : P[8240 + i - 8]; v = (d < 8) ? v * cs - o * sn : v * cs + o * sn; }
        qr[i] = v; }
    for (int it = tid; it < 8192; it += 512) { const int j = it >> 7, hs = (it >> 3) & 15, d = it & 7; float cs, sn; rope_cs(pos[j], d, cs, sn);
        float* kp = KV + (size_t)j * 2048 + hs * 64 + d; const float k1 = kp[0], k2 = kp[8]; kp[0] = k1 * cs - k2 * sn; kp[8] = k2 * cs + k1 * sn; }
    __threadfence_block();
    __syncthreads();
    for (int i = tid; i < 1024; i += 512) { const int hs = i >> 6, j = i & 63; const float* kp = KV + (size_t)j * 2048 + hs * 64; float sacc = 0.f;
        for (int d = 0; d < 64; ++d) sacc += qr[hs * 64 + d] * kp[d];
        lg[i] = sacc * 0.125f; }
    __syncthreads();
    if (tid < 16) { float m = -1e30f; for (int j = 0; j < 64; ++j) m = fmaxf(m, lg[tid * 64 + j]); float sum = 0.f; for (int j = 0; j < 64; ++j) { const float e = expf(lg[tid * 64 + j] - m); pr[tid * 64 + j] = e; sum += e; }
        const float inv = 1.f / sum; for (int j = 0; j < 64; ++j) pr[tid * 64 + j] *= inv; }
    __syncthreads();
    float d1 = 0.f, d2 = 0.f;
    for (int i = 0; i < 64; ++i) { d1 += p.in[14][i] * p.in[15][i]; d2 += p.in[16][i] * p.in[17][i]; }
    const float lam = expf(d1) - expf(d2) + 0.2f;
    for (int i = tid; i < 1024; i += 512) { const int h = i >> 7; float o = 0.f;
        for (int j = 0; j < 64; ++j) o += (pr[(2 * h) * 64 + j] - lam * pr[(2 * h + 1) * 64 + j]) * KV[(size_t)j * 2048 + 1024 + i];
        ypre[i] = o; }
    __syncthreads();
    if (tid < 8) { float ss = 0.f; for (int i = 0; i < 128; ++i) ss += ypre[tid * 128 + i] * ypre[tid * 128 + i]; red[48 + tid] = rsqrtf(ss * (1.f / 128.f) + 1e-5f) * 0.8f; }
    __syncthreads();
    for (int i = tid; i < 1024; i += 512) Y[3072 + i] = ypre[i] * red[48 + (i >> 7)] * p.in[18][i & 127];
    float* G = (float*)(p.ws + SB_GATE) + b * 3072;
    for (int i = tid; i < 3072; i += 512) G[i] = sigmoidf_(P[11312 + i] + p.in[4][i]);
    __syncthreads();
}
DI void side_glue(const Params& p, int step, int b, LAS unsigned char* lds) {
    const int tid = opaque_tid(); unsigned char* ws = p.ws; LAS float* red = (LAS float*)lds;
    if (step == 4) {
        const float* G = (const float*)(ws + SB_GATE) + b * 3072; const float* BR = (const float*)(ws + SB_BR) + b * 3072;
        for (int c = tid; c < 1024; c += 512) { ((float*)(ws + SB_MIX))[b * 1024 + c] = G[c] * BR[c] + G[1024 + c] * BR[1024 + c] + G[2048 + c] * BR[2048 + c];
            ((float*)(ws + SB_XM))[b * 1024 + c] = p.in[0][(size_t)b * SEQ * 1024 + c]; }
    } else if (step == 6 || step == 100) {
        const float* src = (const float*)(ws + (step == 6 ? SB_XM : SB_X1)) + b * 1024; float* dst = (float*)(ws + (step == 6 ? SB_H2 : SB_HN1)) + b * 1024;
        const float* g = step == 6 ? p.in[23] : p.in[2] + 1024;
        __syncthreads();
        float s2 = 0.f; for (int c = tid; c < 1024; c += 512) s2 += src[c] * src[c];
        s2 = wave_sum(s2); if ((tid & 63) == 0) red[tid >> 6] = s2;
        __syncthreads();
        float tot = 0.f; for (int w = 0; w < 8; ++w) tot += red[w];
        const float rs = rsqrtf(tot * (1.f / 1024.f) + EPS);
        for (int c = tid; c < 1024; c += 512) dst[c] = src[c] * rs * g[c];
        if (step == 100) { const size_t row = (size_t)b * SEQ; bf16_t* xb = (bf16_t*)(ws + WS_XB);
            for (int c = tid; c < 1024; c += 512) { p.out[row * 1024 + c] = src[c]; xb[row * 1024 + c] = f2bf(src[c]); }
            if (tid == 0) ((float*)(ws + WS_ROWSQ))[2 * T + row] = tot; }
        __syncthreads();
    } else if (step == 8) {
        const float* up = (const float*)(ws + SB_UP) + b * 4096; float* hh = (float*)(ws + SB_HH) + b * 4096;
        for (int c = tid; c < 4096; c += 512) { const float r = fmaxf(up[c], 0.f); hh[c] = r * r; }
        for (int c = tid; c < 1024; c += 512) ((float*)(ws + SB_X1))[b * 1024 + c] = ((const float*)(ws + SB_XM))[b * 1024 + c];
    }
}
DI void side_phase(const Params& p, int l, int k, LAS unsigned char* lds) {
    unsigned char* ws = p.ws; const int bid = blockIdx.x;
    if (l == 0) {
        if (k == 0) side_init(p);
        else if (k == 1) { gemv2((float*)(ws + SB_PROJ), 14384, (const float*)(ws + SB_HN), 64 * 1024, p.in[3], INC, 1024, INC, 128); side_kv(p); }
        else if (k == 2) { if (bid < 2) side_mixers(p, bid, lds); }
        else if (k == 3) { float* br = (float*)(ws + SB_BR); const float* y = (const float*)(ws + SB_Y);
            gemv2(br, 3072, y, 4096, p.in[19], 1024, 1024, 1024, 128); gemv2(br + 1024, 3072, y + 1024, 4096, p.in[20], 1024, 2048, 1024, 128); gemv2(br + 2048, 3072, y + 3072, 4096, p.in[21], 1024, 1024, 1024, 128); }
        else if (k == 4) { if (bid < 2) side_glue(p, 4, bid, lds); }
        else if (k == 5) gemv2((float*)(ws + SB_XM), 1024, (const float*)(ws + SB_MIX), 1024, p.in[22], 1024, 1024, 1024, 128);
        else if (k == 6) { if (bid < 2) side_glue(p, 6, bid, lds); }
        else if (k == 7) gemv2((float*)(ws + SB_UP), 4096, (const float*)(ws + SB_H2), 1024, p.in[24], 4096, 1024, 4096, 128);
        else if (k == 8) { if (bid < 2) side_glue(p, 8, bid, lds); }
        else if (k == 9) gemv2((float*)(ws + SB_X1), 1024, (const float*)(ws + SB_HH), 4096, p.in[25], 1024, 4096, 1024, 128);
    } else {
        if (k == 0) { if (bid < 2) side_glue(p, 100, bid, lds); }
        else if (k == 1) gemv2((float*)(ws + SB_QK1), 1024, (const float*)(ws + SB_HN1), 1024, p.in[3] + (size_t)1024 * INC, INC, 1024, 1024, 128);
    }
}


DI void grid_bar(unsigned* ctr, unsigned target) {
    asm volatile("s_waitcnt vmcnt(0)" ::: "memory");
    __syncthreads();
    if (threadIdx.x == 0) {
        __builtin_amdgcn_fence(__ATOMIC_RELEASE, "agent");
        asm volatile("s_waitcnt vmcnt(0)" ::: "memory");
        __hip_atomic_fetch_add(ctr, 1u, __ATOMIC_RELAXED, __HIP_MEMORY_SCOPE_AGENT);
        while (__hip_atomic_load(ctr, __ATOMIC_RELAXED, __HIP_MEMORY_SCOPE_AGENT) < target) __builtin_amdgcn_s_sleep(8);
        __builtin_amdgcn_fence(__ATOMIC_ACQUIRE, "agent");
        asm volatile("s_waitcnt vmcnt(0)" ::: "memory");
    }
    __syncthreads();
}

constexpr int NPHASE = 31, PPL = 15;
#ifndef PH_MASK
#define PH_MASK 0xFFFFFFFFu
#endif
#define EN(k_) ((PH_MASK >> (k_)) & 1u)
constexpr int LDS_BYTES = 147456;
template <bool COOP> __global__ void __launch_bounds__(512, 2) mk(Params p) {
    extern __shared__ __attribute__((aligned(16))) unsigned char lds_raw[];
    LAS unsigned char* lds = (LAS unsigned char*)lds_raw;
    unsigned char* ws = p.ws;
    float* rowsq = (float*)(ws + WS_ROWSQ);
    bf16_t* xb = (bf16_t*)(ws + WS_XB); bf16_t* mixb = (bf16_t*)(ws + WS_MIXB); bf16_t* R = (bf16_t*)(ws + WS_R);
    const unsigned char* wt = ws + WS_WT;
    const int G = gridDim.x, bid = blockIdx.x;
    for (int ph = p.ph_lo; ph < p.ph_hi; ++ph) {
        if (ph == 30) { final_norm(p); }
        else {
            const int l = ph / PPL, k = ph % PPL;
            if (EN(0) && k == 0) phase_prep(p, l, lds);
            else if (k == 1 || k == 6) {
                const bool gd = (k == 1);
                pg8::Gemm g{xb, (const bf16_t*)(wt + (gd ? WT_GD : WT_S)), T, gd ? 8448 : 6144, 1024, 1024, 1024};
                pg8::StaticOrder S; S.init(T, g.N, G, bid);
                EpiIn E{R, rowsq + (2 * l) * T, (float*)(ws + WS_SMALL), gd ? 32 : -1, gd ? 3 : 5, gd ? 7 : -1,
                        p.in[4] + l * 3072 + (gd ? 0 : 1024), p.in[4] + l * 3072 + 2048};
                pg8::gemm_phase(lds, g, S, E);
            }
            else if (EN(2) && k == 2) { rope_pass(p); for (int un = bid; un < 256; un += G) gla_unit<1>(p, l, un, lds); }
            else if (EN(3) && k == 3) { gla_scan(p); attn_phase(p, l, lds); }
            else if (EN(4) && k == 4) { for (int un = bid; un < 256; un += G) gla_unit<3>(p, l, un, lds); }
            else if (k == 5 || k == 11) {
                const int nrun = (k == 5) ? 2 : 4;
                for (int r = 0; r < nrun; ++r) {
                    pg8::Gemm g; EpiMix E;
                    if (k == 5) {
                        g = pg8::Gemm{R + (size_t)(r == 0 ? 2 : 4) * (BLK / 2), (const bf16_t*)(wt + (r == 0 ? WT_GLA : WT_DIFF)), T, 1024, 1024, 1024, 1024};
                        E = EpiMix{mixb, R + (size_t)(r == 0 ? 3 : 7) * (BLK / 2), nullptr, 0, r == 0 ? 1 : 0};
                    } else {
                        g = pg8::Gemm{R + (size_t)(r >> 1) * (BLK / 2) + (r & 1) * 512, (const bf16_t*)(wt + WT_SSM) + r * 512, T, 1024, 512, 1024, 2048};
                        E = EpiMix{mixb, R + (size_t)5 * (BLK / 2), (const float*)(ws + WS_SSQ), r, 0};
                    }
                    pg8::StaticOrder S; S.init(T, 1024, G, bid);
                    pg8::gemm_phase(lds, g, S, E);
                }
            }
            else if (k == 7) { conv_bc(p, l); }
            else if (k == 8) { for (int un = bid; un < 2048; un += G) ssd_unit<1>(p, l, un, lds); }
            else if (k == 9) { ssd_scan(p); }
            else if (k == 10) { for (int un = bid; un < 2048; un += G) ssd_unit<3>(p, l, un, lds); }
            else if (k == 12 || k == 14) {
                const bool dn = (k == 14);
                pg8::Gemm g{dn ? R : mixb, (const bf16_t*)(wt + (dn ? WT_DOWN : WT_OUT)), T, 1024, dn ? 4096 : 1024, dn ? 4096 : 1024, dn ? 4096 : 1024};
                pg8::StaticOrder S; S.init(T, 1024, G, bid);
                EpiRes E{(l == 0 && !dn) ? p.in[0] : p.out, p.out, xb, rowsq + (2 * l + (dn ? 2 : 1)) * T};
                pg8::gemm_phase(lds, g, S, E);
            }
            else if (k == 13) {
                pg8::Gemm g{xb, (const bf16_t*)(wt + WT_UP), T, 4096, 1024, 1024, 1024};
                pg8::StaticOrder S; S.init(T, 4096, G, bid);
                EpiUp E{R, rowsq + (2 * l + 1) * T};
                pg8::gemm_phase(lds, g, S, E);
            }
        }
        if (ph < 30) side_phase(p, ph / PPL, ph % PPL, lds);
        if (COOP) { if (ph + 1 < p.ph_hi) { if (ph == p.ph_lo) cg::this_grid().sync(); else grid_bar((unsigned*)(ws + WS_BAR), (unsigned)(ph - p.ph_lo) * (unsigned)gridDim.x); } }
    }
}

extern "C" void kernel_launch(void* const* d_in, const int* in_sizes, int n_in, void* d_out, int out_size, void* d_ws, size_t ws_size, hipStream_t stream) {
    static int grid = 0;
    if (grid == 0) {
        if (n_in != 27 || out_size != T * 1024 || ws_size < WS_END) { fprintf(stderr, "kernel_launch: unexpected shapes/ws (n_in %d out %d ws %zu need %zu)\n", n_in, out_size, ws_size, (size_t)WS_END); grid = -1; return; }
        int dev = 0, cus = 0, per_cu = 0;
        (void)hipGetDevice(&dev); (void)hipDeviceGetAttribute(&cus, hipDeviceAttributeMultiprocessorCount, dev);
        (void)hipFuncSetAttribute((const void*)mk<true>, hipFuncAttributeMaxDynamicSharedMemorySize, LDS_BYTES);
        (void)hipOccupancyMaxActiveBlocksPerMultiprocessor(&per_cu, (const void*)mk<true>, 512, LDS_BYTES);
        if (per_cu < 1) fprintf(stderr, "kernel_launch: occupancy query says %d blocks/CU\n", per_cu);
        (void)hipGetLastError();
        grid = cus;
    }
    if (grid < 0) return;
    Params p{};
    for (int i = 0; i < 27; ++i) p.in[i] = (const float*)d_in[i];
    p.out = (float*)d_out; p.ws = (unsigned char*)d_ws;
    p.ph_lo = 0; p.ph_hi = NPHASE;
    (void)hipMemsetAsync((unsigned char*)d_ws + WS_BAR, 0, 256, stream);
    void* args[] = {&p};
    hipError_t e = hipLaunchCooperativeKernel((const void*)mk<true>, dim3(grid), dim3(512), args, LDS_BYTES, stream);
    if (e != hipSuccess) fprintf(stderr, "cooperative launch failed: %s (grid %d)\n", hipGetErrorString(e), grid);
}
```

```cpp
#include <hip/hip_runtime.h>
#include <hip/hip_cooperative_groups.h>
#include <cstdio>
#include <cstdint>
namespace cg = cooperative_groups;

#define LAS __attribute__((address_space(3)))
#define DI __device__ __forceinline__
typedef unsigned short bf16_t;
typedef short bf16x8 __attribute__((ext_vector_type(8)));
typedef short s16x4 __attribute__((ext_vector_type(4)));
typedef float f32x4 __attribute__((ext_vector_type(4)));
typedef float f32x16 __attribute__((ext_vector_type(16)));
typedef unsigned u32x4 __attribute__((ext_vector_type(4)));
typedef unsigned u32x2 __attribute__((ext_vector_type(2)));
typedef float f32x2_t __attribute__((ext_vector_type(2)));
typedef __bf16 bf16x2_t __attribute__((ext_vector_type(2)));

DI unsigned pk2(float lo, float hi) { f32x2_t v = {lo, hi}; bf16x2_t b = __builtin_convertvector(v, bf16x2_t); return __builtin_bit_cast(unsigned, b); }
DI bf16_t f2bf(float f) { return (bf16_t)(pk2(f, 0.f) & 0xffffu); }
DI float bf2f(unsigned b) { return __uint_as_float(b << 16); }
DI float bflo(unsigned w) { return __uint_as_float(w << 16); }
DI float bfhi(unsigned w) { return __uint_as_float(w & 0xffff0000u); }
DI f32x4 mfma16(bf16x8 a, bf16x8 b, f32x4 c) { return __builtin_amdgcn_mfma_f32_16x16x32_bf16(a, b, c, 0, 0, 0); }
DI f32x16 mfma32(bf16x8 a, bf16x8 b, f32x16 c) { return __builtin_amdgcn_mfma_f32_32x32x16_bf16(a, b, c, 0, 0, 0); }
DI float sigmoidf_(float x) { return 1.f / (1.f + __expf(-x)); }
DI float siluf_(float x) { return x / (1.f + __expf(-x)); }
DI int opaque_tid() { int t = threadIdx.x; asm volatile("" : "+v"(t)); return t; }
DI int crow(int r, int hi) { return (r & 3) + 8 * (r >> 2) + 4 * hi; }

constexpr int T = 16384, SEQ = 8192, DM = 1024, DFF = 4096, INC = 14384;
constexpr float EPS = 1e-6f;
constexpr size_t MiB = 1u << 20;
constexpr size_t WS_ROWSQ = 0;
constexpr size_t WS_BAR = 448 * 1024;
constexpr size_t WS_DECG = 512 * 1024;
constexpr size_t WS_DECS = 768 * 1024;
constexpr size_t WS_SSQ = 1 * MiB;
constexpr size_t WS_SMALL = 2 * MiB;
constexpr size_t WS_XB = 6 * MiB;
constexpr size_t WS_MIXB = 38 * MiB;
constexpr size_t WS_WT = 70 * MiB;
constexpr size_t WT_GD = 0, WT_S = WT_GD + (size_t)8448 * 1024 * 2, WT_GLA = WT_S + (size_t)6144 * 1024 * 2, WT_SSM = WT_GLA + 2 * MiB,
                 WT_DIFF = WT_SSM + 4 * MiB, WT_OUT = WT_DIFF + 2 * MiB, WT_UP = WT_OUT + 2 * MiB, WT_DOWN = WT_UP + 8 * MiB, WT_END = WT_DOWN + 8 * MiB;
static_assert(WT_END <= 56 * MiB, "wt");
constexpr size_t WS_R = 126 * MiB;
constexpr size_t BLK = 32 * MiB;
constexpr size_t WS_STG = WS_R + 8 * BLK;
constexpr size_t WS_STS = WS_R + 6 * BLK;
constexpr size_t WS_SIDE = WS_R + 9 * BLK;
constexpr size_t SB_HN = WS_SIDE, SB_PROJ = SB_HN + 512 * 1024, SB_KV = SB_PROJ + 128 * 1024, SB_Y = SB_KV + 1024 * 1024, SB_GATE = SB_Y + 32 * 1024,
                 SB_BR = SB_GATE + 32 * 1024, SB_MIX = SB_BR + 32 * 1024, SB_XM = SB_MIX + 8192, SB_H2 = SB_XM + 8192, SB_UP = SB_H2 + 8192,
                 SB_HH = SB_UP + 32768, SB_X1 = SB_HH + 32768, SB_HN1 = SB_X1 + 8192, SB_QK1 = SB_HN1 + 8192, SB_END = SB_QK1 + 8192;
constexpr size_t WS_END = WS_SIDE + 2 * MiB;
static_assert(SB_END <= WS_END, "side");

struct Params {
    const float* in[27];
    float* out; unsigned char* ws;
    int ph_lo, ph_hi;
};

namespace pg8 {
constexpr int BM = 256, BK = 64, HALF = 128, HTB = HALF * BK * 2, STAGE_BYTES = 8 * HTB, NXCD = 8, WGM = 8;
__host__ __device__ __forceinline__ int lds_byte(int r, int c) { const int st = (r >> 4) * 2 + (c >> 5), rr = r & 15, cc = c & 31, ob = rr * 64 + cc * 2; return st * 1024 + (ob ^ (((ob >> 9) & 1) << 5)); }
__host__ __device__ __forceinline__ void stage_rc(int b, int& R, int& C) { const int st = b / 1024, sb = b % 1024, swz = sb ^ (((sb >> 9) & 1) << 5); R = (st >> 1) * 16 + swz / 64; C = (st & 1) * 32 + (swz % 64) / 2; }
struct Unit { int pm, pn; };
struct Gemm { const bf16_t* A; const bf16_t* Bt; int M, N, K, lda, ldb; };
struct StaticOrder {
    int nM, nN, nwg, G, c;
    __host__ __device__ void init(int M, int N, int G_, int c_) { nM = M / BM; nN = N / BM; nwg = nM * nN; G = G_; c = c_; }
    __host__ __device__ bool next(int i, Unit& u) const {
        const long L = (long)i * G + c; if (L >= nwg) return false;
        int wgid = (int)L; { const int q = nwg / NXCD, r = nwg % NXCD, xcd = wgid % NXCD, off = wgid / NXCD; wgid = (xcd < r ? xcd * (q + 1) : r * (q + 1) + (xcd - r) * q) + off; }
        const int nig = WGM * nN, gid = wgid / nig, fm = gid * WGM, gsz = (nM - fm) < WGM ? (nM - fm) : WGM;
        u.pm = fm + ((wgid % nig) % gsz); u.pn = (wgid % nig) / gsz; return true;
    }
};
template <class Epi, class Sched>
__device__ __forceinline__ void gemm_phase(LAS unsigned char* lds, const Gemm g, const Sched& S, const Epi& E) {
    const int tid = opaque_tid(), wid = __builtin_amdgcn_readfirstlane(tid >> 6), lane = tid & 63, wr = wid >> 2, wc = wid & 3, fr = lane & 15, fq = lane >> 4;
    const int K = g.K, nt = K / BK;
    unsigned voffA[2], voffB[2];
#pragma unroll
    for (int i = 0; i < 2; ++i) { int R, C; stage_rc(tid * 16 + i * 8192, R, C);
        voffA[i] = (unsigned)(R * g.lda + C) * 2u; voffB[i] = (unsigned)(R * g.ldb + C) * 2u; }
    const size_t kstep = (size_t)(BK * 2);
    const size_t hstepA = (size_t)HALF * g.lda * 2, hstepB = (size_t)HALF * g.ldb * 2;
    const size_t tstepA = 2 * hstepA, tstepB = 2 * hstepB;
    const unsigned ldsw = (unsigned)wid * 1024u;
    const int aoff = lds_byte(wr * 64 + fr, fq * 8), boff = lds_byte(wc * 32 + fr, fq * 8);
#define PG8_SA(b, h) (((b) * 2 + (h)) * HTB)
#define PG8_SB(b, h) ((4 + (b) * 2 + (h)) * HTB)
#define PG8_STAGE(bufoff, gbase, voff) do { _Pragma("unroll") for (int _i = 0; _i < 2; ++_i) \
        __builtin_amdgcn_global_load_lds((const unsigned*)((const char*)(gbase) + (voff)[_i]), (LAS unsigned*)(lds + (bufoff) + ldsw + _i * 8192), 16, 0, 0); } while (0)
#define PG8_LDA(dst, b, h) do { _Pragma("unroll") for (int m = 0; m < 4; ++m) _Pragma("unroll") for (int k = 0; k < 2; ++k) dst[m][k] = *(const LAS bf16x8*)(lds + PG8_SA(b, h) + aoff + m * 2048 + k * 1024); } while (0)
#define PG8_LDB(dst, b, h) do { _Pragma("unroll") for (int n = 0; n < 2; ++n) _Pragma("unroll") for (int k = 0; k < 2; ++k) dst[n][k] = *(const LAS bf16x8*)(lds + PG8_SB(b, h) + boff + n * 2048 + k * 1024); } while (0)
#define PG8_MMA(ai, bj, At, Bt) do { __builtin_amdgcn_s_setprio(1); _Pragma("unroll") for (int m = 0; m < 4; ++m) _Pragma("unroll") for (int n = 0; n < 2; ++n) _Pragma("unroll") for (int k = 0; k < 2; ++k) \
        acc[ai][bj][m][n] = __builtin_amdgcn_mfma_f32_16x16x32_bf16(Bt[n][k], At[m][k], acc[ai][bj][m][n], 0, 0, 0); __builtin_amdgcn_s_setprio(0); } while (0)
#define PG8_WAIT_V(n) asm volatile("s_waitcnt vmcnt(" #n ")" ::: "memory")
#define PG8_WAIT_L(n) asm volatile("s_waitcnt lgkmcnt(" #n ")" ::: "memory")
#define PG8_BAR __builtin_amdgcn_s_barrier()
#define PG8_SCHED __builtin_amdgcn_sched_barrier(0)
    Unit cur, nxt; int ui = 0;
    if (!S.next(0, cur)) return;
    f32x4 acc[2][2][4][2];
#pragma unroll
    for (int a = 0; a < 2; ++a)
#pragma unroll
        for (int b = 0; b < 2; ++b)
#pragma unroll
            for (int m = 0; m < 4; ++m)
#pragma unroll
                for (int n = 0; n < 2; ++n) acc[a][b][m][n] = (f32x4){0.f, 0.f, 0.f, 0.f};
    bf16x8 At[4][2], B0[2][2], B1[2][2];
    const char* cA = (const char*)g.A + (size_t)cur.pm * tstepA; const char* cB = (const char*)g.Bt + (size_t)cur.pn * tstepB;
    PG8_STAGE(PG8_SB(0, 0), cB, voffB); PG8_STAGE(PG8_SB(0, 1), cB + hstepB, voffB); PG8_STAGE(PG8_SA(0, 0), cA, voffA); PG8_STAGE(PG8_SA(0, 1), cA + hstepA, voffA);
    if (wr == 1) PG8_BAR;
    PG8_WAIT_V(2); PG8_BAR;
    PG8_STAGE(PG8_SB(1, 0), cB + kstep, voffB); PG8_STAGE(PG8_SA(1, 0), cA + kstep, voffA); PG8_STAGE(PG8_SB(1, 1), cB + hstepB + kstep, voffB);
    PG8_WAIT_V(6); PG8_BAR;
    for (;;) {
        const bool has_next = S.next(ui + 1, nxt);
        const char* nA = has_next ? (const char*)g.A + (size_t)nxt.pm * tstepA : cA; const char* nB = has_next ? (const char*)g.Bt + (size_t)nxt.pn * tstepB : cB;
        for (int t = 0; t < nt; t += 2) {
            const bool last = (t == nt - 2);
            const char* a1 = cA + (size_t)(t + 1) * kstep;
            const char* a2 = last ? nA : cA + (size_t)(t + 2) * kstep; const char* b2 = last ? nB : cB + (size_t)(t + 2) * kstep;
            const char* a3 = a2 + kstep; const char* b3 = b2 + kstep;
            PG8_LDB(B0, 0, 0); PG8_LDB(B1, 0, 1); PG8_SCHED; PG8_LDA(At, 0, 0); PG8_STAGE(PG8_SA(1, 1), a1 + hstepA, voffA);
            PG8_WAIT_V(8); PG8_WAIT_L(0); PG8_BAR; PG8_MMA(0, 0, At, B0); PG8_MMA(0, 1, At, B1); PG8_BAR; PG8_SCHED;
            PG8_LDA(At, 0, 1); PG8_STAGE(PG8_SB(0, 0), b2, voffB); PG8_STAGE(PG8_SB(0, 1), b2 + hstepB, voffB); PG8_STAGE(PG8_SA(0, 0), a2, voffA);
            PG8_WAIT_V(8); PG8_WAIT_L(0); PG8_BAR; PG8_MMA(1, 0, At, B0); PG8_MMA(1, 1, At, B1); PG8_BAR; PG8_SCHED;
            PG8_LDB(B0, 1, 0); PG8_LDB(B1, 1, 1); PG8_SCHED; PG8_LDA(At, 1, 0); PG8_STAGE(PG8_SA(0, 1), a2 + hstepA, voffA);
            PG8_WAIT_V(8); PG8_WAIT_L(0); PG8_BAR; PG8_MMA(0, 0, At, B0); PG8_MMA(0, 1, At, B1); PG8_BAR; PG8_SCHED;
            PG8_LDA(At, 1, 1); PG8_STAGE(PG8_SB(1, 0), b3, voffB); PG8_STAGE(PG8_SB(1, 1), b3 + hstepB, voffB); PG8_STAGE(PG8_SA(1, 0), a3, voffA);
            PG8_WAIT_V(8); PG8_WAIT_L(0); PG8_BAR; PG8_MMA(1, 0, At, B0); PG8_MMA(1, 1, At, B1); PG8_BAR; PG8_SCHED;
        }
        if (wr == 0) PG8_BAR;
        E(acc, cur, wr, wc, fr, fq);
        if (!has_next) break;
#pragma unroll
        for (int a = 0; a < 2; ++a)
#pragma unroll
            for (int b = 0; b < 2; ++b)
#pragma unroll
                for (int m = 0; m < 4; ++m)
#pragma unroll
                    for (int n = 0; n < 2; ++n) acc[a][b][m][n] = (f32x4){0.f, 0.f, 0.f, 0.f};
        cur = nxt; cA = nA; cB = nB; ++ui;
        if (wr == 1) PG8_BAR;
    }
    PG8_WAIT_V(0);
    PG8_BAR;
#undef PG8_SA
#undef PG8_SB
#undef PG8_STAGE
#undef PG8_LDA
#undef PG8_LDB
#undef PG8_MMA
#undef PG8_WAIT_V
#undef PG8_WAIT_L
#undef PG8_BAR
#undef PG8_SCHED
}
}

typedef f32x4 Acc[2][2][4][2];
#define EPI_LOOP(body) \
    _Pragma("unroll") for (int ai = 0; ai < 2; ++ai) _Pragma("unroll") for (int m = 0; m < 4; ++m) { const int row = u.pm * 256 + ai * 128 + wr * 64 + m * 16 + fr; \
    _Pragma("unroll") for (int bj = 0; bj < 2; ++bj) _Pragma("unroll") for (int n = 0; n < 2; ++n) { const int ct = bj * 128 + wc * 32 + n * 16 + fq * 4; f32x4 v = acc[ai][bj][m][n]; body } }

struct EpiIn {
    bf16_t* R; const float* rowsq; float* small; int small_tile; int gblkA, gblkB; const float* biasA; const float* biasB;
    DI void operator()(const Acc& acc, const pg8::Unit& u, int wr, int wc, int fr, int fq) const {
        const int blk = u.pn >> 2, cb = (u.pn & 3) * 256;
        if (u.pn == small_tile) {
            EPI_LOOP( if (ct < 64) { const float rs = rsqrtf(rowsq[row] * (1.f / 1024.f) + EPS); *(f32x4*)(small + (size_t)row * 64 + ct) = v * rs; } )
            return;
        }
        bf16_t* dst = R + (size_t)blk * (BLK / 2);
        const float* bias = (blk == gblkA) ? biasA : ((blk == gblkB) ? biasB : nullptr);
        if (bias) {
            EPI_LOOP( const float rs = rsqrtf(rowsq[row] * (1.f / 1024.f) + EPS); const f32x4 bv = *(const f32x4*)(bias + cb + ct); v = v * rs + bv;
                u32x2 w; w.x = pk2(sigmoidf_(v[0]), sigmoidf_(v[1])); w.y = pk2(sigmoidf_(v[2]), sigmoidf_(v[3])); *(u32x2*)(dst + (size_t)row * 1024 + cb + ct) = w; )
        } else {
            EPI_LOOP( const float rs = rsqrtf(rowsq[row] * (1.f / 1024.f) + EPS); v = v * rs;
                u32x2 w; w.x = pk2(v[0], v[1]); w.y = pk2(v[2], v[3]); *(u32x2*)(dst + (size_t)row * 1024 + cb + ct) = w; )
        }
    }
};
struct EpiMix {
    bf16_t* mixb; const bf16_t* gate; const float* ssq; int grp; int first;
    DI void operator()(const Acc& acc, const pg8::Unit& u, int wr, int wc, int fr, int fq) const {
        EPI_LOOP( const int col = u.pn * 256 + ct; const size_t o = (size_t)row * 1024 + col;
            float rs = 1.f; if (ssq) rs = rsqrtf(ssq[(size_t)row * 4 + grp] * (1.f / 512.f) + EPS);
            const u32x2 gw = *(const u32x2*)(gate + o);
            f32x4 r; r[0] = bflo(gw.x) * v[0] * rs; r[1] = bfhi(gw.x) * v[1] * rs; r[2] = bflo(gw.y) * v[2] * rs; r[3] = bfhi(gw.y) * v[3] * rs;
            if (!first) { const u32x2 mw = *(const u32x2*)(mixb + o); r[0] += bflo(mw.x); r[1] += bfhi(mw.x); r[2] += bflo(mw.y); r[3] += bfhi(mw.y); }
            u32x2 w; w.x = pk2(r[0], r[1]); w.y = pk2(r[2], r[3]); *(u32x2*)(mixb + o) = w; )
    }
};
struct EpiRes {
    const float* xold; float* xnew; bf16_t* xb; float* rowsq;
    DI void operator()(const Acc& acc, const pg8::Unit& u, int wr, int wc, int fr, int fq) const {
#pragma unroll
        for (int ai = 0; ai < 2; ++ai)
#pragma unroll
            for (int m = 0; m < 4; ++m) { const int row = u.pm * 256 + ai * 128 + wr * 64 + m * 16 + fr; float ss = 0.f;
#pragma unroll
                for (int bj = 0; bj < 2; ++bj)
#pragma unroll
                    for (int n = 0; n < 2; ++n) { const int col = u.pn * 256 + bj * 128 + wc * 32 + n * 16 + fq * 4; const size_t o = (size_t)row * 1024 + col;
                        f32x4 v = acc[ai][bj][m][n] + *(const f32x4*)(xold + o); *(f32x4*)(xnew + o) = v;
                        u32x2 w; w.x = pk2(v[0], v[1]); w.y = pk2(v[2], v[3]); *(u32x2*)(xb + o) = w;
                        ss += v[0] * v[0] + v[1] * v[1] + v[2] * v[2] + v[3] * v[3]; }
                ss += __shfl_xor(ss, 16); ss += __shfl_xor(ss, 32);
                if (fq == 0) atomicAdd(rowsq + row, ss); }
    }
};
struct EpiUp {
    bf16_t* h; const float* rowsq;
    DI void operator()(const Acc& acc, const pg8::Unit& u, int wr, int wc, int fr, int fq) const {
        EPI_LOOP( const float rs = rsqrtf(rowsq[row] * (1.f / 1024.f) + EPS); v = v * rs;
            f32x4 r; r[0] = fmaxf(v[0], 0.f); r[1] = fmaxf(v[1], 0.f); r[2] = fmaxf(v[2], 0.f); r[3] = fmaxf(v[3], 0.f); r = r * r;
            u32x2 w; w.x = pk2(r[0], r[1]); w.y = pk2(r[2], r[3]); *(u32x2*)(h + (size_t)row * 4096 + u.pn * 256 + ct) = w; )
    }
};

DI int colmap(int kind, int n) {
    if (kind == 1) {
        if (n < 2048) return n;
        if (n < 3072) return 2064 + (n - 2048);
        if (n < 4096) return 11312 + (n - 3072);
        if (n < 5120) return 8240 + (n - 4096);
        if (n < 6144) return 9264 + (n - 5120);
        if (n < 7168) return 10288 + (n - 6144);
        if (n < 8192) return 13360 + (n - 7168);
        const int i = n - 8192; if (i < 16) return 2048 + i; if (i < 48) return 8208 + (i - 16); return -1;
    }
    if (kind == 2) {
        if (n < 2048) return 3088 + n;
        if (n < 5120) return 5136 + (n - 2048);
        return 12336 + (n - 5120);
    }
    return n;
}
DI void tr_item(const float* W, int ldw, int K, bf16_t* WT, const float* kscale, int kind, int kb, int nb, LAS float* scr, int lane) {
    const int k0 = 64 * kb, n0 = 32 * nb; const int sc = colmap(kind, n0 + (lane & 31));
#pragma unroll 8
    for (int i = 0; i < 32; ++i) { const int kk = 2 * i + (lane >> 5); float v = 0.f; if (sc >= 0) { v = W[(size_t)(k0 + kk) * ldw + sc]; if (kscale) v *= kscale[k0 + kk]; } scr[kk * 33 + (lane & 31)] = v; }
    asm volatile("s_waitcnt lgkmcnt(0)" ::: "memory");
    const int c = lane & 7;
#pragma unroll
    for (int j = 0; j < 4; ++j) { const int n = (lane >> 3) + 8 * j; const LAS float* s = scr + (8 * c) * 33 + n;
        u32x4 o; o.x = pk2(s[0 * 33], s[1 * 33]); o.y = pk2(s[2 * 33], s[3 * 33]); o.z = pk2(s[4 * 33], s[5 * 33]); o.w = pk2(s[6 * 33], s[7 * 33]);
        *(u32x4*)(WT + (size_t)(n0 + n) * K + k0 + 8 * c) = o; }
    asm volatile("s_waitcnt lgkmcnt(0)" ::: "memory");
}
DI float wave_sum(float v) {
#pragma unroll
    for (int o = 1; o < 64; o <<= 1) v += __shfl_xor(v, o);
    return v;
}
DI void phase_prep(const Params& p, int l, LAS unsigned char* lds) {
    const int tid = opaque_tid(), lane = tid & 63, wave = __builtin_amdgcn_readfirstlane(tid >> 6);
    const int gw = blockIdx.x * 8 + wave, NGW = gridDim.x * 8;
    LAS float* scr = (LAS float*)(lds + wave * 8704);
    unsigned char* ws = p.ws; bf16_t* wt = (bf16_t*)(ws + WS_WT);
    const float* w_in = p.in[3] + (size_t)l * 1024 * INC;
    constexpr int I0 = 16 * 264, I1 = 16 * 192, I2 = 16 * 32, I3 = 32 * 32, I4 = 16 * 32, I5 = 16 * 32, I6 = 16 * 128, I7 = 64 * 32;
    constexpr int NIT = I0 + I1 + I2 + I3 + I4 + I5 + I6 + I7;
    for (int it = gw; it < NIT; it += NGW) {
        int r = it;
        if (r < I0) { tr_item(w_in, INC, 1024, (bf16_t*)((char*)wt + WT_GD), p.in[2] + l * 1024, 1, r / 264, r % 264, scr, lane); continue; } r -= I0;
        if (r < I1) { tr_item(w_in, INC, 1024, (bf16_t*)((char*)wt + WT_S), p.in[2] + l * 1024, 2, r / 192, r % 192, scr, lane); continue; } r -= I1;
        if (r < I2) { tr_item(p.in[19] + (size_t)l * 1024 * 1024, 1024, 1024, (bf16_t*)((char*)wt + WT_GLA), nullptr, 0, r / 32, r % 32, scr, lane); continue; } r -= I2;
        if (r < I3) { tr_item(p.in[20] + (size_t)l * 2048 * 1024, 1024, 2048, (bf16_t*)((char*)wt + WT_SSM), p.in[13] + l * 2048, 0, r / 32, r % 32, scr, lane); continue; } r -= I3;
        if (r < I4) { tr_item(p.in[21] + (size_t)l * 1024 * 1024, 1024, 1024, (bf16_t*)((char*)wt + WT_DIFF), nullptr, 0, r / 32, r % 32, scr, lane); continue; } r -= I4;
        if (r < I5) { tr_item(p.in[22] + (size_t)l * 1024 * 1024, 1024, 1024, (bf16_t*)((char*)wt + WT_OUT), nullptr, 0, r / 32, r % 32, scr, lane); continue; } r -= I5;
        if (r < I6) { tr_item(p.in[24] + (size_t)l * 1024 * 4096, 4096, 1024, (bf16_t*)((char*)wt + WT_UP), p.in[23] + l * 1024, 0, r / 128, r % 128, scr, lane); continue; } r -= I6;
        tr_item(p.in[25] + (size_t)l * 4096 * 1024, 1024, 4096, (bf16_t*)((char*)wt + WT_DOWN), nullptr, 0, r / 32, r % 32, scr, lane);
    }
    const int gt = blockIdx.x * 512 + tid, NT_ = gridDim.x * 512;
    float* ssq = (float*)(ws + WS_SSQ);
    for (int i = gt; i < T * 4; i += NT_) ssq[i] = 0.f;
    if (l == 0) {
        float* rowsq = (float*)(ws + WS_ROWSQ);
        for (int i = gt; i < 4 * T; i += NT_) rowsq[T + i] = 0.f;
        bf16_t* xb = (bf16_t*)(ws + WS_XB); const float* x = p.in[0];
        for (int m = gw; m < T; m += NGW) {
            const f32x4* xr = (const f32x4*)(x + (size_t)m * 1024) + lane; float s = 0.f;
            u32x2* o = (u32x2*)(xb + (size_t)m * 1024) + lane;
#pragma unroll
            for (int j = 0; j < 4; ++j) { const f32x4 v = xr[64 * j]; s += v[0] * v[0] + v[1] * v[1] + v[2] * v[2] + v[3] * v[3]; u32x2 w; w.x = pk2(v[0], v[1]); w.y = pk2(v[2], v[3]); o[64 * j] = w; }
            s = wave_sum(s); if (lane == 0) rowsq[m] = s;
        }
    }
}

DI void rope_pass(const Params& p) {
    const int* pos = (const int*)p.in[1];
    bf16_t* Qd = (bf16_t*)(p.ws + WS_R + 4 * BLK); bf16_t* Kd = (bf16_t*)(p.ws + WS_R + 5 * BLK);
    const double cf[8] = {0.15915494309189535, 0.03086376340470123, 0.005985185712713705, 0.001160663641240061, 0.00022507907903927653, 4.364795279280289e-05, 8.464330808241401e-06, 1.6414262627950345e-06};
    const int gt = blockIdx.x * 512 + opaque_tid(), NTH = gridDim.x * 512;
    for (int it = gt; it < T * 32; it += NTH) {
        const int t = it >> 5, w = it & 31; bf16_t* base = ((w & 16) ? Kd : Qd) + (size_t)t * 1024 + (w & 15) * 64;
        const double ps = (double)pos[t];
        u32x4 a = *(u32x4*)base, b = *(u32x4*)(base + 8);
        float t1[8], t2[8];
#pragma unroll
        for (int i = 0; i < 4; ++i) { t1[2 * i] = bflo(a[i]); t1[2 * i + 1] = bfhi(a[i]); t2[2 * i] = bflo(b[i]); t2[2 * i + 1] = bfhi(b[i]); }
        float o1[8], o2[8];
#pragma unroll
        for (int i = 0; i < 8; ++i) { double rv = ps * cf[i]; rv -= floor(rv); const float fr = (float)rv; const float sn = __builtin_amdgcn_sinf(fr), cs = __builtin_amdgcn_cosf(fr);
            o1[i] = t1[i] * cs - t2[i] * sn; o2[i] = t2[i] * cs + t1[i] * sn; }
#pragma unroll
        for (int i = 0; i < 4; ++i) { a[i] = pk2(o1[2 * i], o1[2 * i + 1]); b[i] = pk2(o2[2 * i], o2[2 * i + 1]); }
        *(u32x4*)base = a; *(u32x4*)(base + 8) = b;
    }
}

template <int KS> DI f32x4 mm16(f32x4 acc, const LAS unsigned char* A, int lda_b, const LAS unsigned char* B, int ldb_b, int lane) {
    const int r = lane & 15, q = lane >> 4;
    const LAS unsigned char* ap = A + r * lda_b + q * 16; const LAS unsigned char* bp = B + r * ldb_b + q * 16;
#pragma unroll
    for (int s = 0; s < KS; ++s) acc = mfma16(*(const LAS bf16x8*)(ap + s * 64), *(const LAS bf16x8*)(bp + s * 64), acc);
    return acc;
}
DI float logsigmoidf_(float x) { return fminf(x, 0.f) - log1pf(__expf(-fabsf(x))); }

constexpr int G_GKL = 0, G_QTOT = 4096, G_BLAST = 6144, G_PART = 6656, G_QT = 8704, G_KT = 26112, G_KHT = 43520, G_VT = 61952, G_P = 98816;
template <int MODE> DI void gla_unit(const Params& p, int l, int un, LAS unsigned char* lds) {
    const int tid = opaque_tid(), lane = tid & 63, w = __builtin_amdgcn_readfirstlane(tid >> 6), r16 = lane & 15, quad = lane >> 4;
    const int sc = un >> 2, h = un & 3, tok0 = sc * 256;
    unsigned char* ws = p.ws;
    const bf16_t* QK = (const bf16_t*)(ws + WS_R); const bf16_t* Vg = (const bf16_t*)(ws + WS_R + BLK); bf16_t* Gg = (bf16_t*)(ws + WS_R + 2 * BLK);
    const float* small = (const float*)(ws + WS_SMALL);
    float* states = (float*)(ws + WS_STG) + (size_t)un * 32768;
    const int d = tid & 127, qr = tid >> 7;
    float wk[16];
#pragma unroll
    for (int r = 0; r < 16; ++r) wk[r] = p.in[5][(size_t)l * 16 * 512 + r * 512 + h * 128 + d];
    const float bk = p.in[6][l * 512 + h * 128 + d];
    f32x4 S[8][2];
    if (MODE == 3) {
#pragma unroll
        for (int mb = 0; mb < 8; ++mb)
#pragma unroll
            for (int nb = 0; nb < 2; ++nb) S[mb][nb] = *(const f32x4*)(states + ((size_t)(w * 16 + mb * 2 + nb) * 64 + lane) * 4);
    } else {
#pragma unroll
        for (int mb = 0; mb < 8; ++mb)
#pragma unroll
            for (int nb = 0; nb < 2; ++nb) S[mb][nb] = (f32x4){0.f, 0.f, 0.f, 0.f};
    }
    float ng[2] = {0.f, 0.f};
    if (MODE == 3) { ng[0] = p.in[7][l * 256 + 32 * w + r16]; ng[1] = p.in[7][l * 256 + 32 * w + 16 + r16]; }
    float dtot = 1.f;
    for (int j = 0; j < 4; ++j) {
        const int t0 = tok0 + 64 * j;
        if (tid < 256) { const int row = tid >> 2, c4 = (tid & 3) * 4; *(LAS f32x4*)(lds + G_GKL + (row * 16 + c4) * 4) = *(const f32x4*)(small + (size_t)(t0 + row) * 64 + c4); }
        if (tid < 64) ((LAS float*)(lds + G_PART))[tid] = 0.f;
        __syncthreads();
        float c[16]; float run = 0.f;
#pragma unroll
        for (int i = 0; i < 16; ++i) { const LAS float* gr = (const LAS float*)(lds + G_GKL) + (qr * 16 + i) * 16; float x = bk;
#pragma unroll
            for (int r = 0; r < 16; ++r) x += gr[r] * wk[r];
            run += logsigmoidf_(x) * (1.f / 16.f); c[i] = run; }
        ((LAS float*)(lds + G_QTOT))[qr * 128 + d] = run;
        __syncthreads();
        {
            float off = 0.f, bl = 0.f;
#pragma unroll
            for (int q2 = 0; q2 < 4; ++q2) { const float v = ((const LAS float*)(lds + G_QTOT))[q2 * 128 + d]; bl += v; if (q2 < qr) off += v; }
            unsigned khp[8];
#pragma unroll
            for (int i = 0; i < 16; i += 2) {
                float kh2[2];
#pragma unroll
                for (int e = 0; e < 2; ++e) { const int t = qr * 16 + i + e; const float b = off + c[i + e];
                    const float k = bf2f(QK[(size_t)(t0 + t) * 1024 + 512 + h * 128 + d]);
                    kh2[e] = k * __expf(bl - b);
                    if (MODE == 3) { const float q = bf2f(QK[(size_t)(t0 + t) * 1024 + h * 128 + d]);
                        ((LAS bf16_t*)(lds + G_QT))[t * 136 + d] = f2bf(q * 0.08838834764831845f * __expf(b));
                        ((LAS bf16_t*)(lds + G_KT))[t * 136 + d] = f2bf(k * __expf(-b)); } }
                khp[i >> 1] = pk2(kh2[0], kh2[1]);
            }
            *(LAS u32x4*)(lds + G_KHT + d * 144 + qr * 32) = (u32x4){khp[0], khp[1], khp[2], khp[3]};
            *(LAS u32x4*)(lds + G_KHT + d * 144 + qr * 32 + 16) = (u32x4){khp[4], khp[5], khp[6], khp[7]};
            if (qr == 0) { ((LAS float*)(lds + G_BLAST))[d] = bl; dtot *= __expf(bl); }
#pragma unroll
            for (int i = 0; i < 4; ++i) { const int pid = tid + 512 * i, g8 = pid >> 6, t = pid & 63;
                const u32x4 v = *(const u32x4*)(Vg + (size_t)(t0 + t) * 1024 + h * 256 + g8 * 8);
                LAS bf16_t* vt = (LAS bf16_t*)(lds + G_VT) + (g8 * 8) * 72 + t;
#pragma unroll
                for (int e = 0; e < 4; ++e) { vt[(2 * e) * 72] = (bf16_t)(v[e] & 0xffffu); vt[(2 * e + 1) * 72] = (bf16_t)(v[e] >> 16); } }
        }
        __syncthreads();
        if (MODE == 3) {
#pragma unroll
            for (int e = 0; e < 2; ++e) { const int x = 2 * w + e, tb = x >> 2, sb = x & 3;
                f32x4 a = (f32x4){0.f, 0.f, 0.f, 0.f};
                if (sb <= tb) a = mm16<4>(a, lds + G_KT + sb * 16 * 272, 272, lds + G_QT + tb * 16 * 272, 272, lane);
                const int t = 16 * tb + r16, s0 = 16 * sb + quad * 4;
                float v[4];
#pragma unroll
                for (int jj = 0; jj < 4; ++jj) v[jj] = (s0 + jj <= t) ? a[jj] : 0.f;
                if (x == 0 && lane == 0 && j == 0 && (tok0 & (SEQ - 1)) == 0) { const float* qk_ = (l == 0) ? (const float*)(ws + SB_PROJ) + (tok0 >> 13) * 14384 : (const float*)(ws + SB_QK1) + (tok0 >> 13) * 1024;
                    float acc_ = 0.f; for (int d_ = 0; d_ < 128; ++d_) acc_ += qk_[h * 128 + d_] * qk_[512 + h * 128 + d_]; v[0] = acc_ * 0.08838834764831845f; }
                *(LAS u32x2*)(lds + G_P + t * 144 + s0 * 2) = (u32x2){pk2(v[0], v[1]), pk2(v[2], v[3])}; }
            f32x4 o[4][2];
#pragma unroll
            for (int mb = 0; mb < 4; ++mb) { o[mb][0] = (f32x4){0.f, 0.f, 0.f, 0.f}; o[mb][1] = (f32x4){0.f, 0.f, 0.f, 0.f}; }
#pragma unroll
            for (int ks = 0; ks < 4; ++ks) {
                bf16x8 bf[2];
#pragma unroll
                for (int nb = 0; nb < 2; ++nb) { const f32x4 s0v = S[2 * ks][nb], s1v = S[2 * ks + 1][nb];
                    u32x4 pk; pk.x = pk2(s0v[0], s0v[1]); pk.y = pk2(s0v[2], s0v[3]); pk.z = pk2(s1v[0], s1v[1]); pk.w = pk2(s1v[2], s1v[3]); bf[nb] = __builtin_bit_cast(bf16x8, pk); }
#pragma unroll
                for (int mb = 0; mb < 4; ++mb) { const LAS unsigned char* ap = lds + G_QT + (16 * mb + r16) * 272 + (32 * ks + quad * 4) * 2;
                    const u32x2 lo = *(const LAS u32x2*)ap, hi = *(const LAS u32x2*)(ap + 32);
                    const bf16x8 af = __builtin_bit_cast(bf16x8, (u32x4){lo.x, lo.y, hi.x, hi.y});
                    o[mb][0] = mfma16(af, bf[0], o[mb][0]); o[mb][1] = mfma16(af, bf[1], o[mb][1]); }
            }
            __syncthreads();
#pragma unroll
            for (int mb = 0; mb < 4; ++mb)
#pragma unroll
                for (int nb = 0; nb < 2; ++nb) o[mb][nb] = mm16<2>(o[mb][nb], lds + G_P + mb * 16 * 144, 144, lds + G_VT + (32 * w + 16 * nb) * 144, 144, lane);
#pragma unroll
            for (int mb = 0; mb < 4; ++mb)
#pragma unroll
                for (int jj = 0; jj < 4; ++jj) { float ss = o[mb][0][jj] * o[mb][0][jj] + o[mb][1][jj] * o[mb][1][jj];
                    ss += __shfl_xor(ss, 1); ss += __shfl_xor(ss, 2); ss += __shfl_xor(ss, 4); ss += __shfl_xor(ss, 8);
                    if (r16 == 0) __hip_atomic_fetch_add((LAS float*)(lds + G_PART) + 16 * mb + quad * 4 + jj, ss, __ATOMIC_RELAXED, __HIP_MEMORY_SCOPE_WORKGROUP); }
            __syncthreads();
#pragma unroll
            for (int mb = 0; mb < 4; ++mb)
#pragma unroll
                for (int jj = 0; jj < 4; ++jj) { const int t = 16 * mb + quad * 4 + jj; const float rs = rsqrtf(((const LAS float*)(lds + G_PART))[t] * (1.f / 256.f) + EPS);
#pragma unroll
                    for (int nb = 0; nb < 2; ++nb) { bf16_t* gp = Gg + (size_t)(t0 + t) * 1024 + h * 256 + 32 * w + 16 * nb + r16;
                        const float gv = bf2f(*gp); *gp = f2bf(o[mb][nb][jj] * rs * ng[nb] * siluf_(gv)); } }
        }
#pragma unroll
        for (int mb = 0; mb < 8; ++mb) { const f32x4 bl4 = *(const LAS f32x4*)(lds + G_BLAST + (16 * mb + quad * 4) * 4);
            const f32x4 dc = (f32x4){__expf(bl4[0]), __expf(bl4[1]), __expf(bl4[2]), __expf(bl4[3])};
#pragma unroll
            for (int nb = 0; nb < 2; ++nb) { S[mb][nb] = S[mb][nb] * dc;
                S[mb][nb] = mm16<2>(S[mb][nb], lds + G_KHT + mb * 16 * 144, 144, lds + G_VT + (32 * w + 16 * nb) * 144, 144, lane); } }
        __syncthreads();
    }
    if (MODE == 1) {
#pragma unroll
        for (int mb = 0; mb < 8; ++mb)
#pragma unroll
            for (int nb = 0; nb < 2; ++nb) *(f32x4*)(states + ((size_t)(w * 16 + mb * 2 + nb) * 64 + lane) * 4) = S[mb][nb];
        if (tid < 128) ((float*)(ws + WS_DECG))[un * 128 + tid] = dtot;
    }
}
DI void gla_scan(const Params& p) {
    const int gid = blockIdx.x * 512 + opaque_tid();
    for (int it = gid; it < 65536; it += gridDim.x * 512) {
        const int chain = it >> 13, e = it & 8191, b = chain >> 2, h = chain & 3;
        const int tile = (e >> 6) & 15, lane = e & 63, d0 = 16 * (tile >> 1) + (lane >> 4) * 4;
        f32x4* st = (f32x4*)(p.ws + WS_STG); const float* dec = (const float*)(p.ws + WS_DECG);
        f32x4 run = (f32x4){0.f, 0.f, 0.f, 0.f};
        for (int hb = 0; hb < 4; ++hb) {
            f32x4 u[8];
#pragma unroll
            for (int s = 0; s < 8; ++s) u[s] = st[(size_t)((b * 32 + hb * 8 + s) * 4 + h) * 8192 + e];
            asm volatile("" ::: "memory");
#pragma unroll
            for (int s = 0; s < 8; ++s) { const int un = (b * 32 + hb * 8 + s) * 4 + h; const f32x4 dc = *(const f32x4*)(dec + un * 128 + d0);
                st[(size_t)un * 8192 + e] = run; run = run * dc + u[s]; }
        }
    }
}

constexpr int S_ACUM = 0, S_DTV = 256, S_MISC = 512, S_XDT = 1024, S_XD2 = 10240, S_BN = 19456, S_BT = 36864, S_CN = 55296, S_GL = 72704, S_SB = 81920;
DI float softplusf_(float x) { return x > 20.f ? x : log1pf(__expf(x)); }
template <int MODE> DI void ssd_unit(const Params& p, int l, int un, LAS unsigned char* lds) {
    const int tid = opaque_tid(), lane = tid & 63, w = __builtin_amdgcn_readfirstlane(tid >> 6), r16 = lane & 15, quad = lane >> 4;
    const int sc = un >> 5, head = un & 31, g = head >> 3, tok0 = sc * 256;
    unsigned char* ws = p.ws;
    bf16_t* Zb = (bf16_t*)(ws + WS_R + (size_t)(head >> 4) * BLK) + (head & 15) * 64;
    const bf16_t* Xb = (const bf16_t*)(ws + WS_R + (size_t)(2 + (head >> 4)) * BLK) + (head & 15) * 64;
    const bf16_t* BCb = (const bf16_t*)(ws + WS_R + 4 * BLK);
    const float* small = (const float*)(ws + WS_SMALL);
    float* ssq = (float*)(ws + WS_SSQ);
    float* states = (float*)(ws + WS_STS) + (size_t)un * 8192;
    const float* cw = p.in[8] + (size_t)l * 4 * 3072; const float* cbias = p.in[9] + l * 3072;
    const float dtb = p.in[10][l * 32 + head], aneg = -__expf(p.in[11][l * 32 + head]), Dh = p.in[12][l * 32 + head];
    f32x4 st[4];
    if (MODE == 3) {
#pragma unroll
        for (int pb = 0; pb < 4; ++pb) { st[pb] = *(const f32x4*)(states + ((size_t)(w * 4 + pb) * 64 + lane) * 4);
            *(LAS u32x2*)(lds + S_SB + (16 * pb + r16) * 272 + (16 * w + quad * 4) * 2) = (u32x2){pk2(st[pb][0], st[pb][1]), pk2(st[pb][2], st[pb][3])}; }
    } else {
#pragma unroll
        for (int pb = 0; pb < 4; ++pb) st[pb] = (f32x4){0.f, 0.f, 0.f, 0.f};
    }
    const int px = tid & 63, tq = tid >> 6;
    float wx[4];
#pragma unroll
    for (int i = 0; i < 4; ++i) wx[i] = cw[i * 3072 + head * 64 + px];
    const float bx = cbias[head * 64 + px];
    float atot = 0.f;
    for (int j = 0; j < 4; ++j) {
        const int t0 = tok0 + 64 * j, s0 = t0 & (SEQ - 1);
        if (w == 0) {
            const float dt = softplusf_(small[(size_t)(t0 + lane) * 64 + 16 + head] + dtb);
            float cs = dt * aneg;
#pragma unroll
            for (int o = 1; o < 64; o <<= 1) { const float v = __shfl_up(cs, o); if (lane >= o) cs += v; }
            ((LAS float*)(lds + S_ACUM))[lane] = cs; ((LAS float*)(lds + S_DTV))[lane] = dt;
            if (lane == 63) ((LAS float*)(lds + S_MISC))[0] = cs;
        }
        __syncthreads();
        const float alast = ((const LAS float*)(lds + S_MISC))[0];
        atot += alast;
        {
            float xv[11];
#pragma unroll
            for (int k = 0; k < 11; ++k) { const int tt = tq * 8 - 3 + k; xv[k] = (s0 + tt >= 0) ? bf2f(Xb[(size_t)(t0 + tt) * 1024 + px]) : 0.f; }
            unsigned a1[4], a2[4]; float e1[2], e2[2];
#pragma unroll
            for (int i = 0; i < 8; ++i) { const int t = tq * 8 + i;
                const float cv = bx + xv[i] * wx[0] + xv[i + 1] * wx[1] + xv[i + 2] * wx[2] + xv[i + 3] * wx[3];
                const float xd = siluf_(cv) * ((const LAS float*)(lds + S_DTV))[t];
                e1[i & 1] = xd; e2[i & 1] = xd * __expf(alast - ((const LAS float*)(lds + S_ACUM))[t]);
                if (i & 1) { a1[i >> 1] = pk2(e1[0], e1[1]); a2[i >> 1] = pk2(e2[0], e2[1]); } }
            *(LAS u32x4*)(lds + S_XDT + px * 144 + tq * 16) = (u32x4){a1[0], a1[1], a1[2], a1[3]};
            *(LAS u32x4*)(lds + S_XD2 + px * 144 + tq * 16) = (u32x4){a2[0], a2[1], a2[2], a2[3]};
        }
        {
            const bf16_t* BCc = (const bf16_t*)(ws + WS_STG);
#pragma unroll
            for (int i = 0; i < 2; ++i) { const int pid = tid + 512 * i, c8 = pid >> 6, t = pid & 63;
                const u32x4 v = *(const u32x4*)(BCc + (size_t)(t0 + t) * 1024 + g * 128 + c8 * 8);
                if (MODE == 3) *(LAS u32x4*)(lds + S_BN + t * 272 + c8 * 16) = v;
                LAS bf16_t* bt = (LAS bf16_t*)(lds + S_BT) + (c8 * 8) * 72 + t;
#pragma unroll
                for (int e = 0; e < 4; ++e) { bt[(2 * e) * 72] = (bf16_t)(v[e] & 0xffffu); bt[(2 * e + 1) * 72] = (bf16_t)(v[e] >> 16); }
                if (MODE == 3) { const u32x4 cv = *(const u32x4*)(BCc + (size_t)(t0 + t) * 1024 + 512 + g * 128 + c8 * 8); *(LAS u32x4*)(lds + S_CN + t * 272 + c8 * 16) = cv; } }
        }
        __syncthreads();
        if (MODE == 3) {
            f32x4 y[2];
#pragma unroll
            for (int e = 0; e < 2; ++e) { const int x = 2 * w + e, tb = x >> 2, sb = x & 3;
                f32x4 a = (f32x4){0.f, 0.f, 0.f, 0.f};
                if (sb <= tb) a = mm16<4>(a, lds + S_BN + sb * 16 * 272, 272, lds + S_CN + tb * 16 * 272, 272, lane);
                const int t = 16 * tb + r16, sb0 = 16 * sb + quad * 4;
                const float act = ((const LAS float*)(lds + S_ACUM))[t], dtt = ((const LAS float*)(lds + S_DTV))[t];
                float v[4];
#pragma unroll
                for (int jj = 0; jj < 4; ++jj) { const int s = sb0 + jj; float val = 0.f;
                    if (s <= t) val = a[jj] * __expf(act - ((const LAS float*)(lds + S_ACUM))[s]);
                    if (s == t) val += Dh / dtt;
                    v[jj] = val; }
                *(LAS u32x2*)(lds + S_GL + t * 144 + sb0 * 2) = (u32x2){pk2(v[0], v[1]), pk2(v[2], v[3])};
                const int pb = sb;
                y[e] = mm16<4>((f32x4){0.f, 0.f, 0.f, 0.f}, lds + S_SB + pb * 16 * 272, 272, lds + S_CN + tb * 16 * 272, 272, lane);
                y[e] = y[e] * __expf(act);
            }
            __syncthreads();
#pragma unroll
            for (int e = 0; e < 2; ++e) { const int x = 2 * w + e, tb = x >> 2, pb = x & 3;
                y[e] = mm16<2>(y[e], lds + S_XDT + pb * 16 * 144, 144, lds + S_GL + tb * 16 * 144, 144, lane);
                const int t = 16 * tb + r16; bf16_t* zp = Zb + (size_t)(t0 + t) * 1024 + 16 * pb + quad * 4;
                const u32x2 zw = *(const u32x2*)zp;
                f32x4 r; r[0] = y[e][0] * siluf_(bflo(zw.x)); r[1] = y[e][1] * siluf_(bfhi(zw.x)); r[2] = y[e][2] * siluf_(bflo(zw.y)); r[3] = y[e][3] * siluf_(bfhi(zw.y));
                float ss = r[0] * r[0] + r[1] * r[1] + r[2] * r[2] + r[3] * r[3];
                ss += __shfl_xor(ss, 16); ss += __shfl_xor(ss, 32);
                if (quad == 0) atomicAdd(ssq + (size_t)(t0 + t) * 4 + g, ss);
                *(u32x2*)zp = (u32x2){pk2(r[0], r[1]), pk2(r[2], r[3])}; }
        }
        {
            const float da = __expf(alast);
#pragma unroll
            for (int pb = 0; pb < 4; ++pb) { st[pb] = st[pb] * da;
                st[pb] = mm16<2>(st[pb], lds + S_BT + w * 16 * 144, 144, lds + S_XD2 + pb * 16 * 144, 144, lane);
                if (MODE == 3) *(LAS u32x2*)(lds + S_SB + (16 * pb + r16) * 272 + (16 * w + quad * 4) * 2) = (u32x2){pk2(st[pb][0], st[pb][1]), pk2(st[pb][2], st[pb][3])}; }
        }
        __syncthreads();
    }
    if (MODE == 1) {
#pragma unroll
        for (int pb = 0; pb < 4; ++pb) *(f32x4*)(states + ((size_t)(w * 4 + pb) * 64 + lane) * 4) = st[pb];
        if (tid == 0) ((float*)(ws + WS_DECS))[un] = __expf(atot);
    }
}

DI void conv_bc(const Params& p, int l) {
    const bf16_t* BC = (const bf16_t*)(p.ws + WS_R + 4 * BLK); bf16_t* O = (bf16_t*)(p.ws + WS_STG);
    const float* cw = p.in[8] + (size_t)l * 4 * 3072 + 2048; const float* cb = p.in[9] + l * 3072 + 2048;
    const int gt = blockIdx.x * 512 + opaque_tid();
    for (int it = gt; it < 1024 * 256; it += gridDim.x * 512) {
        const int c = it & 1023, r0 = (it >> 10) * 64;
        const float w0 = cw[c], w1 = cw[3072 + c], w2 = cw[2 * 3072 + c], w3 = cw[3 * 3072 + c], b = cb[c];
        float x0 = 0.f, x1 = 0.f, x2 = 0.f;
        if ((r0 & (SEQ - 1)) != 0) { x0 = bf2f(BC[(size_t)(r0 - 3) * 1024 + c]); x1 = bf2f(BC[(size_t)(r0 - 2) * 1024 + c]); x2 = bf2f(BC[(size_t)(r0 - 1) * 1024 + c]); }
#pragma unroll 8
        for (int i = 0; i < 64; ++i) { const float x3 = bf2f(BC[(size_t)(r0 + i) * 1024 + c]); const float cv = b + x0 * w0 + x1 * w1 + x2 * w2 + x3 * w3;
            O[(size_t)(r0 + i) * 1024 + c] = f2bf(siluf_(cv)); x0 = x1; x1 = x2; x2 = x3; }
    }
}
DI void ssd_scan(const Params& p) {
    const int gid = blockIdx.x * 512 + opaque_tid();
    for (int it = gid; it < 131072; it += gridDim.x * 512) {
        const int chain = it >> 11, e = it & 2047, b = chain >> 5, head = chain & 31;
        f32x4* st = (f32x4*)(p.ws + WS_STS); const float* dec = (const float*)(p.ws + WS_DECS);
        f32x4 run = (f32x4){0.f, 0.f, 0.f, 0.f};
        for (int hb = 0; hb < 4; ++hb) {
            f32x4 u[8];
#pragma unroll
            for (int s = 0; s < 8; ++s) u[s] = st[(size_t)((b * 32 + hb * 8 + s) * 32 + head) * 2048 + e];
            asm volatile("" ::: "memory");
#pragma unroll
            for (int s = 0; s < 8; ++s) { const int un = (b * 32 + hb * 8 + s) * 32 + head; const float dc = dec[un];
                st[(size_t)un * 2048 + e] = run; run = run * dc + u[s]; }
        }
    }
}

typedef short v4i16_t __attribute__((ext_vector_type(4)));
DI s16x4 vtr(const LAS unsigned char* p) { return __builtin_bit_cast(s16x4, __builtin_amdgcn_ds_read_tr16_b64_v4i16((LAS v4i16_t*)p)); }
constexpr int A_K = 0, A_V = 34816, A_X = 0, A_Y = 65536, A_NG = 100352;
DI void attn_unit(const Params& p, int b, int h, int qb, float lam, float oscale, LAS unsigned char* lds) {
    const int tid = opaque_tid(), lane = tid & 63, w = __builtin_amdgcn_readfirstlane(tid >> 6), rg = w & 3, sub = w >> 2, q = lane & 31, hh = lane >> 5;
    bf16_t* Qd = (bf16_t*)(p.ws + WS_R + 4 * BLK); const bf16_t* Kd = (const bf16_t*)(p.ws + WS_R + 5 * BLK); const bf16_t* Vd = (const bf16_t*)(p.ws + WS_R + 6 * BLK);
    const int tok0 = b * SEQ + qb * 128;
    bf16x8 qf[4];
    { const bf16_t* qp = Qd + (size_t)(tok0 + rg * 32 + q) * 1024 + h * 128 + sub * 64 + hh * 8;
#pragma unroll
      for (int ks = 0; ks < 4; ++ks) qf[ks] = *(const bf16x8*)(qp + ks * 16); }
    const int NT = 2 * qb + 2;
    u32x4 kr[2], vr[2];
    const int prow = tid >> 4, pc16 = tid & 15;
#define ATT_LOAD(t) do { _Pragma("unroll") for (int i_ = 0; i_ < 2; ++i_) { const size_t off_ = (size_t)(b * SEQ + (t) * 64 + prow + 32 * i_) * 1024 + h * 128 + pc16 * 8; \
        kr[i_] = *(const u32x4*)(Kd + off_); vr[i_] = *(const u32x4*)(Vd + off_); } } while (0)
#define ATT_STORE(buf) do { _Pragma("unroll") for (int i_ = 0; i_ < 2; ++i_) { const int o_ = (buf) * 17408 + (prow + 32 * i_) * 272 + pc16 * 16; \
        *(LAS u32x4*)(lds + A_K + o_) = kr[i_]; *(LAS u32x4*)(lds + A_V + o_) = vr[i_]; } } while (0)
    f32x16 o[4];
#pragma unroll
    for (int db = 0; db < 4; ++db)
#pragma unroll
        for (int i = 0; i < 16; ++i) o[db][i] = 0.f;
    float m_run = -1e30f, l_run = 0.f;
    const float C2 = 0.18033688011112042f;
    ATT_LOAD(0); ATT_STORE(0); ATT_LOAD(1);
    __syncthreads();
    const int i16 = lane & 15, blk = (lane >> 4) & 1;
    for (int t = 0; t < NT; ++t) {
        if (t + 1 < NT) ATT_STORE((t + 1) & 1);
        if (t + 2 < NT) ATT_LOAD(t + 2);
        if (t <= 2 * qb + (rg >> 1)) {
            const LAS unsigned char* Kb = lds + A_K + (t & 1) * 17408; const LAS unsigned char* Vb = lds + A_V + (t & 1) * 17408;
            f32x16 s0, s1;
#pragma unroll
            for (int i = 0; i < 16; ++i) { s0[i] = 0.f; s1[i] = 0.f; }
#pragma unroll
            for (int ks = 0; ks < 4; ++ks) { const LAS unsigned char* kp = Kb + q * 272 + (sub * 64 + ks * 16 + hh * 8) * 2;
                s0 = mfma32(*(const LAS bf16x8*)kp, qf[ks], s0); s1 = mfma32(*(const LAS bf16x8*)(kp + 32 * 272), qf[ks], s1); }
            float mx = fmaxf(s0[0], s1[0]);
#pragma unroll
            for (int i = 1; i < 16; ++i) mx = fmaxf(mx, fmaxf(s0[i], s1[i]));
            mx = fmaxf(mx, __shfl_xor(mx, 32));
            const float m_new = fmaxf(m_run, mx), negm = -m_new * C2;
            if (__any(m_new > m_run)) {
                const float alpha = __builtin_amdgcn_exp2f((m_run - m_new) * C2);
                l_run *= alpha;
#pragma unroll
                for (int db = 0; db < 4; ++db)
#pragma unroll
                    for (int i = 0; i < 16; ++i) o[db][i] *= alpha;
            }
            float sum = 0.f;
#pragma unroll
            for (int i = 0; i < 16; ++i) { s0[i] = __builtin_amdgcn_exp2f(fmaf(s0[i], C2, negm)); s1[i] = __builtin_amdgcn_exp2f(fmaf(s1[i], C2, negm)); sum += s0[i] + s1[i]; }
            l_run += sum; m_run = m_new;
            bf16x8 pf[2][2];
#pragma unroll
            for (int s = 0; s < 2; ++s) {
                pf[0][s] = __builtin_bit_cast(bf16x8, (u32x4){pk2(s0[8 * s], s0[8 * s + 1]), pk2(s0[8 * s + 2], s0[8 * s + 3]), pk2(s0[8 * s + 4], s0[8 * s + 5]), pk2(s0[8 * s + 6], s0[8 * s + 7])});
                pf[1][s] = __builtin_bit_cast(bf16x8, (u32x4){pk2(s1[8 * s], s1[8 * s + 1]), pk2(s1[8 * s + 2], s1[8 * s + 3]), pk2(s1[8 * s + 4], s1[8 * s + 5]), pk2(s1[8 * s + 6], s1[8 * s + 7])}); }
#pragma unroll
            for (int kb = 0; kb < 2; ++kb)
#pragma unroll
                for (int s = 0; s < 2; ++s) { const LAS unsigned char* vp = Vb + (32 * kb + 16 * s + 4 * hh + (i16 >> 2)) * 272 + blk * 32 + (i16 & 3) * 8;
#pragma unroll
                    for (int db = 0; db < 4; ++db) { const s16x4 lo = vtr(vp + db * 64), hi = vtr(vp + db * 64 + 8 * 272);
                        const bf16x8 vf = (bf16x8){lo[0], lo[1], lo[2], lo[3], hi[0], hi[1], hi[2], hi[3]};
                        o[db] = mfma32(vf, pf[kb][s], o[db]); } }
        }
        __syncthreads();
    }
#undef ATT_LOAD
#undef ATT_STORE
    const float l_tot = l_run + __shfl_xor(l_run, 32);
    LAS float* X = (LAS float*)(lds + A_X) + rg * 4096;
    if (sub == 1) { const float inv = lam / l_tot;
#pragma unroll
        for (int db = 0; db < 4; ++db)
#pragma unroll
            for (int i = 0; i < 16; ++i) X[(db * 16 + i) * 64 + lane] = o[db][i] * inv; }
    __syncthreads();
    if (sub == 0) { const float inv = 1.f / l_tot; float ss = 0.f;
#pragma unroll
        for (int db = 0; db < 4; ++db)
#pragma unroll
            for (int i = 0; i < 16; ++i) { const float v = o[db][i] * inv - X[(db * 16 + i) * 64 + lane]; o[db][i] = v; ss += v * v; }
        ss += __shfl_xor(ss, 32);
        const float rs = rsqrtf(ss * (1.f / 128.f) + 1e-5f) * oscale;
        LAS bf16_t* Y = (LAS bf16_t*)(lds + A_Y) + rg * (32 * 136);
        const LAS float* ngl = (const LAS float*)(lds + A_NG);
#pragma unroll
        for (int db = 0; db < 4; ++db)
#pragma unroll
            for (int i = 0; i < 16; ++i) { const int dv = 32 * db + crow(i, hh); Y[q * 136 + dv] = f2bf(o[db][i] * rs * ngl[dv]); }
        asm volatile("s_waitcnt lgkmcnt(0)" ::: "memory");
#pragma unroll
        for (int k = 0; k < 8; ++k) { const int piece = lane + 64 * k, row = piece >> 4, c16 = piece & 15;
            const u32x4 v = *(const LAS u32x4*)((const LAS unsigned char*)Y + row * 272 + c16 * 16);
            *(u32x4*)(Qd + (size_t)(tok0 + rg * 32 + row) * 1024 + h * 128 + c16 * 8) = v; }
    }
    __syncthreads();
}
DI void attn_phase(const Params& p, int l, LAS unsigned char* lds) {
    const int tid = opaque_tid();
    float d1 = 0.f, d2 = 0.f;
    for (int i = 0; i < 64; ++i) { d1 += p.in[14][l * 64 + i] * p.in[15][l * 64 + i]; d2 += p.in[16][l * 64 + i] * p.in[17][l * 64 + i]; }
    const float lambda_init = (l == 0) ? 0.2f : 0.35550906759096934f;
    const float lam = expf(d1) - expf(d2) + lambda_init;
    if (tid < 128) ((LAS float*)(lds + A_NG))[tid] = p.in[18][l * 128 + tid];
    __syncthreads();
    for (int i = 0; i < 4; ++i)
        for (int vc = blockIdx.x; vc < 256; vc += gridDim.x) {
            const int bh = vc >> 4, s = vc & 15; const int qb = (i == 0) ? s : (i == 1) ? 31 - s : (i == 2) ? 32 + s : 63 - s;
            attn_unit(p, bh >> 3, bh & 7, qb, lam, 1.f - lambda_init, lds);
        }
}

DI void final_norm(const Params& p) {
    const float* rowsq = (const float*)(p.ws + WS_ROWSQ) + 4 * T; const float* g = p.in[26];
    const int gt = blockIdx.x * 512 + opaque_tid();
    for (int i = gt; i < T * 256; i += gridDim.x * 512) { const int row = i >> 8, c = (i & 255) * 4;
        const float rs = rsqrtf(rowsq[row] * (1.f / 1024.f) + EPS);
        f32x4 v = *(f32x4*)(p.out + (size_t)row * 1024 + c); const f32x4 gv = *(const f32x4*)(g + c);
        *(f32x4*)(p.out + (size_t)row * 1024 + c) = v * rs * gv; }
}


DI void gemv2(float* out, int ldo, const float* in, int ldi, const float* W, int ldw, int K, int N, int kchunk) {
    const int tid = opaque_tid(), lane = tid & 63, wave = __builtin_amdgcn_readfirstlane(tid >> 6);
    const int gw = blockIdx.x * 8 + wave, NGW = gridDim.x * 8, nstrip = (N + 63) / 64, nk = K / 128;
    for (int job = gw; job < nstrip * nk; job += NGW) {
        const int strip = job % nstrip, kq = job / nstrip, col = strip * 64 + lane; const bool ok = col < N;
        const float* wp = W + (size_t)(kq * 128) * ldw + (ok ? col : 0);
        const float* i0 = in + kq * 128; const float* i1 = in + ldi + kq * 128;
        float a0 = 0.f, a1 = 0.f;
        for (int kk = 0; kk < 2; ++kk) {
            const float h0 = i0[kk * 64 + lane], h1 = i1[kk * 64 + lane];
#pragma unroll
            for (int k = 0; k < 64; ++k) { const float wv = wp[(size_t)(kk * 64 + k) * ldw];
                a0 += __uint_as_float(__builtin_amdgcn_readlane(__float_as_uint(h0), k)) * wv; a1 += __uint_as_float(__builtin_amdgcn_readlane(__float_as_uint(h1), k)) * wv; }
        }
        if (ok) { atomicAdd(out + col, a0); atomicAdd(out + ldo + col, a1); }
    }
}
DI void side_init(const Params& p) {
    const int tid = opaque_tid(), lane = tid & 63, wave = __builtin_amdgcn_readfirstlane(tid >> 6);
    const int gt = blockIdx.x * 512 + tid, NTH = gridDim.x * 512, gw = blockIdx.x * 8 + wave, NGW = gridDim.x * 8;
    float* z = (float*)(p.ws + SB_PROJ);
    for (int i = gt; i < (int)((SB_END - SB_PROJ) / 4); i += NTH) z[i] = 0.f;
    float* hn = (float*)(p.ws + SB_HN);
    for (int r = gw; r < 128; r += NGW) { const int row = (r >> 6) * SEQ + (r & 63);
        const f32x4* xr = (const f32x4*)(p.in[0] + (size_t)row * 1024) + lane; f32x4 v[4]; float s2 = 0.f;
#pragma unroll
        for (int j = 0; j < 4; ++j) { v[j] = xr[64 * j]; s2 += v[j][0] * v[j][0] + v[j][1] * v[j][1] + v[j][2] * v[j][2] + v[j][3] * v[j][3]; }
        const float rs = rsqrtf(wave_sum(s2) * (1.f / 1024.f) + EPS);
#pragma unroll
        for (int j = 0; j < 4; ++j) { const f32x4 g = *((const f32x4*)p.in[2] + lane + 64 * j); *((f32x4*)(hn + (size_t)r * 1024) + lane + 64 * j) = v[j] * rs * g; } }
}
DI void side_kv(const Params& p) {
    const int tid = opaque_tid(), lane = tid & 63, wave = __builtin_amdgcn_readfirstlane(tid >> 6);
    const int gw = blockIdx.x * 8 + wave, NGW = gridDim.x * 8;
    const float* hn = (const float*)(p.ws + SB_HN); float* kv = (float*)(p.ws + SB_KV);
    for (int job = gw; job < 4096; job += NGW) {
        const int strip = job & 31, grp = (job >> 5) & 15, kq = job >> 9, col = strip * 64 + lane;
        const float* wp = p.in[3] + (size_t)(kq * 128) * INC + 9264 + col; const float* hp = hn + (size_t)(grp * 8) * 1024 + kq * 128;
        float a[8];
#pragma unroll
        for (int t = 0; t < 8; ++t) a[t] = 0.f;
        for (int kk = 0; kk < 2; ++kk) {
            float h[8];
#pragma unroll
            for (int t = 0; t < 8; ++t) h[t] = hp[t * 1024 + kk * 64 + lane];
#pragma unroll 16
            for (int k = 0; k < 64; ++k) { const float wv = wp[(size_t)(kk * 64 + k) * INC];
#pragma unroll
                for (int t = 0; t < 8; ++t) a[t] += __uint_as_float(__builtin_amdgcn_readlane(__float_as_uint(h[t]), k)) * wv; }
        }
#pragma unroll
        for (int t = 0; t < 8; ++t) atomicAdd(kv + (size_t)(grp * 8 + t) * 2048 + col, a[t]);
    }
}
DI void rope_cs(int pos, int i, float& cs, float& sn) {
    const double cf[8] = {0.15915494309189535, 0.03086376340470123, 0.005985185712713705, 0.001160663641240061, 0.00022507907903927653, 4.364795279280289e-05, 8.464330808241401e-06, 1.6414262627950345e-06};
    double c = cf[0];
#pragma unroll
    for (int q = 1; q < 8; ++q) c = (i == q) ? cf[q] : c;
    double rv = (double)pos * c; rv -= floor(rv); const float fr = (float)rv; sn = __builtin_amdgcn_sinf(fr); cs = __builtin_amdgcn_cosf(fr);
}
DI void side_mixers(const Params& p, int b, LAS unsigned char* lds) {
    const int tid = opaque_tid();
    const float* P = (const float*)(p.ws + SB_PROJ) + b * 14384; float* Y = (float*)(p.ws + SB_Y) + b * 4096; float* KV = (float*)(p.ws + SB_KV) + (size_t)b * 64 * 2048;
    LAS float* cx = (LAS float*)lds; LAS float* ypre = cx + 3072; LAS float* lg = ypre + 2048; LAS float* pr = lg + 1024; LAS float* red = pr + 1024; LAS float* qr = red + 64;
    const int* pos = (const int*)p.in[1] + b * SEQ;
    __syncthreads();
    if (tid < 4) { float qk = 0.f, vv = 0.f; for (int d = 0; d < 128; ++d) qk += P[tid * 128 + d] * P[512 + tid * 128 + d]; for (int d = 0; d < 256; ++d) { const float v = P[1024 + tid * 256 + d]; vv += v * v; }
        red[tid] = qk * 0.08838834764831845f; red[4 + tid] = vv * (1.f / 256.f); }
    for (int c = tid; c < 3072; c += 512) cx[c] = siluf_(p.in[9][c] + p.in[8][3 * 3072 + c] * P[5136 + c]);
    if (tid < 32) red[8 + tid] = softplusf_(P[8208 + tid] + p.in[10][tid]);
    __syncthreads();
    for (int i = tid; i < 1024; i += 512) { const int h = i >> 8; const float p00 = red[h], o = p00 * P[1024 + i];
        Y[i] = o * rsqrtf(p00 * p00 * red[4 + h] + EPS) * p.in[7][i & 255] * siluf_(P[2064 + i]); }
    if (tid < 4) { float cb = 0.f; for (int n = 0; n < 128; ++n) cb += cx[2560 + tid * 128 + n] * cx[2048 + tid * 128 + n]; red[40 + tid] = cb; }
    __syncthreads();
    for (int i = tid; i < 2048; i += 512) { const int head = i >> 6; ypre[i] = (red[40 + (head >> 3)] * red[8 + head] + p.in[12][head]) * cx[i] * siluf_(P[3088 + i]); }
    __syncthreads();
    if (tid < 4) { float ss = 0.f; for (int i = 0; i < 512; ++i) ss += ypre[tid * 512 + i] * ypre[tid * 512 + i]; red[44 + tid] = rsqrtf(ss * (1.f / 512.f) + EPS); }
    __syncthreads();
    for (int i = tid; i < 2048; i += 512) Y[1024 + i] = ypre[i] * red[44 + (i >> 9)] * p.in[13][i];
    for (int i = tid; i < 1024; i += 512) { const int d = i & 63; float v = P[8240 + i];
        if (d < 16) { float cs, sn; rope_cs(pos[0], d & 7, cs, sn); const float o = (d < 8) ? P[8240 + i + 8] : P[8240 + i - 8]; v = (d < 8) ? v * cs - o * sn : v * cs + o * sn; }
        qr[i] = v; }
    for (int it = tid; it < 8192; it += 512) { const int j = it >> 7, hs = (it >> 3) & 15, d = it & 7; float cs, sn; rope_cs(pos[j], d, cs, sn);
        float* kp = KV + (size_t)j * 2048 + hs * 64 + d; const float k1 = kp[0], k2 = kp[8]; kp[0] = k1 * cs - k2 * sn; kp[8] = k2 * cs + k1 * sn; }
    __threadfence_block();
    __syncthreads();
    for (int i = tid; i < 1024; i += 512) { const int hs = i >> 6, j = i & 63; const float* kp = KV + (size_t)j * 2048 + hs * 64; float sacc = 0.f;
        for (int d = 0; d < 64; ++d) sacc += qr[hs * 64 + d] * kp[d];
        lg[i] = sacc * 0.125f; }
    __syncthreads();
    if (tid < 16) { float m = -1e30f; for (int j = 0; j < 64; ++j) m = fmaxf(m, lg[tid * 64 + j]); float sum = 0.f; for (int j = 0; j < 64; ++j) { const float e = expf(lg[tid * 64 + j] - m); pr[tid * 64 + j] = e; sum += e; }
        const float inv = 1.f / sum; for (int j = 0; j < 64; ++j) pr[tid * 64 + j] *= inv; }
    __syncthreads();
    float d1 = 0.f, d2 = 0.f;
    for (int i = 0; i < 64; ++i) { d1 += p.in[14][i] * p.in[15][i]; d2 += p.in[16][i] * p.in[17][i]; }
    const float lam = expf(d1) - expf(d2) + 0.2f;
    for (int i = tid; i < 1024; i += 512) { const int h = i >> 7; float o = 0.f;
        for (int j = 0; j < 64; ++j) o += (pr[(2 * h) * 64 + j] - lam * pr[(2 * h + 1) * 64 + j]) * KV[(size_t)j * 2048 + 1024 + i];
        ypre[i] = o; }
    __syncthreads();
    if (tid < 8) { float ss = 0.f; for (int i = 0; i < 128; ++i) ss += ypre[tid * 128 + i] * ypre[tid * 128 + i]; red[48 + tid] = rsqrtf(ss * (1.f / 128.f) + 1e-5f) * 0.8f; }
    __syncthreads();
    for (int i = tid; i < 1024; i += 512) Y[3072 + i] = ypre[i] * red[48 + (i >> 7)] * p.in[18][i & 127];
    float* G = (float*)(p.ws + SB_GATE) + b * 3072;
    for (int i = tid; i < 3072; i += 512) G[i] = sigmoidf_(P[11312 + i] + p.in[4][i]);
    __syncthreads();
}
DI void side_glue(const Params& p, int step, int b, LAS unsigned char* lds) {
    const int tid = opaque_tid(); unsigned char* ws = p.ws; LAS float* red = (LAS float*)lds;
    if (step == 4) {
        const float* G = (const float*)(ws + SB_GATE) + b * 3072; const float* BR = (const float*)(ws + SB_BR) + b * 3072;
        for (int c = tid; c < 1024; c += 512) { ((float*)(ws + SB_MIX))[b * 1024 + c] = G[c] * BR[c] + G[1024 + c] * BR[1024 + c] + G[2048 + c] * BR[2048 + c];
            ((float*)(ws + SB_XM))[b * 1024 + c] = p.in[0][(size_t)b * SEQ * 1024 + c]; }
    } else if (step == 6 || step == 100) {
        const float* src = (const float*)(ws + (step == 6 ? SB_XM : SB_X1)) + b * 1024; float* dst = (float*)(ws + (step == 6 ? SB_H2 : SB_HN1)) + b * 1024;
        const float* g = step == 6 ? p.in[23] : p.in[2] + 1024;
        __syncthreads();
        float s2 = 0.f; for (int c = tid; c < 1024; c += 512) s2 += src[c] * src[c];
        s2 = wave_sum(s2); if ((tid & 63) == 0) red[tid >> 6] = s2;
        __syncthreads();
        float tot = 0.f; for (int w = 0; w < 8; ++w) tot += red[w];
        const float rs = rsqrtf(tot * (1.f / 1024.f) + EPS);
        for (int c = tid; c < 1024; c += 512) dst[c] = src[c] * rs * g[c];
        if (step == 100) { const size_t row = (size_t)b * SEQ; bf16_t* xb = (bf16_t*)(ws + WS_XB);
            for (int c = tid; c < 1024; c += 512) { p.out[row * 1024 + c] = src[c]; xb[row * 1024 + c] = f2bf(src[c]); }
            if (tid == 0) ((float*)(ws + WS_ROWSQ))[2 * T + row] = tot; }
        __syncthreads();
    } else if (step == 8) {
        const float* up = (const float*)(ws + SB_UP) + b * 4096; float* hh = (float*)(ws + SB_HH) + b * 4096;
        for (int c = tid; c < 4096; c += 512) { const float r = fmaxf(up[c], 0.f); hh[c] = r * r; }
        for (int c = tid; c < 1024; c += 512) ((float*)(ws + SB_X1))[b * 1024 + c] = ((const float*)(ws + SB_XM))[b * 1024 + c];
    }
}
DI void side_phase(const Params& p, int l, int k, LAS unsigned char* lds) {
    unsigned char* ws = p.ws; const int bid = blockIdx.x;
    if (l == 0) {
        if (k == 0) side_init(p);
        else if (k == 1) { gemv2((float*)(ws + SB_PROJ), 14384, (const float*)(ws + SB_HN), 64 * 1024, p.in[3], INC, 1024, INC, 128); side_kv(p); }
        else if (k == 2) { if (bid < 2) side_mixers(p, bid, lds); }
        else if (k == 3) { float* br = (float*)(ws + SB_BR); const float* y = (const float*)(ws + SB_Y);
            gemv2(br, 3072, y, 4096, p.in[19], 1024, 1024, 1024, 128); gemv2(br + 1024, 3072, y + 1024, 4096, p.in[20], 1024, 2048, 1024, 128); gemv2(br + 2048, 3072, y + 3072, 4096, p.in[21], 1024, 1024, 1024, 128); }
        else if (k == 4) { if (bid < 2) side_glue(p, 4, bid, lds); }
        else if (k == 5) gemv2((float*)(ws + SB_XM), 1024, (const float*)(ws + SB_MIX), 1024, p.in[22], 1024, 1024, 1024, 128);
        else if (k == 6) { if (bid < 2) side_glue(p, 6, bid, lds); }
        else if (k == 7) gemv2((float*)(ws + SB_UP), 4096, (const float*)(ws + SB_H2), 1024, p.in[24], 4096, 1024, 4096, 128);
        else if (k == 8) { if (bid < 2) side_glue(p, 8, bid, lds); }
        else if (k == 9) gemv2((float*)(ws + SB_X1), 1024, (const float*)(ws + SB_HH), 4096, p.in[25], 1024, 4096, 1024, 128);
    } else {
        if (k == 0) { if (bid < 2) side_glue(p, 100, bid, lds); }
        else if (k == 1) gemv2((float*)(ws + SB_QK1), 1024, (const float*)(ws + SB_HN1), 1024, p.in[3] + (size_t)1024 * INC, INC, 1024, 1024, 128);
    }
}


DI void grid_bar(unsigned* ctr, unsigned target) {
    asm volatile("s_waitcnt vmcnt(0)" ::: "memory");
    __syncthreads();
    if (threadIdx.x == 0) {
        __builtin_amdgcn_fence(__ATOMIC_RELEASE, "agent");
        asm volatile("s_waitcnt vmcnt(0)" ::: "memory");
        __hip_atomic_fetch_add(ctr, 1u, __ATOMIC_RELAXED, __HIP_MEMORY_SCOPE_AGENT);
        while (__hip_atomic_load(ctr, __ATOMIC_RELAXED, __HIP_MEMORY_SCOPE_AGENT) < target) __builtin_amdgcn_s_sleep(8);
        __builtin_amdgcn_fence(__ATOMIC_ACQUIRE, "agent");
        asm volatile("s_waitcnt vmcnt(0)" ::: "memory");
    }
    __syncthreads();
}

constexpr int NPHASE = 31, PPL = 15;
#ifndef PH_MASK
#define PH_MASK 0xFFFFFFFFu
#endif
#define EN(k_) ((PH_MASK >> (k_)) & 1u)
constexpr int LDS_BYTES = 147456;
template <bool COOP> __global__ void __launch_bounds__(512, 2) mk(Params p) {
    extern __shared__ __attribute__((aligned(16))) unsigned char lds_raw[];
    LAS unsigned char* lds = (LAS unsigned char*)lds_raw;
    unsigned char* ws = p.ws;
    float* rowsq = (float*)(ws + WS_ROWSQ);
    bf16_t* xb = (bf16_t*)(ws + WS_XB); bf16_t* mixb = (bf16_t*)(ws + WS_MIXB); bf16_t* R = (bf16_t*)(ws + WS_R);
    const unsigned char* wt = ws + WS_WT;
    const int G = gridDim.x, bid = blockIdx.x;
    for (int ph = p.ph_lo; ph < p.ph_hi; ++ph) {
        if (ph == 30) { final_norm(p); }
        else {
            const int l = ph / PPL, k = ph % PPL;
            if (EN(0) && k == 0) phase_prep(p, l, lds);
            else if (k == 1 || k == 6) {
                const bool gd = (k == 1);
                pg8::Gemm g{xb, (const bf16_t*)(wt + (gd ? WT_GD : WT_S)), T, gd ? 8448 : 6144, 1024, 1024, 1024};
                pg8::StaticOrder S; S.init(T, g.N, G, bid);
                EpiIn E{R, rowsq + (2 * l) * T, (float*)(ws + WS_SMALL), gd ? 32 : -1, gd ? 3 : 5, gd ? 7 : -1,
                        p.in[4] + l * 3072 + (gd ? 0 : 1024), p.in[4] + l * 3072 + 2048};
                pg8::gemm_phase(lds, g, S, E);
            }
            else if (EN(2) && k == 2) { rope_pass(p); for (int un = bid; un < 256; un += G) gla_unit<1>(p, l, un, lds); }
            else if (EN(3) && k == 3) { gla_scan(p); attn_phase(p, l, lds); }
            else if (EN(4) && k == 4) { for (int un = bid; un < 256; un += G) gla_unit<3>(p, l, un, lds); }
            else if (k == 5 || k == 11) {
                const int nrun = (k == 5) ? 2 : 4;
                for (int r = 0; r < nrun; ++r) {
                    pg8::Gemm g; EpiMix E;
                    if (k == 5) {
                        g = pg8::Gemm{R + (size_t)(r == 0 ? 2 : 4) * (BLK / 2), (const bf16_t*)(wt + (r == 0 ? WT_GLA : WT_DIFF)), T, 1024, 1024, 1024, 1024};
                        E = EpiMix{mixb, R + (size_t)(r == 0 ? 3 : 7) * (BLK / 2), nullptr, 0, r == 0 ? 1 : 0};
                    } else {
                        g = pg8::Gemm{R + (size_t)(r >> 1) * (BLK / 2) + (r & 1) * 512, (const bf16_t*)(wt + WT_SSM) + r * 512, T, 1024, 512, 1024, 2048};
                        E = EpiMix{mixb, R + (size_t)5 * (BLK / 2), (const float*)(ws + WS_SSQ), r, 0};
                    }
                    pg8::StaticOrder S; S.init(T, 1024, G, bid);
                    pg8::gemm_phase(lds, g, S, E);
                }
            }
            else if (k == 7) { conv_bc(p, l); }
            else if (k == 8) { for (int un = bid; un < 2048; un += G) ssd_unit<1>(p, l, un, lds); }
            else if (k == 9) { ssd_scan(p); }
            else if (k == 10) { for (int un = bid; un < 2048; un += G) ssd_unit<3>(p, l, un, lds); }
            else if (k == 12 || k == 14) {
                const bool dn = (k == 14);
                pg8::Gemm g{dn ? R : mixb, (const bf16_t*)(wt + (dn ? WT_DOWN : WT_OUT)), T, 1024, dn ? 4096 : 1024, dn ? 4096 : 1024, dn ? 4096 : 1024};
                pg8::StaticOrder S; S.init(T, 1024, G, bid);
                EpiRes E{(l == 0 && !dn) ? p.in[0] : p.out, p.out, xb, rowsq + (2 * l + (dn ? 2 : 1)) * T};
                pg8::gemm_phase(lds, g, S, E);
            }
            else if (k == 13) {
                pg8::Gemm g{xb, (const bf16_t*)(wt + WT_UP), T, 4096, 1024, 1024, 1024};
                pg8::StaticOrder S; S.init(T, 4096, G, bid);
                EpiUp E{R, rowsq + (2 * l + 1) * T};
                pg8::gemm_phase(lds, g, S, E);
            }
        }
        if (ph < 30) side_phase(p, ph / PPL, ph % PPL, lds);
        if (COOP) { if (ph + 1 < p.ph_hi) { if (ph == p.ph_lo) cg::this_grid().sync(); else grid_bar((unsigned*)(ws + WS_BAR), (unsigned)(ph - p.ph_lo) * (unsigned)gridDim.x); } }
    }
}

extern "C" void kernel_launch(void* const* d_in, const int* in_sizes, int n_in, void* d_out, int out_size, void* d_ws, size_t ws_size, hipStream_t stream) {
    static int grid = 0;
    if (grid == 0) {
        if (n_in != 27 || out_size != T * 1024 || ws_size < WS_END) { fprintf(stderr, "kernel_launch: unexpected shapes/ws (n_in %d out %d ws %zu need %zu)\n", n_in, out_size, ws_size, (size_t)WS_END); grid = -1; return; }
        int dev = 0, cus = 0, per_cu = 0;
        (void)hipGetDevice(&dev); (void)hipDeviceGetAttribute(&cus, hipDeviceAttributeMultiprocessorCount, dev);
        (void)hipFuncSetAttribute((const void*)mk<true>, hipFuncAttributeMaxDynamicSharedMemorySize, LDS_BYTES);
        (void)hipOccupancyMaxActiveBlocksPerMultiprocessor(&per_cu, (const void*)mk<true>, 512, LDS_BYTES);
        if (per_cu < 1) fprintf(stderr, "kernel_launch: occupancy query says %d blocks/CU\n", per_cu);
        (void)hipGetLastError();
        grid = cus;
    }
    if (grid < 0) return;
    Params p{};
    for (int i = 0; i < 27; ++i) p.in[i] = (const float*)d_in[i];
    p.out = (float*)d_out; p.ws = (unsigned char*)d_ws;
    p.ph_lo = 0; p.ph_hi = NPHASE;
    (void)hipMemsetAsync((unsigned char*)d_ws + WS_BAR, 0, 256, stream);
    void* args[] = {&p};
    hipError_t e = hipLaunchCooperativeKernel((const void*)mk<true>, dim3(grid), dim3(512), args, LDS_BYTES, stream);
    if (e != hipSuccess) fprintf(stderr, "cooperative launch failed: %s (grid %d)\n", hipGetErrorString(e), grid);
}
```

```cpp
#include <hip/hip_runtime.h>
#include <hip/hip_cooperative_groups.h>
#include <cstdio>
#include <cstdint>
namespace cg = cooperative_groups;

#define LAS __attribute__((address_space(3)))
#define DI __device__ __forceinline__
typedef unsigned short bf16_t;
typedef short bf16x8 __attribute__((ext_vector_type(8)));
typedef short s16x4 __attribute__((ext_vector_type(4)));
typedef float f32x4 __attribute__((ext_vector_type(4)));
typedef float f32x16 __attribute__((ext_vector_type(16)));
typedef unsigned u32x4 __attribute__((ext_vector_type(4)));
typedef unsigned u32x2 __attribute__((ext_vector_type(2)));
typedef float f32x2_t __attribute__((ext_vector_type(2)));
typedef __bf16 bf16x2_t __attribute__((ext_vector_type(2)));

DI unsigned pk2(float lo, float hi) { f32x2_t v = {lo, hi}; bf16x2_t b = __builtin_convertvector(v, bf16x2_t); return __builtin_bit_cast(unsigned, b); }
DI bf16_t f2bf(float f) { return (bf16_t)(pk2(f, 0.f) & 0xffffu); }
DI float bf2f(unsigned b) { return __uint_as_float(b << 16); }
DI float bflo(unsigned w) { return __uint_as_float(w << 16); }
DI float bfhi(unsigned w) { return __uint_as_float(w & 0xffff0000u); }
DI f32x4 mfma16(bf16x8 a, bf16x8 b, f32x4 c) { return __builtin_amdgcn_mfma_f32_16x16x32_bf16(a, b, c, 0, 0, 0); }
DI f32x16 mfma32(bf16x8 a, bf16x8 b, f32x16 c) { return __builtin_amdgcn_mfma_f32_32x32x16_bf16(a, b, c, 0, 0, 0); }
DI float sigmoidf_(float x) { return __builtin_amdgcn_rcpf(1.f + __expf(-x)); }
DI float siluf_(float x) { return x * __builtin_amdgcn_rcpf(1.f + __expf(-x)); }
DI int opaque_tid() { int t = threadIdx.x; asm volatile("" : "+v"(t)); return t; }
DI int crow(int r, int hi) { return (r & 3) + 8 * (r >> 2) + 4 * hi; }

constexpr int T = 16384, SEQ = 8192, DM = 1024, DFF = 4096, INC = 14384;
constexpr float EPS = 1e-6f;
constexpr size_t MiB = 1u << 20;
constexpr size_t WS_ROWSQ = 0;
constexpr size_t WS_BAR = 448 * 1024;
constexpr size_t WS_DECG = 512 * 1024;
constexpr size_t WS_DECS = 768 * 1024;
constexpr size_t WS_SSQ = 1 * MiB;
constexpr size_t WS_SMALL = 2 * MiB;
constexpr size_t WS_XB = 6 * MiB;
constexpr size_t WS_MIXB = 38 * MiB;
constexpr size_t WS_WT = 70 * MiB;
constexpr size_t WT_GD = 0, WT_S = WT_GD + (size_t)8448 * 1024 * 2, WT_GLA = WT_S + (size_t)6144 * 1024 * 2, WT_SSM = WT_GLA + 2 * MiB,
                 WT_DIFF = WT_SSM + 4 * MiB, WT_OUT = WT_DIFF + 2 * MiB, WT_UP = WT_OUT + 2 * MiB, WT_DOWN = WT_UP + 8 * MiB, WT_END = WT_DOWN + 8 * MiB;
static_assert(WT_END <= 56 * MiB, "wt");
constexpr size_t WS_R = 126 * MiB;
constexpr size_t BLK = 32 * MiB;
constexpr size_t WS_STG = WS_R + 8 * BLK;
constexpr size_t WS_STS = WS_R + 6 * BLK;
constexpr size_t WS_SIDE = WS_R + 9 * BLK;
constexpr size_t SB_HN = WS_SIDE, SB_PROJ = SB_HN + 512 * 1024, SB_KV = SB_PROJ + 128 * 1024, SB_Y = SB_KV + 1024 * 1024, SB_GATE = SB_Y + 32 * 1024,
                 SB_BR = SB_GATE + 32 * 1024, SB_MIX = SB_BR + 32 * 1024, SB_XM = SB_MIX + 8192, SB_H2 = SB_XM + 8192, SB_UP = SB_H2 + 8192,
                 SB_HH = SB_UP + 32768, SB_X1 = SB_HH + 32768, SB_HN1 = SB_X1 + 8192, SB_QK1 = SB_HN1 + 8192, SB_END = SB_QK1 + 8192;
constexpr size_t WS_END = WS_SIDE + 2 * MiB;
static_assert(SB_END <= WS_END, "side");

struct Params {
    const float* in[27];
    float* out; unsigned char* ws;
    int ph_lo, ph_hi;
};

namespace pg8 {
constexpr int BM = 256, BK = 64, HALF = 128, HTB = HALF * BK * 2, STAGE_BYTES = 8 * HTB, NXCD = 8, WGM = 8;
__host__ __device__ __forceinline__ int lds_byte(int r, int c) { const int st = (r >> 4) * 2 + (c >> 5), rr = r & 15, cc = c & 31, ob = rr * 64 + cc * 2; return st * 1024 + (ob ^ (((ob >> 9) & 1) << 5)); }
__host__ __device__ __forceinline__ void stage_rc(int b, int& R, int& C) { const int st = b / 1024, sb = b % 1024, swz = sb ^ (((sb >> 9) & 1) << 5); R = (st >> 1) * 16 + swz / 64; C = (st & 1) * 32 + (swz % 64) / 2; }
struct Unit { int pm, pn; };
struct Gemm { const bf16_t* A; const bf16_t* Bt; int M, N, K, lda, ldb; };
struct StaticOrder {
    int nM, nN, nwg, G, c;
    __host__ __device__ void init(int M, int N, int G_, int c_) { nM = M / BM; nN = N / BM; nwg = nM * nN; G = G_; c = c_; }
    __host__ __device__ bool next(int i, Unit& u) const {
        const long L = (long)i * G + c; if (L >= nwg) return false;
        int wgid = (int)L; { const int q = nwg / NXCD, r = nwg % NXCD, xcd = wgid % NXCD, off = wgid / NXCD; wgid = (xcd < r ? xcd * (q + 1) : r * (q + 1) + (xcd - r) * q) + off; }
        const int nig = WGM * nN, gid = wgid / nig, fm = gid * WGM, gsz = (nM - fm) < WGM ? (nM - fm) : WGM;
        u.pm = fm + ((wgid % nig) % gsz); u.pn = (wgid % nig) / gsz; return true;
    }
};
template <class Epi, class Sched>
__device__ __forceinline__ void gemm_phase(LAS unsigned char* lds, const Gemm g, const Sched& S, const Epi& E) {
    const int tid = opaque_tid(), wid = __builtin_amdgcn_readfirstlane(tid >> 6), lane = tid & 63, wr = wid >> 2, wc = wid & 3, fr = lane & 15, fq = lane >> 4;
    const int K = g.K, nt = K / BK;
    unsigned voffA[2], voffB[2];
#pragma unroll
    for (int i = 0; i < 2; ++i) { int R, C; stage_rc(tid * 16 + i * 8192, R, C);
        voffA[i] = (unsigned)(R * g.lda + C) * 2u; voffB[i] = (unsigned)(R * g.ldb + C) * 2u; }
    const size_t kstep = (size_t)(BK * 2);
    const size_t hstepA = (size_t)HALF * g.lda * 2, hstepB = (size_t)HALF * g.ldb * 2;
    const size_t tstepA = 2 * hstepA, tstepB = 2 * hstepB;
    const unsigned ldsw = (unsigned)wid * 1024u;
    const int aoff = lds_byte(wr * 64 + fr, fq * 8), boff = lds_byte(wc * 32 + fr, fq * 8);
#define PG8_SA(b, h) (((b) * 2 + (h)) * HTB)
#define PG8_SB(b, h) ((4 + (b) * 2 + (h)) * HTB)
#define PG8_STAGE(bufoff, gbase, voff) do { _Pragma("unroll") for (int _i = 0; _i < 2; ++_i) \
        __builtin_amdgcn_global_load_lds((const unsigned*)((const char*)(gbase) + (voff)[_i]), (LAS unsigned*)(lds + (bufoff) + ldsw + _i * 8192), 16, 0, 0); } while (0)
#define PG8_LDA(dst, b, h) do { _Pragma("unroll") for (int m = 0; m < 4; ++m) _Pragma("unroll") for (int k = 0; k < 2; ++k) dst[m][k] = *(const LAS bf16x8*)(lds + PG8_SA(b, h) + aoff + m * 2048 + k * 1024); } while (0)
#define PG8_LDB(dst, b, h) do { _Pragma("unroll") for (int n = 0; n < 2; ++n) _Pragma("unroll") for (int k = 0; k < 2; ++k) dst[n][k] = *(const LAS bf16x8*)(lds + PG8_SB(b, h) + boff + n * 2048 + k * 1024); } while (0)
#define PG8_MMA(ai, bj, At, Bt) do { __builtin_amdgcn_s_setprio(1); _Pragma("unroll") for (int m = 0; m < 4; ++m) _Pragma("unroll") for (int n = 0; n < 2; ++n) _Pragma("unroll") for (int k = 0; k < 2; ++k) \
        acc[ai][bj][m][n] = __builtin_amdgcn_mfma_f32_16x16x32_bf16(Bt[n][k], At[m][k], acc[ai][bj][m][n], 0, 0, 0); __builtin_amdgcn_s_setprio(0); } while (0)
#define PG8_WAIT_V(n) asm volatile("s_waitcnt vmcnt(" #n ")" ::: "memory")
#define PG8_WAIT_L(n) asm volatile("s_waitcnt lgkmcnt(" #n ")" ::: "memory")
#define PG8_BAR __builtin_amdgcn_s_barrier()
#define PG8_SCHED __builtin_amdgcn_sched_barrier(0)
    Unit cur, nxt; int ui = 0;
    if (!S.next(0, cur)) return;
    f32x4 acc[2][2][4][2];
#pragma unroll
    for (int a = 0; a < 2; ++a)
#pragma unroll
        for (int b = 0; b < 2; ++b)
#pragma unroll
            for (int m = 0; m < 4; ++m)
#pragma unroll
                for (int n = 0; n < 2; ++n) acc[a][b][m][n] = (f32x4){0.f, 0.f, 0.f, 0.f};
    bf16x8 At[4][2], B0[2][2], B1[2][2];
    const char* cA = (const char*)g.A + (size_t)cur.pm * tstepA; const char* cB = (const char*)g.Bt + (size_t)cur.pn * tstepB;
    PG8_STAGE(PG8_SB(0, 0), cB, voffB); PG8_STAGE(PG8_SB(0, 1), cB + hstepB, voffB); PG8_STAGE(PG8_SA(0, 0), cA, voffA); PG8_STAGE(PG8_SA(0, 1), cA + hstepA, voffA);
    if (wr == 1) PG8_BAR;
    PG8_WAIT_V(2); PG8_BAR;
    PG8_STAGE(PG8_SB(1, 0), cB + kstep, voffB); PG8_STAGE(PG8_SA(1, 0), cA + kstep, voffA); PG8_STAGE(PG8_SB(1, 1), cB + hstepB + kstep, voffB);
    PG8_WAIT_V(6); PG8_BAR;
    for (;;) {
        const bool has_next = S.next(ui + 1, nxt);
        const char* nA = has_next ? (const char*)g.A + (size_t)nxt.pm * tstepA : cA; const char* nB = has_next ? (const char*)g.Bt + (size_t)nxt.pn * tstepB : cB;
        for (int t = 0; t < nt; t += 2) {
            const bool last = (t == nt - 2);
            const char* a1 = cA + (size_t)(t + 1) * kstep;
            const char* a2 = last ? nA : cA + (size_t)(t + 2) * kstep; const char* b2 = last ? nB : cB + (size_t)(t + 2) * kstep;
            const char* a3 = a2 + kstep; const char* b3 = b2 + kstep;
            PG8_LDB(B0, 0, 0); PG8_LDB(B1, 0, 1); PG8_SCHED; PG8_LDA(At, 0, 0); PG8_STAGE(PG8_SA(1, 1), a1 + hstepA, voffA);
            PG8_WAIT_V(8); PG8_WAIT_L(0); PG8_BAR; PG8_MMA(0, 0, At, B0); PG8_MMA(0, 1, At, B1); PG8_BAR; PG8_SCHED;
            PG8_LDA(At, 0, 1); PG8_STAGE(PG8_SB(0, 0), b2, voffB); PG8_STAGE(PG8_SB(0, 1), b2 + hstepB, voffB); PG8_STAGE(PG8_SA(0, 0), a2, voffA);
            PG8_WAIT_V(8); PG8_WAIT_L(0); PG8_BAR; PG8_MMA(1, 0, At, B0); PG8_MMA(1, 1, At, B1); PG8_BAR; PG8_SCHED;
            PG8_LDB(B0, 1, 0); PG8_LDB(B1, 1, 1); PG8_SCHED; PG8_LDA(At, 1, 0); PG8_STAGE(PG8_SA(0, 1), a2 + hstepA, voffA);
            PG8_WAIT_V(8); PG8_WAIT_L(0); PG8_BAR; PG8_MMA(0, 0, At, B0); PG8_MMA(0, 1, At, B1); PG8_BAR; PG8_SCHED;
            PG8_LDA(At, 1, 1); PG8_STAGE(PG8_SB(1, 0), b3, voffB); PG8_STAGE(PG8_SB(1, 1), b3 + hstepB, voffB); PG8_STAGE(PG8_SA(1, 0), a3, voffA);
            PG8_WAIT_V(8); PG8_WAIT_L(0); PG8_BAR; PG8_MMA(1, 0, At, B0); PG8_MMA(1, 1, At, B1); PG8_BAR; PG8_SCHED;
        }
        if (wr == 0) PG8_BAR;
        E(acc, cur, wr, wc, fr, fq);
        if (!has_next) break;
#pragma unroll
        for (int a = 0; a < 2; ++a)
#pragma unroll
            for (int b = 0; b < 2; ++b)
#pragma unroll
                for (int m = 0; m < 4; ++m)
#pragma unroll
                    for (int n = 0; n < 2; ++n) acc[a][b][m][n] = (f32x4){0.f, 0.f, 0.f, 0.f};
        cur = nxt; cA = nA; cB = nB; ++ui;
        if (wr == 1) PG8_BAR;
    }
    PG8_WAIT_V(0);
    PG8_BAR;
#undef PG8_SA
#undef PG8_SB
#undef PG8_STAGE
#undef PG8_LDA
#undef PG8_LDB
#undef PG8_MMA
#undef PG8_WAIT_V
#undef PG8_WAIT_L
#undef PG8_BAR
#undef PG8_SCHED
}
}

typedef f32x4 Acc[2][2][4][2];
#define EPI_LOOP(body) \
    _Pragma("unroll") for (int ai = 0; ai < 2; ++ai) _Pragma("unroll") for (int m = 0; m < 4; ++m) { const int row = u.pm * 256 + ai * 128 + wr * 64 + m * 16 + fr; \
    _Pragma("unroll") for (int bj = 0; bj < 2; ++bj) _Pragma("unroll") for (int n = 0; n < 2; ++n) { const int ct = bj * 128 + wc * 32 + n * 16 + fq * 4; f32x4 v = acc[ai][bj][m][n]; body } }

struct EpiIn {
    bf16_t* R; const float* rowsq; float* small; int small_tile; int gblkA, gblkB; const float* biasA; const float* biasB;
    DI void operator()(const Acc& acc, const pg8::Unit& u, int wr, int wc, int fr, int fq) const {
        const int blk = u.pn >> 2, cb = (u.pn & 3) * 256;
        if (u.pn == small_tile) {
            EPI_LOOP( if (ct < 64) { const float rs = rsqrtf(rowsq[row] * (1.f / 1024.f) + EPS); *(f32x4*)(small + (size_t)row * 64 + ct) = v * rs; } )
            return;
        }
        bf16_t* dst = R + (size_t)blk * (BLK / 2);
        const float* bias = (blk == gblkA) ? biasA : ((blk == gblkB) ? biasB : nullptr);
        if (bias) {
            EPI_LOOP( const float rs = rsqrtf(rowsq[row] * (1.f / 1024.f) + EPS); const f32x4 bv = *(const f32x4*)(bias + cb + ct); v = v * rs + bv;
                u32x2 w; w.x = pk2(sigmoidf_(v[0]), sigmoidf_(v[1])); w.y = pk2(sigmoidf_(v[2]), sigmoidf_(v[3])); *(u32x2*)(dst + (size_t)row * 1024 + cb + ct) = w; )
        } else {
            EPI_LOOP( const float rs = rsqrtf(rowsq[row] * (1.f / 1024.f) + EPS); v = v * rs;
                u32x2 w; w.x = pk2(v[0], v[1]); w.y = pk2(v[2], v[3]); *(u32x2*)(dst + (size_t)row * 1024 + cb + ct) = w; )
        }
    }
};
struct EpiMix {
    bf16_t* mixb; const bf16_t* gate; const float* ssq; int grp; int first;
    DI void operator()(const Acc& acc, const pg8::Unit& u, int wr, int wc, int fr, int fq) const {
        EPI_LOOP( const int col = u.pn * 256 + ct; const size_t o = (size_t)row * 1024 + col;
            float rs = 1.f; if (ssq) rs = rsqrtf(ssq[(size_t)row * 4 + grp] * (1.f / 512.f) + EPS);
            const u32x2 gw = *(const u32x2*)(gate + o);
            f32x4 r; r[0] = bflo(gw.x) * v[0] * rs; r[1] = bfhi(gw.x) * v[1] * rs; r[2] = bflo(gw.y) * v[2] * rs; r[3] = bfhi(gw.y) * v[3] * rs;
            if (!first) { const u32x2 mw = *(const u32x2*)(mixb + o); r[0] += bflo(mw.x); r[1] += bfhi(mw.x); r[2] += bflo(mw.y); r[3] += bfhi(mw.y); }
            u32x2 w; w.x = pk2(r[0], r[1]); w.y = pk2(r[2], r[3]); *(u32x2*)(mixb + o) = w; )
    }
};
struct EpiRes {
    const float* xold; float* xnew; bf16_t* xb; float* rowsq;
    DI void operator()(const Acc& acc, const pg8::Unit& u, int wr, int wc, int fr, int fq) const {
#pragma unroll
        for (int ai = 0; ai < 2; ++ai)
#pragma unroll
            for (int m = 0; m < 4; ++m) { const int row = u.pm * 256 + ai * 128 + wr * 64 + m * 16 + fr; float ss = 0.f;
#pragma unroll
                for (int bj = 0; bj < 2; ++bj)
#pragma unroll
                    for (int n = 0; n < 2; ++n) { const int col = u.pn * 256 + bj * 128 + wc * 32 + n * 16 + fq * 4; const size_t o = (size_t)row * 1024 + col;
                        f32x4 v = acc[ai][bj][m][n] + *(const f32x4*)(xold + o); *(f32x4*)(xnew + o) = v;
                        u32x2 w; w.x = pk2(v[0], v[1]); w.y = pk2(v[2], v[3]); *(u32x2*)(xb + o) = w;
                        ss += v[0] * v[0] + v[1] * v[1] + v[2] * v[2] + v[3] * v[3]; }
                ss += __shfl_xor(ss, 16); ss += __shfl_xor(ss, 32);
                if (fq == 0) atomicAdd(rowsq + row, ss); }
    }
};
struct EpiUp {
    bf16_t* h; const float* rowsq;
    DI void operator()(const Acc& acc, const pg8::Unit& u, int wr, int wc, int fr, int fq) const {
        EPI_LOOP( const float rs = rsqrtf(rowsq[row] * (1.f / 1024.f) + EPS); v = v * rs;
            f32x4 r; r[0] = fmaxf(v[0], 0.f); r[1] = fmaxf(v[1], 0.f); r[2] = fmaxf(v[2], 0.f); r[3] = fmaxf(v[3], 0.f); r = r * r;
            u32x2 w; w.x = pk2(r[0], r[1]); w.y = pk2(r[2], r[3]); *(u32x2*)(h + (size_t)row * 4096 + u.pn * 256 + ct) = w; )
    }
};

DI int colmap(int kind, int n) {
    if (kind == 1) {
        if (n < 2048) return n;
        if (n < 3072) return 2064 + (n - 2048);
        if (n < 4096) return 11312 + (n - 3072);
        if (n < 5120) return 8240 + (n - 4096);
        if (n < 6144) return 9264 + (n - 5120);
        if (n < 7168) return 10288 + (n - 6144);
        if (n < 8192) return 13360 + (n - 7168);
        const int i = n - 8192; if (i < 16) return 2048 + i; if (i < 48) return 8208 + (i - 16); return -1;
    }
    if (kind == 2) {
        if (n < 2048) return 3088 + n;
        if (n < 5120) return 5136 + (n - 2048);
        return 12336 + (n - 5120);
    }
    return n;
}
DI void tr_item(const float* W, int ldw, int K, bf16_t* WT, const float* kscale, int kind, int kb, int nb, LAS float* scr, int lane) {
    const int k0 = 64 * kb, n0 = 32 * nb; const int sc = colmap(kind, n0 + (lane & 31));
#pragma unroll 8
    for (int i = 0; i < 32; ++i) { const int kk = 2 * i + (lane >> 5); float v = 0.f; if (sc >= 0) { v = W[(size_t)(k0 + kk) * ldw + sc]; if (kscale) v *= kscale[k0 + kk]; } scr[kk * 33 + (lane & 31)] = v; }
    asm volatile("s_waitcnt lgkmcnt(0)" ::: "memory");
    const int c = lane & 7;
#pragma unroll
    for (int j = 0; j < 4; ++j) { const int n = (lane >> 3) + 8 * j; const LAS float* s = scr + (8 * c) * 33 + n;
        u32x4 o; o.x = pk2(s[0 * 33], s[1 * 33]); o.y = pk2(s[2 * 33], s[3 * 33]); o.z = pk2(s[4 * 33], s[5 * 33]); o.w = pk2(s[6 * 33], s[7 * 33]);
        *(u32x4*)(WT + (size_t)(n0 + n) * K + k0 + 8 * c) = o; }
    asm volatile("s_waitcnt lgkmcnt(0)" ::: "memory");
}
DI float wave_sum(float v) {
#pragma unroll
    for (int o = 1; o < 64; o <<= 1) v += __shfl_xor(v, o);
    return v;
}
DI void phase_prep(const Params& p, int l, LAS unsigned char* lds) {
    const int tid = opaque_tid(), lane = tid & 63, wave = __builtin_amdgcn_readfirstlane(tid >> 6);
    const int gw = blockIdx.x * 8 + wave, NGW = gridDim.x * 8;
    LAS float* scr = (LAS float*)(lds + wave * 8704);
    unsigned char* ws = p.ws; bf16_t* wt = (bf16_t*)(ws + WS_WT);
    const float* w_in = p.in[3] + (size_t)l * 1024 * INC;
    constexpr int I0 = 16 * 264, I1 = 16 * 192, I2 = 16 * 32, I3 = 32 * 32, I4 = 16 * 32, I5 = 16 * 32, I6 = 16 * 128, I7 = 64 * 32;
    constexpr int NIT = I0 + I1 + I2 + I3 + I4 + I5 + I6 + I7;
    for (int it = gw; it < NIT; it += NGW) {
        int r = it;
        if (r < I0) { tr_item(w_in, INC, 1024, (bf16_t*)((char*)wt + WT_GD), p.in[2] + l * 1024, 1, r / 264, r % 264, scr, lane); continue; } r -= I0;
        if (r < I1) { tr_item(w_in, INC, 1024, (bf16_t*)((char*)wt + WT_S), p.in[2] + l * 1024, 2, r / 192, r % 192, scr, lane); continue; } r -= I1;
        if (r < I2) { tr_item(p.in[19] + (size_t)l * 1024 * 1024, 1024, 1024, (bf16_t*)((char*)wt + WT_GLA), nullptr, 0, r / 32, r % 32, scr, lane); continue; } r -= I2;
        if (r < I3) { tr_item(p.in[20] + (size_t)l * 2048 * 1024, 1024, 2048, (bf16_t*)((char*)wt + WT_SSM), p.in[13] + l * 2048, 0, r / 32, r % 32, scr, lane); continue; } r -= I3;
        if (r < I4) { tr_item(p.in[21] + (size_t)l * 1024 * 1024, 1024, 1024, (bf16_t*)((char*)wt + WT_DIFF), nullptr, 0, r / 32, r % 32, scr, lane); continue; } r -= I4;
        if (r < I5) { tr_item(p.in[22] + (size_t)l * 1024 * 1024, 1024, 1024, (bf16_t*)((char*)wt + WT_OUT), nullptr, 0, r / 32, r % 32, scr, lane); continue; } r -= I5;
        if (r < I6) { tr_item(p.in[24] + (size_t)l * 1024 * 4096, 4096, 1024, (bf16_t*)((char*)wt + WT_UP), p.in[23] + l * 1024, 0, r / 128, r % 128, scr, lane); continue; } r -= I6;
        tr_item(p.in[25] + (size_t)l * 4096 * 1024, 1024, 4096, (bf16_t*)((char*)wt + WT_DOWN), nullptr, 0, r / 32, r % 32, scr, lane);
    }
    const int gt = blockIdx.x * 512 + tid, NT_ = gridDim.x * 512;
    float* ssq = (float*)(ws + WS_SSQ);
    for (int i = gt; i < T * 4; i += NT_) ssq[i] = 0.f;
    if (l == 0) {
        float* rowsq = (float*)(ws + WS_ROWSQ);
        for (int i = gt; i < 4 * T; i += NT_) rowsq[T + i] = 0.f;
        bf16_t* xb = (bf16_t*)(ws + WS_XB); const float* x = p.in[0];
        for (int m = gw; m < T; m += NGW) {
            const f32x4* xr = (const f32x4*)(x + (size_t)m * 1024) + lane; float s = 0.f;
            u32x2* o = (u32x2*)(xb + (size_t)m * 1024) + lane;
#pragma unroll
            for (int j = 0; j < 4; ++j) { const f32x4 v = xr[64 * j]; s += v[0] * v[0] + v[1] * v[1] + v[2] * v[2] + v[3] * v[3]; u32x2 w; w.x = pk2(v[0], v[1]); w.y = pk2(v[2], v[3]); o[64 * j] = w; }
            s = wave_sum(s); if (lane == 0) rowsq[m] = s;
        }
    }
}

DI void rope_pass(const Params& p) {
    const int* pos = (const int*)p.in[1];
    bf16_t* Qd = (bf16_t*)(p.ws + WS_R + 4 * BLK); bf16_t* Kd = (bf16_t*)(p.ws + WS_R + 5 * BLK);
    const double cf[8] = {0.15915494309189535, 0.03086376340470123, 0.005985185712713705, 0.001160663641240061, 0.00022507907903927653, 4.364795279280289e-05, 8.464330808241401e-06, 1.6414262627950345e-06};
    const int gt = blockIdx.x * 512 + opaque_tid(), NTH = gridDim.x * 512;
    for (int it = gt; it < T * 32; it += NTH) {
        const int t = it >> 5, w = it & 31; bf16_t* base = ((w & 16) ? Kd : Qd) + (size_t)t * 1024 + (w & 15) * 64;
        const double ps = (double)pos[t];
        u32x4 a = *(u32x4*)base, b = *(u32x4*)(base + 8);
        float t1[8], t2[8];
#pragma unroll
        for (int i = 0; i < 4; ++i) { t1[2 * i] = bflo(a[i]); t1[2 * i + 1] = bfhi(a[i]); t2[2 * i] = bflo(b[i]); t2[2 * i + 1] = bfhi(b[i]); }
        float o1[8], o2[8];
#pragma unroll
        for (int i = 0; i < 8; ++i) { double rv = ps * cf[i]; rv -= floor(rv); const float fr = (float)rv; const float sn = __builtin_amdgcn_sinf(fr), cs = __builtin_amdgcn_cosf(fr);
            o1[i] = t1[i] * cs - t2[i] * sn; o2[i] = t2[i] * cs + t1[i] * sn; }
#pragma unroll
        for (int i = 0; i < 4; ++i) { a[i] = pk2(o1[2 * i], o1[2 * i + 1]); b[i] = pk2(o2[2 * i], o2[2 * i + 1]); }
        *(u32x4*)base = a; *(u32x4*)(base + 8) = b;
    }
}

template <int KS> DI f32x4 mm16(f32x4 acc, const LAS unsigned char* A, int lda_b, const LAS unsigned char* B, int ldb_b, int lane) {
    const int r = lane & 15, q = lane >> 4;
    const LAS unsigned char* ap = A + r * lda_b + q * 16; const LAS unsigned char* bp = B + r * ldb_b + q * 16;
#pragma unroll
    for (int s = 0; s < KS; ++s) acc = mfma16(*(const LAS bf16x8*)(ap + s * 64), *(const LAS bf16x8*)(bp + s * 64), acc);
    return acc;
}
DI float logsigmoidf_(float x) { return fminf(x, 0.f) - __logf(1.f + __expf(-fabsf(x))); }

constexpr int G_GKL = 0, G_QTOT = 4096, G_BLAST = 6144, G_PART = 6656, G_QT = 8704, G_KT = 26112, G_KHT = 43520, G_VT = 61952, G_P = 98816;
template <int MODE> DI void gla_unit(const Params& p, int l, int un, LAS unsigned char* lds) {
    const int tid = opaque_tid(), lane = tid & 63, w = __builtin_amdgcn_readfirstlane(tid >> 6), r16 = lane & 15, quad = lane >> 4;
    const int sc = un >> 2, h = un & 3, tok0 = sc * 256;
    unsigned char* ws = p.ws;
    const bf16_t* QK = (const bf16_t*)(ws + WS_R); const bf16_t* Vg = (const bf16_t*)(ws + WS_R + BLK); bf16_t* Gg = (bf16_t*)(ws + WS_R + 2 * BLK);
    const float* small = (const float*)(ws + WS_SMALL);
    float* states = (float*)(ws + WS_STG) + (size_t)un * 32768;
    const int d = tid & 127, qr = tid >> 7;
    float wk[16];
#pragma unroll
    for (int r = 0; r < 16; ++r) wk[r] = p.in[5][(size_t)l * 16 * 512 + r * 512 + h * 128 + d];
    const float bk = p.in[6][l * 512 + h * 128 + d];
    f32x4 S[8][2];
    if (MODE == 3) {
#pragma unroll
        for (int mb = 0; mb < 8; ++mb)
#pragma unroll
            for (int nb = 0; nb < 2; ++nb) S[mb][nb] = *(const f32x4*)(states + ((size_t)(w * 16 + mb * 2 + nb) * 64 + lane) * 4);
    } else {
#pragma unroll
        for (int mb = 0; mb < 8; ++mb)
#pragma unroll
            for (int nb = 0; nb < 2; ++nb) S[mb][nb] = (f32x4){0.f, 0.f, 0.f, 0.f};
    }
    float ng[2] = {0.f, 0.f};
    if (MODE == 3) { ng[0] = p.in[7][l * 256 + 32 * w + r16]; ng[1] = p.in[7][l * 256 + 32 * w + 16 + r16]; }
    float dtot = 1.f;
    for (int j = 0; j < 4; ++j) {
        const int t0 = tok0 + 64 * j;
        if (tid < 256) { const int row = tid >> 2, c4 = (tid & 3) * 4; *(LAS f32x4*)(lds + G_GKL + (row * 16 + c4) * 4) = *(const f32x4*)(small + (size_t)(t0 + row) * 64 + c4); }
        if (tid < 64) ((LAS float*)(lds + G_PART))[tid] = 0.f;
        __syncthreads();
        float c[16]; float run = 0.f;
#pragma unroll
        for (int i = 0; i < 16; ++i) { const LAS f32x4* gr = (const LAS f32x4*)(lds + G_GKL) + (qr * 16 + i) * 4; float x = bk;
#pragma unroll
            for (int r = 0; r < 4; ++r) { const f32x4 g4 = gr[r]; x += g4[0] * wk[4 * r] + g4[1] * wk[4 * r + 1] + g4[2] * wk[4 * r + 2] + g4[3] * wk[4 * r + 3]; }
            run += logsigmoidf_(x) * (1.f / 16.f); c[i] = run; }
        ((LAS float*)(lds + G_QTOT))[qr * 128 + d] = run;
        __syncthreads();
        {
            float off = 0.f, bl = 0.f;
#pragma unroll
            for (int q2 = 0; q2 < 4; ++q2) { const float v = ((const LAS float*)(lds + G_QTOT))[q2 * 128 + d]; bl += v; if (q2 < qr) off += v; }
            unsigned khp[8]; const float ebl = __expf(bl);
#pragma unroll
            for (int i = 0; i < 16; i += 2) {
                float kh2[2];
#pragma unroll
                for (int e = 0; e < 2; ++e) { const int t = qr * 16 + i + e; const float b = off + c[i + e];
                    const float k = bf2f(QK[(size_t)(t0 + t) * 1024 + 512 + h * 128 + d]);
                    const float enb = __expf(-b), kt_ = k * enb;
                    kh2[e] = kt_ * ebl;
                    if (MODE == 3) { const float q = bf2f(QK[(size_t)(t0 + t) * 1024 + h * 128 + d]);
                        ((LAS bf16_t*)(lds + G_QT))[t * 136 + d] = f2bf(q * 0.08838834764831845f * __builtin_amdgcn_rcpf(enb));
                        ((LAS bf16_t*)(lds + G_KT))[t * 136 + d] = f2bf(kt_); } }
                khp[i >> 1] = pk2(kh2[0], kh2[1]);
            }
            *(LAS u32x4*)(lds + G_KHT + d * 144 + qr * 32) = (u32x4){khp[0], khp[1], khp[2], khp[3]};
            *(LAS u32x4*)(lds + G_KHT + d * 144 + qr * 32 + 16) = (u32x4){khp[4], khp[5], khp[6], khp[7]};
            if (qr == 0) { ((LAS float*)(lds + G_BLAST))[d] = bl; dtot *= ebl; }
#pragma unroll
            for (int i = 0; i < 4; ++i) { const int pid = tid + 512 * i, g8 = pid >> 6, t = pid & 63;
                const u32x4 v = *(const u32x4*)(Vg + (size_t)(t0 + t) * 1024 + h * 256 + g8 * 8);
                LAS bf16_t* vt = (LAS bf16_t*)(lds + G_VT) + (g8 * 8) * 72 + t;
#pragma unroll
                for (int e = 0; e < 4; ++e) { vt[(2 * e) * 72] = (bf16_t)(v[e] & 0xffffu); vt[(2 * e + 1) * 72] = (bf16_t)(v[e] >> 16); } }
        }
        __syncthreads();
        if (MODE == 3) {
#pragma unroll
            for (int e = 0; e < 2; ++e) { const int x = 2 * w + e, tb = x >> 2, sb = x & 3;
                f32x4 a = (f32x4){0.f, 0.f, 0.f, 0.f};
                if (sb <= tb) a = mm16<4>(a, lds + G_KT + sb * 16 * 272, 272, lds + G_QT + tb * 16 * 272, 272, lane);
                const int t = 16 * tb + r16, s0 = 16 * sb + quad * 4;
                float v[4];
#pragma unroll
                for (int jj = 0; jj < 4; ++jj) v[jj] = (s0 + jj <= t) ? a[jj] : 0.f;
                if (x == 0 && lane == 0 && j == 0 && (tok0 & (SEQ - 1)) == 0) { const float* qk_ = (l == 0) ? (const float*)(ws + SB_PROJ) + (tok0 >> 13) * 14384 : (const float*)(ws + SB_QK1) + (tok0 >> 13) * 1024;
                    float acc_ = 0.f; for (int d_ = 0; d_ < 128; ++d_) acc_ += qk_[h * 128 + d_] * qk_[512 + h * 128 + d_]; v[0] = acc_ * 0.08838834764831845f; }
                *(LAS u32x2*)(lds + G_P + t * 144 + s0 * 2) = (u32x2){pk2(v[0], v[1]), pk2(v[2], v[3])}; }
            f32x4 o[4][2];
#pragma unroll
            for (int mb = 0; mb < 4; ++mb) { o[mb][0] = (f32x4){0.f, 0.f, 0.f, 0.f}; o[mb][1] = (f32x4){0.f, 0.f, 0.f, 0.f}; }
#pragma unroll
            for (int ks = 0; ks < 4; ++ks) {
                bf16x8 bf[2];
#pragma unroll
                for (int nb = 0; nb < 2; ++nb) { const f32x4 s0v = S[2 * ks][nb], s1v = S[2 * ks + 1][nb];
                    u32x4 pk; pk.x = pk2(s0v[0], s0v[1]); pk.y = pk2(s0v[2], s0v[3]); pk.z = pk2(s1v[0], s1v[1]); pk.w = pk2(s1v[2], s1v[3]); bf[nb] = __builtin_bit_cast(bf16x8, pk); }
#pragma unroll
                for (int mb = 0; mb < 4; ++mb) { const LAS unsigned char* ap = lds + G_QT + (16 * mb + r16) * 272 + (32 * ks + quad * 4) * 2;
                    const u32x2 lo = *(const LAS u32x2*)ap, hi = *(const LAS u32x2*)(ap + 32);
                    const bf16x8 af = __builtin_bit_cast(bf16x8, (u32x4){lo.x, lo.y, hi.x, hi.y});
                    o[mb][0] = mfma16(af, bf[0], o[mb][0]); o[mb][1] = mfma16(af, bf[1], o[mb][1]); }
            }
            __syncthreads();
#pragma unroll
            for (int mb = 0; mb < 4; ++mb)
#pragma unroll
                for (int nb = 0; nb < 2; ++nb) o[mb][nb] = mm16<2>(o[mb][nb], lds + G_P + mb * 16 * 144, 144, lds + G_VT + (32 * w + 16 * nb) * 144, 144, lane);
#pragma unroll
            for (int mb = 0; mb < 4; ++mb)
#pragma unroll
                for (int jj = 0; jj < 4; ++jj) { float ss = o[mb][0][jj] * o[mb][0][jj] + o[mb][1][jj] * o[mb][1][jj];
                    ss += __shfl_xor(ss, 1); ss += __shfl_xor(ss, 2); ss += __shfl_xor(ss, 4); ss += __shfl_xor(ss, 8);
                    if (r16 == 0) __hip_atomic_fetch_add((LAS float*)(lds + G_PART) + 16 * mb + quad * 4 + jj, ss, __ATOMIC_RELAXED, __HIP_MEMORY_SCOPE_WORKGROUP); }
            __syncthreads();
#pragma unroll
            for (int mb = 0; mb < 4; ++mb)
#pragma unroll
                for (int jj = 0; jj < 4; ++jj) { const int t = 16 * mb + quad * 4 + jj; const float rs = rsqrtf(((const LAS float*)(lds + G_PART))[t] * (1.f / 256.f) + EPS);
#pragma unroll
                    for (int nb = 0; nb < 2; ++nb) { bf16_t* gp = Gg + (size_t)(t0 + t) * 1024 + h * 256 + 32 * w + 16 * nb + r16;
                        const float gv = bf2f(*gp); *gp = f2bf(o[mb][nb][jj] * rs * ng[nb] * siluf_(gv)); } }
        }
#pragma unroll
        for (int mb = 0; mb < 8; ++mb) { const f32x4 bl4 = *(const LAS f32x4*)(lds + G_BLAST + (16 * mb + quad * 4) * 4);
            const f32x4 dc = (f32x4){__expf(bl4[0]), __expf(bl4[1]), __expf(bl4[2]), __expf(bl4[3])};
#pragma unroll
            for (int nb = 0; nb < 2; ++nb) { S[mb][nb] = S[mb][nb] * dc;
                S[mb][nb] = mm16<2>(S[mb][nb], lds + G_KHT + mb * 16 * 144, 144, lds + G_VT + (32 * w + 16 * nb) * 144, 144, lane); } }
        __syncthreads();
    }
    if (MODE == 1) {
#pragma unroll
        for (int mb = 0; mb < 8; ++mb)
#pragma unroll
            for (int nb = 0; nb < 2; ++nb) *(f32x4*)(states + ((size_t)(w * 16 + mb * 2 + nb) * 64 + lane) * 4) = S[mb][nb];
        if (tid < 128) ((float*)(ws + WS_DECG))[un * 128 + tid] = dtot;
    }
}
DI void gla_scan(const Params& p) {
    const int gid = blockIdx.x * 512 + opaque_tid();
    for (int it = gid; it < 65536; it += gridDim.x * 512) {
        const int chain = it >> 13, e = it & 8191, b = chain >> 2, h = chain & 3;
        const int tile = (e >> 6) & 15, lane = e & 63, d0 = 16 * (tile >> 1) + (lane >> 4) * 4;
        f32x4* st = (f32x4*)(p.ws + WS_STG); const float* dec = (const float*)(p.ws + WS_DECG);
        f32x4 run = (f32x4){0.f, 0.f, 0.f, 0.f};
        for (int hb = 0; hb < 4; ++hb) {
            f32x4 u[8];
#pragma unroll
            for (int s = 0; s < 8; ++s) u[s] = st[(size_t)((b * 32 + hb * 8 + s) * 4 + h) * 8192 + e];
            asm volatile("" ::: "memory");
#pragma unroll
            for (int s = 0; s < 8; ++s) { const int un = (b * 32 + hb * 8 + s) * 4 + h; const f32x4 dc = *(const f32x4*)(dec + un * 128 + d0);
                st[(size_t)un * 8192 + e] = run; run = run * dc + u[s]; }
        }
    }
}

constexpr int S_ACUM = 0, S_DTV = 256, S_MISC = 512, S_XDT = 1024, S_XD2 = 10240, S_BN = 19456, S_BT = 36864, S_CN = 55296, S_GL = 72704, S_SB = 81920;
DI float softplusf_(float x) { const float e = __expf(x); return x > 20.f ? x : (x < -10.f ? e : __logf(1.f + e)); }
template <int MODE> DI void ssd_unit(const Params& p, int l, int un, LAS unsigned char* lds) {
    const int tid = opaque_tid(), lane = tid & 63, w = __builtin_amdgcn_readfirstlane(tid >> 6), r16 = lane & 15, quad = lane >> 4;
    const int sc = un >> 5, head = un & 31, g = head >> 3, tok0 = sc * 256;
    unsigned char* ws = p.ws;
    bf16_t* Zb = (bf16_t*)(ws + WS_R + (size_t)(head >> 4) * BLK) + (head & 15) * 64;
    const bf16_t* Xb = (const bf16_t*)(ws + WS_R + (size_t)(2 + (head >> 4)) * BLK) + (head & 15) * 64;
    const bf16_t* BCb = (const bf16_t*)(ws + WS_R + 4 * BLK);
    const float* small = (const float*)(ws + WS_SMALL);
    float* ssq = (float*)(ws + WS_SSQ);
    float* states = (float*)(ws + WS_STS) + (size_t)un * 8192;
    const float* cw = p.in[8] + (size_t)l * 4 * 3072; const float* cbias = p.in[9] + l * 3072;
    const float dtb = p.in[10][l * 32 + head], aneg = -__expf(p.in[11][l * 32 + head]), Dh = p.in[12][l * 32 + head];
    f32x4 st[4];
    if (MODE == 3) {
#pragma unroll
        for (int pb = 0; pb < 4; ++pb) { st[pb] = *(const f32x4*)(states + ((size_t)(w * 4 + pb) * 64 + lane) * 4);
            *(LAS u32x2*)(lds + S_SB + (16 * pb + r16) * 272 + (16 * w + quad * 4) * 2) = (u32x2){pk2(st[pb][0], st[pb][1]), pk2(st[pb][2], st[pb][3])}; }
    } else {
#pragma unroll
        for (int pb = 0; pb < 4; ++pb) st[pb] = (f32x4){0.f, 0.f, 0.f, 0.f};
    }
    const int px = tid & 63, tq = tid >> 6;
    float wx[4];
#pragma unroll
    for (int i = 0; i < 4; ++i) wx[i] = cw[i * 3072 + head * 64 + px];
    const float bx = cbias[head * 64 + px];
    float atot = 0.f;
    for (int j = 0; j < 4; ++j) {
        const int t0 = tok0 + 64 * j, s0 = t0 & (SEQ - 1);
        if (w == 0) {
            const float dt = softplusf_(small[(size_t)(t0 + lane) * 64 + 16 + head] + dtb);
            float cs = dt * aneg;
#pragma unroll
            for (int o = 1; o < 64; o <<= 1) { const float v = __shfl_up(cs, o); if (lane >= o) cs += v; }
            ((LAS float*)(lds + S_ACUM))[lane] = cs; ((LAS float*)(lds + S_DTV))[lane] = dt;
            if (lane == 63) ((LAS float*)(lds + S_MISC))[0] = cs;
        }
        __syncthreads();
        const float alast = ((const LAS float*)(lds + S_MISC))[0];
        atot += alast;
        {
            float xv[11];
#pragma unroll
            for (int k = 0; k < 11; ++k) { const int tt = tq * 8 - 3 + k; xv[k] = (s0 + tt >= 0) ? bf2f(Xb[(size_t)(t0 + tt) * 1024 + px]) : 0.f; }
            unsigned a1[4], a2[4]; float e1[2], e2[2];
#pragma unroll
            for (int i = 0; i < 8; ++i) { const int t = tq * 8 + i;
                const float cv = bx + xv[i] * wx[0] + xv[i + 1] * wx[1] + xv[i + 2] * wx[2] + xv[i + 3] * wx[3];
                const float xd = siluf_(cv) * ((const LAS float*)(lds + S_DTV))[t];
                e1[i & 1] = xd; e2[i & 1] = xd * __expf(alast - ((const LAS float*)(lds + S_ACUM))[t]);
                if (i & 1) { a1[i >> 1] = pk2(e1[0], e1[1]); a2[i >> 1] = pk2(e2[0], e2[1]); } }
            *(LAS u32x4*)(lds + S_XDT + px * 144 + tq * 16) = (u32x4){a1[0], a1[1], a1[2], a1[3]};
            *(LAS u32x4*)(lds + S_XD2 + px * 144 + tq * 16) = (u32x4){a2[0], a2[1], a2[2], a2[3]};
        }
        {
            const bf16_t* BCc = (const bf16_t*)(ws + WS_STG);
#pragma unroll
            for (int i = 0; i < 2; ++i) { const int pid = tid + 512 * i, c8 = pid >> 6, t = pid & 63;
                const u32x4 v = *(const u32x4*)(BCc + (size_t)(t0 + t) * 1024 + g * 128 + c8 * 8);
                if (MODE == 3) *(LAS u32x4*)(lds + S_BN + t * 272 + c8 * 16) = v;
                LAS bf16_t* bt = (LAS bf16_t*)(lds + S_BT) + (c8 * 8) * 72 + t;
#pragma unroll
                for (int e = 0; e < 4; ++e) { bt[(2 * e) * 72] = (bf16_t)(v[e] & 0xffffu); bt[(2 * e + 1) * 72] = (bf16_t)(v[e] >> 16); }
                if (MODE == 3) { const u32x4 cv = *(const u32x4*)(BCc + (size_t)(t0 + t) * 1024 + 512 + g * 128 + c8 * 8); *(LAS u32x4*)(lds + S_CN + t * 272 + c8 * 16) = cv; } }
        }
        __syncthreads();
        if (MODE == 3) {
            f32x4 y[2];
#pragma unroll
            for (int e = 0; e < 2; ++e) { const int x = 2 * w + e, tb = x >> 2, sb = x & 3;
                f32x4 a = (f32x4){0.f, 0.f, 0.f, 0.f};
                if (sb <= tb) a = mm16<4>(a, lds + S_BN + sb * 16 * 272, 272, lds + S_CN + tb * 16 * 272, 272, lane);
                const int t = 16 * tb + r16, sb0 = 16 * sb + quad * 4;
                const float act = ((const LAS float*)(lds + S_ACUM))[t], dtt = ((const LAS float*)(lds + S_DTV))[t];
                float v[4];
#pragma unroll
                for (int jj = 0; jj < 4; ++jj) { const int s = sb0 + jj; float val = 0.f;
                    if (s <= t) val = a[jj] * __expf(act - ((const LAS float*)(lds + S_ACUM))[s]);
                    if (s == t) val += Dh * __builtin_amdgcn_rcpf(dtt);
                    v[jj] = val; }
                *(LAS u32x2*)(lds + S_GL + t * 144 + sb0 * 2) = (u32x2){pk2(v[0], v[1]), pk2(v[2], v[3])};
                const int pb = sb;
                y[e] = mm16<4>((f32x4){0.f, 0.f, 0.f, 0.f}, lds + S_SB + pb * 16 * 272, 272, lds + S_CN + tb * 16 * 272, 272, lane);
                y[e] = y[e] * __expf(act);
            }
            __syncthreads();
#pragma unroll
            for (int e = 0; e < 2; ++e) { const int x = 2 * w + e, tb = x >> 2, pb = x & 3;
                y[e] = mm16<2>(y[e], lds + S_XDT + pb * 16 * 144, 144, lds + S_GL + tb * 16 * 144, 144, lane);
                const int t = 16 * tb + r16; bf16_t* zp = Zb + (size_t)(t0 + t) * 1024 + 16 * pb + quad * 4;
                const u32x2 zw = *(const u32x2*)zp;
                f32x4 r; r[0] = y[e][0] * siluf_(bflo(zw.x)); r[1] = y[e][1] * siluf_(bfhi(zw.x)); r[2] = y[e][2] * siluf_(bflo(zw.y)); r[3] = y[e][3] * siluf_(bfhi(zw.y));
                float ss = r[0] * r[0] + r[1] * r[1] + r[2] * r[2] + r[3] * r[3];
                ss += __shfl_xor(ss, 16); ss += __shfl_xor(ss, 32);
                if (quad == 0) atomicAdd(ssq + (size_t)(t0 + t) * 4 + g, ss);
                *(u32x2*)zp = (u32x2){pk2(r[0], r[1]), pk2(r[2], r[3])}; }
        }
        {
            const float da = __expf(alast);
#pragma unroll
            for (int pb = 0; pb < 4; ++pb) { st[pb] = st[pb] * da;
                st[pb] = mm16<2>(st[pb], lds + S_BT + w * 16 * 144, 144, lds + S_XD2 + pb * 16 * 144, 144, lane);
                if (MODE == 3) *(LAS u32x2*)(lds + S_SB + (16 * pb + r16) * 272 + (16 * w + quad * 4) * 2) = (u32x2){pk2(st[pb][0], st[pb][1]), pk2(st[pb][2], st[pb][3])}; }
        }
        __syncthreads();
    }
    if (MODE == 1) {
#pragma unroll
        for (int pb = 0; pb < 4; ++pb) *(f32x4*)(states + ((size_t)(w * 4 + pb) * 64 + lane) * 4) = st[pb];
        if (tid == 0) ((float*)(ws + WS_DECS))[un] = __expf(atot);
    }
}

DI void conv_bc(const Params& p, int l) {
    const bf16_t* BC = (const bf16_t*)(p.ws + WS_R + 4 * BLK); bf16_t* O = (bf16_t*)(p.ws + WS_STG);
    const float* cw = p.in[8] + (size_t)l * 4 * 3072 + 2048; const float* cb = p.in[9] + l * 3072 + 2048;
    const int gt = blockIdx.x * 512 + opaque_tid();
    for (int it = gt; it < 1024 * 256; it += gridDim.x * 512) {
        const int c = it & 1023, r0 = (it >> 10) * 64;
        const float w0 = cw[c], w1 = cw[3072 + c], w2 = cw[2 * 3072 + c], w3 = cw[3 * 3072 + c], b = cb[c];
        float x0 = 0.f, x1 = 0.f, x2 = 0.f;
        if ((r0 & (SEQ - 1)) != 0) { x0 = bf2f(BC[(size_t)(r0 - 3) * 1024 + c]); x1 = bf2f(BC[(size_t)(r0 - 2) * 1024 + c]); x2 = bf2f(BC[(size_t)(r0 - 1) * 1024 + c]); }
#pragma unroll 8
        for (int i = 0; i < 64; ++i) { const float x3 = bf2f(BC[(size_t)(r0 + i) * 1024 + c]); const float cv = b + x0 * w0 + x1 * w1 + x2 * w2 + x3 * w3;
            O[(size_t)(r0 + i) * 1024 + c] = f2bf(siluf_(cv)); x0 = x1; x1 = x2; x2 = x3; }
    }
}
DI void ssd_scan(const Params& p) {
    const int gid = blockIdx.x * 512 + opaque_tid();
    for (int it = gid; it < 131072; it += gridDim.x * 512) {
        const int chain = it >> 11, e = it & 2047, b = chain >> 5, head = chain & 31;
        f32x4* st = (f32x4*)(p.ws + WS_STS); const float* dec = (const float*)(p.ws + WS_DECS);
        f32x4 run = (f32x4){0.f, 0.f, 0.f, 0.f};
        for (int hb = 0; hb < 4; ++hb) {
            f32x4 u[8];
#pragma unroll
            for (int s = 0; s < 8; ++s) u[s] = st[(size_t)((b * 32 + hb * 8 + s) * 32 + head) * 2048 + e];
            asm volatile("" ::: "memory");
#pragma unroll
            for (int s = 0; s < 8; ++s) { const int un = (b * 32 + hb * 8 + s) * 32 + head; const float dc = dec[un];
                st[(size_t)un * 2048 + e] = run; run = run * dc + u[s]; }
        }
    }
}

typedef short v4i16_t __attribute__((ext_vector_type(4)));
DI s16x4 vtr(const LAS unsigned char* p) { return __builtin_bit_cast(s16x4, __builtin_amdgcn_ds_read_tr16_b64_v4i16((LAS v4i16_t*)p)); }
constexpr int A_K = 0, A_V = 34816, A_X = 0, A_Y = 65536, A_NG = 100352;
DI void attn_unit(const Params& p, int b, int h, int qb, float lam, float oscale, LAS unsigned char* lds) {
    const int tid = opaque_tid(), lane = tid & 63, w = __builtin_amdgcn_readfirstlane(tid >> 6), rg = w & 3, sub = w >> 2, q = lane & 31, hh = lane >> 5;
    bf16_t* Qd = (bf16_t*)(p.ws + WS_R + 4 * BLK); const bf16_t* Kd = (const bf16_t*)(p.ws + WS_R + 5 * BLK); const bf16_t* Vd = (const bf16_t*)(p.ws + WS_R + 6 * BLK);
    const int tok0 = b * SEQ + qb * 128;
    bf16x8 qf[4];
    { const bf16_t* qp = Qd + (size_t)(tok0 + rg * 32 + q) * 1024 + h * 128 + sub * 64 + hh * 8;
#pragma unroll
      for (int ks = 0; ks < 4; ++ks) qf[ks] = *(const bf16x8*)(qp + ks * 16); }
    const int NT = 2 * qb + 2;
    u32x4 kr[2], vr[2];
    const int prow = tid >> 4, pc16 = tid & 15;
#define ATT_LOAD(t) do { _Pragma("unroll") for (int i_ = 0; i_ < 2; ++i_) { const size_t off_ = (size_t)(b * SEQ + (t) * 64 + prow + 32 * i_) * 1024 + h * 128 + pc16 * 8; \
        kr[i_] = *(const u32x4*)(Kd + off_); vr[i_] = *(const u32x4*)(Vd + off_); } } while (0)
#define ATT_STORE(buf) do { _Pragma("unroll") for (int i_ = 0; i_ < 2; ++i_) { const int o_ = (buf) * 17408 + (prow + 32 * i_) * 272 + pc16 * 16; \
        *(LAS u32x4*)(lds + A_K + o_) = kr[i_]; *(LAS u32x4*)(lds + A_V + (buf) * 18432 + (prow + 32 * i_) * 288 + pc16 * 16) = vr[i_]; } } while (0)
    f32x16 o[4];
#pragma unroll
    for (int db = 0; db < 4; ++db)
#pragma unroll
        for (int i = 0; i < 16; ++i) o[db][i] = 0.f;
    float m_run = -1e30f, l_run = 0.f;
    const float C2 = 0.18033688011112042f;
    ATT_LOAD(0); ATT_STORE(0); ATT_LOAD(1);
    __syncthreads();
    const int i16 = lane & 15, blk = (lane >> 4) & 1;
    for (int t = 0; t < NT; ++t) {
        if (t + 1 < NT) ATT_STORE((t + 1) & 1);
        if (t + 2 < NT) ATT_LOAD(t + 2);
        if (t <= 2 * qb + (rg >> 1)) {
            const LAS unsigned char* Kb = lds + A_K + (t & 1) * 17408; const LAS unsigned char* Vb = lds + A_V + (t & 1) * 18432;
            f32x16 s0, s1;
#pragma unroll
            for (int i = 0; i < 16; ++i) { s0[i] = 0.f; s1[i] = 0.f; }
#pragma unroll
            for (int ks = 0; ks < 4; ++ks) { const LAS unsigned char* kp = Kb + q * 272 + (sub * 64 + ks * 16 + hh * 8) * 2;
                s0 = mfma32(*(const LAS bf16x8*)kp, qf[ks], s0); s1 = mfma32(*(const LAS bf16x8*)(kp + 32 * 272), qf[ks], s1); }
            float mx = fmaxf(s0[0], s1[0]);
#pragma unroll
            for (int i = 1; i < 16; ++i) mx = fmaxf(mx, fmaxf(s0[i], s1[i]));
            mx = fmaxf(mx, __shfl_xor(mx, 32));
            const float m_new = fmaxf(m_run, mx), negm = -m_new * C2;
            if (__any(m_new > m_run)) {
                const float alpha = __builtin_amdgcn_exp2f((m_run - m_new) * C2);
                l_run *= alpha;
#pragma unroll
                for (int db = 0; db < 4; ++db)
#pragma unroll
                    for (int i = 0; i < 16; ++i) o[db][i] *= alpha;
            }
            float sum = 0.f;
#pragma unroll
            for (int i = 0; i < 16; ++i) { s0[i] = __builtin_amdgcn_exp2f(fmaf(s0[i], C2, negm)); s1[i] = __builtin_amdgcn_exp2f(fmaf(s1[i], C2, negm)); sum += s0[i] + s1[i]; }
            l_run += sum; m_run = m_new;
            bf16x8 pf[2][2];
#pragma unroll
            for (int s = 0; s < 2; ++s) {
                pf[0][s] = __builtin_bit_cast(bf16x8, (u32x4){pk2(s0[8 * s], s0[8 * s + 1]), pk2(s0[8 * s + 2], s0[8 * s + 3]), pk2(s0[8 * s + 4], s0[8 * s + 5]), pk2(s0[8 * s + 6], s0[8 * s + 7])});
                pf[1][s] = __builtin_bit_cast(bf16x8, (u32x4){pk2(s1[8 * s], s1[8 * s + 1]), pk2(s1[8 * s + 2], s1[8 * s + 3]), pk2(s1[8 * s + 4], s1[8 * s + 5]), pk2(s1[8 * s + 6], s1[8 * s + 7])}); }
#pragma unroll
            for (int kb = 0; kb < 2; ++kb)
#pragma unroll
                for (int s = 0; s < 2; ++s) { const LAS unsigned char* vp = Vb + (32 * kb + 16 * s + 4 * hh + (i16 >> 2)) * 288 + blk * 32 + (i16 & 3) * 8;
#pragma unroll
                    for (int db = 0; db < 4; ++db) { const s16x4 lo = vtr(vp + db * 64), hi = vtr(vp + db * 64 + 8 * 288);
                        const bf16x8 vf = (bf16x8){lo[0], lo[1], lo[2], lo[3], hi[0], hi[1], hi[2], hi[3]};
                        o[db] = mfma32(vf, pf[kb][s], o[db]); } }
        }
        __syncthreads();
    }
#undef ATT_LOAD
#undef ATT_STORE
    const float l_tot = l_run + __shfl_xor(l_run, 32);
    LAS float* X = (LAS float*)(lds + A_X) + rg * 4096;
    if (sub == 1) { const float inv = lam / l_tot;
#pragma unroll
        for (int db = 0; db < 4; ++db)
#pragma unroll
            for (int i = 0; i < 16; ++i) X[(db * 16 + i) * 64 + lane] = o[db][i] * inv; }
    __syncthreads();
    if (sub == 0) { const float inv = 1.f / l_tot; float ss = 0.f;
#pragma unroll
        for (int db = 0; db < 4; ++db)
#pragma unroll
            for (int i = 0; i < 16; ++i) { const float v = o[db][i] * inv - X[(db * 16 + i) * 64 + lane]; o[db][i] = v; ss += v * v; }
        ss += __shfl_xor(ss, 32);
        const float rs = rsqrtf(ss * (1.f / 128.f) + 1e-5f) * oscale;
        LAS bf16_t* Y = (LAS bf16_t*)(lds + A_Y) + rg * (32 * 136);
        const LAS float* ngl = (const LAS float*)(lds + A_NG);
#pragma unroll
        for (int db = 0; db < 4; ++db)
#pragma unroll
            for (int i = 0; i < 16; ++i) { const int dv = 32 * db + crow(i, hh); Y[q * 136 + dv] = f2bf(o[db][i] * rs * ngl[dv]); }
        asm volatile("s_waitcnt lgkmcnt(0)" ::: "memory");
#pragma unroll
        for (int k = 0; k < 8; ++k) { const int piece = lane + 64 * k, row = piece >> 4, c16 = piece & 15;
            const u32x4 v = *(const LAS u32x4*)((const LAS unsigned char*)Y + row * 272 + c16 * 16);
            *(u32x4*)(Qd + (size_t)(tok0 + rg * 32 + row) * 1024 + h * 128 + c16 * 8) = v; }
    }
    __syncthreads();
}
DI void attn_phase(const Params& p, int l, LAS unsigned char* lds) {
    const int tid = opaque_tid();
    float d1 = 0.f, d2 = 0.f;
    for (int i = 0; i < 64; ++i) { d1 += p.in[14][l * 64 + i] * p.in[15][l * 64 + i]; d2 += p.in[16][l * 64 + i] * p.in[17][l * 64 + i]; }
    const float lambda_init = (l == 0) ? 0.2f : 0.35550906759096934f;
    const float lam = expf(d1) - expf(d2) + lambda_init;
    if (tid < 128) ((LAS float*)(lds + A_NG))[tid] = p.in[18][l * 128 + tid];
    __syncthreads();
    for (int i = 0; i < 4; ++i)
        for (int vc = blockIdx.x; vc < 256; vc += gridDim.x) {
            const int bh = vc >> 4, s = vc & 15; const int qb = (i == 0) ? s : (i == 1) ? 31 - s : (i == 2) ? 32 + s : 63 - s;
            attn_unit(p, bh >> 3, bh & 7, qb, lam, 1.f - lambda_init, lds);
        }
}

DI void final_norm(const Params& p) {
    const float* rowsq = (const float*)(p.ws + WS_ROWSQ) + 4 * T; const float* g = p.in[26];
    const int gt = blockIdx.x * 512 + opaque_tid();
    for (int i = gt; i < T * 256; i += gridDim.x * 512) { const int row = i >> 8, c = (i & 255) * 4;
        const float rs = rsqrtf(rowsq[row] * (1.f / 1024.f) + EPS);
        f32x4 v = *(f32x4*)(p.out + (size_t)row * 1024 + c); const f32x4 gv = *(const f32x4*)(g + c);
        *(f32x4*)(p.out + (size_t)row * 1024 + c) = v * rs * gv; }
}


DI void gemv2(float* out, int ldo, const float* in, int ldi, const float* W, int ldw, int K, int N, int kchunk) {
    const int tid = opaque_tid(), lane = tid & 63, wave = __builtin_amdgcn_readfirstlane(tid >> 6);
    const int gw = blockIdx.x * 8 + wave, NGW = gridDim.x * 8, nstrip = (N + 63) / 64, nk = K / 128;
    for (int job = gw; job < nstrip * nk; job += NGW) {
        const int strip = job % nstrip, kq = job / nstrip, col = strip * 64 + lane; const bool ok = col < N;
        const float* wp = W + (size_t)(kq * 128) * ldw + (ok ? col : 0);
        const float* i0 = in + kq * 128; const float* i1 = in + ldi + kq * 128;
        float a0 = 0.f, a1 = 0.f;
        for (int kk = 0; kk < 2; ++kk) {
            const float h0 = i0[kk * 64 + lane], h1 = i1[kk * 64 + lane];
#pragma unroll
            for (int k = 0; k < 64; ++k) { const float wv = wp[(size_t)(kk * 64 + k) * ldw];
                a0 += __uint_as_float(__builtin_amdgcn_readlane(__float_as_uint(h0), k)) * wv; a1 += __uint_as_float(__builtin_amdgcn_readlane(__float_as_uint(h1), k)) * wv; }
        }
        if (ok) { atomicAdd(out + col, a0); atomicAdd(out + ldo + col, a1); }
    }
}
DI void side_init(const Params& p) {
    const int tid = opaque_tid(), lane = tid & 63, wave = __builtin_amdgcn_readfirstlane(tid >> 6);
    const int gt = blockIdx.x * 512 + tid, NTH = gridDim.x * 512, gw = blockIdx.x * 8 + wave, NGW = gridDim.x * 8;
    float* z = (float*)(p.ws + SB_PROJ);
    for (int i = gt; i < (int)((SB_END - SB_PROJ) / 4); i += NTH) z[i] = 0.f;
    float* hn = (float*)(p.ws + SB_HN);
    for (int r = gw; r < 128; r += NGW) { const int row = (r >> 6) * SEQ + (r & 63);
        const f32x4* xr = (const f32x4*)(p.in[0] + (size_t)row * 1024) + lane; f32x4 v[4]; float s2 = 0.f;
#pragma unroll
        for (int j = 0; j < 4; ++j) { v[j] = xr[64 * j]; s2 += v[j][0] * v[j][0] + v[j][1] * v[j][1] + v[j][2] * v[j][2] + v[j][3] * v[j][3]; }
        const float rs = rsqrtf(wave_sum(s2) * (1.f / 1024.f) + EPS);
#pragma unroll
        for (int j = 0; j < 4; ++j) { const f32x4 g = *((const f32x4*)p.in[2] + lane + 64 * j); *((f32x4*)(hn + (size_t)r * 1024) + lane + 64 * j) = v[j] * rs * g; } }
}
DI void side_kv(const Params& p) {
    const int tid = opaque_tid(), lane = tid & 63, wave = __builtin_amdgcn_readfirstlane(tid >> 6);
    const int gw = blockIdx.x * 8 + wave, NGW = gridDim.x * 8;
    const float* hn = (const float*)(p.ws + SB_HN); float* kv = (float*)(p.ws + SB_KV);
    for (int job = gw; job < 4096; job += NGW) {
        const int strip = job & 31, grp = (job >> 5) & 15, kq = job >> 9, col = strip * 64 + lane;
        const float* wp = p.in[3] + (size_t)(kq * 128) * INC + 9264 + col; const float* hp = hn + (size_t)(grp * 8) * 1024 + kq * 128;
        float a[8];
#pragma unroll
        for (int t = 0; t < 8; ++t) a[t] = 0.f;
        for (int kk = 0; kk < 2; ++kk) {
            float h[8];
#pragma unroll
            for (int t = 0; t < 8; ++t) h[t] = hp[t * 1024 + kk * 64 + lane];
#pragma unroll 16
            for (int k = 0; k < 64; ++k) { const float wv = wp[(size_t)(kk * 64 + k) * INC];
#pragma unroll
                for (int t = 0; t < 8; ++t) a[t] += __uint_as_float(__builtin_amdgcn_readlane(__float_as_uint(h[t]), k)) * wv; }
        }
#pragma unroll
        for (int t = 0; t < 8; ++t) atomicAdd(kv + (size_t)(grp * 8 + t) * 2048 + col, a[t]);
    }
}
DI void rope_cs(int pos, int i, float& cs, float& sn) {
    const double cf[8] = {0.15915494309189535, 0.03086376340470123, 0.005985185712713705, 0.001160663641240061, 0.00022507907903927653, 4.364795279280289e-05, 8.464330808241401e-06, 1.6414262627950345e-06};
    double c = cf[0];
#pragma unroll
    for (int q = 1; q < 8; ++q) c = (i == q) ? cf[q] : c;
    double rv = (double)pos * c; rv -= floor(rv); const float fr = (float)rv; sn = __builtin_amdgcn_sinf(fr); cs = __builtin_amdgcn_cosf(fr);
}
DI void side_mixers(const Params& p, int b, LAS unsigned char* lds) {
    const int tid = opaque_tid();
    const float* P = (const float*)(p.ws + SB_PROJ) + b * 14384; float* Y = (float*)(p.ws + SB_Y) + b * 4096; float* KV = (float*)(p.ws + SB_KV) + (size_t)b * 64 * 2048;
    LAS float* cx = (LAS float*)lds; LAS float* ypre = cx + 3072; LAS float* lg = ypre + 2048; LAS float* pr = lg + 1024; LAS float* red = pr + 1024; LAS float* qr = red + 64;
    const int* pos = (const int*)p.in[1] + b * SEQ;
    __syncthreads();
    if (tid < 4) { float qk = 0.f, vv = 0.f; for (int d = 0; d < 128; ++d) qk += P[tid * 128 + d] * P[512 + tid * 128 + d]; for (int d = 0; d < 256; ++d) { const float v = P[1024 + tid * 256 + d]; vv += v * v; }
        red[tid] = qk * 0.08838834764831845f; red[4 + tid] = vv * (1.f / 256.f); }
    for (int c = tid; c < 3072; c += 512) cx[c] = siluf_(p.in[9][c] + p.in[8][3 * 3072 + c] * P[5136 + c]);
    if (tid < 32) red[8 + tid] = softplusf_(P[8208 + tid] + p.in[10][tid]);
    __syncthreads();
    for (int i = tid; i < 1024; i += 512) { const int h = i >> 8; const float p00 = red[h], o = p00 * P[1024 + i];
        Y[i] = o * rsqrtf(p00 * p00 * red[4 + h] + EPS) * p.in[7][i & 255] * siluf_(P[2064 + i]); }
    if (tid < 4) { float cb = 0.f; for (int n = 0; n < 128; ++n) cb += cx[2560 + tid * 128 + n] * cx[2048 + tid * 128 + n]; red[40 + tid] = cb; }
    __syncthreads();
    for (int i = tid; i < 2048; i += 512) { const int head = i >> 6; ypre[i] = (red[40 + (head >> 3)] * red[8 + head] + p.in[12][head]) * cx[i] * siluf_(P[3088 + i]); }
    __syncthreads();
    if (tid < 4) { float ss = 0.f; for (int i = 0; i < 512; ++i) ss += ypre[tid * 512 + i] * ypre[tid * 512 + i]; red[44 + tid] = rsqrtf(ss * (1.f / 512.f) + EPS); }
    __syncthreads();
    for (int i = tid; i < 2048; i += 512) Y[1024 + i] = ypre[i] * red[44 + (i >> 9)] * p.in[13][i];
    for (int i = tid; i < 1024; i += 512) { const int d = i & 63; float v = P[8240 + i];
        if (d < 16) { float cs, sn; rope_cs(pos[0], d & 7, cs, sn); const float o = (d < 8) ? P[8240 + i + 8] : P[8240 + i - 8]; v = (d < 8) ? v * cs - o * sn : v * cs + o * sn; }
        qr[i] = v; }
    for (int it = tid; it < 8192; it += 512) { const int j = it >> 7, hs = (it >> 3) & 15, d = it & 7; float cs, sn; rope_cs(pos[j], d, cs, sn);
        float* kp = KV + (size_t)j * 2048 + hs * 64 + d; const float k1 = kp[0], k2 = kp[8]; kp[0] = k1 * cs - k2 * sn; kp[8] = k2 * cs + k1 * sn; }
    __threadfence_block();
    __syncthreads();
    for (int i = tid; i < 1024; i += 512) { const int hs = i >> 6, j = i & 63; const float* kp = KV + (size_t)j * 2048 + hs * 64; float sacc = 0.f;
        for (int d = 0; d < 64; ++d) sacc += qr[hs * 64 + d] * kp[d];
        lg[i] = sacc * 0.125f; }
    __syncthreads();
    if (tid < 16) { float m = -1e30f; for (int j = 0; j < 64; ++j) m = fmaxf(m, lg[tid * 64 + j]); float sum = 0.f; for (int j = 0; j < 64; ++j) { const float e = expf(lg[tid * 64 + j] - m); pr[tid * 64 + j] = e; sum += e; }
        const float inv = 1.f / sum; for (int j = 0; j < 64; ++j) pr[tid * 64 + j] *= inv; }
    __syncthreads();
    float d1 = 0.f, d2 = 0.f;
    for (int i = 0; i < 64; ++i) { d1 += p.in[14][i] * p.in[15][i]; d2 += p.in[16][i] * p.in[17][i]; }
    const float lam = expf(d1) - expf(d2) + 0.2f;
    for (int i = tid; i < 1024; i += 512) { const int h = i >> 7; float o = 0.f;
        for (int j = 0; j < 64; ++j) o += (pr[(2 * h) * 64 + j] - lam * pr[(2 * h + 1) * 64 + j]) * KV[(size_t)j * 2048 + 1024 + i];
        ypre[i] = o; }
    __syncthreads();
    if (tid < 8) { float ss = 0.f; for (int i = 0; i < 128; ++i) ss += ypre[tid * 128 + i] * ypre[tid * 128 + i]; red[48 + tid] = rsqrtf(ss * (1.f / 128.f) + 1e-5f) * 0.8f; }
    __syncthreads();
    for (int i = tid; i < 1024; i += 512) Y[3072 + i] = ypre[i] * red[48 + (i >> 7)] * p.in[18][i & 127];
    float* G = (float*)(p.ws + SB_GATE) + b * 3072;
    for (int i = tid; i < 3072; i += 512) G[i] = sigmoidf_(P[11312 + i] + p.in[4][i]);
    __syncthreads();
}
DI void side_glue(const Params& p, int step, int b, LAS unsigned char* lds) {
    const int tid = opaque_tid(); unsigned char* ws = p.ws; LAS float* red = (LAS float*)lds;
    if (step == 4) {
        const float* G = (const float*)(ws + SB_GATE) + b * 3072; const float* BR = (const float*)(ws + SB_BR) + b * 3072;
        for (int c = tid; c < 1024; c += 512) { ((float*)(ws + SB_MIX))[b * 1024 + c] = G[c] * BR[c] + G[1024 + c] * BR[1024 + c] + G[2048 + c] * BR[2048 + c];
            ((float*)(ws + SB_XM))[b * 1024 + c] = p.in[0][(size_t)b * SEQ * 1024 + c]; }
    } else if (step == 6 || step == 100) {
        const float* src = (const float*)(ws + (step == 6 ? SB_XM : SB_X1)) + b * 1024; float* dst = (float*)(ws + (step == 6 ? SB_H2 : SB_HN1)) + b * 1024;
        const float* g = step == 6 ? p.in[23] : p.in[2] + 1024;
        __syncthreads();
        float s2 = 0.f; for (int c = tid; c < 1024; c += 512) s2 += src[c] * src[c];
        s2 = wave_sum(s2); if ((tid & 63) == 0) red[tid >> 6] = s2;
        __syncthreads();
        float tot = 0.f; for (int w = 0; w < 8; ++w) tot += red[w];
        const float rs = rsqrtf(tot * (1.f / 1024.f) + EPS);
        for (int c = tid; c < 1024; c += 512) dst[c] = src[c] * rs * g[c];
        if (step == 100) { const size_t row = (size_t)b * SEQ; bf16_t* xb = (bf16_t*)(ws + WS_XB);
            for (int c = tid; c < 1024; c += 512) { p.out[row * 1024 + c] = src[c]; xb[row * 1024 + c] = f2bf(src[c]); }
            if (tid == 0) ((float*)(ws + WS_ROWSQ))[2 * T + row] = tot; }
        __syncthreads();
    } else if (step == 8) {
        const float* up = (const float*)(ws + SB_UP) + b * 4096; float* hh = (float*)(ws + SB_HH) + b * 4096;
        for (int c = tid; c < 4096; c += 512) { const float r = fmaxf(up[c], 0.f); hh[c] = r * r; }
        for (int c = tid; c < 1024; c += 512) ((float*)(ws + SB_X1))[b * 1024 + c] = ((const float*)(ws + SB_XM))[b * 1024 + c];
    }
}
DI void side_phase(const Params& p, int l, int k, LAS unsigned char* lds) {
    unsigned char* ws = p.ws; const int bid = blockIdx.x;
    if (l == 0) {
        if (k == 0) side_init(p);
        else if (k == 1) { gemv2((float*)(ws + SB_PROJ), 14384, (const float*)(ws + SB_HN), 64 * 1024, p.in[3], INC, 1024, INC, 128); side_kv(p); }
        else if (k == 2) { if (bid < 2) side_mixers(p, bid, lds); }
        else if (k == 3) { float* br = (float*)(ws + SB_BR); const float* y = (const float*)(ws + SB_Y);
            gemv2(br, 3072, y, 4096, p.in[19], 1024, 1024, 1024, 128); gemv2(br + 1024, 3072, y + 1024, 4096, p.in[20], 1024, 2048, 1024, 128); gemv2(br + 2048, 3072, y + 3072, 4096, p.in[21], 1024, 1024, 1024, 128); }
        else if (k == 4) { if (bid < 2) side_glue(p, 4, bid, lds); }
        else if (k == 5) gemv2((float*)(ws + SB_XM), 1024, (const float*)(ws + SB_MIX), 1024, p.in[22], 1024, 1024, 1024, 128);
        else if (k == 6) { if (bid < 2) side_glue(p, 6, bid, lds); }
        else if (k == 7) gemv2((float*)(ws + SB_UP), 4096, (const float*)(ws + SB_H2), 1024, p.in[24], 4096, 1024, 4096, 128);
        else if (k == 8) { if (bid < 2) side_glue(p, 8, bid, lds); }
        else if (k == 9) gemv2((float*)(ws + SB_X1), 1024, (const float*)(ws + SB_HH), 4096, p.in[25], 1024, 4096, 1024, 128);
    } else {
        if (k == 0) { if (bid < 2) side_glue(p, 100, bid, lds); }
        else if (k == 1) gemv2((float*)(ws + SB_QK1), 1024, (const float*)(ws + SB_HN1), 1024, p.in[3] + (size_t)1024 * INC, INC, 1024, 1024, 128);
    }
}


DI void grid_bar(unsigned* ctr, unsigned target) {
    asm volatile("s_waitcnt vmcnt(0)" ::: "memory");
    __syncthreads();
    if (threadIdx.x == 0) {
        __builtin_amdgcn_fence(__ATOMIC_RELEASE, "agent");
        asm volatile("s_waitcnt vmcnt(0)" ::: "memory");
        __hip_atomic_fetch_add(ctr, 1u, __ATOMIC_RELAXED, __HIP_MEMORY_SCOPE_AGENT);
        while (__hip_atomic_load(ctr, __ATOMIC_RELAXED, __HIP_MEMORY_SCOPE_AGENT) < target) __builtin_amdgcn_s_sleep(8);
        __builtin_amdgcn_fence(__ATOMIC_ACQUIRE, "agent");
        asm volatile("s_waitcnt vmcnt(0)" ::: "memory");
    }
    __syncthreads();
}

constexpr int NPHASE = 31, PPL = 15;
#ifndef PH_MASK
#define PH_MASK 0xFFFFFFFFu
#endif
#define EN(k_) ((PH_MASK >> (k_)) & 1u)
constexpr int LDS_BYTES = 147456;
template <bool COOP> __global__ void __launch_bounds__(512, 2) mk(Params p) {
    extern __shared__ __attribute__((aligned(16))) unsigned char lds_raw[];
    LAS unsigned char* lds = (LAS unsigned char*)lds_raw;
    unsigned char* ws = p.ws;
    float* rowsq = (float*)(ws + WS_ROWSQ);
    bf16_t* xb = (bf16_t*)(ws + WS_XB); bf16_t* mixb = (bf16_t*)(ws + WS_MIXB); bf16_t* R = (bf16_t*)(ws + WS_R);
    const unsigned char* wt = ws + WS_WT;
    const int G = gridDim.x, bid = blockIdx.x;
    for (int ph = p.ph_lo; ph < p.ph_hi; ++ph) {
        if (ph == 30) { final_norm(p); }
        else {
            const int l = ph / PPL, k = ph % PPL;
            if (EN(0) && k == 0) phase_prep(p, l, lds);
            else if (k == 1 || k == 6) {
                const bool gd = (k == 1);
                pg8::Gemm g{xb, (const bf16_t*)(wt + (gd ? WT_GD : WT_S)), T, gd ? 8448 : 6144, 1024, 1024, 1024};
                pg8::StaticOrder S; S.init(T, g.N, G, bid);
                EpiIn E{R, rowsq + (2 * l) * T, (float*)(ws + WS_SMALL), gd ? 32 : -1, gd ? 3 : 5, gd ? 7 : -1,
                        p.in[4] + l * 3072 + (gd ? 0 : 1024), p.in[4] + l * 3072 + 2048};
                pg8::gemm_phase(lds, g, S, E);
            }
            else if (EN(2) && k == 2) { rope_pass(p); for (int un = bid; un < 256; un += G) gla_unit<1>(p, l, un, lds); }
            else if (EN(3) && k == 3) { gla_scan(p); attn_phase(p, l, lds); }
            else if (EN(4) && k == 4) { for (int un = bid; un < 256; un += G) gla_unit<3>(p, l, un, lds); }
            else if (k == 5 || k == 11) {
                const int nrun = (k == 5) ? 2 : 4;
                for (int r = 0; r < nrun; ++r) {
                    pg8::Gemm g; EpiMix E;
                    if (k == 5) {
                        g = pg8::Gemm{R + (size_t)(r == 0 ? 2 : 4) * (BLK / 2), (const bf16_t*)(wt + (r == 0 ? WT_GLA : WT_DIFF)), T, 1024, 1024, 1024, 1024};
                        E = EpiMix{mixb, R + (size_t)(r == 0 ? 3 : 7) * (BLK / 2), nullptr, 0, r == 0 ? 1 : 0};
                    } else {
                        g = pg8::Gemm{R + (size_t)(r >> 1) * (BLK / 2) + (r & 1) * 512, (const bf16_t*)(wt + WT_SSM) + r * 512, T, 1024, 512, 1024, 2048};
                        E = EpiMix{mixb, R + (size_t)5 * (BLK / 2), (const float*)(ws + WS_SSQ), r, 0};
                    }
                    pg8::StaticOrder S; S.init(T, 1024, G, bid);
                    pg8::gemm_phase(lds, g, S, E);
                }
            }
            else if (k == 7) { conv_bc(p, l); }
            else if (k == 8) { for (int un = bid; un < 2048; un += G) ssd_unit<1>(p, l, un, lds); }
            else if (k == 9) { ssd_scan(p); }
            else if (k == 10) { for (int un = bid; un < 2048; un += G) ssd_unit<3>(p, l, un, lds); }
            else if (k == 12 || k == 14) {
                const bool dn = (k == 14);
                pg8::Gemm g{dn ? R : mixb, (const bf16_t*)(wt + (dn ? WT_DOWN : WT_OUT)), T, 1024, dn ? 4096 : 1024, dn ? 4096 : 1024, dn ? 4096 : 1024};
                pg8::StaticOrder S; S.init(T, 1024, G, bid);
                EpiRes E{(l == 0 && !dn) ? p.in[0] : p.out, p.out, xb, rowsq + (2 * l + (dn ? 2 : 1)) * T};
                pg8::gemm_phase(lds, g, S, E);
            }
            else if (k == 13) {
                pg8::Gemm g{xb, (const bf16_t*)(wt + WT_UP), T, 4096, 1024, 1024, 1024};
                pg8::StaticOrder S; S.init(T, 4096, G, bid);
                EpiUp E{R, rowsq + (2 * l + 1) * T};
                pg8::gemm_phase(lds, g, S, E);
            }
        }
        if (ph < 30) side_phase(p, ph / PPL, ph % PPL, lds);
        if (COOP) { if (ph + 1 < p.ph_hi) { if (ph == p.ph_lo) cg::this_grid().sync(); else grid_bar((unsigned*)(ws + WS_BAR), (unsigned)(ph - p.ph_lo) * (unsigned)gridDim.x); } }
    }
}

extern "C" void kernel_launch(void* const* d_in, const int* in_sizes, int n_in, void* d_out, int out_size, void* d_ws, size_t ws_size, hipStream_t stream) {
    static int grid = 0;
    if (grid == 0) {
        if (n_in != 27 || out_size != T * 1024 || ws_size < WS_END) { fprintf(stderr, "kernel_launch: unexpected shapes/ws (n_in %d out %d ws %zu need %zu)\n", n_in, out_size, ws_size, (size_t)WS_END); grid = -1; return; }
        int dev = 0, cus = 0, per_cu = 0;
        (void)hipGetDevice(&dev); (void)hipDeviceGetAttribute(&cus, hipDeviceAttributeMultiprocessorCount, dev);
        (void)hipFuncSetAttribute((const void*)mk<true>, hipFuncAttributeMaxDynamicSharedMemorySize, LDS_BYTES);
        (void)hipOccupancyMaxActiveBlocksPerMultiprocessor(&per_cu, (const void*)mk<true>, 512, LDS_BYTES);
        if (per_cu < 1) fprintf(stderr, "kernel_launch: occupancy query says %d blocks/CU\n", per_cu);
        (void)hipGetLastError();
        grid = cus;
    }
    if (grid < 0) return;
    Params p{};
    for (int i = 0; i < 27; ++i) p.in[i] = (const float*)d_in[i];
    p.out = (float*)d_out; p.ws = (unsigned char*)d_ws;
    p.ph_lo = 0; p.ph_hi = NPHASE;
    (void)hipMemsetAsync((unsigned char*)d_ws + WS_BAR, 0, 256, stream);
    void* args[] = {&p};
    hipError_t e = hipLaunchCooperativeKernel((const void*)mk<true>, dim3(grid), dim3(512), args, LDS_BYTES, stream);
    if (e != hipSuccess) fprintf(stderr, "cooperative launch failed: %s (grid %d)\n", hipGetErrorString(e), grid);
}
```

```cpp
#include <hip/hip_runtime.h>
#include <hip/hip_cooperative_groups.h>
#include <cstdio>
#include <cstdint>
namespace cg = cooperative_groups;

#define LAS __attribute__((address_space(3)))
#define DI __device__ __forceinline__
typedef unsigned short bf16_t;
typedef short bf16x8 __attribute__((ext_vector_type(8)));
typedef short s16x4 __attribute__((ext_vector_type(4)));
typedef float f32x4 __attribute__((ext_vector_type(4)));
typedef float f32x16 __attribute__((ext_vector_type(16)));
typedef unsigned u32x4 __attribute__((ext_vector_type(4)));
typedef unsigned u32x2 __attribute__((ext_vector_type(2)));
typedef float f32x2_t __attribute__((ext_vector_type(2)));
typedef __bf16 bf16x2_t __attribute__((ext_vector_type(2)));

DI unsigned pk2(float lo, float hi) { f32x2_t v = {lo, hi}; bf16x2_t b = __builtin_convertvector(v, bf16x2_t); return __builtin_bit_cast(unsigned, b); }
DI bf16_t f2bf(float f) { return (bf16_t)(pk2(f, 0.f) & 0xffffu); }
DI float bf2f(unsigned b) { return __uint_as_float(b << 16); }
DI float bflo(unsigned w) { return __uint_as_float(w << 16); }
DI float bfhi(unsigned w) { return __uint_as_float(w & 0xffff0000u); }
DI f32x4 mfma16(bf16x8 a, bf16x8 b, f32x4 c) { return __builtin_amdgcn_mfma_f32_16x16x32_bf16(a, b, c, 0, 0, 0); }
DI f32x16 mfma32(bf16x8 a, bf16x8 b, f32x16 c) { return __builtin_amdgcn_mfma_f32_32x32x16_bf16(a, b, c, 0, 0, 0); }
DI float sigmoidf_(float x) { return __builtin_amdgcn_rcpf(1.f + __expf(-x)); }
DI float siluf_(float x) { return x * __builtin_amdgcn_rcpf(1.f + __expf(-x)); }
DI int opaque_tid() { int t = threadIdx.x; asm volatile("" : "+v"(t)); return t; }
DI int crow(int r, int hi) { return (r & 3) + 8 * (r >> 2) + 4 * hi; }

constexpr int T = 16384, SEQ = 8192, DM = 1024, DFF = 4096, INC = 14384;
constexpr float EPS = 1e-6f;
constexpr size_t MiB = 1u << 20;
constexpr size_t WS_ROWSQ = 0;
constexpr size_t WS_BAR = 448 * 1024;
constexpr size_t WS_DECG = 512 * 1024;
constexpr size_t WS_DECS = 768 * 1024;
constexpr size_t WS_SSQ = 1 * MiB;
constexpr size_t WS_SMALL = 2 * MiB;
constexpr size_t WS_XB = 6 * MiB;
constexpr size_t WS_MIXB = 38 * MiB;
constexpr size_t WS_WT = 70 * MiB;
constexpr size_t WT_GD = 0, WT_S = WT_GD + (size_t)8448 * 1024 * 2, WT_GLA = WT_S + (size_t)6144 * 1024 * 2, WT_SSM = WT_GLA + 2 * MiB,
                 WT_DIFF = WT_SSM + 4 * MiB, WT_OUT = WT_DIFF + 2 * MiB, WT_UP = WT_OUT + 2 * MiB, WT_DOWN = WT_UP + 8 * MiB, WT_END = WT_DOWN + 8 * MiB;
static_assert(WT_END <= 56 * MiB, "wt");
constexpr size_t WS_R = 126 * MiB;
constexpr size_t BLK = 32 * MiB;
constexpr size_t WS_STG = WS_R + 8 * BLK;
constexpr size_t WS_STS = WS_R + 6 * BLK;
constexpr size_t WS_SIDE = WS_R + 9 * BLK;
constexpr size_t SB_HN = WS_SIDE, SB_PROJ = SB_HN + 512 * 1024, SB_KV = SB_PROJ + 128 * 1024, SB_Y = SB_KV + 1024 * 1024, SB_GATE = SB_Y + 32 * 1024,
                 SB_BR = SB_GATE + 32 * 1024, SB_MIX = SB_BR + 32 * 1024, SB_XM = SB_MIX + 8192, SB_H2 = SB_XM + 8192, SB_UP = SB_H2 + 8192,
                 SB_HH = SB_UP + 32768, SB_X1 = SB_HH + 32768, SB_HN1 = SB_X1 + 8192, SB_QK1 = SB_HN1 + 8192, SB_END = SB_QK1 + 8192;
constexpr size_t WS_END = WS_SIDE + 2 * MiB;
static_assert(SB_END <= WS_END, "side");

struct Params {
    const float* in[27];
    float* out; unsigned char* ws;
    int ph_lo, ph_hi;
};

namespace pg8 {
constexpr int BM = 256, BK = 64, HALF = 128, HTB = HALF * BK * 2, STAGE_BYTES = 8 * HTB, NXCD = 8, WGM = 8;
__host__ __device__ __forceinline__ int lds_byte(int r, int c) { const int st = (r >> 4) * 2 + (c >> 5), rr = r & 15, cc = c & 31, ob = rr * 64 + cc * 2; return st * 1024 + (ob ^ (((ob >> 9) & 1) << 5)); }
__host__ __device__ __forceinline__ void stage_rc(int b, int& R, int& C) { const int st = b / 1024, sb = b % 1024, swz = sb ^ (((sb >> 9) & 1) << 5); R = (st >> 1) * 16 + swz / 64; C = (st & 1) * 32 + (swz % 64) / 2; }
struct Unit { int pm, pn; };
struct Gemm { const bf16_t* A; const bf16_t* Bt; int M, N, K, lda, ldb; };
struct StaticOrder {
    int nM, nN, nwg, G, c;
    __host__ __device__ void init(int M, int N, int G_, int c_) { nM = M / BM; nN = N / BM; nwg = nM * nN; G = G_; c = c_; }
    __host__ __device__ bool next(int i, Unit& u) const {
        const long L = (long)i * G + c; if (L >= nwg) return false;
        int wgid = (int)L; { const int q = nwg / NXCD, r = nwg % NXCD, xcd = wgid % NXCD, off = wgid / NXCD; wgid = (xcd < r ? xcd * (q + 1) : r * (q + 1) + (xcd - r) * q) + off; }
        const int nig = WGM * nN, gid = wgid / nig, fm = gid * WGM, gsz = (nM - fm) < WGM ? (nM - fm) : WGM;
        u.pm = fm + ((wgid % nig) % gsz); u.pn = (wgid % nig) / gsz; return true;
    }
};
template <class Epi, class Sched>
__device__ __forceinline__ void gemm_phase(LAS unsigned char* lds, const Gemm g, const Sched& S, const Epi& E) {
    const int tid = opaque_tid(), wid = __builtin_amdgcn_readfirstlane(tid >> 6), lane = tid & 63, wr = wid >> 2, wc = wid & 3, fr = lane & 15, fq = lane >> 4;
    const int K = g.K, nt = K / BK;
    unsigned voffA[2], voffB[2];
#pragma unroll
    for (int i = 0; i < 2; ++i) { int R, C; stage_rc(tid * 16 + i * 8192, R, C);
        voffA[i] = (unsigned)(R * g.lda + C) * 2u; voffB[i] = (unsigned)(R * g.ldb + C) * 2u; }
    const size_t kstep = (size_t)(BK * 2);
    const size_t hstepA = (size_t)HALF * g.lda * 2, hstepB = (size_t)HALF * g.ldb * 2;
    const size_t tstepA = 2 * hstepA, tstepB = 2 * hstepB;
    const unsigned ldsw = (unsigned)wid * 1024u;
    const int aoff = lds_byte(wr * 64 + fr, fq * 8), boff = lds_byte(wc * 32 + fr, fq * 8);
#define PG8_SA(b, h) (((b) * 2 + (h)) * HTB)
#define PG8_SB(b, h) ((4 + (b) * 2 + (h)) * HTB)
#define PG8_STAGE(bufoff, gbase, voff) do { _Pragma("unroll") for (int _i = 0; _i < 2; ++_i) \
        __builtin_amdgcn_global_load_lds((const unsigned*)((const char*)(gbase) + (voff)[_i]), (LAS unsigned*)(lds + (bufoff) + ldsw + _i * 8192), 16, 0, 0); } while (0)
#define PG8_LDA(dst, b, h) do { _Pragma("unroll") for (int m = 0; m < 4; ++m) _Pragma("unroll") for (int k = 0; k < 2; ++k) dst[m][k] = *(const LAS bf16x8*)(lds + PG8_SA(b, h) + aoff + m * 2048 + k * 1024); } while (0)
#define PG8_LDB(dst, b, h) do { _Pragma("unroll") for (int n = 0; n < 2; ++n) _Pragma("unroll") for (int k = 0; k < 2; ++k) dst[n][k] = *(const LAS bf16x8*)(lds + PG8_SB(b, h) + boff + n * 2048 + k * 1024); } while (0)
#define PG8_MMA(ai, bj, At, Bt) do { __builtin_amdgcn_s_setprio(1); _Pragma("unroll") for (int m = 0; m < 4; ++m) _Pragma("unroll") for (int n = 0; n < 2; ++n) _Pragma("unroll") for (int k = 0; k < 2; ++k) \
        acc[ai][bj][m][n] = __builtin_amdgcn_mfma_f32_16x16x32_bf16(Bt[n][k], At[m][k], acc[ai][bj][m][n], 0, 0, 0); __builtin_amdgcn_s_setprio(0); } while (0)
#define PG8_WAIT_V(n) asm volatile("s_waitcnt vmcnt(" #n ")" ::: "memory")
#define PG8_WAIT_L(n) asm volatile("s_waitcnt lgkmcnt(" #n ")" ::: "memory")
#define PG8_BAR __builtin_amdgcn_s_barrier()
#define PG8_SCHED __builtin_amdgcn_sched_barrier(0)
    Unit cur, nxt; int ui = 0;
    if (!S.next(0, cur)) return;
    f32x4 acc[2][2][4][2];
#pragma unroll
    for (int a = 0; a < 2; ++a)
#pragma unroll
        for (int b = 0; b < 2; ++b)
#pragma unroll
            for (int m = 0; m < 4; ++m)
#pragma unroll
                for (int n = 0; n < 2; ++n) acc[a][b][m][n] = (f32x4){0.f, 0.f, 0.f, 0.f};
    bf16x8 At[4][2], B0[2][2], B1[2][2];
    const char* cA = (const char*)g.A + (size_t)cur.pm * tstepA; const char* cB = (const char*)g.Bt + (size_t)cur.pn * tstepB;
    PG8_STAGE(PG8_SB(0, 0), cB, voffB); PG8_STAGE(PG8_SB(0, 1), cB + hstepB, voffB); PG8_STAGE(PG8_SA(0, 0), cA, voffA); PG8_STAGE(PG8_SA(0, 1), cA + hstepA, voffA);
    if (wr == 1) PG8_BAR;
    PG8_WAIT_V(2); PG8_BAR;
    PG8_STAGE(PG8_SB(1, 0), cB + kstep, voffB); PG8_STAGE(PG8_SA(1, 0), cA + kstep, voffA); PG8_STAGE(PG8_SB(1, 1), cB + hstepB + kstep, voffB);
    PG8_WAIT_V(6); PG8_BAR;
    for (;;) {
        const bool has_next = S.next(ui + 1, nxt);
        const char* nA = has_next ? (const char*)g.A + (size_t)nxt.pm * tstepA : cA; const char* nB = has_next ? (const char*)g.Bt + (size_t)nxt.pn * tstepB : cB;
        for (int t = 0; t < nt; t += 2) {
            const bool last = (t == nt - 2);
            const char* a1 = cA + (size_t)(t + 1) * kstep;
            const char* a2 = last ? nA : cA + (size_t)(t + 2) * kstep; const char* b2 = last ? nB : cB + (size_t)(t + 2) * kstep;
            const char* a3 = a2 + kstep; const char* b3 = b2 + kstep;
            PG8_LDB(B0, 0, 0); PG8_LDB(B1, 0, 1); PG8_SCHED; PG8_LDA(At, 0, 0); PG8_STAGE(PG8_SA(1, 1), a1 + hstepA, voffA);
            PG8_WAIT_V(8); PG8_WAIT_L(0); PG8_BAR; PG8_MMA(0, 0, At, B0); PG8_MMA(0, 1, At, B1); PG8_BAR; PG8_SCHED;
            PG8_LDA(At, 0, 1); PG8_STAGE(PG8_SB(0, 0), b2, voffB); PG8_STAGE(PG8_SB(0, 1), b2 + hstepB, voffB); PG8_STAGE(PG8_SA(0, 0), a2, voffA);
            PG8_WAIT_V(8); PG8_WAIT_L(0); PG8_BAR; PG8_MMA(1, 0, At, B0); PG8_MMA(1, 1, At, B1); PG8_BAR; PG8_SCHED;
            PG8_LDB(B0, 1, 0); PG8_LDB(B1, 1, 1); PG8_SCHED; PG8_LDA(At, 1, 0); PG8_STAGE(PG8_SA(0, 1), a2 + hstepA, voffA);
            PG8_WAIT_V(8); PG8_WAIT_L(0); PG8_BAR; PG8_MMA(0, 0, At, B0); PG8_MMA(0, 1, At, B1); PG8_BAR; PG8_SCHED;
            PG8_LDA(At, 1, 1); PG8_STAGE(PG8_SB(1, 0), b3, voffB); PG8_STAGE(PG8_SB(1, 1), b3 + hstepB, voffB); PG8_STAGE(PG8_SA(1, 0), a3, voffA);
            PG8_WAIT_V(8); PG8_WAIT_L(0); PG8_BAR; PG8_MMA(1, 0, At, B0); PG8_MMA(1, 1, At, B1); PG8_BAR; PG8_SCHED;
        }
        if (wr == 0) PG8_BAR;
        E(acc, cur, wr, wc, fr, fq);
        if (!has_next) break;
#pragma unroll
        for (int a = 0; a < 2; ++a)
#pragma unroll
            for (int b = 0; b < 2; ++b)
#pragma unroll
                for (int m = 0; m < 4; ++m)
#pragma unroll
                    for (int n = 0; n < 2; ++n) acc[a][b][m][n] = (f32x4){0.f, 0.f, 0.f, 0.f};
        cur = nxt; cA = nA; cB = nB; ++ui;
        if (wr == 1) PG8_BAR;
    }
    PG8_WAIT_V(0);
    PG8_BAR;
#undef PG8_SA
#undef PG8_SB
#undef PG8_STAGE
#undef PG8_LDA
#undef PG8_LDB
#undef PG8_MMA
#undef PG8_WAIT_V
#undef PG8_WAIT_L
#undef PG8_BAR
#undef PG8_SCHED
}
}

typedef f32x4 Acc[2][2][4][2];
#define EPI_LOOP(body) \
    _Pragma("unroll") for (int ai = 0; ai < 2; ++ai) _Pragma("unroll") for (int m = 0; m < 4; ++m) { const int row = u.pm * 256 + ai * 128 + wr * 64 + m * 16 + fr; \
    _Pragma("unroll") for (int bj = 0; bj < 2; ++bj) _Pragma("unroll") for (int n = 0; n < 2; ++n) { const int ct = bj * 128 + wc * 32 + n * 16 + fq * 4; f32x4 v = acc[ai][bj][m][n]; body } }

struct EpiIn {
    bf16_t* R; const float* rowsq; float* small; int small_tile; int gblkA, gblkB; const float* biasA; const float* biasB;
    DI void operator()(const Acc& acc, const pg8::Unit& u, int wr, int wc, int fr, int fq) const {
        const int blk = u.pn >> 2, cb = (u.pn & 3) * 256;
        if (u.pn == small_tile) {
            EPI_LOOP( if (ct < 64) { const float rs = rsqrtf(rowsq[row] * (1.f / 1024.f) + EPS); *(f32x4*)(small + (size_t)row * 64 + ct) = v * rs; } )
            return;
        }
        bf16_t* dst = R + (size_t)blk * (BLK / 2);
        const float* bias = (blk == gblkA) ? biasA : ((blk == gblkB) ? biasB : nullptr);
        if (bias) {
            EPI_LOOP( const float rs = rsqrtf(rowsq[row] * (1.f / 1024.f) + EPS); const f32x4 bv = *(const f32x4*)(bias + cb + ct); v = v * rs + bv;
                u32x2 w; w.x = pk2(sigmoidf_(v[0]), sigmoidf_(v[1])); w.y = pk2(sigmoidf_(v[2]), sigmoidf_(v[3])); *(u32x2*)(dst + (size_t)row * 1024 + cb + ct) = w; )
        } else {
            EPI_LOOP( const float rs = rsqrtf(rowsq[row] * (1.f / 1024.f) + EPS); v = v * rs;
                u32x2 w; w.x = pk2(v[0], v[1]); w.y = pk2(v[2], v[3]); *(u32x2*)(dst + (size_t)row * 1024 + cb + ct) = w; )
        }
    }
};
struct EpiMix {
    bf16_t* mixb; const bf16_t* gate; const float* ssq; int grp; int first;
    DI void operator()(const Acc& acc, const pg8::Unit& u, int wr, int wc, int fr, int fq) const {
        EPI_LOOP( const int col = u.pn * 256 + ct; const size_t o = (size_t)row * 1024 + col;
            float rs = 1.f; if (ssq) rs = rsqrtf(ssq[(size_t)row * 4 + grp] * (1.f / 512.f) + EPS);
            const u32x2 gw = *(const u32x2*)(gate + o);
            f32x4 r; r[0] = bflo(gw.x) * v[0] * rs; r[1] = bfhi(gw.x) * v[1] * rs; r[2] = bflo(gw.y) * v[2] * rs; r[3] = bfhi(gw.y) * v[3] * rs;
            if (!first) { const u32x2 mw = *(const u32x2*)(mixb + o); r[0] += bflo(mw.x); r[1] += bfhi(mw.x); r[2] += bflo(mw.y); r[3] += bfhi(mw.y); }
            u32x2 w; w.x = pk2(r[0], r[1]); w.y = pk2(r[2], r[3]); *(u32x2*)(mixb + o) = w; )
    }
};
struct EpiRes {
    const float* xold; float* xnew; bf16_t* xb; float* rowsq;
    DI void operator()(const Acc& acc, const pg8::Unit& u, int wr, int wc, int fr, int fq) const {
#pragma unroll
        for (int ai = 0; ai < 2; ++ai)
#pragma unroll
            for (int m = 0; m < 4; ++m) { const int row = u.pm * 256 + ai * 128 + wr * 64 + m * 16 + fr; float ss = 0.f;
#pragma unroll
                for (int bj = 0; bj < 2; ++bj)
#pragma unroll
                    for (int n = 0; n < 2; ++n) { const int col = u.pn * 256 + bj * 128 + wc * 32 + n * 16 + fq * 4; const size_t o = (size_t)row * 1024 + col;
                        f32x4 v = acc[ai][bj][m][n] + *(const f32x4*)(xold + o); *(f32x4*)(xnew + o) = v;
                        u32x2 w; w.x = pk2(v[0], v[1]); w.y = pk2(v[2], v[3]); *(u32x2*)(xb + o) = w;
                        ss += v[0] * v[0] + v[1] * v[1] + v[2] * v[2] + v[3] * v[3]; }
                ss += __shfl_xor(ss, 16); ss += __shfl_xor(ss, 32);
                if (fq == 0) atomicAdd(rowsq + row, ss); }
    }
};
struct EpiUp {
    bf16_t* h; const float* rowsq;
    DI void operator()(const Acc& acc, const pg8::Unit& u, int wr, int wc, int fr, int fq) const {
        EPI_LOOP( const float rs = rsqrtf(rowsq[row] * (1.f / 1024.f) + EPS); v = v * rs;
            f32x4 r; r[0] = fmaxf(v[0], 0.f); r[1] = fmaxf(v[1], 0.f); r[2] = fmaxf(v[2], 0.f); r[3] = fmaxf(v[3], 0.f); r = r * r;
            u32x2 w; w.x = pk2(r[0], r[1]); w.y = pk2(r[2], r[3]); *(u32x2*)(h + (size_t)row * 4096 + u.pn * 256 + ct) = w; )
    }
};

DI int colmap(int kind, int n) {
    if (kind == 1) {
        if (n < 2048) return n;
        if (n < 3072) return 2064 + (n - 2048);
        if (n < 4096) return 11312 + (n - 3072);
        if (n < 5120) return 8240 + (n - 4096);
        if (n < 6144) return 9264 + (n - 5120);
        if (n < 7168) return 10288 + (n - 6144);
        if (n < 8192) return 13360 + (n - 7168);
        const int i = n - 8192; if (i < 16) return 2048 + i; if (i < 48) return 8208 + (i - 16); return -1;
    }
    if (kind == 2) {
        if (n < 2048) return 3088 + n;
        if (n < 5120) return 5136 + (n - 2048);
        return 12336 + (n - 5120);
    }
    return n;
}
DI void tr_item(const float* W, int ldw, int K, bf16_t* WT, const float* kscale, int kind, int kb, int nb, LAS float* scr, int lane) {
    const int k0 = 64 * kb, n0 = 32 * nb; const int sc = colmap(kind, n0 + (lane & 31));
#pragma unroll 8
    for (int i = 0; i < 32; ++i) { const int kk = 2 * i + (lane >> 5); float v = 0.f; if (sc >= 0) { v = W[(size_t)(k0 + kk) * ldw + sc]; if (kscale) v *= kscale[k0 + kk]; } scr[kk * 33 + (lane & 31)] = v; }
    asm volatile("s_waitcnt lgkmcnt(0)" ::: "memory");
    const int c = lane & 7;
#pragma unroll
    for (int j = 0; j < 4; ++j) { const int n = (lane >> 3) + 8 * j; const LAS float* s = scr + (8 * c) * 33 + n;
        u32x4 o; o.x = pk2(s[0 * 33], s[1 * 33]); o.y = pk2(s[2 * 33], s[3 * 33]); o.z = pk2(s[4 * 33], s[5 * 33]); o.w = pk2(s[6 * 33], s[7 * 33]);
        *(u32x4*)(WT + (size_t)(n0 + n) * K + k0 + 8 * c) = o; }
    asm volatile("s_waitcnt lgkmcnt(0)" ::: "memory");
}
DI float wave_sum(float v) {
#pragma unroll
    for (int o = 1; o < 64; o <<= 1) v += __shfl_xor(v, o);
    return v;
}
DI void phase_prep(const Params& p, int l, LAS unsigned char* lds) {
    const int tid = opaque_tid(), lane = tid & 63, wave = __builtin_amdgcn_readfirstlane(tid >> 6);
    const int gw = blockIdx.x * 8 + wave, NGW = gridDim.x * 8;
    LAS float* scr = (LAS float*)(lds + wave * 8704);
    unsigned char* ws = p.ws; bf16_t* wt = (bf16_t*)(ws + WS_WT);
    const float* w_in = p.in[3] + (size_t)l * 1024 * INC;
    constexpr int I0 = 16 * 264, I1 = 16 * 192, I2 = 16 * 32, I3 = 32 * 32, I4 = 16 * 32, I5 = 16 * 32, I6 = 16 * 128, I7 = 64 * 32;
    constexpr int NIT = I0 + I1 + I2 + I3 + I4 + I5 + I6 + I7;
    for (int it = gw; it < NIT; it += NGW) {
        int r = it;
        if (r < I0) { tr_item(w_in, INC, 1024, (bf16_t*)((char*)wt + WT_GD), p.in[2] + l * 1024, 1, r / 264, r % 264, scr, lane); continue; } r -= I0;
        if (r < I1) { tr_item(w_in, INC, 1024, (bf16_t*)((char*)wt + WT_S), p.in[2] + l * 1024, 2, r / 192, r % 192, scr, lane); continue; } r -= I1;
        if (r < I2) { tr_item(p.in[19] + (size_t)l * 1024 * 1024, 1024, 1024, (bf16_t*)((char*)wt + WT_GLA), nullptr, 0, r / 32, r % 32, scr, lane); continue; } r -= I2;
        if (r < I3) { tr_item(p.in[20] + (size_t)l * 2048 * 1024, 1024, 2048, (bf16_t*)((char*)wt + WT_SSM), p.in[13] + l * 2048, 0, r / 32, r % 32, scr, lane); continue; } r -= I3;
        if (r < I4) { tr_item(p.in[21] + (size_t)l * 1024 * 1024, 1024, 1024, (bf16_t*)((char*)wt + WT_DIFF), nullptr, 0, r / 32, r % 32, scr, lane); continue; } r -= I4;
        if (r < I5) { tr_item(p.in[22] + (size_t)l * 1024 * 1024, 1024, 1024, (bf16_t*)((char*)wt + WT_OUT), nullptr, 0, r / 32, r % 32, scr, lane); continue; } r -= I5;
        if (r < I6) { tr_item(p.in[24] + (size_t)l * 1024 * 4096, 4096, 1024, (bf16_t*)((char*)wt + WT_UP), p.in[23] + l * 1024, 0, r / 128, r % 128, scr, lane); continue; } r -= I6;
        tr_item(p.in[25] + (size_t)l * 4096 * 1024, 1024, 4096, (bf16_t*)((char*)wt + WT_DOWN), nullptr, 0, r / 32, r % 32, scr, lane);
    }
    const int gt = blockIdx.x * 512 + tid, NT_ = gridDim.x * 512;
    float* ssq = (float*)(ws + WS_SSQ);
    for (int i = gt; i < T * 4; i += NT_) ssq[i] = 0.f;
    if (l == 0) {
        float* rowsq = (float*)(ws + WS_ROWSQ);
        for (int i = gt; i < 4 * T; i += NT_) rowsq[T + i] = 0.f;
        bf16_t* xb = (bf16_t*)(ws + WS_XB); const float* x = p.in[0];
        for (int m = gw; m < T; m += NGW) {
            const f32x4* xr = (const f32x4*)(x + (size_t)m * 1024) + lane; float s = 0.f;
            u32x2* o = (u32x2*)(xb + (size_t)m * 1024) + lane;
#pragma unroll
            for (int j = 0; j < 4; ++j) { const f32x4 v = xr[64 * j]; s += v[0] * v[0] + v[1] * v[1] + v[2] * v[2] + v[3] * v[3]; u32x2 w; w.x = pk2(v[0], v[1]); w.y = pk2(v[2], v[3]); o[64 * j] = w; }
            s = wave_sum(s); if (lane == 0) rowsq[m] = s;
        }
    }
}

DI void rope_pass(const Params& p) {
    const int* pos = (const int*)p.in[1];
    bf16_t* Qd = (bf16_t*)(p.ws + WS_R + 4 * BLK); bf16_t* Kd = (bf16_t*)(p.ws + WS_R + 5 * BLK);
    const double cf[8] = {0.15915494309189535, 0.03086376340470123, 0.005985185712713705, 0.001160663641240061, 0.00022507907903927653, 4.364795279280289e-05, 8.464330808241401e-06, 1.6414262627950345e-06};
    const int gt = blockIdx.x * 512 + opaque_tid(), NTH = gridDim.x * 512;
    for (int it = gt; it < T * 32; it += NTH) {
        const int t = it >> 5, w = it & 31; bf16_t* base = ((w & 16) ? Kd : Qd) + (size_t)t * 1024 + (w & 15) * 64;
        const double ps = (double)pos[t];
        u32x4 a = *(u32x4*)base, b = *(u32x4*)(base + 8);
        float t1[8], t2[8];
#pragma unroll
        for (int i = 0; i < 4; ++i) { t1[2 * i] = bflo(a[i]); t1[2 * i + 1] = bfhi(a[i]); t2[2 * i] = bflo(b[i]); t2[2 * i + 1] = bfhi(b[i]); }
        float o1[8], o2[8];
#pragma unroll
        for (int i = 0; i < 8; ++i) { double rv = ps * cf[i]; rv -= floor(rv); const float fr = (float)rv; const float sn = __builtin_amdgcn_sinf(fr), cs = __builtin_amdgcn_cosf(fr);
            o1[i] = t1[i] * cs - t2[i] * sn; o2[i] = t2[i] * cs + t1[i] * sn; }
#pragma unroll
        for (int i = 0; i < 4; ++i) { a[i] = pk2(o1[2 * i], o1[2 * i + 1]); b[i] = pk2(o2[2 * i], o2[2 * i + 1]); }
        *(u32x4*)base = a; *(u32x4*)(base + 8) = b;
    }
}

template <int KS> DI f32x4 mm16(f32x4 acc, const LAS unsigned char* A, int lda_b, const LAS unsigned char* B, int ldb_b, int lane) {
    const int r = lane & 15, q = lane >> 4;
    const LAS unsigned char* ap = A + r * lda_b + q * 16; const LAS unsigned char* bp = B + r * ldb_b + q * 16;
#pragma unroll
    for (int s = 0; s < KS; ++s) acc = mfma16(*(const LAS bf16x8*)(ap + s * 64), *(const LAS bf16x8*)(bp + s * 64), acc);
    return acc;
}
DI float logsigmoidf_(float x) { return fminf(x, 0.f) - __logf(1.f + __expf(-fabsf(x))); }

constexpr int G_GKL = 0, G_QTOT = 4096, G_BLAST = 6144, G_PART = 6656, G_QT = 8704, G_KT = 26112, G_KHT = 43520, G_VT = 61952, G_P = 98816;
template <int MODE> DI void gla_unit(const Params& p, int l, int un, LAS unsigned char* lds) {
    const int tid = opaque_tid(), lane = tid & 63, w = __builtin_amdgcn_readfirstlane(tid >> 6), r16 = lane & 15, quad = lane >> 4;
    const int sc = un >> 2, h = un & 3, tok0 = sc * 256;
    unsigned char* ws = p.ws;
    const bf16_t* QK = (const bf16_t*)(ws + WS_R); const bf16_t* Vg = (const bf16_t*)(ws + WS_R + BLK); bf16_t* Gg = (bf16_t*)(ws + WS_R + 2 * BLK);
    const float* small = (const float*)(ws + WS_SMALL);
    float* states = (float*)(ws + WS_STG) + (size_t)un * 32768;
    const int d = tid & 127, qr = tid >> 7;
    float wk[16];
#pragma unroll
    for (int r = 0; r < 16; ++r) wk[r] = p.in[5][(size_t)l * 16 * 512 + r * 512 + h * 128 + d];
    const float bk = p.in[6][l * 512 + h * 128 + d];
    f32x4 S[8][2];
    if (MODE == 3) {
#pragma unroll
        for (int mb = 0; mb < 8; ++mb)
#pragma unroll
            for (int nb = 0; nb < 2; ++nb) S[mb][nb] = *(const f32x4*)(states + ((size_t)(w * 16 + mb * 2 + nb) * 64 + lane) * 4);
    } else {
#pragma unroll
        for (int mb = 0; mb < 8; ++mb)
#pragma unroll
            for (int nb = 0; nb < 2; ++nb) S[mb][nb] = (f32x4){0.f, 0.f, 0.f, 0.f};
    }
    float ng[2] = {0.f, 0.f};
    if (MODE == 3) { ng[0] = p.in[7][l * 256 + 32 * w + r16]; ng[1] = p.in[7][l * 256 + 32 * w + 16 + r16]; }
    float dtot = 1.f;
    for (int j = 0; j < 4; ++j) {
        const int t0 = tok0 + 64 * j;
        if (tid < 256) { const int row = tid >> 2, c4 = (tid & 3) * 4; *(LAS f32x4*)(lds + G_GKL + (row * 16 + c4) * 4) = *(const f32x4*)(small + (size_t)(t0 + row) * 64 + c4); }
        if (tid < 64) ((LAS float*)(lds + G_PART))[tid] = 0.f;
        __syncthreads();
        float c[16]; float run = 0.f;
#pragma unroll
        for (int i = 0; i < 16; ++i) { const LAS f32x4* gr = (const LAS f32x4*)(lds + G_GKL) + (qr * 16 + i) * 4; float x = bk;
#pragma unroll
            for (int r = 0; r < 4; ++r) { const f32x4 g4 = gr[r]; x += g4[0] * wk[4 * r] + g4[1] * wk[4 * r + 1] + g4[2] * wk[4 * r + 2] + g4[3] * wk[4 * r + 3]; }
            run += logsigmoidf_(x) * (1.f / 16.f); c[i] = run; }
        ((LAS float*)(lds + G_QTOT))[qr * 128 + d] = run;
        __syncthreads();
        {
            float off = 0.f, bl = 0.f;
#pragma unroll
            for (int q2 = 0; q2 < 4; ++q2) { const float v = ((const LAS float*)(lds + G_QTOT))[q2 * 128 + d]; bl += v; if (q2 < qr) off += v; }
            unsigned khp[8]; const float ebl = __expf(bl);
#pragma unroll
            for (int i = 0; i < 16; i += 2) {
                float kh2[2];
#pragma unroll
                for (int e = 0; e < 2; ++e) { const int t = qr * 16 + i + e; const float b = off + c[i + e];
                    const float k = bf2f(QK[(size_t)(t0 + t) * 1024 + 512 + h * 128 + d]);
                    const float enb = __expf(-b), kt_ = k * enb;
                    kh2[e] = kt_ * ebl;
                    if (MODE == 3) { const float q = bf2f(QK[(size_t)(t0 + t) * 1024 + h * 128 + d]);
                        ((LAS bf16_t*)(lds + G_QT))[t * 136 + d] = f2bf(q * 0.08838834764831845f * __builtin_amdgcn_rcpf(enb));
                        ((LAS bf16_t*)(lds + G_KT))[t * 136 + d] = f2bf(kt_); } }
                khp[i >> 1] = pk2(kh2[0], kh2[1]);
            }
            *(LAS u32x4*)(lds + G_KHT + d * 144 + qr * 32) = (u32x4){khp[0], khp[1], khp[2], khp[3]};
            *(LAS u32x4*)(lds + G_KHT + d * 144 + qr * 32 + 16) = (u32x4){khp[4], khp[5], khp[6], khp[7]};
            if (qr == 0) { ((LAS float*)(lds + G_BLAST))[d] = bl; dtot *= ebl; }
#pragma unroll
            for (int i = 0; i < 4; ++i) { const int pid = tid + 512 * i, g8 = pid >> 6, t = pid & 63;
                const u32x4 v = *(const u32x4*)(Vg + (size_t)(t0 + t) * 1024 + h * 256 + g8 * 8);
                LAS bf16_t* vt = (LAS bf16_t*)(lds + G_VT) + (g8 * 8) * 72 + t;
#pragma unroll
                for (int e = 0; e < 4; ++e) { vt[(2 * e) * 72] = (bf16_t)(v[e] & 0xffffu); vt[(2 * e + 1) * 72] = (bf16_t)(v[e] >> 16); } }
        }
        __syncthreads();
        if (MODE == 3) {
#pragma unroll
            for (int e = 0; e < 2; ++e) { const int x = 2 * w + e, tb = x >> 2, sb = x & 3;
                f32x4 a = (f32x4){0.f, 0.f, 0.f, 0.f};
                if (sb <= tb) a = mm16<4>(a, lds + G_KT + sb * 16 * 272, 272, lds + G_QT + tb * 16 * 272, 272, lane);
                const int t = 16 * tb + r16, s0 = 16 * sb + quad * 4;
                float v[4];
#pragma unroll
                for (int jj = 0; jj < 4; ++jj) v[jj] = (s0 + jj <= t) ? a[jj] : 0.f;
                if (x == 0 && lane == 0 && j == 0 && (tok0 & (SEQ - 1)) == 0) { const float* qk_ = (l == 0) ? (const float*)(ws + SB_PROJ) + (tok0 >> 13) * 14384 : (const float*)(ws + SB_QK1) + (tok0 >> 13) * 1024;
                    float acc_ = 0.f; for (int d_ = 0; d_ < 128; ++d_) acc_ += qk_[h * 128 + d_] * qk_[512 + h * 128 + d_]; v[0] = acc_ * 0.08838834764831845f; }
                *(LAS u32x2*)(lds + G_P + t * 144 + s0 * 2) = (u32x2){pk2(v[0], v[1]), pk2(v[2], v[3])}; }
            f32x4 o[4][2];
#pragma unroll
            for (int mb = 0; mb < 4; ++mb) { o[mb][0] = (f32x4){0.f, 0.f, 0.f, 0.f}; o[mb][1] = (f32x4){0.f, 0.f, 0.f, 0.f}; }
#pragma unroll
            for (int ks = 0; ks < 4; ++ks) {
                bf16x8 bf[2];
#pragma unroll
                for (int nb = 0; nb < 2; ++nb) { const f32x4 s0v = S[2 * ks][nb], s1v = S[2 * ks + 1][nb];
                    u32x4 pk; pk.x = pk2(s0v[0], s0v[1]); pk.y = pk2(s0v[2], s0v[3]); pk.z = pk2(s1v[0], s1v[1]); pk.w = pk2(s1v[2], s1v[3]); bf[nb] = __builtin_bit_cast(bf16x8, pk); }
#pragma unroll
                for (int mb = 0; mb < 4; ++mb) { const LAS unsigned char* ap = lds + G_QT + (16 * mb + r16) * 272 + (32 * ks + quad * 4) * 2;
                    const u32x2 lo = *(const LAS u32x2*)ap, hi = *(const LAS u32x2*)(ap + 32);
                    const bf16x8 af = __builtin_bit_cast(bf16x8, (u32x4){lo.x, lo.y, hi.x, hi.y});
                    o[mb][0] = mfma16(af, bf[0], o[mb][0]); o[mb][1] = mfma16(af, bf[1], o[mb][1]); }
            }
            __syncthreads();
#pragma unroll
            for (int mb = 0; mb < 4; ++mb)
#pragma unroll
                for (int nb = 0; nb < 2; ++nb) o[mb][nb] = mm16<2>(o[mb][nb], lds + G_P + mb * 16 * 144, 144, lds + G_VT + (32 * w + 16 * nb) * 144, 144, lane);
#pragma unroll
            for (int mb = 0; mb < 4; ++mb)
#pragma unroll
                for (int jj = 0; jj < 4; ++jj) { float ss = o[mb][0][jj] * o[mb][0][jj] + o[mb][1][jj] * o[mb][1][jj];
                    ss += __shfl_xor(ss, 1); ss += __shfl_xor(ss, 2); ss += __shfl_xor(ss, 4); ss += __shfl_xor(ss, 8);
                    if (r16 == 0) __hip_atomic_fetch_add((LAS float*)(lds + G_PART) + 16 * mb + quad * 4 + jj, ss, __ATOMIC_RELAXED, __HIP_MEMORY_SCOPE_WORKGROUP); }
            __syncthreads();
#pragma unroll
            for (int mb = 0; mb < 4; ++mb)
#pragma unroll
                for (int jj = 0; jj < 4; ++jj) { const int t = 16 * mb + quad * 4 + jj; const float rs = rsqrtf(((const LAS float*)(lds + G_PART))[t] * (1.f / 256.f) + EPS);
#pragma unroll
                    for (int nb = 0; nb < 2; ++nb) { bf16_t* gp = Gg + (size_t)(t0 + t) * 1024 + h * 256 + 32 * w + 16 * nb + r16;
                        const float gv = bf2f(*gp); *gp = f2bf(o[mb][nb][jj] * rs * ng[nb] * siluf_(gv)); } }
        }
#pragma unroll
        for (int mb = 0; mb < 8; ++mb) { const f32x4 bl4 = *(const LAS f32x4*)(lds + G_BLAST + (16 * mb + quad * 4) * 4);
            const f32x4 dc = (f32x4){__expf(bl4[0]), __expf(bl4[1]), __expf(bl4[2]), __expf(bl4[3])};
#pragma unroll
            for (int nb = 0; nb < 2; ++nb) { S[mb][nb] = S[mb][nb] * dc;
                S[mb][nb] = mm16<2>(S[mb][nb], lds + G_KHT + mb * 16 * 144, 144, lds + G_VT + (32 * w + 16 * nb) * 144, 144, lane); } }
        __syncthreads();
    }
    if (MODE == 1) {
#pragma unroll
        for (int mb = 0; mb < 8; ++mb)
#pragma unroll
            for (int nb = 0; nb < 2; ++nb) *(f32x4*)(states + ((size_t)(w * 16 + mb * 2 + nb) * 64 + lane) * 4) = S[mb][nb];
        if (tid < 128) ((float*)(ws + WS_DECG))[un * 128 + tid] = dtot;
    }
}
DI void gla_scan(const Params& p) {
    const int gid = blockIdx.x * 512 + opaque_tid();
    for (int it = gid; it < 65536; it += gridDim.x * 512) {
        const int chain = it >> 13, e = it & 8191, b = chain >> 2, h = chain & 3;
        const int tile = (e >> 6) & 15, lane = e & 63, d0 = 16 * (tile >> 1) + (lane >> 4) * 4;
        f32x4* st = (f32x4*)(p.ws + WS_STG); const float* dec = (const float*)(p.ws + WS_DECG);
        f32x4 run = (f32x4){0.f, 0.f, 0.f, 0.f};
        for (int hb = 0; hb < 4; ++hb) {
            f32x4 u[8];
#pragma unroll
            for (int s = 0; s < 8; ++s) u[s] = st[(size_t)((b * 32 + hb * 8 + s) * 4 + h) * 8192 + e];
            asm volatile("" ::: "memory");
#pragma unroll
            for (int s = 0; s < 8; ++s) { const int un = (b * 32 + hb * 8 + s) * 4 + h; const f32x4 dc = *(const f32x4*)(dec + un * 128 + d0);
                st[(size_t)un * 8192 + e] = run; run = run * dc + u[s]; }
        }
    }
}

constexpr int S_ACUM = 0, S_DTV = 256, S_MISC = 512, S_XDT = 1024, S_XD2 = 10240, S_BN = 19456, S_BT = 36864, S_CN = 55296, S_GL = 72704, S_SB = 81920;
DI float softplusf_(float x) { const float e = __expf(x); return x > 20.f ? x : (x < -10.f ? e : __logf(1.f + e)); }
template <int MODE> DI void ssd_unit(const Params& p, int l, int un, LAS unsigned char* lds) {
    const int tid = opaque_tid(), lane = tid & 63, w = __builtin_amdgcn_readfirstlane(tid >> 6), r16 = lane & 15, quad = lane >> 4;
    const int sc = un >> 5, head = un & 31, g = head >> 3, tok0 = sc * 256;
    unsigned char* ws = p.ws;
    bf16_t* Zb = (bf16_t*)(ws + WS_R + (size_t)(head >> 4) * BLK) + (head & 15) * 64;
    const bf16_t* Xb = (const bf16_t*)(ws + WS_R + (size_t)(2 + (head >> 4)) * BLK) + (head & 15) * 64;
    const bf16_t* BCb = (const bf16_t*)(ws + WS_R + 4 * BLK);
    const float* small = (const float*)(ws + WS_SMALL);
    float* ssq = (float*)(ws + WS_SSQ);
    float* states = (float*)(ws + WS_STS) + (size_t)un * 8192;
    const float* cw = p.in[8] + (size_t)l * 4 * 3072; const float* cbias = p.in[9] + l * 3072;
    const float dtb = p.in[10][l * 32 + head], aneg = -__expf(p.in[11][l * 32 + head]), Dh = p.in[12][l * 32 + head];
    f32x4 st[4];
    if (MODE == 3) {
#pragma unroll
        for (int pb = 0; pb < 4; ++pb) { st[pb] = *(const f32x4*)(states + ((size_t)(w * 4 + pb) * 64 + lane) * 4);
            *(LAS u32x2*)(lds + S_SB + (16 * pb + r16) * 272 + (16 * w + quad * 4) * 2) = (u32x2){pk2(st[pb][0], st[pb][1]), pk2(st[pb][2], st[pb][3])}; }
    } else {
#pragma unroll
        for (int pb = 0; pb < 4; ++pb) st[pb] = (f32x4){0.f, 0.f, 0.f, 0.f};
    }
    const int px = tid & 63, tq = tid >> 6;
    float wx[4];
#pragma unroll
    for (int i = 0; i < 4; ++i) wx[i] = cw[i * 3072 + head * 64 + px];
    const float bx = cbias[head * 64 + px];
    float atot = 0.f;
    for (int j = 0; j < 4; ++j) {
        const int t0 = tok0 + 64 * j, s0 = t0 & (SEQ - 1);
        if (w == 0) {
            const float dt = softplusf_(small[(size_t)(t0 + lane) * 64 + 16 + head] + dtb);
            float cs = dt * aneg;
#pragma unroll
            for (int o = 1; o < 64; o <<= 1) { const float v = __shfl_up(cs, o); if (lane >= o) cs += v; }
            ((LAS float*)(lds + S_ACUM))[lane] = cs; ((LAS float*)(lds + S_DTV))[lane] = dt;
            if (lane == 63) ((LAS float*)(lds + S_MISC))[0] = cs;
        }
        __syncthreads();
        const float alast = ((const LAS float*)(lds + S_MISC))[0];
        atot += alast;
        {
            float xv[11];
#pragma unroll
            for (int k = 0; k < 11; ++k) { const int tt = tq * 8 - 3 + k; xv[k] = (s0 + tt >= 0) ? bf2f(Xb[(size_t)(t0 + tt) * 1024 + px]) : 0.f; }
            unsigned a1[4], a2[4]; float e1[2], e2[2];
#pragma unroll
            for (int i = 0; i < 8; ++i) { const int t = tq * 8 + i;
                const float cv = bx + xv[i] * wx[0] + xv[i + 1] * wx[1] + xv[i + 2] * wx[2] + xv[i + 3] * wx[3];
                const float xd = siluf_(cv) * ((const LAS float*)(lds + S_DTV))[t];
                e1[i & 1] = xd; e2[i & 1] = xd * __expf(alast - ((const LAS float*)(lds + S_ACUM))[t]);
                if (i & 1) { a1[i >> 1] = pk2(e1[0], e1[1]); a2[i >> 1] = pk2(e2[0], e2[1]); } }
            *(LAS u32x4*)(lds + S_XDT + px * 144 + tq * 16) = (u32x4){a1[0], a1[1], a1[2], a1[3]};
            *(LAS u32x4*)(lds + S_XD2 + px * 144 + tq * 16) = (u32x4){a2[0], a2[1], a2[2], a2[3]};
        }
        {
            const bf16_t* BCc = (const bf16_t*)(ws + WS_STG);
#pragma unroll
            for (int i = 0; i < 2; ++i) { const int pid = tid + 512 * i, c8 = pid >> 6, t = pid & 63;
                const u32x4 v = *(const u32x4*)(BCc + (size_t)(t0 + t) * 1024 + g * 128 + c8 * 8);
                if (MODE == 3) *(LAS u32x4*)(lds + S_BN + t * 272 + c8 * 16) = v;
                LAS bf16_t* bt = (LAS bf16_t*)(lds + S_BT) + (c8 * 8) * 72 + t;
#pragma unroll
                for (int e = 0; e < 4; ++e) { bt[(2 * e) * 72] = (bf16_t)(v[e] & 0xffffu); bt[(2 * e + 1) * 72] = (bf16_t)(v[e] >> 16); }
                if (MODE == 3) { const u32x4 cv = *(const u32x4*)(BCc + (size_t)(t0 + t) * 1024 + 512 + g * 128 + c8 * 8); *(LAS u32x4*)(lds + S_CN + t * 272 + c8 * 16) = cv; } }
        }
        __syncthreads();
        if (MODE == 3) {
            f32x4 y[2];
#pragma unroll
            for (int e = 0; e < 2; ++e) { const int x = 2 * w + e, tb = x >> 2, sb = x & 3;
                f32x4 a = (f32x4){0.f, 0.f, 0.f, 0.f};
                if (sb <= tb) a = mm16<4>(a, lds + S_BN + sb * 16 * 272, 272, lds + S_CN + tb * 16 * 272, 272, lane);
                const int t = 16 * tb + r16, sb0 = 16 * sb + quad * 4;
                const float act = ((const LAS float*)(lds + S_ACUM))[t], dtt = ((const LAS float*)(lds + S_DTV))[t];
                float v[4];
#pragma unroll
                for (int jj = 0; jj < 4; ++jj) { const int s = sb0 + jj; float val = 0.f;
                    if (s <= t) val = a[jj] * __expf(act - ((const LAS float*)(lds + S_ACUM))[s]);
                    if (s == t) val += Dh * __builtin_amdgcn_rcpf(dtt);
                    v[jj] = val; }
                *(LAS u32x2*)(lds + S_GL + t * 144 + sb0 * 2) = (u32x2){pk2(v[0], v[1]), pk2(v[2], v[3])};
                const int pb = sb;
                y[e] = mm16<4>((f32x4){0.f, 0.f, 0.f, 0.f}, lds + S_SB + pb * 16 * 272, 272, lds + S_CN + tb * 16 * 272, 272, lane);
                y[e] = y[e] * __expf(act);
            }
            __syncthreads();
#pragma unroll
            for (int e = 0; e < 2; ++e) { const int x = 2 * w + e, tb = x >> 2, pb = x & 3;
                y[e] = mm16<2>(y[e], lds + S_XDT + pb * 16 * 144, 144, lds + S_GL + tb * 16 * 144, 144, lane);
                const int t = 16 * tb + r16; bf16_t* zp = Zb + (size_t)(t0 + t) * 1024 + 16 * pb + quad * 4;
                const u32x2 zw = *(const u32x2*)zp;
                f32x4 r; r[0] = y[e][0] * siluf_(bflo(zw.x)); r[1] = y[e][1] * siluf_(bfhi(zw.x)); r[2] = y[e][2] * siluf_(bflo(zw.y)); r[3] = y[e][3] * siluf_(bfhi(zw.y));
                float ss = r[0] * r[0] + r[1] * r[1] + r[2] * r[2] + r[3] * r[3];
                ss += __shfl_xor(ss, 16); ss += __shfl_xor(ss, 32);
                if (quad == 0) atomicAdd(ssq + (size_t)(t0 + t) * 4 + g, ss);
                *(u32x2*)zp = (u32x2){pk2(r[0], r[1]), pk2(r[2], r[3])}; }
        }
        {
            const float da = __expf(alast);
#pragma unroll
            for (int pb = 0; pb < 4; ++pb) { st[pb] = st[pb] * da;
                st[pb] = mm16<2>(st[pb], lds + S_BT + w * 16 * 144, 144, lds + S_XD2 + pb * 16 * 144, 144, lane);
                if (MODE == 3) *(LAS u32x2*)(lds + S_SB + (16 * pb + r16) * 272 + (16 * w + quad * 4) * 2) = (u32x2){pk2(st[pb][0], st[pb][1]), pk2(st[pb][2], st[pb][3])}; }
        }
        __syncthreads();
    }
    if (MODE == 1) {
#pragma unroll
        for (int pb = 0; pb < 4; ++pb) *(f32x4*)(states + ((size_t)(w * 4 + pb) * 64 + lane) * 4) = st[pb];
        if (tid == 0) ((float*)(ws + WS_DECS))[un] = __expf(atot);
    }
}

DI void conv_bc(const Params& p, int l) {
    const bf16_t* BC = (const bf16_t*)(p.ws + WS_R + 4 * BLK); bf16_t* O = (bf16_t*)(p.ws + WS_STG);
    const float* cw = p.in[8] + (size_t)l * 4 * 3072 + 2048; const float* cb = p.in[9] + l * 3072 + 2048;
    const int gt = blockIdx.x * 512 + opaque_tid();
    for (int it = gt; it < 1024 * 256; it += gridDim.x * 512) {
        const int c = it & 1023, r0 = (it >> 10) * 64;
        const float w0 = cw[c], w1 = cw[3072 + c], w2 = cw[2 * 3072 + c], w3 = cw[3 * 3072 + c], b = cb[c];
        float x0 = 0.f, x1 = 0.f, x2 = 0.f;
        if ((r0 & (SEQ - 1)) != 0) { x0 = bf2f(BC[(size_t)(r0 - 3) * 1024 + c]); x1 = bf2f(BC[(size_t)(r0 - 2) * 1024 + c]); x2 = bf2f(BC[(size_t)(r0 - 1) * 1024 + c]); }
#pragma unroll 8
        for (int i = 0; i < 64; ++i) { const float x3 = bf2f(BC[(size_t)(r0 + i) * 1024 + c]); const float cv = b + x0 * w0 + x1 * w1 + x2 * w2 + x3 * w3;
            O[(size_t)(r0 + i) * 1024 + c] = f2bf(siluf_(cv)); x0 = x1; x1 = x2; x2 = x3; }
    }
}

constexpr int L_ACUM = 0, L_DTV = 1024, L_TOT = 2048, L_XD2 = 2304, L_BT = 36096;
DI void ssd_local(const Params& p, int l, int un, LAS unsigned char* lds) {
    const int tid = opaque_tid(), lane = tid & 63, w = __builtin_amdgcn_readfirstlane(tid >> 6);
    const int sc = un >> 5, head = un & 31, g = head >> 3, tok0 = sc * 256, s0 = tok0 & (SEQ - 1);
    unsigned char* ws = p.ws;
    const bf16_t* Xb = (const bf16_t*)(ws + WS_R + (size_t)(2 + (head >> 4)) * BLK) + (head & 15) * 64;
    const bf16_t* BCc = (const bf16_t*)(ws + WS_STG);
    const float* small = (const float*)(ws + WS_SMALL);
    float* states = (float*)(ws + WS_STS) + (size_t)un * 8192;
    const float* cw = p.in[8] + (size_t)l * 4 * 3072; const float* cbias = p.in[9] + l * 3072;
    const float dtb = p.in[10][l * 32 + head], aneg = -__expf(p.in[11][l * 32 + head]);
    if (w < 4) {
        const int t = w * 64 + lane; const float dt = softplusf_(small[(size_t)(tok0 + t) * 64 + 16 + head] + dtb);
        float cs = dt * aneg;
#pragma unroll
        for (int o = 1; o < 64; o <<= 1) { const float v = __shfl_up(cs, o); if (lane >= o) cs += v; }
        ((LAS float*)(lds + L_ACUM))[t] = cs; ((LAS float*)(lds + L_DTV))[t] = dt;
        if (lane == 63) ((LAS float*)(lds + L_TOT))[w] = cs;
    }
    __syncthreads();
    const float t0_ = ((const LAS float*)(lds + L_TOT))[0], t1_ = ((const LAS float*)(lds + L_TOT))[1], t2_ = ((const LAS float*)(lds + L_TOT))[2], t3_ = ((const LAS float*)(lds + L_TOT))[3];
    const float atot = t0_ + t1_ + t2_ + t3_;
    {
        const int px = tid & 63, tq = tid >> 6;
        float wx[4];
#pragma unroll
        for (int i = 0; i < 4; ++i) wx[i] = cw[i * 3072 + head * 64 + px];
        const float bx = cbias[head * 64 + px];
        const float offq = (tq >= 6) ? t0_ + t1_ + t2_ : (tq >= 4) ? t0_ + t1_ : (tq >= 2) ? t0_ : 0.f;
#pragma unroll
        for (int c4 = 0; c4 < 4; ++c4) { const int tb = tq * 32 + c4 * 8;
            float xv[11];
#pragma unroll
            for (int k = 0; k < 11; ++k) { const int tt = tb - 3 + k; xv[k] = (s0 + tt >= 0) ? bf2f(Xb[(size_t)(tok0 + tt) * 1024 + px]) : 0.f; }
            unsigned a2[4]; float e2[2];
#pragma unroll
            for (int i = 0; i < 8; ++i) { const int t = tb + i;
                const float cv = bx + xv[i] * wx[0] + xv[i + 1] * wx[1] + xv[i + 2] * wx[2] + xv[i + 3] * wx[3];
                e2[i & 1] = siluf_(cv) * ((const LAS float*)(lds + L_DTV))[t] * __expf(atot - offq - ((const LAS float*)(lds + L_ACUM))[t]);
                if (i & 1) a2[i >> 1] = pk2(e2[0], e2[1]); }
            *(LAS u32x4*)(lds + L_XD2 + px * 528 + tb * 2) = (u32x4){a2[0], a2[1], a2[2], a2[3]}; }
    }
#pragma unroll
    for (int i = 0; i < 8; ++i) { const int pid = tid + 512 * i, c8 = pid >> 8, t = pid & 255;
        const u32x4 v = *(const u32x4*)(BCc + (size_t)(tok0 + t) * 1024 + g * 128 + c8 * 8);
        LAS bf16_t* bt = (LAS bf16_t*)(lds + L_BT) + (c8 * 8) * 264 + t;
#pragma unroll
        for (int e = 0; e < 4; ++e) { bt[(2 * e) * 264] = (bf16_t)(v[e] & 0xffffu); bt[(2 * e + 1) * 264] = (bf16_t)(v[e] >> 16); } }
    __syncthreads();
#pragma unroll
    for (int pb = 0; pb < 4; ++pb) { const f32x4 st = mm16<8>((f32x4){0.f, 0.f, 0.f, 0.f}, lds + L_BT + w * 16 * 528, 528, lds + L_XD2 + pb * 16 * 528, 528, lane);
        *(f32x4*)(states + ((size_t)(w * 4 + pb) * 64 + lane) * 4) = st; }
    if (tid == 0) ((float*)(ws + WS_DECS))[un] = __expf(atot);
    __syncthreads();
}
DI void ssd_scan(const Params& p) {
    const int gid = blockIdx.x * 512 + opaque_tid();
    for (int it = gid; it < 131072; it += gridDim.x * 512) {
        const int chain = it >> 11, e = it & 2047, b = chain >> 5, head = chain & 31;
        f32x4* st = (f32x4*)(p.ws + WS_STS); const float* dec = (const float*)(p.ws + WS_DECS);
        f32x4 run = (f32x4){0.f, 0.f, 0.f, 0.f};
        for (int hb = 0; hb < 4; ++hb) {
            f32x4 u[8];
#pragma unroll
            for (int s = 0; s < 8; ++s) u[s] = st[(size_t)((b * 32 + hb * 8 + s) * 32 + head) * 2048 + e];
            asm volatile("" ::: "memory");
#pragma unroll
            for (int s = 0; s < 8; ++s) { const int un = (b * 32 + hb * 8 + s) * 32 + head; const float dc = dec[un];
                st[(size_t)un * 2048 + e] = run; run = run * dc + u[s]; }
        }
    }
}

typedef short v4i16_t __attribute__((ext_vector_type(4)));
DI s16x4 vtr(const LAS unsigned char* p) { return __builtin_bit_cast(s16x4, __builtin_amdgcn_ds_read_tr16_b64_v4i16((LAS v4i16_t*)p)); }
constexpr int A_K = 0, A_V = 34816, A_X = 0, A_Y = 65536, A_NG = 100352;
DI void attn_unit(const Params& p, int b, int h, int qb, float lam, float oscale, LAS unsigned char* lds) {
    const int tid = opaque_tid(), lane = tid & 63, w = __builtin_amdgcn_readfirstlane(tid >> 6), rg = w & 3, sub = w >> 2, q = lane & 31, hh = lane >> 5;
    bf16_t* Qd = (bf16_t*)(p.ws + WS_R + 4 * BLK); const bf16_t* Kd = (const bf16_t*)(p.ws + WS_R + 5 * BLK); const bf16_t* Vd = (const bf16_t*)(p.ws + WS_R + 6 * BLK);
    const int tok0 = b * SEQ + qb * 128;
    bf16x8 qf[4];
    { const bf16_t* qp = Qd + (size_t)(tok0 + rg * 32 + q) * 1024 + h * 128 + sub * 64 + hh * 8;
#pragma unroll
      for (int ks = 0; ks < 4; ++ks) qf[ks] = *(const bf16x8*)(qp + ks * 16); }
    const int NT = 2 * qb + 2;
    u32x4 kr[2], vr[2];
    const int prow = tid >> 4, pc16 = tid & 15;
#define ATT_LOAD(t) do { _Pragma("unroll") for (int i_ = 0; i_ < 2; ++i_) { const size_t off_ = (size_t)(b * SEQ + (t) * 64 + prow + 32 * i_) * 1024 + h * 128 + pc16 * 8; \
        kr[i_] = *(const u32x4*)(Kd + off_); vr[i_] = *(const u32x4*)(Vd + off_); } } while (0)
#define ATT_STORE(buf) do { _Pragma("unroll") for (int i_ = 0; i_ < 2; ++i_) { const int o_ = (buf) * 17408 + (prow + 32 * i_) * 272 + pc16 * 16; \
        *(LAS u32x4*)(lds + A_K + o_) = kr[i_]; *(LAS u32x4*)(lds + A_V + (buf) * 18432 + (prow + 32 * i_) * 288 + pc16 * 16) = vr[i_]; } } while (0)
    f32x16 o[4];
#pragma unroll
    for (int db = 0; db < 4; ++db)
#pragma unroll
        for (int i = 0; i < 16; ++i) o[db][i] = 0.f;
    float m_run = -1e30f, l_run = 0.f;
    const float C2 = 0.18033688011112042f;
    ATT_LOAD(0); ATT_STORE(0); ATT_LOAD(1);
    __syncthreads();
    const int i16 = lane & 15, blk = (lane >> 4) & 1;
    for (int t = 0; t < NT; ++t) {
        if (t + 1 < NT) ATT_STORE((t + 1) & 1);
        if (t + 2 < NT) ATT_LOAD(t + 2);
        if (t <= 2 * qb + (rg >> 1)) {
            const LAS unsigned char* Kb = lds + A_K + (t & 1) * 17408; const LAS unsigned char* Vb = lds + A_V + (t & 1) * 18432;
            f32x16 s0, s1;
#pragma unroll
            for (int i = 0; i < 16; ++i) { s0[i] = 0.f; s1[i] = 0.f; }
#pragma unroll
            for (int ks = 0; ks < 4; ++ks) { const LAS unsigned char* kp = Kb + q * 272 + (sub * 64 + ks * 16 + hh * 8) * 2;
                s0 = mfma32(*(const LAS bf16x8*)kp, qf[ks], s0); s1 = mfma32(*(const LAS bf16x8*)(kp + 32 * 272), qf[ks], s1); }
            float mx = fmaxf(s0[0], s1[0]);
#pragma unroll
            for (int i = 1; i < 16; ++i) mx = fmaxf(mx, fmaxf(s0[i], s1[i]));
            mx = fmaxf(mx, __shfl_xor(mx, 32));
            const float m_new = fmaxf(m_run, mx), negm = -m_new * C2;
            if (__any(m_new > m_run)) {
                const float alpha = __builtin_amdgcn_exp2f((m_run - m_new) * C2);
                l_run *= alpha;
#pragma unroll
                for (int db = 0; db < 4; ++db)
#pragma unroll
                    for (int i = 0; i < 16; ++i) o[db][i] *= alpha;
            }
            float sum = 0.f;
#pragma unroll
            for (int i = 0; i < 16; ++i) { s0[i] = __builtin_amdgcn_exp2f(fmaf(s0[i], C2, negm)); s1[i] = __builtin_amdgcn_exp2f(fmaf(s1[i], C2, negm)); sum += s0[i] + s1[i]; }
            l_run += sum; m_run = m_new;
            bf16x8 pf[2][2];
#pragma unroll
            for (int s = 0; s < 2; ++s) {
                pf[0][s] = __builtin_bit_cast(bf16x8, (u32x4){pk2(s0[8 * s], s0[8 * s + 1]), pk2(s0[8 * s + 2], s0[8 * s + 3]), pk2(s0[8 * s + 4], s0[8 * s + 5]), pk2(s0[8 * s + 6], s0[8 * s + 7])});
                pf[1][s] = __builtin_bit_cast(bf16x8, (u32x4){pk2(s1[8 * s], s1[8 * s + 1]), pk2(s1[8 * s + 2], s1[8 * s + 3]), pk2(s1[8 * s + 4], s1[8 * s + 5]), pk2(s1[8 * s + 6], s1[8 * s + 7])}); }
#pragma unroll
            for (int kb = 0; kb < 2; ++kb)
#pragma unroll
                for (int s = 0; s < 2; ++s) { const LAS unsigned char* vp = Vb + (32 * kb + 16 * s + 4 * hh + (i16 >> 2)) * 288 + blk * 32 + (i16 & 3) * 8;
#pragma unroll
                    for (int db = 0; db < 4; ++db) { const s16x4 lo = vtr(vp + db * 64), hi = vtr(vp + db * 64 + 8 * 288);
                        const bf16x8 vf = (bf16x8){lo[0], lo[1], lo[2], lo[3], hi[0], hi[1], hi[2], hi[3]};
                        o[db] = mfma32(vf, pf[kb][s], o[db]); } }
        }
        __syncthreads();
    }
#undef ATT_LOAD
#undef ATT_STORE
    const float l_tot = l_run + __shfl_xor(l_run, 32);
    LAS float* X = (LAS float*)(lds + A_X) + rg * 4096;
    if (sub == 1) { const float inv = lam / l_tot;
#pragma unroll
        for (int db = 0; db < 4; ++db)
#pragma unroll
            for (int i = 0; i < 16; ++i) X[(db * 16 + i) * 64 + lane] = o[db][i] * inv; }
    __syncthreads();
    if (sub == 0) { const float inv = 1.f / l_tot; float ss = 0.f;
#pragma unroll
        for (int db = 0; db < 4; ++db)
#pragma unroll
            for (int i = 0; i < 16; ++i) { const float v = o[db][i] * inv - X[(db * 16 + i) * 64 + lane]; o[db][i] = v; ss += v * v; }
        ss += __shfl_xor(ss, 32);
        const float rs = rsqrtf(ss * (1.f / 128.f) + 1e-5f) * oscale;
        LAS bf16_t* Y = (LAS bf16_t*)(lds + A_Y) + rg * (32 * 136);
        const LAS float* ngl = (const LAS float*)(lds + A_NG);
#pragma unroll
        for (int db = 0; db < 4; ++db)
#pragma unroll
            for (int i = 0; i < 16; ++i) { const int dv = 32 * db + crow(i, hh); Y[q * 136 + dv] = f2bf(o[db][i] * rs * ngl[dv]); }
        asm volatile("s_waitcnt lgkmcnt(0)" ::: "memory");
#pragma unroll
        for (int k = 0; k < 8; ++k) { const int piece = lane + 64 * k, row = piece >> 4, c16 = piece & 15;
            const u32x4 v = *(const LAS u32x4*)((const LAS unsigned char*)Y + row * 272 + c16 * 16);
            *(u32x4*)(Qd + (size_t)(tok0 + rg * 32 + row) * 1024 + h * 128 + c16 * 8) = v; }
    }
    __syncthreads();
}
DI void attn_phase(const Params& p, int l, LAS unsigned char* lds, int vcu) {
    const int tid = opaque_tid();
    float d1 = 0.f, d2 = 0.f;
    for (int i = 0; i < 64; ++i) { d1 += p.in[14][l * 64 + i] * p.in[15][l * 64 + i]; d2 += p.in[16][l * 64 + i] * p.in[17][l * 64 + i]; }
    const float lambda_init = (l == 0) ? 0.2f : 0.35550906759096934f;
    const float lam = expf(d1) - expf(d2) + lambda_init;
    if (tid < 128) ((LAS float*)(lds + A_NG))[tid] = p.in[18][l * 128 + tid];
    __syncthreads();
    for (int i = 0; i < 4; ++i)
        for (int vc = vcu; vc < 256; vc += gridDim.x) {
            const int bh = vc >> 4, s = vc & 15; const int qb = (i == 0) ? s : (i == 1) ? 31 - s : (i == 2) ? 32 + s : 63 - s;
            attn_unit(p, bh >> 3, bh & 7, qb, lam, 1.f - lambda_init, lds);
        }
}

DI void final_norm(const Params& p) {
    const float* rowsq = (const float*)(p.ws + WS_ROWSQ) + 4 * T; const float* g = p.in[26];
    const int gt = blockIdx.x * 512 + opaque_tid();
    for (int i = gt; i < T * 256; i += gridDim.x * 512) { const int row = i >> 8, c = (i & 255) * 4;
        const float rs = rsqrtf(rowsq[row] * (1.f / 1024.f) + EPS);
        f32x4 v = *(f32x4*)(p.out + (size_t)row * 1024 + c); const f32x4 gv = *(const f32x4*)(g + c);
        *(f32x4*)(p.out + (size_t)row * 1024 + c) = v * rs * gv; }
}


DI void gemv2(float* out, int ldo, const float* in, int ldi, const float* W, int ldw, int K, int N, int kchunk) {
    const int tid = opaque_tid(), lane = tid & 63, wave = __builtin_amdgcn_readfirstlane(tid >> 6);
    const int gw = blockIdx.x * 8 + wave, NGW = gridDim.x * 8, nstrip = (N + 63) / 64, nk = K / 128;
    for (int job = gw; job < nstrip * nk; job += NGW) {
        const int strip = job % nstrip, kq = job / nstrip, col = strip * 64 + lane; const bool ok = col < N;
        const float* wp = W + (size_t)(kq * 128) * ldw + (ok ? col : 0);
        const float* i0 = in + kq * 128; const float* i1 = in + ldi + kq * 128;
        float a0 = 0.f, a1 = 0.f;
        for (int kk = 0; kk < 2; ++kk) {
            const float h0 = i0[kk * 64 + lane], h1 = i1[kk * 64 + lane];
#pragma unroll
            for (int k = 0; k < 64; ++k) { const float wv = wp[(size_t)(kk * 64 + k) * ldw];
                a0 += __uint_as_float(__builtin_amdgcn_readlane(__float_as_uint(h0), k)) * wv; a1 += __uint_as_float(__builtin_amdgcn_readlane(__float_as_uint(h1), k)) * wv; }
        }
        if (ok) { atomicAdd(out + col, a0); atomicAdd(out + ldo + col, a1); }
    }
}
DI void side_init(const Params& p) {
    const int tid = opaque_tid(), lane = tid & 63, wave = __builtin_amdgcn_readfirstlane(tid >> 6);
    const int gt = blockIdx.x * 512 + tid, NTH = gridDim.x * 512, gw = blockIdx.x * 8 + wave, NGW = gridDim.x * 8;
    float* z = (float*)(p.ws + SB_PROJ);
    for (int i = gt; i < (int)((SB_END - SB_PROJ) / 4); i += NTH) z[i] = 0.f;
    float* hn = (float*)(p.ws + SB_HN);
    for (int r = gw; r < 128; r += NGW) { const int row = (r >> 6) * SEQ + (r & 63);
        const f32x4* xr = (const f32x4*)(p.in[0] + (size_t)row * 1024) + lane; f32x4 v[4]; float s2 = 0.f;
#pragma unroll
        for (int j = 0; j < 4; ++j) { v[j] = xr[64 * j]; s2 += v[j][0] * v[j][0] + v[j][1] * v[j][1] + v[j][2] * v[j][2] + v[j][3] * v[j][3]; }
        const float rs = rsqrtf(wave_sum(s2) * (1.f / 1024.f) + EPS);
#pragma unroll
        for (int j = 0; j < 4; ++j) { const f32x4 g = *((const f32x4*)p.in[2] + lane + 64 * j); *((f32x4*)(hn + (size_t)r * 1024) + lane + 64 * j) = v[j] * rs * g; } }
}
DI void side_kv(const Params& p) {
    const int tid = opaque_tid(), lane = tid & 63, wave = __builtin_amdgcn_readfirstlane(tid >> 6);
    const int gw = blockIdx.x * 8 + wave, NGW = gridDim.x * 8;
    const float* hn = (const float*)(p.ws + SB_HN); float* kv = (float*)(p.ws + SB_KV);
    for (int job = gw; job < 4096; job += NGW) {
        const int strip = job & 31, grp = (job >> 5) & 15, kq = job >> 9, col = strip * 64 + lane;
        const float* wp = p.in[3] + (size_t)(kq * 128) * INC + 9264 + col; const float* hp = hn + (size_t)(grp * 8) * 1024 + kq * 128;
        float a[8];
#pragma unroll
        for (int t = 0; t < 8; ++t) a[t] = 0.f;
        for (int kk = 0; kk < 2; ++kk) {
            float h[8];
#pragma unroll
            for (int t = 0; t < 8; ++t) h[t] = hp[t * 1024 + kk * 64 + lane];
#pragma unroll 16
            for (int k = 0; k < 64; ++k) { const float wv = wp[(size_t)(kk * 64 + k) * INC];
#pragma unroll
                for (int t = 0; t < 8; ++t) a[t] += __uint_as_float(__builtin_amdgcn_readlane(__float_as_uint(h[t]), k)) * wv; }
        }
#pragma unroll
        for (int t = 0; t < 8; ++t) atomicAdd(kv + (size_t)(grp * 8 + t) * 2048 + col, a[t]);
    }
}
DI void rope_cs(int pos, int i, float& cs, float& sn) {
    const double cf[8] = {0.15915494309189535, 0.03086376340470123, 0.005985185712713705, 0.001160663641240061, 0.00022507907903927653, 4.364795279280289e-05, 8.464330808241401e-06, 1.6414262627950345e-06};
    double c = cf[0];
#pragma unroll
    for (int q = 1; q < 8; ++q) c = (i == q) ? cf[q] : c;
    double rv = (double)pos * c; rv -= floor(rv); const float fr = (float)rv; sn = __builtin_amdgcn_sinf(fr); cs = __builtin_amdgcn_cosf(fr);
}
DI void side_mixers(const Params& p, int b, LAS unsigned char* lds) {
    const int tid = opaque_tid();
    const float* P = (const float*)(p.ws + SB_PROJ) + b * 14384; float* Y = (float*)(p.ws + SB_Y) + b * 4096; float* KV = (float*)(p.ws + SB_KV) + (size_t)b * 64 * 2048;
    LAS float* cx = (LAS float*)lds; LAS float* ypre = cx + 3072; LAS float* lg = ypre + 2048; LAS float* pr = lg + 1024; LAS float* red = pr + 1024; LAS float* qr = red + 64;
    const int* pos = (const int*)p.in[1] + b * SEQ;
    __syncthreads();
    if (tid < 4) { float qk = 0.f, vv = 0.f; for (int d = 0; d < 128; ++d) qk += P[tid * 128 + d] * P[512 + tid * 128 + d]; for (int d = 0; d < 256; ++d) { const float v = P[1024 + tid * 256 + d]; vv += v * v; }
        red[tid] = qk * 0.08838834764831845f; red[4 + tid] = vv * (1.f / 256.f); }
    for (int c = tid; c < 3072; c += 512) cx[c] = siluf_(p.in[9][c] + p.in[8][3 * 3072 + c] * P[5136 + c]);
    if (tid < 32) red[8 + tid] = softplusf_(P[8208 + tid] + p.in[10][tid]);
    __syncthreads();
    for (int i = tid; i < 1024; i += 512) { const int h = i >> 8; const float p00 = red[h], o = p00 * P[1024 + i];
        Y[i] = o * rsqrtf(p00 * p00 * red[4 + h] + EPS) * p.in[7][i & 255] * siluf_(P[2064 + i]); }
    if (tid < 4) { float cb = 0.f; for (int n = 0; n < 128; ++n) cb += cx[2560 + tid * 128 + n] * cx[2048 + tid * 128 + n]; red[40 + tid] = cb; }
    __syncthreads();
    for (int i = tid; i < 2048; i += 512) { const int head = i >> 6; ypre[i] = (red[40 + (head >> 3)] * red[8 + head] + p.in[12][head]) * cx[i] * siluf_(P[3088 + i]); }
    __syncthreads();
    if (tid < 4) { float ss = 0.f; for (int i = 0; i < 512; ++i) ss += ypre[tid * 512 + i] * ypre[tid * 512 + i]; red[44 + tid] = rsqrtf(ss * (1.f / 512.f) + EPS); }
    __syncthreads();
    for (int i = tid; i < 2048; i += 512) Y[1024 + i] = ypre[i] * red[44 + (i >> 9)] * p.in[13][i];
    for (int i = tid; i < 1024; i += 512) { const int d = i & 63; float v = P[8240 + i];
        if (d < 16) { float cs, sn; rope_cs(pos[0], d & 7, cs, sn); const float o = (d < 8) ? P[8240 + i + 8] : P[8240 + i - 8]; v = (d < 8) ? v * cs - o * sn : v * cs + o * sn; }
        qr[i] = v; }
    for (int it = tid; it < 8192; it += 512) { const int j = it >> 7, hs = (it >> 3) & 15, d = it & 7; float cs, sn; rope_cs(pos[j], d, cs, sn);
        float* kp = KV + (size_t)j * 2048 + hs * 64 + d; const float k1 = kp[0], k2 = kp[8]; kp[0] = k1 * cs - k2 * sn; kp[8] = k2 * cs + k1 * sn; }
    __threadfence_block();
    __syncthreads();
    for (int i = tid; i < 1024; i += 512) { const int hs = i >> 6, j = i & 63; const float* kp = KV + (size_t)j * 2048 + hs * 64; float sacc = 0.f;
        for (int d = 0; d < 64; ++d) sacc += qr[hs * 64 + d] * kp[d];
        lg[i] = sacc * 0.125f; }
    __syncthreads();
    if (tid < 16) { float m = -1e30f; for (int j = 0; j < 64; ++j) m = fmaxf(m, lg[tid * 64 + j]); float sum = 0.f; for (int j = 0; j < 64; ++j) { const float e = expf(lg[tid * 64 + j] - m); pr[tid * 64 + j] = e; sum += e; }
        const float inv = 1.f / sum; for (int j = 0; j < 64; ++j) pr[tid * 64 + j] *= inv; }
    __syncthreads();
    float d1 = 0.f, d2 = 0.f;
    for (int i = 0; i < 64; ++i) { d1 += p.in[14][i] * p.in[15][i]; d2 += p.in[16][i] * p.in[17][i]; }
    const float lam = expf(d1) - expf(d2) + 0.2f;
    for (int i = tid; i < 1024; i += 512) { const int h = i >> 7; float o = 0.f;
        for (int j = 0; j < 64; ++j) o += (pr[(2 * h) * 64 + j] - lam * pr[(2 * h + 1) * 64 + j]) * KV[(size_t)j * 2048 + 1024 + i];
        ypre[i] = o; }
    __syncthreads();
    if (tid < 8) { float ss = 0.f; for (int i = 0; i < 128; ++i) ss += ypre[tid * 128 + i] * ypre[tid * 128 + i]; red[48 + tid] = rsqrtf(ss * (1.f / 128.f) + 1e-5f) * 0.8f; }
    __syncthreads();
    for (int i = tid; i < 1024; i += 512) Y[3072 + i] = ypre[i] * red[48 + (i >> 7)] * p.in[18][i & 127];
    float* G = (float*)(p.ws + SB_GATE) + b * 3072;
    for (int i = tid; i < 3072; i += 512) G[i] = sigmoidf_(P[11312 + i] + p.in[4][i]);
    __syncthreads();
}
DI void side_glue(const Params& p, int step, int b, LAS unsigned char* lds) {
    const int tid = opaque_tid(); unsigned char* ws = p.ws; LAS float* red = (LAS float*)lds;
    if (step == 4) {
        const float* G = (const float*)(ws + SB_GATE) + b * 3072; const float* BR = (const float*)(ws + SB_BR) + b * 3072;
        for (int c = tid; c < 1024; c += 512) { ((float*)(ws + SB_MIX))[b * 1024 + c] = G[c] * BR[c] + G[1024 + c] * BR[1024 + c] + G[2048 + c] * BR[2048 + c];
            ((float*)(ws + SB_XM))[b * 1024 + c] = p.in[0][(size_t)b * SEQ * 1024 + c]; }
    } else if (step == 6 || step == 100) {
        const float* src = (const float*)(ws + (step == 6 ? SB_XM : SB_X1)) + b * 1024; float* dst = (float*)(ws + (step == 6 ? SB_H2 : SB_HN1)) + b * 1024;
        const float* g = step == 6 ? p.in[23] : p.in[2] + 1024;
        __syncthreads();
        float s2 = 0.f; for (int c = tid; c < 1024; c += 512) s2 += src[c] * src[c];
        s2 = wave_sum(s2); if ((tid & 63) == 0) red[tid >> 6] = s2;
        __syncthreads();
        float tot = 0.f; for (int w = 0; w < 8; ++w) tot += red[w];
        const float rs = rsqrtf(tot * (1.f / 1024.f) + EPS);
        for (int c = tid; c < 1024; c += 512) dst[c] = src[c] * rs * g[c];
        if (step == 100) { const size_t row = (size_t)b * SEQ; bf16_t* xb = (bf16_t*)(ws + WS_XB);
            for (int c = tid; c < 1024; c += 512) { p.out[row * 1024 + c] = src[c]; xb[row * 1024 + c] = f2bf(src[c]); }
            if (tid == 0) ((float*)(ws + WS_ROWSQ))[2 * T + row] = tot; }
        __syncthreads();
    } else if (step == 8) {
        const float* up = (const float*)(ws + SB_UP) + b * 4096; float* hh = (float*)(ws + SB_HH) + b * 4096;
        for (int c = tid; c < 4096; c += 512) { const float r = fmaxf(up[c], 0.f); hh[c] = r * r; }
        for (int c = tid; c < 1024; c += 512) ((float*)(ws + SB_X1))[b * 1024 + c] = ((const float*)(ws + SB_XM))[b * 1024 + c];
    }
}
DI void side_phase(const Params& p, int l, int k, LAS unsigned char* lds) {
    unsigned char* ws = p.ws; const int bid = blockIdx.x;
    if (l == 0) {
        if (k == 0) side_init(p);
        else if (k == 1) { gemv2((float*)(ws + SB_PROJ), 14384, (const float*)(ws + SB_HN), 64 * 1024, p.in[3], INC, 1024, INC, 128); side_kv(p); }
        else if (k == 2) { if (bid < 2) side_mixers(p, bid, lds); }
        else if (k == 3) { float* br = (float*)(ws + SB_BR); const float* y = (const float*)(ws + SB_Y);
            gemv2(br, 3072, y, 4096, p.in[19], 1024, 1024, 1024, 128); gemv2(br + 1024, 3072, y + 1024, 4096, p.in[20], 1024, 2048, 1024, 128); gemv2(br + 2048, 3072, y + 3072, 4096, p.in[21], 1024, 1024, 1024, 128); }
        else if (k == 4) { if (bid < 2) side_glue(p, 4, bid, lds); }
        else if (k == 5) gemv2((float*)(ws + SB_XM), 1024, (const float*)(ws + SB_MIX), 1024, p.in[22], 1024, 1024, 1024, 128);
        else if (k == 6) { if (bid < 2) side_glue(p, 6, bid, lds); }
        else if (k == 7) gemv2((float*)(ws + SB_UP), 4096, (const float*)(ws + SB_H2), 1024, p.in[24], 4096, 1024, 4096, 128);
        else if (k == 8) { if (bid < 2) side_glue(p, 8, bid, lds); }
        else if (k == 9) gemv2((float*)(ws + SB_X1), 1024, (const float*)(ws + SB_HH), 4096, p.in[25], 1024, 4096, 1024, 128);
    } else {
        if (k == 0) { if (bid < 2) side_glue(p, 100, bid, lds); }
        else if (k == 1) gemv2((float*)(ws + SB_QK1), 1024, (const float*)(ws + SB_HN1), 1024, p.in[3] + (size_t)1024 * INC, INC, 1024, 1024, 128);
    }
}


DI void grid_bar(unsigned* ctr, unsigned target) {
    asm volatile("s_waitcnt vmcnt(0)" ::: "memory");
    __syncthreads();
    if (threadIdx.x == 0) {
        __builtin_amdgcn_fence(__ATOMIC_RELEASE, "agent");
        asm volatile("s_waitcnt vmcnt(0)" ::: "memory");
        __hip_atomic_fetch_add(ctr, 1u, __ATOMIC_RELAXED, __HIP_MEMORY_SCOPE_AGENT);
        while (__hip_atomic_load(ctr, __ATOMIC_RELAXED, __HIP_MEMORY_SCOPE_AGENT) < target) __builtin_amdgcn_s_sleep(8);
        __builtin_amdgcn_fence(__ATOMIC_ACQUIRE, "agent");
        asm volatile("s_waitcnt vmcnt(0)" ::: "memory");
    }
    __syncthreads();
}

constexpr int NPHASE = 31, PPL = 15;
#ifndef PH_MASK
#define PH_MASK 0xFFFFFFFFu
#endif
#define EN(k_) ((PH_MASK >> (k_)) & 1u)
constexpr int LDS_BYTES = 147456;
template <bool COOP> __global__ void __launch_bounds__(512, 2) mk(Params p) {
    extern __shared__ __attribute__((aligned(16))) unsigned char lds_raw[];
    LAS unsigned char* lds = (LAS unsigned char*)lds_raw;
    unsigned char* ws = p.ws;
    float* rowsq = (float*)(ws + WS_ROWSQ);
    bf16_t* xb = (bf16_t*)(ws + WS_XB); bf16_t* mixb = (bf16_t*)(ws + WS_MIXB); bf16_t* R = (bf16_t*)(ws + WS_R);
    const unsigned char* wt = ws + WS_WT;
    const int G = gridDim.x, bid = blockIdx.x;
    const int vcu = (G % 8 == 0) ? (bid % 8) * (G / 8) + bid / 8 : bid;
    for (int ph = p.ph_lo; ph < p.ph_hi; ++ph) {
        if (ph == 30) { final_norm(p); }
        else {
            const int l = ph / PPL, k = ph % PPL;
            if (EN(0) && k == 0) phase_prep(p, l, lds);
            else if (k == 1 || k == 6) {
                const bool gd = (k == 1);
                pg8::Gemm g{xb, (const bf16_t*)(wt + (gd ? WT_GD : WT_S)), T, gd ? 8448 : 6144, 1024, 1024, 1024};
                pg8::StaticOrder S; S.init(T, g.N, G, bid);
                EpiIn E{R, rowsq + (2 * l) * T, (float*)(ws + WS_SMALL), gd ? 32 : -1, gd ? 3 : 5, gd ? 7 : -1,
                        p.in[4] + l * 3072 + (gd ? 0 : 1024), p.in[4] + l * 3072 + 2048};
                pg8::gemm_phase(lds, g, S, E);
            }
            else if (EN(2) && k == 2) { rope_pass(p); for (int un = vcu; un < 256; un += G) gla_unit<1>(p, l, un, lds); }
            else if (EN(3) && k == 3) { gla_scan(p); attn_phase(p, l, lds, vcu); }
            else if (EN(4) && k == 4) { for (int un = vcu; un < 256; un += G) gla_unit<3>(p, l, un, lds); }
            else if (k == 5 || k == 11) {
                const int nrun = (k == 5) ? 2 : 4;
                for (int r = 0; r < nrun; ++r) {
                    pg8::Gemm g; EpiMix E;
                    if (k == 5) {
                        g = pg8::Gemm{R + (size_t)(r == 0 ? 2 : 4) * (BLK / 2), (const bf16_t*)(wt + (r == 0 ? WT_GLA : WT_DIFF)), T, 1024, 1024, 1024, 1024};
                        E = EpiMix{mixb, R + (size_t)(r == 0 ? 3 : 7) * (BLK / 2), nullptr, 0, r == 0 ? 1 : 0};
                    } else {
                        g = pg8::Gemm{R + (size_t)(r >> 1) * (BLK / 2) + (r & 1) * 512, (const bf16_t*)(wt + WT_SSM) + r * 512, T, 1024, 512, 1024, 2048};
                        E = EpiMix{mixb, R + (size_t)5 * (BLK / 2), (const float*)(ws + WS_SSQ), r, 0};
                    }
                    pg8::StaticOrder S; S.init(T, 1024, G, bid);
                    pg8::gemm_phase(lds, g, S, E);
                }
            }
            else if (k == 7) { conv_bc(p, l); }
            else if (k == 8) { for (int un = vcu; un < 2048; un += G) ssd_local(p, l, un, lds); }
            else if (k == 9) { ssd_scan(p); }
            else if (k == 10) { for (int un = vcu; un < 2048; un += G) ssd_unit<3>(p, l, un, lds); }
            else if (k == 12 || k == 14) {
                const bool dn = (k == 14);
                pg8::Gemm g{dn ? R : mixb, (const bf16_t*)(wt + (dn ? WT_DOWN : WT_OUT)), T, 1024, dn ? 4096 : 1024, dn ? 4096 : 1024, dn ? 4096 : 1024};
                pg8::StaticOrder S; S.init(T, 1024, G, bid);
                EpiRes E{(l == 0 && !dn) ? p.in[0] : p.out, p.out, xb, rowsq + (2 * l + (dn ? 2 : 1)) * T};
                pg8::gemm_phase(lds, g, S, E);
            }
            else if (k == 13) {
                pg8::Gemm g{xb, (const bf16_t*)(wt + WT_UP), T, 4096, 1024, 1024, 1024};
                pg8::StaticOrder S; S.init(T, 4096, G, bid);
                EpiUp E{R, rowsq + (2 * l + 1) * T};
                pg8::gemm_phase(lds, g, S, E);
            }
        }
        if (ph < 30) side_phase(p, ph / PPL, ph % PPL, lds);
        if (COOP) { if (ph + 1 < p.ph_hi) { if (ph == p.ph_lo) cg::this_grid().sync(); else grid_bar((unsigned*)(ws + WS_BAR), (unsigned)(ph - p.ph_lo) * (unsigned)gridDim.x); } }
    }
}

extern "C" void kernel_launch(void* const* d_in, const int* in_sizes, int n_in, void* d_out, int out_size, void* d_ws, size_t ws_size, hipStream_t stream) {
    static int grid = 0;
    if (grid == 0) {
        if (n_in != 27 || out_size != T * 1024 || ws_size < WS_END) { fprintf(stderr, "kernel_launch: unexpected shapes/ws (n_in %d out %d ws %zu need %zu)\n", n_in, out_size, ws_size, (size_t)WS_END); grid = -1; return; }
        int dev = 0, cus = 0, per_cu = 0;
        (void)hipGetDevice(&dev); (void)hipDeviceGetAttribute(&cus, hipDeviceAttributeMultiprocessorCount, dev);
        (void)hipFuncSetAttribute((const void*)mk<true>, hipFuncAttributeMaxDynamicSharedMemorySize, LDS_BYTES);
        (void)hipOccupancyMaxActiveBlocksPerMultiprocessor(&per_cu, (const void*)mk<true>, 512, LDS_BYTES);
        if (per_cu < 1) fprintf(stderr, "kernel_launch: occupancy query says %d blocks/CU\n", per_cu);
        (void)hipGetLastError();
        grid = cus;
    }
    if (grid < 0) return;
    Params p{};
    for (int i = 0; i < 27; ++i) p.in[i] = (const float*)d_in[i];
    p.out = (float*)d_out; p.ws = (unsigned char*)d_ws;
    p.ph_lo = 0; p.ph_hi = NPHASE;
    (void)hipMemsetAsync((unsigned char*)d_ws + WS_BAR, 0, 256, stream);
    void* args[] = {&p};
    hipError_t e = hipLaunchCooperativeKernel((const void*)mk<true>, dim3(grid), dim3(512), args, LDS_BYTES, stream);
    if (e != hipSuccess) fprintf(stderr, "cooperative launch failed: %s (grid %d)\n", hipGetErrorString(e), grid);
}
```

```cpp
#include <hip/hip_runtime.h>
#include <hip/hip_cooperative_groups.h>
#include <cstdio>
#include <cstdint>
namespace cg = cooperative_groups;

#define LAS __attribute__((address_space(3)))
#define DI __device__ __forceinline__
typedef unsigned short bf16_t;
typedef short bf16x8 __attribute__((ext_vector_type(8)));
typedef short s16x4 __attribute__((ext_vector_type(4)));
typedef float f32x4 __attribute__((ext_vector_type(4)));
typedef float f32x16 __attribute__((ext_vector_type(16)));
typedef unsigned u32x4 __attribute__((ext_vector_type(4)));
typedef unsigned u32x2 __attribute__((ext_vector_type(2)));
typedef float f32x2_t __attribute__((ext_vector_type(2)));
typedef __bf16 bf16x2_t __attribute__((ext_vector_type(2)));

DI unsigned pk2(float lo, float hi) { f32x2_t v = {lo, hi}; bf16x2_t b = __builtin_convertvector(v, bf16x2_t); return __builtin_bit_cast(unsigned, b); }
DI bf16_t f2bf(float f) { return (bf16_t)(pk2(f, 0.f) & 0xffffu); }
DI float bf2f(unsigned b) { return __uint_as_float(b << 16); }
DI float bflo(unsigned w) { return __uint_as_float(w << 16); }
DI float bfhi(unsigned w) { return __uint_as_float(w & 0xffff0000u); }
DI f32x4 mfma16(bf16x8 a, bf16x8 b, f32x4 c) { return __builtin_amdgcn_mfma_f32_16x16x32_bf16(a, b, c, 0, 0, 0); }
DI f32x16 mfma32(bf16x8 a, bf16x8 b, f32x16 c) { return __builtin_amdgcn_mfma_f32_32x32x16_bf16(a, b, c, 0, 0, 0); }
DI float sigmoidf_(float x) { return __builtin_amdgcn_rcpf(1.f + __expf(-x)); }
DI float siluf_(float x) { return x * __builtin_amdgcn_rcpf(1.f + __expf(-x)); }
DI int opaque_tid() { int t = threadIdx.x; asm volatile("" : "+v"(t)); return t; }
DI int crow(int r, int hi) { return (r & 3) + 8 * (r >> 2) + 4 * hi; }

constexpr int T = 16384, SEQ = 8192, DM = 1024, DFF = 4096, INC = 14384;
constexpr float EPS = 1e-6f;
constexpr size_t MiB = 1u << 20;
constexpr size_t WS_ROWSQ = 0;
constexpr size_t WS_BAR = 448 * 1024;
constexpr size_t WS_DECG = 512 * 1024;
constexpr size_t WS_DECS = 768 * 1024;
constexpr size_t WS_SSQ = 1 * MiB;
constexpr size_t WS_SMALL = 2 * MiB;
constexpr size_t WS_XB = 6 * MiB;
constexpr size_t WS_MIXB = 38 * MiB;
constexpr size_t WS_WT = 70 * MiB;
constexpr size_t WT_GD = 0, WT_S = WT_GD + (size_t)8448 * 1024 * 2, WT_GLA = WT_S + (size_t)6144 * 1024 * 2, WT_SSM = WT_GLA + 2 * MiB,
                 WT_DIFF = WT_SSM + 4 * MiB, WT_OUT = WT_DIFF + 2 * MiB, WT_UP = WT_OUT + 2 * MiB, WT_DOWN = WT_UP + 8 * MiB, WT_END = WT_DOWN + 8 * MiB;
static_assert(WT_END <= 56 * MiB, "wt");
constexpr size_t WS_R = 126 * MiB;
constexpr size_t BLK = 32 * MiB;
constexpr size_t WS_STG = WS_R + 8 * BLK;
constexpr size_t WS_STS = WS_R + 6 * BLK;
constexpr size_t WS_SIDE = WS_R + 9 * BLK;
constexpr size_t SB_HN = WS_SIDE, SB_PROJ = SB_HN + 512 * 1024, SB_KV = SB_PROJ + 128 * 1024, SB_Y = SB_KV + 1024 * 1024, SB_GATE = SB_Y + 32 * 1024,
                 SB_BR = SB_GATE + 32 * 1024, SB_MIX = SB_BR + 32 * 1024, SB_XM = SB_MIX + 8192, SB_H2 = SB_XM + 8192, SB_UP = SB_H2 + 8192,
                 SB_HH = SB_UP + 32768, SB_X1 = SB_HH + 32768, SB_HN1 = SB_X1 + 8192, SB_QK1 = SB_HN1 + 8192, SB_END = SB_QK1 + 8192;
constexpr size_t WS_END = WS_SIDE + 2 * MiB;
static_assert(SB_END <= WS_END, "side");

struct Params {
    const float* in[27];
    float* out; unsigned char* ws;
    int ph_lo, ph_hi;
};

namespace pg8 {
constexpr int BM = 256, BK = 64, HALF = 128, HTB = HALF * BK * 2, STAGE_BYTES = 8 * HTB, NXCD = 8, WGM = 8;
__host__ __device__ __forceinline__ int lds_byte(int r, int c) { const int st = (r >> 4) * 2 + (c >> 5), rr = r & 15, cc = c & 31, ob = rr * 64 + cc * 2; return st * 1024 + (ob ^ (((ob >> 9) & 1) << 5)); }
__host__ __device__ __forceinline__ void stage_rc(int b, int& R, int& C) { const int st = b / 1024, sb = b % 1024, swz = sb ^ (((sb >> 9) & 1) << 5); R = (st >> 1) * 16 + swz / 64; C = (st & 1) * 32 + (swz % 64) / 2; }
__host__ __device__ __forceinline__ int perm32(int rho) { const int n = rho >> 4, i = rho & 15; return 8 * (i >> 2) + 4 * n + (i & 3); }
struct Unit { int pm, pn; };
struct Gemm { const bf16_t* A; const bf16_t* Bt; int M, N, K, lda, ldb; };
struct StaticOrder {
    int nM, nN, nwg, G, c;
    __host__ __device__ void init(int M, int N, int G_, int c_) { nM = M / BM; nN = N / BM; nwg = nM * nN; G = G_; c = c_; }
    __host__ __device__ bool next(int i, Unit& u) const {
        const long L = (long)i * G + c; if (L >= nwg) return false;
        int wgid = (int)L; { const int q = nwg / NXCD, r = nwg % NXCD, xcd = wgid % NXCD, off = wgid / NXCD; wgid = (xcd < r ? xcd * (q + 1) : r * (q + 1) + (xcd - r) * q) + off; }
        const int nig = WGM * nN, gid = wgid / nig, fm = gid * WGM, gsz = (nM - fm) < WGM ? (nM - fm) : WGM;
        u.pm = fm + ((wgid % nig) % gsz); u.pn = (wgid % nig) / gsz; return true;
    }
};
template <class Epi, class Sched>
__device__ __forceinline__ void gemm_phase(LAS unsigned char* lds, const Gemm g, const Sched& S, const Epi& E) {
    const int tid = opaque_tid(), wid = __builtin_amdgcn_readfirstlane(tid >> 6), lane = tid & 63, wr = wid >> 2, wc = wid & 3, fr = lane & 15, fq = lane >> 4;
    const int K = g.K, nt = K / BK;
    unsigned voffA[2], voffB[2];
#pragma unroll
    for (int i = 0; i < 2; ++i) { int R, C; stage_rc(tid * 16 + i * 8192, R, C);
        const int Rb = (R & ~31) + perm32(R & 31);
        voffA[i] = (unsigned)(R * g.lda + C) * 2u; voffB[i] = (unsigned)(Rb * g.ldb + C) * 2u; }
    const size_t kstep = (size_t)(BK * 2);
    const size_t hstepA = (size_t)HALF * g.lda * 2, hstepB = (size_t)HALF * g.ldb * 2;
    const size_t tstepA = 2 * hstepA, tstepB = 2 * hstepB;
    const unsigned ldsw = (unsigned)wid * 1024u;
    const int aoff = lds_byte(wr * 64 + fr, fq * 8), boff = lds_byte(wc * 32 + fr, fq * 8);
#define PG8_SA(b, h) (((b) * 2 + (h)) * HTB)
#define PG8_SB(b, h) ((4 + (b) * 2 + (h)) * HTB)
#define PG8_STAGE(bufoff, gbase, voff) do { _Pragma("unroll") for (int _i = 0; _i < 2; ++_i) \
        __builtin_amdgcn_global_load_lds((const unsigned*)((const char*)(gbase) + (voff)[_i]), (LAS unsigned*)(lds + (bufoff) + ldsw + _i * 8192), 16, 0, 0); } while (0)
#define PG8_LDA(dst, b, h) do { _Pragma("unroll") for (int m = 0; m < 4; ++m) _Pragma("unroll") for (int k = 0; k < 2; ++k) dst[m][k] = *(const LAS bf16x8*)(lds + PG8_SA(b, h) + aoff + m * 2048 + k * 1024); } while (0)
#define PG8_LDB(dst, b, h) do { _Pragma("unroll") for (int n = 0; n < 2; ++n) _Pragma("unroll") for (int k = 0; k < 2; ++k) dst[n][k] = *(const LAS bf16x8*)(lds + PG8_SB(b, h) + boff + n * 2048 + k * 1024); } while (0)
#define PG8_MMA(ai, bj, At, Bt) do { __builtin_amdgcn_s_setprio(1); _Pragma("unroll") for (int m = 0; m < 4; ++m) _Pragma("unroll") for (int n = 0; n < 2; ++n) _Pragma("unroll") for (int k = 0; k < 2; ++k) \
        acc[ai][bj][m][n] = __builtin_amdgcn_mfma_f32_16x16x32_bf16(Bt[n][k], At[m][k], acc[ai][bj][m][n], 0, 0, 0); __builtin_amdgcn_s_setprio(0); } while (0)
#define PG8_WAIT_V(n) asm volatile("s_waitcnt vmcnt(" #n ")" ::: "memory")
#define PG8_WAIT_L(n) asm volatile("s_waitcnt lgkmcnt(" #n ")" ::: "memory")
#define PG8_BAR __builtin_amdgcn_s_barrier()
#define PG8_SCHED __builtin_amdgcn_sched_barrier(0)
    Unit cur, nxt; int ui = 0;
    if (!S.next(0, cur)) return;
    f32x4 acc[2][2][4][2];
#pragma unroll
    for (int a = 0; a < 2; ++a)
#pragma unroll
        for (int b = 0; b < 2; ++b)
#pragma unroll
            for (int m = 0; m < 4; ++m)
#pragma unroll
                for (int n = 0; n < 2; ++n) acc[a][b][m][n] = (f32x4){0.f, 0.f, 0.f, 0.f};
    bf16x8 At[4][2], B0[2][2], B1[2][2];
    const char* cA = (const char*)g.A + (size_t)cur.pm * tstepA; const char* cB = (const char*)g.Bt + (size_t)cur.pn * tstepB;
    PG8_STAGE(PG8_SB(0, 0), cB, voffB); PG8_STAGE(PG8_SB(0, 1), cB + hstepB, voffB); PG8_STAGE(PG8_SA(0, 0), cA, voffA); PG8_STAGE(PG8_SA(0, 1), cA + hstepA, voffA);
    if (wr == 1) PG8_BAR;
    PG8_WAIT_V(2); PG8_BAR;
    PG8_STAGE(PG8_SB(1, 0), cB + kstep, voffB); PG8_STAGE(PG8_SA(1, 0), cA + kstep, voffA); PG8_STAGE(PG8_SB(1, 1), cB + hstepB + kstep, voffB);
    PG8_WAIT_V(6); PG8_BAR;
    for (;;) {
        const bool has_next = S.next(ui + 1, nxt);
        const char* nA = has_next ? (const char*)g.A + (size_t)nxt.pm * tstepA : cA; const char* nB = has_next ? (const char*)g.Bt + (size_t)nxt.pn * tstepB : cB;
        for (int t = 0; t < nt; t += 2) {
            const bool last = (t == nt - 2);
            const char* a1 = cA + (size_t)(t + 1) * kstep;
            const char* a2 = last ? nA : cA + (size_t)(t + 2) * kstep; const char* b2 = last ? nB : cB + (size_t)(t + 2) * kstep;
            const char* a3 = a2 + kstep; const char* b3 = b2 + kstep;
            PG8_LDB(B0, 0, 0); PG8_LDB(B1, 0, 1); PG8_SCHED; PG8_LDA(At, 0, 0); PG8_STAGE(PG8_SA(1, 1), a1 + hstepA, voffA);
            PG8_WAIT_V(8); PG8_WAIT_L(0); PG8_BAR; PG8_MMA(0, 0, At, B0); PG8_MMA(0, 1, At, B1); PG8_BAR; PG8_SCHED;
            PG8_LDA(At, 0, 1); PG8_STAGE(PG8_SB(0, 0), b2, voffB); PG8_STAGE(PG8_SB(0, 1), b2 + hstepB, voffB); PG8_STAGE(PG8_SA(0, 0), a2, voffA);
            PG8_WAIT_V(8); PG8_WAIT_L(0); PG8_BAR; PG8_MMA(1, 0, At, B0); PG8_MMA(1, 1, At, B1); PG8_BAR; PG8_SCHED;
            PG8_LDB(B0, 1, 0); PG8_LDB(B1, 1, 1); PG8_SCHED; PG8_LDA(At, 1, 0); PG8_STAGE(PG8_SA(0, 1), a2 + hstepA, voffA);
            PG8_WAIT_V(8); PG8_WAIT_L(0); PG8_BAR; PG8_MMA(0, 0, At, B0); PG8_MMA(0, 1, At, B1); PG8_BAR; PG8_SCHED;
            PG8_LDA(At, 1, 1); PG8_STAGE(PG8_SB(1, 0), b3, voffB); PG8_STAGE(PG8_SB(1, 1), b3 + hstepB, voffB); PG8_STAGE(PG8_SA(1, 0), a3, voffA);
            PG8_WAIT_V(8); PG8_WAIT_L(0); PG8_BAR; PG8_MMA(1, 0, At, B0); PG8_MMA(1, 1, At, B1); PG8_BAR; PG8_SCHED;
        }
        if (wr == 0) PG8_BAR;
        E(acc, cur, wr, wc, fr, fq);
        if (!has_next) break;
#pragma unroll
        for (int a = 0; a < 2; ++a)
#pragma unroll
            for (int b = 0; b < 2; ++b)
#pragma unroll
                for (int m = 0; m < 4; ++m)
#pragma unroll
                    for (int n = 0; n < 2; ++n) acc[a][b][m][n] = (f32x4){0.f, 0.f, 0.f, 0.f};
        cur = nxt; cA = nA; cB = nB; ++ui;
        if (wr == 1) PG8_BAR;
    }
    PG8_WAIT_V(0);
    PG8_BAR;
#undef PG8_SA
#undef PG8_SB
#undef PG8_STAGE
#undef PG8_LDA
#undef PG8_LDB
#undef PG8_MMA
#undef PG8_WAIT_V
#undef PG8_WAIT_L
#undef PG8_BAR
#undef PG8_SCHED
}
}

typedef f32x4 Acc[2][2][4][2];
#define EPI_LOOP(body) \
    _Pragma("unroll") for (int ai = 0; ai < 2; ++ai) _Pragma("unroll") for (int m = 0; m < 4; ++m) { const int row = u.pm * 256 + ai * 128 + wr * 64 + m * 16 + fr; \
    _Pragma("unroll") for (int bj = 0; bj < 2; ++bj) _Pragma("unroll") for (int n = 0; n < 2; ++n) { const int ct = bj * 128 + wc * 32 + fq * 8 + n * 4; f32x4 v = acc[ai][bj][m][n]; body } }

struct EpiIn {
    bf16_t* R; const float* rowsq; float* small; int small_tile; int gblkA, gblkB; const float* biasA; const float* biasB;
    DI void operator()(const Acc& acc, const pg8::Unit& u, int wr, int wc, int fr, int fq) const {
        const int blk = u.pn >> 2, cb = (u.pn & 3) * 256;
        if (u.pn == small_tile) {
            EPI_LOOP( if (ct < 64) { const float rs = rsqrtf(rowsq[row] * (1.f / 1024.f) + EPS); *(f32x4*)(small + (size_t)row * 64 + ct) = v * rs; } )
            return;
        }
        bf16_t* dst = R + (size_t)blk * (BLK / 2);
        const float* bias = (blk == gblkA) ? biasA : ((blk == gblkB) ? biasB : nullptr);
        if (bias) {
            EPI_LOOP( const float rs = rsqrtf(rowsq[row] * (1.f / 1024.f) + EPS); const f32x4 bv = *(const f32x4*)(bias + cb + ct); v = v * rs + bv;
                u32x2 w; w.x = pk2(sigmoidf_(v[0]), sigmoidf_(v[1])); w.y = pk2(sigmoidf_(v[2]), sigmoidf_(v[3])); *(u32x2*)(dst + (size_t)row * 1024 + cb + ct) = w; )
        } else {
            EPI_LOOP( const float rs = rsqrtf(rowsq[row] * (1.f / 1024.f) + EPS); v = v * rs;
                u32x2 w; w.x = pk2(v[0], v[1]); w.y = pk2(v[2], v[3]); *(u32x2*)(dst + (size_t)row * 1024 + cb + ct) = w; )
        }
    }
};
struct EpiMix {
    bf16_t* mixb; const bf16_t* gate; const float* ssq; int grp; int first;
    DI void operator()(const Acc& acc, const pg8::Unit& u, int wr, int wc, int fr, int fq) const {
        EPI_LOOP( const int col = u.pn * 256 + ct; const size_t o = (size_t)row * 1024 + col;
            float rs = 1.f; if (ssq) rs = rsqrtf(ssq[(size_t)row * 4 + grp] * (1.f / 512.f) + EPS);
            const u32x2 gw = *(const u32x2*)(gate + o);
            f32x4 r; r[0] = bflo(gw.x) * v[0] * rs; r[1] = bfhi(gw.x) * v[1] * rs; r[2] = bflo(gw.y) * v[2] * rs; r[3] = bfhi(gw.y) * v[3] * rs;
            if (!first) { const u32x2 mw = *(const u32x2*)(mixb + o); r[0] += bflo(mw.x); r[1] += bfhi(mw.x); r[2] += bflo(mw.y); r[3] += bfhi(mw.y); }
            u32x2 w; w.x = pk2(r[0], r[1]); w.y = pk2(r[2], r[3]); *(u32x2*)(mixb + o) = w; )
    }
};
struct EpiRes {
    const float* xold; float* xnew; bf16_t* xb; float* rowsq;
    DI void operator()(const Acc& acc, const pg8::Unit& u, int wr, int wc, int fr, int fq) const {
#pragma unroll
        for (int ai = 0; ai < 2; ++ai)
#pragma unroll
            for (int m = 0; m < 4; ++m) { const int row = u.pm * 256 + ai * 128 + wr * 64 + m * 16 + fr; float ss = 0.f;
#pragma unroll
                for (int bj = 0; bj < 2; ++bj)
#pragma unroll
                    for (int n = 0; n < 2; ++n) { const int col = u.pn * 256 + bj * 128 + wc * 32 + fq * 8 + n * 4; const size_t o = (size_t)row * 1024 + col;
                        f32x4 v = acc[ai][bj][m][n] + *(const f32x4*)(xold + o); *(f32x4*)(xnew + o) = v;
                        u32x2 w; w.x = pk2(v[0], v[1]); w.y = pk2(v[2], v[3]); *(u32x2*)(xb + o) = w;
                        ss += v[0] * v[0] + v[1] * v[1] + v[2] * v[2] + v[3] * v[3]; }
                ss += __shfl_xor(ss, 16); ss += __shfl_xor(ss, 32);
                if (fq == 0) atomicAdd(rowsq + row, ss); }
    }
};
struct EpiUp {
    bf16_t* h; const float* rowsq;
    DI void operator()(const Acc& acc, const pg8::Unit& u, int wr, int wc, int fr, int fq) const {
        EPI_LOOP( const float rs = rsqrtf(rowsq[row] * (1.f / 1024.f) + EPS); v = v * rs;
            f32x4 r; r[0] = fmaxf(v[0], 0.f); r[1] = fmaxf(v[1], 0.f); r[2] = fmaxf(v[2], 0.f); r[3] = fmaxf(v[3], 0.f); r = r * r;
            u32x2 w; w.x = pk2(r[0], r[1]); w.y = pk2(r[2], r[3]); *(u32x2*)(h + (size_t)row * 4096 + u.pn * 256 + ct) = w; )
    }
};

DI int colmap(int kind, int n) {
    if (kind == 1) {
        if (n < 2048) return n;
        if (n < 3072) return 2064 + (n - 2048);
        if (n < 4096) return 11312 + (n - 3072);
        if (n < 5120) return 8240 + (n - 4096);
        if (n < 6144) return 9264 + (n - 5120);
        if (n < 7168) return 10288 + (n - 6144);
        if (n < 8192) return 13360 + (n - 7168);
        const int i = n - 8192; if (i < 16) return 2048 + i; if (i < 48) return 8208 + (i - 16); return -1;
    }
    if (kind == 2) {
        if (n < 2048) return 3088 + n;
        if (n < 5120) return 5136 + (n - 2048);
        return 12336 + (n - 5120);
    }
    return n;
}
DI void tr_item(const float* W, int ldw, int K, bf16_t* WT, const float* kscale, int kind, int kb, int nb, LAS float* scr, int lane) {
    const int k0 = 64 * kb, n0 = 32 * nb; const int sc = colmap(kind, n0 + (lane & 31));
#pragma unroll 8
    for (int i = 0; i < 32; ++i) { const int kk = 2 * i + (lane >> 5); float v = 0.f; if (sc >= 0) { v = W[(size_t)(k0 + kk) * ldw + sc]; if (kscale) v *= kscale[k0 + kk]; } scr[kk * 33 + (lane & 31)] = v; }
    asm volatile("s_waitcnt lgkmcnt(0)" ::: "memory");
    const int c = lane & 7;
#pragma unroll
    for (int j = 0; j < 4; ++j) { const int n = (lane >> 3) + 8 * j; const LAS float* s = scr + (8 * c) * 33 + n;
        u32x4 o; o.x = pk2(s[0 * 33], s[1 * 33]); o.y = pk2(s[2 * 33], s[3 * 33]); o.z = pk2(s[4 * 33], s[5 * 33]); o.w = pk2(s[6 * 33], s[7 * 33]);
        *(u32x4*)(WT + (size_t)(n0 + n) * K + k0 + 8 * c) = o; }
    asm volatile("s_waitcnt lgkmcnt(0)" ::: "memory");
}
DI float wave_sum(float v) {
#pragma unroll
    for (int o = 1; o < 64; o <<= 1) v += __shfl_xor(v, o);
    return v;
}
DI void phase_prep(const Params& p, int l, LAS unsigned char* lds) {
    const int tid = opaque_tid(), lane = tid & 63, wave = __builtin_amdgcn_readfirstlane(tid >> 6);
    const int gw = blockIdx.x * 8 + wave, NGW = gridDim.x * 8;
    LAS float* scr = (LAS float*)(lds + wave * 8704);
    unsigned char* ws = p.ws; bf16_t* wt = (bf16_t*)(ws + WS_WT);
    const float* w_in = p.in[3] + (size_t)l * 1024 * INC;
    constexpr int I0 = 16 * 264, I1 = 16 * 192, I2 = 16 * 32, I3 = 32 * 32, I4 = 16 * 32, I5 = 16 * 32, I6 = 16 * 128, I7 = 64 * 32;
    constexpr int NIT = I0 + I1 + I2 + I3 + I4 + I5 + I6 + I7;
    for (int it = gw; it < NIT; it += NGW) {
        int r = it;
        if (r < I0) { tr_item(w_in, INC, 1024, (bf16_t*)((char*)wt + WT_GD), p.in[2] + l * 1024, 1, r / 264, r % 264, scr, lane); continue; } r -= I0;
        if (r < I1) { tr_item(w_in, INC, 1024, (bf16_t*)((char*)wt + WT_S), p.in[2] + l * 1024, 2, r / 192, r % 192, scr, lane); continue; } r -= I1;
        if (r < I2) { tr_item(p.in[19] + (size_t)l * 1024 * 1024, 1024, 1024, (bf16_t*)((char*)wt + WT_GLA), nullptr, 0, r / 32, r % 32, scr, lane); continue; } r -= I2;
        if (r < I3) { tr_item(p.in[20] + (size_t)l * 2048 * 1024, 1024, 2048, (bf16_t*)((char*)wt + WT_SSM), p.in[13] + l * 2048, 0, r / 32, r % 32, scr, lane); continue; } r -= I3;
        if (r < I4) { tr_item(p.in[21] + (size_t)l * 1024 * 1024, 1024, 1024, (bf16_t*)((char*)wt + WT_DIFF), nullptr, 0, r / 32, r % 32, scr, lane); continue; } r -= I4;
        if (r < I5) { tr_item(p.in[22] + (size_t)l * 1024 * 1024, 1024, 1024, (bf16_t*)((char*)wt + WT_OUT), nullptr, 0, r / 32, r % 32, scr, lane); continue; } r -= I5;
        if (r < I6) { tr_item(p.in[24] + (size_t)l * 1024 * 4096, 4096, 1024, (bf16_t*)((char*)wt + WT_UP), p.in[23] + l * 1024, 0, r / 128, r % 128, scr, lane); continue; } r -= I6;
        tr_item(p.in[25] + (size_t)l * 4096 * 1024, 1024, 4096, (bf16_t*)((char*)wt + WT_DOWN), nullptr, 0, r / 32, r % 32, scr, lane);
    }
    const int gt = blockIdx.x * 512 + tid, NT_ = gridDim.x * 512;
    float* ssq = (float*)(ws + WS_SSQ);
    for (int i = gt; i < T * 4; i += NT_) ssq[i] = 0.f;
    if (l == 0) {
        float* rowsq = (float*)(ws + WS_ROWSQ);
        for (int i = gt; i < 4 * T; i += NT_) rowsq[T + i] = 0.f;
        bf16_t* xb = (bf16_t*)(ws + WS_XB); const float* x = p.in[0];
        for (int m = gw; m < T; m += NGW) {
            const f32x4* xr = (const f32x4*)(x + (size_t)m * 1024) + lane; float s = 0.f;
            u32x2* o = (u32x2*)(xb + (size_t)m * 1024) + lane;
#pragma unroll
            for (int j = 0; j < 4; ++j) { const f32x4 v = xr[64 * j]; s += v[0] * v[0] + v[1] * v[1] + v[2] * v[2] + v[3] * v[3]; u32x2 w; w.x = pk2(v[0], v[1]); w.y = pk2(v[2], v[3]); o[64 * j] = w; }
            s = wave_sum(s); if (lane == 0) rowsq[m] = s;
        }
    }
}

DI void rope_pass(const Params& p) {
    const int* pos = (const int*)p.in[1];
    bf16_t* Qd = (bf16_t*)(p.ws + WS_R + 4 * BLK); bf16_t* Kd = (bf16_t*)(p.ws + WS_R + 5 * BLK);
    const double cf[8] = {0.15915494309189535, 0.03086376340470123, 0.005985185712713705, 0.001160663641240061, 0.00022507907903927653, 4.364795279280289e-05, 8.464330808241401e-06, 1.6414262627950345e-06};
    const int gt = blockIdx.x * 512 + opaque_tid(), NTH = gridDim.x * 512;
    for (int it = gt; it < T * 32; it += NTH) {
        const int t = it >> 5, w = it & 31; bf16_t* base = ((w & 16) ? Kd : Qd) + (size_t)t * 1024 + (w & 15) * 64;
        const double ps = (double)pos[t];
        u32x4 a = *(u32x4*)base, b = *(u32x4*)(base + 8);
        float t1[8], t2[8];
#pragma unroll
        for (int i = 0; i < 4; ++i) { t1[2 * i] = bflo(a[i]); t1[2 * i + 1] = bfhi(a[i]); t2[2 * i] = bflo(b[i]); t2[2 * i + 1] = bfhi(b[i]); }
        float o1[8], o2[8];
#pragma unroll
        for (int i = 0; i < 8; ++i) { double rv = ps * cf[i]; rv -= floor(rv); const float fr = (float)rv; const float sn = __builtin_amdgcn_sinf(fr), cs = __builtin_amdgcn_cosf(fr);
            o1[i] = t1[i] * cs - t2[i] * sn; o2[i] = t2[i] * cs + t1[i] * sn; }
#pragma unroll
        for (int i = 0; i < 4; ++i) { a[i] = pk2(o1[2 * i], o1[2 * i + 1]); b[i] = pk2(o2[2 * i], o2[2 * i + 1]); }
        *(u32x4*)base = a; *(u32x4*)(base + 8) = b;
    }
}

template <int KS> DI f32x4 mm16(f32x4 acc, const LAS unsigned char* A, int lda_b, const LAS unsigned char* B, int ldb_b, int lane) {
    const int r = lane & 15, q = lane >> 4;
    const LAS unsigned char* ap = A + r * lda_b + q * 16; const LAS unsigned char* bp = B + r * ldb_b + q * 16;
#pragma unroll
    for (int s = 0; s < KS; ++s) acc = mfma16(*(const LAS bf16x8*)(ap + s * 64), *(const LAS bf16x8*)(bp + s * 64), acc);
    return acc;
}
DI float logsigmoidf_(float x) { return fminf(x, 0.f) - __logf(1.f + __expf(-fabsf(x))); }

constexpr int G_GKL = 0, G_QTOT = 4096, G_BLAST = 6144, G_PART = 6656, G_QT = 8704, G_KT = 26112, G_KHT = 43520, G_VT = 61952, G_P = 98816;
template <int MODE> DI void gla_unit(const Params& p, int l, int un, LAS unsigned char* lds) {
    const int tid = opaque_tid(), lane = tid & 63, w = __builtin_amdgcn_readfirstlane(tid >> 6), r16 = lane & 15, quad = lane >> 4;
    const int sc = un >> 2, h = un & 3, tok0 = sc * 256;
    unsigned char* ws = p.ws;
    const bf16_t* QK = (const bf16_t*)(ws + WS_R); const bf16_t* Vg = (const bf16_t*)(ws + WS_R + BLK); bf16_t* Gg = (bf16_t*)(ws + WS_R + 2 * BLK);
    const float* small = (const float*)(ws + WS_SMALL);
    float* states = (float*)(ws + WS_STG) + (size_t)un * 32768;
    const int d = tid & 127, qr = tid >> 7;
    float wk[16];
#pragma unroll
    for (int r = 0; r < 16; ++r) wk[r] = p.in[5][(size_t)l * 16 * 512 + r * 512 + h * 128 + d];
    const float bk = p.in[6][l * 512 + h * 128 + d];
    f32x4 S[8][2];
    if (MODE == 3) {
#pragma unroll
        for (int mb = 0; mb < 8; ++mb)
#pragma unroll
            for (int nb = 0; nb < 2; ++nb) S[mb][nb] = *(const f32x4*)(states + ((size_t)(w * 16 + mb * 2 + nb) * 64 + lane) * 4);
    } else {
#pragma unroll
        for (int mb = 0; mb < 8; ++mb)
#pragma unroll
            for (int nb = 0; nb < 2; ++nb) S[mb][nb] = (f32x4){0.f, 0.f, 0.f, 0.f};
    }
    float ng[2] = {0.f, 0.f};
    if (MODE == 3) { ng[0] = p.in[7][l * 256 + 32 * w + r16]; ng[1] = p.in[7][l * 256 + 32 * w + 16 + r16]; }
    float dtot = 1.f;
    for (int j = 0; j < 4; ++j) {
        const int t0 = tok0 + 64 * j;
        if (tid < 256) { const int row = tid >> 2, c4 = (tid & 3) * 4; *(LAS f32x4*)(lds + G_GKL + (row * 16 + c4) * 4) = *(const f32x4*)(small + (size_t)(t0 + row) * 64 + c4); }
        if (tid < 64) ((LAS float*)(lds + G_PART))[tid] = 0.f;
        __syncthreads();
        float c[16]; float run = 0.f;
#pragma unroll
        for (int i = 0; i < 16; ++i) { const LAS f32x4* gr = (const LAS f32x4*)(lds + G_GKL) + (qr * 16 + i) * 4; float x = bk;
#pragma unroll
            for (int r = 0; r < 4; ++r) { const f32x4 g4 = gr[r]; x += g4[0] * wk[4 * r] + g4[1] * wk[4 * r + 1] + g4[2] * wk[4 * r + 2] + g4[3] * wk[4 * r + 3]; }
            run += logsigmoidf_(x) * (1.f / 16.f); c[i] = run; }
        ((LAS float*)(lds + G_QTOT))[qr * 128 + d] = run;
        __syncthreads();
        {
            float off = 0.f, bl = 0.f;
#pragma unroll
            for (int q2 = 0; q2 < 4; ++q2) { const float v = ((const LAS float*)(lds + G_QTOT))[q2 * 128 + d]; bl += v; if (q2 < qr) off += v; }
            unsigned khp[8]; const float ebl = __expf(bl);
#pragma unroll
            for (int i = 0; i < 16; i += 2) {
                float kh2[2];
#pragma unroll
                for (int e = 0; e < 2; ++e) { const int t = qr * 16 + i + e; const float b = off + c[i + e];
                    const float k = bf2f(QK[(size_t)(t0 + t) * 1024 + 512 + h * 128 + d]);
                    const float enb = __expf(-b), kt_ = k * enb;
                    kh2[e] = kt_ * ebl;
                    if (MODE == 3) { const float q = bf2f(QK[(size_t)(t0 + t) * 1024 + h * 128 + d]);
                        ((LAS bf16_t*)(lds + G_QT))[t * 136 + d] = f2bf(q * 0.08838834764831845f * __builtin_amdgcn_rcpf(enb));
                        ((LAS bf16_t*)(lds + G_KT))[t * 136 + d] = f2bf(kt_); } }
                khp[i >> 1] = pk2(kh2[0], kh2[1]);
            }
            *(LAS u32x4*)(lds + G_KHT + d * 144 + qr * 32) = (u32x4){khp[0], khp[1], khp[2], khp[3]};
            *(LAS u32x4*)(lds + G_KHT + d * 144 + qr * 32 + 16) = (u32x4){khp[4], khp[5], khp[6], khp[7]};
            if (qr == 0) { ((LAS float*)(lds + G_BLAST))[d] = bl; dtot *= ebl; }
#pragma unroll
            for (int i = 0; i < 4; ++i) { const int pid = tid + 512 * i, g8 = pid >> 6, t = pid & 63;
                const u32x4 v = *(const u32x4*)(Vg + (size_t)(t0 + t) * 1024 + h * 256 + g8 * 8);
                LAS bf16_t* vt = (LAS bf16_t*)(lds + G_VT) + (g8 * 8) * 72 + t;
#pragma unroll
                for (int e = 0; e < 4; ++e) { vt[(2 * e) * 72] = (bf16_t)(v[e] & 0xffffu); vt[(2 * e + 1) * 72] = (bf16_t)(v[e] >> 16); } }
        }
        __syncthreads();
        if (MODE == 3) {
#pragma unroll
            for (int e = 0; e < 2; ++e) { const int x = 2 * w + e, tb = x >> 2, sb = x & 3;
                f32x4 a = (f32x4){0.f, 0.f, 0.f, 0.f};
                if (sb <= tb) a = mm16<4>(a, lds + G_KT + sb * 16 * 272, 272, lds + G_QT + tb * 16 * 272, 272, lane);
                const int t = 16 * tb + r16, s0 = 16 * sb + quad * 4;
                float v[4];
#pragma unroll
                for (int jj = 0; jj < 4; ++jj) v[jj] = (s0 + jj <= t) ? a[jj] : 0.f;
                if (x == 0 && lane == 0 && j == 0 && (tok0 & (SEQ - 1)) == 0) { const float* qk_ = (l == 0) ? (const float*)(ws + SB_PROJ) + (tok0 >> 13) * 14384 : (const float*)(ws + SB_QK1) + (tok0 >> 13) * 1024;
                    float acc_ = 0.f; for (int d_ = 0; d_ < 128; ++d_) acc_ += qk_[h * 128 + d_] * qk_[512 + h * 128 + d_]; v[0] = acc_ * 0.08838834764831845f; }
                *(LAS u32x2*)(lds + G_P + t * 144 + s0 * 2) = (u32x2){pk2(v[0], v[1]), pk2(v[2], v[3])}; }
            f32x4 o[4][2];
#pragma unroll
            for (int mb = 0; mb < 4; ++mb) { o[mb][0] = (f32x4){0.f, 0.f, 0.f, 0.f}; o[mb][1] = (f32x4){0.f, 0.f, 0.f, 0.f}; }
#pragma unroll
            for (int ks = 0; ks < 4; ++ks) {
                bf16x8 bf[2];
#pragma unroll
                for (int nb = 0; nb < 2; ++nb) { const f32x4 s0v = S[2 * ks][nb], s1v = S[2 * ks + 1][nb];
                    u32x4 pk; pk.x = pk2(s0v[0], s0v[1]); pk.y = pk2(s0v[2], s0v[3]); pk.z = pk2(s1v[0], s1v[1]); pk.w = pk2(s1v[2], s1v[3]); bf[nb] = __builtin_bit_cast(bf16x8, pk); }
#pragma unroll
                for (int mb = 0; mb < 4; ++mb) { const LAS unsigned char* ap = lds + G_QT + (16 * mb + r16) * 272 + (32 * ks + quad * 4) * 2;
                    const u32x2 lo = *(const LAS u32x2*)ap, hi = *(const LAS u32x2*)(ap + 32);
                    const bf16x8 af = __builtin_bit_cast(bf16x8, (u32x4){lo.x, lo.y, hi.x, hi.y});
                    o[mb][0] = mfma16(af, bf[0], o[mb][0]); o[mb][1] = mfma16(af, bf[1], o[mb][1]); }
            }
            __syncthreads();
#pragma unroll
            for (int mb = 0; mb < 4; ++mb)
#pragma unroll
                for (int nb = 0; nb < 2; ++nb) o[mb][nb] = mm16<2>(o[mb][nb], lds + G_P + mb * 16 * 144, 144, lds + G_VT + (32 * w + 16 * nb) * 144, 144, lane);
#pragma unroll
            for (int mb = 0; mb < 4; ++mb)
#pragma unroll
                for (int jj = 0; jj < 4; ++jj) { float ss = o[mb][0][jj] * o[mb][0][jj] + o[mb][1][jj] * o[mb][1][jj];
                    ss += __shfl_xor(ss, 1); ss += __shfl_xor(ss, 2); ss += __shfl_xor(ss, 4); ss += __shfl_xor(ss, 8);
                    if (r16 == 0) __hip_atomic_fetch_add((LAS float*)(lds + G_PART) + 16 * mb + quad * 4 + jj, ss, __ATOMIC_RELAXED, __HIP_MEMORY_SCOPE_WORKGROUP); }
            __syncthreads();
#pragma unroll
            for (int mb = 0; mb < 4; ++mb)
#pragma unroll
                for (int jj = 0; jj < 4; ++jj) { const int t = 16 * mb + quad * 4 + jj; const float rs = rsqrtf(((const LAS float*)(lds + G_PART))[t] * (1.f / 256.f) + EPS);
#pragma unroll
                    for (int nb = 0; nb < 2; ++nb) { bf16_t* gp = Gg + (size_t)(t0 + t) * 1024 + h * 256 + 32 * w + 16 * nb + r16;
                        const float gv = bf2f(*gp); *gp = f2bf(o[mb][nb][jj] * rs * ng[nb] * siluf_(gv)); } }
        }
#pragma unroll
        for (int mb = 0; mb < 8; ++mb) { const f32x4 bl4 = *(const LAS f32x4*)(lds + G_BLAST + (16 * mb + quad * 4) * 4);
            const f32x4 dc = (f32x4){__expf(bl4[0]), __expf(bl4[1]), __expf(bl4[2]), __expf(bl4[3])};
#pragma unroll
            for (int nb = 0; nb < 2; ++nb) { S[mb][nb] = S[mb][nb] * dc;
                S[mb][nb] = mm16<2>(S[mb][nb], lds + G_KHT + mb * 16 * 144, 144, lds + G_VT + (32 * w + 16 * nb) * 144, 144, lane); } }
        __syncthreads();
    }
    if (MODE == 1) {
#pragma unroll
        for (int mb = 0; mb < 8; ++mb)
#pragma unroll
            for (int nb = 0; nb < 2; ++nb) *(f32x4*)(states + ((size_t)(w * 16 + mb * 2 + nb) * 64 + lane) * 4) = S[mb][nb];
        if (tid < 128) ((float*)(ws + WS_DECG))[un * 128 + tid] = dtot;
    }
}
DI void gla_scan(const Params& p) {
    const int gid = blockIdx.x * 512 + opaque_tid();
    for (int it = gid; it < 65536; it += gridDim.x * 512) {
        const int chain = it >> 13, e = it & 8191, b = chain >> 2, h = chain & 3;
        const int tile = (e >> 6) & 15, lane = e & 63, d0 = 16 * (tile >> 1) + (lane >> 4) * 4;
        f32x4* st = (f32x4*)(p.ws + WS_STG); const float* dec = (const float*)(p.ws + WS_DECG);
        f32x4 run = (f32x4){0.f, 0.f, 0.f, 0.f};
        for (int hb = 0; hb < 4; ++hb) {
            f32x4 u[8];
#pragma unroll
            for (int s = 0; s < 8; ++s) u[s] = st[(size_t)((b * 32 + hb * 8 + s) * 4 + h) * 8192 + e];
            asm volatile("" ::: "memory");
#pragma unroll
            for (int s = 0; s < 8; ++s) { const int un = (b * 32 + hb * 8 + s) * 4 + h; const f32x4 dc = *(const f32x4*)(dec + un * 128 + d0);
                st[(size_t)un * 8192 + e] = run; run = run * dc + u[s]; }
        }
    }
}

constexpr int S_ACUM = 0, S_DTV = 256, S_MISC = 512, S_XDT = 1024, S_XD2 = 10240, S_BN = 19456, S_BT = 36864, S_CN = 55296, S_GL = 72704, S_SB = 81920;
DI float softplusf_(float x) { const float e = __expf(x); return x > 20.f ? x : (x < -10.f ? e : __logf(1.f + e)); }
template <int MODE> DI void ssd_unit(const Params& p, int l, int un, LAS unsigned char* lds) {
    const int tid = opaque_tid(), lane = tid & 63, w = __builtin_amdgcn_readfirstlane(tid >> 6), r16 = lane & 15, quad = lane >> 4;
    const int sc = un >> 5, head = un & 31, g = head >> 3, tok0 = sc * 256;
    unsigned char* ws = p.ws;
    bf16_t* Zb = (bf16_t*)(ws + WS_R + (size_t)(head >> 4) * BLK) + (head & 15) * 64;
    const bf16_t* Xb = (const bf16_t*)(ws + WS_R + (size_t)(2 + (head >> 4)) * BLK) + (head & 15) * 64;
    const bf16_t* BCb = (const bf16_t*)(ws + WS_R + 4 * BLK);
    const float* small = (const float*)(ws + WS_SMALL);
    float* ssq = (float*)(ws + WS_SSQ);
    float* states = (float*)(ws + WS_STS) + (size_t)un * 8192;
    const float* cw = p.in[8] + (size_t)l * 4 * 3072; const float* cbias = p.in[9] + l * 3072;
    const float dtb = p.in[10][l * 32 + head], aneg = -__expf(p.in[11][l * 32 + head]), Dh = p.in[12][l * 32 + head];
    f32x4 st[4];
    if (MODE == 3) {
#pragma unroll
        for (int pb = 0; pb < 4; ++pb) { st[pb] = *(const f32x4*)(states + ((size_t)(w * 4 + pb) * 64 + lane) * 4);
            *(LAS u32x2*)(lds + S_SB + (16 * pb + r16) * 272 + (16 * w + quad * 4) * 2) = (u32x2){pk2(st[pb][0], st[pb][1]), pk2(st[pb][2], st[pb][3])}; }
    } else {
#pragma unroll
        for (int pb = 0; pb < 4; ++pb) st[pb] = (f32x4){0.f, 0.f, 0.f, 0.f};
    }
    const int px = tid & 63, tq = tid >> 6;
    float wx[4];
#pragma unroll
    for (int i = 0; i < 4; ++i) wx[i] = cw[i * 3072 + head * 64 + px];
    const float bx = cbias[head * 64 + px];
    float atot = 0.f;
    for (int j = 0; j < 4; ++j) {
        const int t0 = tok0 + 64 * j, s0 = t0 & (SEQ - 1);
        if (w == 0) {
            const float dt = softplusf_(small[(size_t)(t0 + lane) * 64 + 16 + head] + dtb);
            float cs = dt * aneg;
#pragma unroll
            for (int o = 1; o < 64; o <<= 1) { const float v = __shfl_up(cs, o); if (lane >= o) cs += v; }
            ((LAS float*)(lds + S_ACUM))[lane] = cs; ((LAS float*)(lds + S_DTV))[lane] = dt;
            if (lane == 63) ((LAS float*)(lds + S_MISC))[0] = cs;
        }
        __syncthreads();
        const float alast = ((const LAS float*)(lds + S_MISC))[0];
        atot += alast;
        {
            float xv[11];
#pragma unroll
            for (int k = 0; k < 11; ++k) { const int tt = tq * 8 - 3 + k; xv[k] = (s0 + tt >= 0) ? bf2f(Xb[(size_t)(t0 + tt) * 1024 + px]) : 0.f; }
            unsigned a1[4], a2[4]; float e1[2], e2[2];
#pragma unroll
            for (int i = 0; i < 8; ++i) { const int t = tq * 8 + i;
                const float cv = bx + xv[i] * wx[0] + xv[i + 1] * wx[1] + xv[i + 2] * wx[2] + xv[i + 3] * wx[3];
                const float xd = siluf_(cv) * ((const LAS float*)(lds + S_DTV))[t];
                e1[i & 1] = xd; e2[i & 1] = xd * __expf(alast - ((const LAS float*)(lds + S_ACUM))[t]);
                if (i & 1) { a1[i >> 1] = pk2(e1[0], e1[1]); a2[i >> 1] = pk2(e2[0], e2[1]); } }
            *(LAS u32x4*)(lds + S_XDT + px * 144 + tq * 16) = (u32x4){a1[0], a1[1], a1[2], a1[3]};
            *(LAS u32x4*)(lds + S_XD2 + px * 144 + tq * 16) = (u32x4){a2[0], a2[1], a2[2], a2[3]};
        }
        {
            const bf16_t* BCc = (const bf16_t*)(ws + WS_STG);
#pragma unroll
            for (int i = 0; i < 2; ++i) { const int pid = tid + 512 * i, c8 = pid >> 6, t = pid & 63;
                const u32x4 v = *(const u32x4*)(BCc + (size_t)(t0 + t) * 1024 + g * 128 + c8 * 8);
                if (MODE == 3) *(LAS u32x4*)(lds + S_BN + t * 272 + c8 * 16) = v;
                LAS bf16_t* bt = (LAS bf16_t*)(lds + S_BT) + (c8 * 8) * 72 + t;
#pragma unroll
                for (int e = 0; e < 4; ++e) { bt[(2 * e) * 72] = (bf16_t)(v[e] & 0xffffu); bt[(2 * e + 1) * 72] = (bf16_t)(v[e] >> 16); }
                if (MODE == 3) { const u32x4 cv = *(const u32x4*)(BCc + (size_t)(t0 + t) * 1024 + 512 + g * 128 + c8 * 8); *(LAS u32x4*)(lds + S_CN + t * 272 + c8 * 16) = cv; } }
        }
        __syncthreads();
        if (MODE == 3) {
            f32x4 y[2];
#pragma unroll
            for (int e = 0; e < 2; ++e) { const int x = 2 * w + e, tb = x >> 2, sb = x & 3;
                f32x4 a = (f32x4){0.f, 0.f, 0.f, 0.f};
                if (sb <= tb) a = mm16<4>(a, lds + S_BN + sb * 16 * 272, 272, lds + S_CN + tb * 16 * 272, 272, lane);
                const int t = 16 * tb + r16, sb0 = 16 * sb + quad * 4;
                const float act = ((const LAS float*)(lds + S_ACUM))[t], dtt = ((const LAS float*)(lds + S_DTV))[t];
                float v[4];
#pragma unroll
                for (int jj = 0; jj < 4; ++jj) { const int s = sb0 + jj; float val = 0.f;
                    if (s <= t) val = a[jj] * __expf(act - ((const LAS float*)(lds + S_ACUM))[s]);
                    if (s == t) val += Dh * __builtin_amdgcn_rcpf(dtt);
                    v[jj] = val; }
                *(LAS u32x2*)(lds + S_GL + t * 144 + sb0 * 2) = (u32x2){pk2(v[0], v[1]), pk2(v[2], v[3])};
                const int pb = sb;
                y[e] = mm16<4>((f32x4){0.f, 0.f, 0.f, 0.f}, lds + S_SB + pb * 16 * 272, 272, lds + S_CN + tb * 16 * 272, 272, lane);
                y[e] = y[e] * __expf(act);
            }
            __syncthreads();
#pragma unroll
            for (int e = 0; e < 2; ++e) { const int x = 2 * w + e, tb = x >> 2, pb = x & 3;
                y[e] = mm16<2>(y[e], lds + S_XDT + pb * 16 * 144, 144, lds + S_GL + tb * 16 * 144, 144, lane);
                const int t = 16 * tb + r16; bf16_t* zp = Zb + (size_t)(t0 + t) * 1024 + 16 * pb + quad * 4;
                const u32x2 zw = *(const u32x2*)zp;
                f32x4 r; r[0] = y[e][0] * siluf_(bflo(zw.x)); r[1] = y[e][1] * siluf_(bfhi(zw.x)); r[2] = y[e][2] * siluf_(bflo(zw.y)); r[3] = y[e][3] * siluf_(bfhi(zw.y));
                float ss = r[0] * r[0] + r[1] * r[1] + r[2] * r[2] + r[3] * r[3];
                ss += __shfl_xor(ss, 16); ss += __shfl_xor(ss, 32);
                if (quad == 0) atomicAdd(ssq + (size_t)(t0 + t) * 4 + g, ss);
                *(u32x2*)zp = (u32x2){pk2(r[0], r[1]), pk2(r[2], r[3])}; }
        }
        {
            const float da = __expf(alast);
#pragma unroll
            for (int pb = 0; pb < 4; ++pb) { st[pb] = st[pb] * da;
                st[pb] = mm16<2>(st[pb], lds + S_BT + w * 16 * 144, 144, lds + S_XD2 + pb * 16 * 144, 144, lane);
                if (MODE == 3) *(LAS u32x2*)(lds + S_SB + (16 * pb + r16) * 272 + (16 * w + quad * 4) * 2) = (u32x2){pk2(st[pb][0], st[pb][1]), pk2(st[pb][2], st[pb][3])}; }
        }
        __syncthreads();
    }
    if (MODE == 1) {
#pragma unroll
        for (int pb = 0; pb < 4; ++pb) *(f32x4*)(states + ((size_t)(w * 4 + pb) * 64 + lane) * 4) = st[pb];
        if (tid == 0) ((float*)(ws + WS_DECS))[un] = __expf(atot);
    }
}

DI void conv_bc(const Params& p, int l) {
    const bf16_t* BC = (const bf16_t*)(p.ws + WS_R + 4 * BLK); bf16_t* O = (bf16_t*)(p.ws + WS_STG);
    const float* cw = p.in[8] + (size_t)l * 4 * 3072 + 2048; const float* cb = p.in[9] + l * 3072 + 2048;
    const int gt = blockIdx.x * 512 + opaque_tid();
    for (int it = gt; it < 1024 * 256; it += gridDim.x * 512) {
        const int c = it & 1023, r0 = (it >> 10) * 64;
        const float w0 = cw[c], w1 = cw[3072 + c], w2 = cw[2 * 3072 + c], w3 = cw[3 * 3072 + c], b = cb[c];
        float x0 = 0.f, x1 = 0.f, x2 = 0.f;
        if ((r0 & (SEQ - 1)) != 0) { x0 = bf2f(BC[(size_t)(r0 - 3) * 1024 + c]); x1 = bf2f(BC[(size_t)(r0 - 2) * 1024 + c]); x2 = bf2f(BC[(size_t)(r0 - 1) * 1024 + c]); }
#pragma unroll 8
        for (int i = 0; i < 64; ++i) { const float x3 = bf2f(BC[(size_t)(r0 + i) * 1024 + c]); const float cv = b + x0 * w0 + x1 * w1 + x2 * w2 + x3 * w3;
            O[(size_t)(r0 + i) * 1024 + c] = f2bf(siluf_(cv)); x0 = x1; x1 = x2; x2 = x3; }
    }
}

constexpr int L_ACUM = 0, L_DTV = 1024, L_TOT = 2048, L_XD2 = 2304, L_BT = 36096;
DI void ssd_local(const Params& p, int l, int un, LAS unsigned char* lds) {
    const int tid = opaque_tid(), lane = tid & 63, w = __builtin_amdgcn_readfirstlane(tid >> 6);
    const int sc = un >> 5, head = un & 31, g = head >> 3, tok0 = sc * 256, s0 = tok0 & (SEQ - 1);
    unsigned char* ws = p.ws;
    const bf16_t* Xb = (const bf16_t*)(ws + WS_R + (size_t)(2 + (head >> 4)) * BLK) + (head & 15) * 64;
    const bf16_t* BCc = (const bf16_t*)(ws + WS_STG);
    const float* small = (const float*)(ws + WS_SMALL);
    float* states = (float*)(ws + WS_STS) + (size_t)un * 8192;
    const float* cw = p.in[8] + (size_t)l * 4 * 3072; const float* cbias = p.in[9] + l * 3072;
    const float dtb = p.in[10][l * 32 + head], aneg = -__expf(p.in[11][l * 32 + head]);
    if (w < 4) {
        const int t = w * 64 + lane; const float dt = softplusf_(small[(size_t)(tok0 + t) * 64 + 16 + head] + dtb);
        float cs = dt * aneg;
#pragma unroll
        for (int o = 1; o < 64; o <<= 1) { const float v = __shfl_up(cs, o); if (lane >= o) cs += v; }
        ((LAS float*)(lds + L_ACUM))[t] = cs; ((LAS float*)(lds + L_DTV))[t] = dt;
        if (lane == 63) ((LAS float*)(lds + L_TOT))[w] = cs;
    }
    __syncthreads();
    const float t0_ = ((const LAS float*)(lds + L_TOT))[0], t1_ = ((const LAS float*)(lds + L_TOT))[1], t2_ = ((const LAS float*)(lds + L_TOT))[2], t3_ = ((const LAS float*)(lds + L_TOT))[3];
    const float atot = t0_ + t1_ + t2_ + t3_;
    {
        const int px = tid & 63, tq = tid >> 6;
        float wx[4];
#pragma unroll
        for (int i = 0; i < 4; ++i) wx[i] = cw[i * 3072 + head * 64 + px];
        const float bx = cbias[head * 64 + px];
        const float offq = (tq >= 6) ? t0_ + t1_ + t2_ : (tq >= 4) ? t0_ + t1_ : (tq >= 2) ? t0_ : 0.f;
#pragma unroll
        for (int c4 = 0; c4 < 4; ++c4) { const int tb = tq * 32 + c4 * 8;
            float xv[11];
#pragma unroll
            for (int k = 0; k < 11; ++k) { const int tt = tb - 3 + k; xv[k] = (s0 + tt >= 0) ? bf2f(Xb[(size_t)(tok0 + tt) * 1024 + px]) : 0.f; }
            unsigned a2[4]; float e2[2];
#pragma unroll
            for (int i = 0; i < 8; ++i) { const int t = tb + i;
                const float cv = bx + xv[i] * wx[0] + xv[i + 1] * wx[1] + xv[i + 2] * wx[2] + xv[i + 3] * wx[3];
                e2[i & 1] = siluf_(cv) * ((const LAS float*)(lds + L_DTV))[t] * __expf(atot - offq - ((const LAS float*)(lds + L_ACUM))[t]);
                if (i & 1) a2[i >> 1] = pk2(e2[0], e2[1]); }
            *(LAS u32x4*)(lds + L_XD2 + px * 528 + tb * 2) = (u32x4){a2[0], a2[1], a2[2], a2[3]}; }
    }
#pragma unroll
    for (int i = 0; i < 8; ++i) { const int pid = tid + 512 * i, c8 = pid >> 8, t = pid & 255;
        const u32x4 v = *(const u32x4*)(BCc + (size_t)(tok0 + t) * 1024 + g * 128 + c8 * 8);
        LAS bf16_t* bt = (LAS bf16_t*)(lds + L_BT) + (c8 * 8) * 264 + t;
#pragma unroll
        for (int e = 0; e < 4; ++e) { bt[(2 * e) * 264] = (bf16_t)(v[e] & 0xffffu); bt[(2 * e + 1) * 264] = (bf16_t)(v[e] >> 16); } }
    __syncthreads();
#pragma unroll
    for (int pb = 0; pb < 4; ++pb) { const f32x4 st = mm16<8>((f32x4){0.f, 0.f, 0.f, 0.f}, lds + L_BT + w * 16 * 528, 528, lds + L_XD2 + pb * 16 * 528, 528, lane);
        *(f32x4*)(states + ((size_t)(w * 4 + pb) * 64 + lane) * 4) = st; }
    if (tid == 0) ((float*)(ws + WS_DECS))[un] = __expf(atot);
    __syncthreads();
}
DI void ssd_scan(const Params& p) {
    const int gid = blockIdx.x * 512 + opaque_tid();
    for (int it = gid; it < 131072; it += gridDim.x * 512) {
        const int chain = it >> 11, e = it & 2047, b = chain >> 5, head = chain & 31;
        f32x4* st = (f32x4*)(p.ws + WS_STS); const float* dec = (const float*)(p.ws + WS_DECS);
        f32x4 run = (f32x4){0.f, 0.f, 0.f, 0.f};
        for (int hb = 0; hb < 4; ++hb) {
            f32x4 u[8];
#pragma unroll
            for (int s = 0; s < 8; ++s) u[s] = st[(size_t)((b * 32 + hb * 8 + s) * 32 + head) * 2048 + e];
            asm volatile("" ::: "memory");
#pragma unroll
            for (int s = 0; s < 8; ++s) { const int un = (b * 32 + hb * 8 + s) * 32 + head; const float dc = dec[un];
                st[(size_t)un * 2048 + e] = run; run = run * dc + u[s]; }
        }
    }
}

typedef short v4i16_t __attribute__((ext_vector_type(4)));
DI s16x4 vtr(const LAS unsigned char* p) { return __builtin_bit_cast(s16x4, __builtin_amdgcn_ds_read_tr16_b64_v4i16((LAS v4i16_t*)p)); }
constexpr int A_K = 0, A_V = 34816, A_X = 0, A_Y = 65536, A_NG = 100352;
DI void attn_unit(const Params& p, int b, int h, int qb, float lam, float oscale, LAS unsigned char* lds) {
    const int tid = opaque_tid(), lane = tid & 63, w = __builtin_amdgcn_readfirstlane(tid >> 6), rg = w & 3, sub = w >> 2, q = lane & 31, hh = lane >> 5;
    bf16_t* Qd = (bf16_t*)(p.ws + WS_R + 4 * BLK); const bf16_t* Kd = (const bf16_t*)(p.ws + WS_R + 5 * BLK); const bf16_t* Vd = (const bf16_t*)(p.ws + WS_R + 6 * BLK);
    const int tok0 = b * SEQ + qb * 128;
    bf16x8 qf[4];
    { const bf16_t* qp = Qd + (size_t)(tok0 + rg * 32 + q) * 1024 + h * 128 + sub * 64 + hh * 8;
#pragma unroll
      for (int ks = 0; ks < 4; ++ks) qf[ks] = *(const bf16x8*)(qp + ks * 16); }
    const int NT = 2 * qb + 2;
    u32x4 kr[2], vr[2];
    const int prow = tid >> 4, pc16 = tid & 15;
#define ATT_LOAD(t) do { _Pragma("unroll") for (int i_ = 0; i_ < 2; ++i_) { const size_t off_ = (size_t)(b * SEQ + (t) * 64 + prow + 32 * i_) * 1024 + h * 128 + pc16 * 8; \
        kr[i_] = *(const u32x4*)(Kd + off_); vr[i_] = *(const u32x4*)(Vd + off_); } } while (0)
#define ATT_STORE(buf) do { _Pragma("unroll") for (int i_ = 0; i_ < 2; ++i_) { const int o_ = (buf) * 17408 + (prow + 32 * i_) * 272 + pc16 * 16; \
        *(LAS u32x4*)(lds + A_K + o_) = kr[i_]; *(LAS u32x4*)(lds + A_V + (buf) * 18432 + (prow + 32 * i_) * 288 + pc16 * 16) = vr[i_]; } } while (0)
    f32x16 o[4];
#pragma unroll
    for (int db = 0; db < 4; ++db)
#pragma unroll
        for (int i = 0; i < 16; ++i) o[db][i] = 0.f;
    float m_run = -1e30f, l_run = 0.f;
    const float C2 = 0.18033688011112042f;
    ATT_LOAD(0); ATT_STORE(0); ATT_LOAD(1);
    __syncthreads();
    const int i16 = lane & 15, blk = (lane >> 4) & 1;
    for (int t = 0; t < NT; ++t) {
        if (t + 1 < NT) ATT_STORE((t + 1) & 1);
        if (t + 2 < NT) ATT_LOAD(t + 2);
        if (t <= 2 * qb + (rg >> 1)) {
            const LAS unsigned char* Kb = lds + A_K + (t & 1) * 17408; const LAS unsigned char* Vb = lds + A_V + (t & 1) * 18432;
            f32x16 s0, s1;
#pragma unroll
            for (int i = 0; i < 16; ++i) { s0[i] = 0.f; s1[i] = 0.f; }
#pragma unroll
            for (int ks = 0; ks < 4; ++ks) { const LAS unsigned char* kp = Kb + q * 272 + (sub * 64 + ks * 16 + hh * 8) * 2;
                s0 = mfma32(*(const LAS bf16x8*)kp, qf[ks], s0); s1 = mfma32(*(const LAS bf16x8*)(kp + 32 * 272), qf[ks], s1); }
            float mx = fmaxf(s0[0], s1[0]);
#pragma unroll
            for (int i = 1; i < 16; ++i) mx = fmaxf(mx, fmaxf(s0[i], s1[i]));
            mx = fmaxf(mx, __shfl_xor(mx, 32));
            const float m_new = fmaxf(m_run, mx), negm = -m_new * C2;
            if (__any(m_new > m_run)) {
                const float alpha = __builtin_amdgcn_exp2f((m_run - m_new) * C2);
                l_run *= alpha;
#pragma unroll
                for (int db = 0; db < 4; ++db)
#pragma unroll
                    for (int i = 0; i < 16; ++i) o[db][i] *= alpha;
            }
            float sum = 0.f;
#pragma unroll
            for (int i = 0; i < 16; ++i) { s0[i] = __builtin_amdgcn_exp2f(fmaf(s0[i], C2, negm)); s1[i] = __builtin_amdgcn_exp2f(fmaf(s1[i], C2, negm)); sum += s0[i] + s1[i]; }
            l_run += sum; m_run = m_new;
            bf16x8 pf[2][2];
#pragma unroll
            for (int s = 0; s < 2; ++s) {
                pf[0][s] = __builtin_bit_cast(bf16x8, (u32x4){pk2(s0[8 * s], s0[8 * s + 1]), pk2(s0[8 * s + 2], s0[8 * s + 3]), pk2(s0[8 * s + 4], s0[8 * s + 5]), pk2(s0[8 * s + 6], s0[8 * s + 7])});
                pf[1][s] = __builtin_bit_cast(bf16x8, (u32x4){pk2(s1[8 * s], s1[8 * s + 1]), pk2(s1[8 * s + 2], s1[8 * s + 3]), pk2(s1[8 * s + 4], s1[8 * s + 5]), pk2(s1[8 * s + 6], s1[8 * s + 7])}); }
#pragma unroll
            for (int kb = 0; kb < 2; ++kb)
#pragma unroll
                for (int s = 0; s < 2; ++s) { const LAS unsigned char* vp = Vb + (32 * kb + 16 * s + 4 * hh + (i16 >> 2)) * 288 + blk * 32 + (i16 & 3) * 8;
#pragma unroll
                    for (int db = 0; db < 4; ++db) { const s16x4 lo = vtr(vp + db * 64), hi = vtr(vp + db * 64 + 8 * 288);
                        const bf16x8 vf = (bf16x8){lo[0], lo[1], lo[2], lo[3], hi[0], hi[1], hi[2], hi[3]};
                        o[db] = mfma32(vf, pf[kb][s], o[db]); } }
        }
        __syncthreads();
    }
#undef ATT_LOAD
#undef ATT_STORE
    const float l_tot = l_run + __shfl_xor(l_run, 32);
    LAS float* X = (LAS float*)(lds + A_X) + rg * 4096;
    if (sub == 1) { const float inv = lam / l_tot;
#pragma unroll
        for (int db = 0; db < 4; ++db)
#pragma unroll
            for (int i = 0; i < 16; ++i) X[(db * 16 + i) * 64 + lane] = o[db][i] * inv; }
    __syncthreads();
    if (sub == 0) { const float inv = 1.f / l_tot; float ss = 0.f;
#pragma unroll
        for (int db = 0; db < 4; ++db)
#pragma unroll
            for (int i = 0; i < 16; ++i) { const float v = o[db][i] * inv - X[(db * 16 + i) * 64 + lane]; o[db][i] = v; ss += v * v; }
        ss += __shfl_xor(ss, 32);
        const float rs = rsqrtf(ss * (1.f / 128.f) + 1e-5f) * oscale;
        LAS bf16_t* Y = (LAS bf16_t*)(lds + A_Y) + rg * (32 * 136);
        const LAS float* ngl = (const LAS float*)(lds + A_NG);
#pragma unroll
        for (int db = 0; db < 4; ++db)
#pragma unroll
            for (int i = 0; i < 16; ++i) { const int dv = 32 * db + crow(i, hh); Y[q * 136 + dv] = f2bf(o[db][i] * rs * ngl[dv]); }
        asm volatile("s_waitcnt lgkmcnt(0)" ::: "memory");
#pragma unroll
        for (int k = 0; k < 8; ++k) { const int piece = lane + 64 * k, row = piece >> 4, c16 = piece & 15;
            const u32x4 v = *(const LAS u32x4*)((const LAS unsigned char*)Y + row * 272 + c16 * 16);
            *(u32x4*)(Qd + (size_t)(tok0 + rg * 32 + row) * 1024 + h * 128 + c16 * 8) = v; }
    }
    __syncthreads();
}
DI void attn_phase(const Params& p, int l, LAS unsigned char* lds, int vcu) {
    const int tid = opaque_tid();
    float d1 = 0.f, d2 = 0.f;
    for (int i = 0; i < 64; ++i) { d1 += p.in[14][l * 64 + i] * p.in[15][l * 64 + i]; d2 += p.in[16][l * 64 + i] * p.in[17][l * 64 + i]; }
    const float lambda_init = (l == 0) ? 0.2f : 0.35550906759096934f;
    const float lam = expf(d1) - expf(d2) + lambda_init;
    if (tid < 128) ((LAS float*)(lds + A_NG))[tid] = p.in[18][l * 128 + tid];
    __syncthreads();
    for (int i = 0; i < 4; ++i)
        for (int vc = vcu; vc < 256; vc += gridDim.x) {
            const int bh = vc >> 4, s = vc & 15; const int qb = (i == 0) ? s : (i == 1) ? 31 - s : (i == 2) ? 32 + s : 63 - s;
            attn_unit(p, bh >> 3, bh & 7, qb, lam, 1.f - lambda_init, lds);
        }
}

DI void final_norm(const Params& p) {
    const float* rowsq = (const float*)(p.ws + WS_ROWSQ) + 4 * T; const float* g = p.in[26];
    const int gt = blockIdx.x * 512 + opaque_tid();
    for (int i = gt; i < T * 256; i += gridDim.x * 512) { const int row = i >> 8, c = (i & 255) * 4;
        const float rs = rsqrtf(rowsq[row] * (1.f / 1024.f) + EPS);
        f32x4 v = *(f32x4*)(p.out + (size_t)row * 1024 + c); const f32x4 gv = *(const f32x4*)(g + c);
        *(f32x4*)(p.out + (size_t)row * 1024 + c) = v * rs * gv; }
}


DI void gemv2(float* out, int ldo, const float* in, int ldi, const float* W, int ldw, int K, int N, int kchunk) {
    const int tid = opaque_tid(), lane = tid & 63, wave = __builtin_amdgcn_readfirstlane(tid >> 6);
    const int gw = blockIdx.x * 8 + wave, NGW = gridDim.x * 8, nstrip = (N + 63) / 64, nk = K / 128;
    for (int job = gw; job < nstrip * nk; job += NGW) {
        const int strip = job % nstrip, kq = job / nstrip, col = strip * 64 + lane; const bool ok = col < N;
        const float* wp = W + (size_t)(kq * 128) * ldw + (ok ? col : 0);
        const float* i0 = in + kq * 128; const float* i1 = in + ldi + kq * 128;
        float a0 = 0.f, a1 = 0.f;
        for (int kk = 0; kk < 2; ++kk) {
            const float h0 = i0[kk * 64 + lane], h1 = i1[kk * 64 + lane];
#pragma unroll
            for (int k = 0; k < 64; ++k) { const float wv = wp[(size_t)(kk * 64 + k) * ldw];
                a0 += __uint_as_float(__builtin_amdgcn_readlane(__float_as_uint(h0), k)) * wv; a1 += __uint_as_float(__builtin_amdgcn_readlane(__float_as_uint(h1), k)) * wv; }
        }
        if (ok) { atomicAdd(out + col, a0); atomicAdd(out + ldo + col, a1); }
    }
}
DI void side_init(const Params& p) {
    const int tid = opaque_tid(), lane = tid & 63, wave = __builtin_amdgcn_readfirstlane(tid >> 6);
    const int gt = blockIdx.x * 512 + tid, NTH = gridDim.x * 512, gw = blockIdx.x * 8 + wave, NGW = gridDim.x * 8;
    float* z = (float*)(p.ws + SB_PROJ);
    for (int i = gt; i < (int)((SB_END - SB_PROJ) / 4); i += NTH) z[i] = 0.f;
    float* hn = (float*)(p.ws + SB_HN);
    for (int r = gw; r < 128; r += NGW) { const int row = (r >> 6) * SEQ + (r & 63);
        const f32x4* xr = (const f32x4*)(p.in[0] + (size_t)row * 1024) + lane; f32x4 v[4]; float s2 = 0.f;
#pragma unroll
        for (int j = 0; j < 4; ++j) { v[j] = xr[64 * j]; s2 += v[j][0] * v[j][0] + v[j][1] * v[j][1] + v[j][2] * v[j][2] + v[j][3] * v[j][3]; }
        const float rs = rsqrtf(wave_sum(s2) * (1.f / 1024.f) + EPS);
#pragma unroll
        for (int j = 0; j < 4; ++j) { const f32x4 g = *((const f32x4*)p.in[2] + lane + 64 * j); *((f32x4*)(hn + (size_t)r * 1024) + lane + 64 * j) = v[j] * rs * g; } }
}
DI void side_kv(const Params& p) {
    const int tid = opaque_tid(), lane = tid & 63, wave = __builtin_amdgcn_readfirstlane(tid >> 6);
    const int gw = blockIdx.x * 8 + wave, NGW = gridDim.x * 8;
    const float* hn = (const float*)(p.ws + SB_HN); float* kv = (float*)(p.ws + SB_KV);
    for (int job = gw; job < 4096; job += NGW) {
        const int strip = job & 31, grp = (job >> 5) & 15, kq = job >> 9, col = strip * 64 + lane;
        const float* wp = p.in[3] + (size_t)(kq * 128) * INC + 9264 + col; const float* hp = hn + (size_t)(grp * 8) * 1024 + kq * 128;
        float a[8];
#pragma unroll
        for (int t = 0; t < 8; ++t) a[t] = 0.f;
        for (int kk = 0; kk < 2; ++kk) {
            float h[8];
#pragma unroll
            for (int t = 0; t < 8; ++t) h[t] = hp[t * 1024 + kk * 64 + lane];
#pragma unroll 16
            for (int k = 0; k < 64; ++k) { const float wv = wp[(size_t)(kk * 64 + k) * INC];
#pragma unroll
                for (int t = 0; t < 8; ++t) a[t] += __uint_as_float(__builtin_amdgcn_readlane(__float_as_uint(h[t]), k)) * wv; }
        }
#pragma unroll
        for (int t = 0; t < 8; ++t) atomicAdd(kv + (size_t)(grp * 8 + t) * 2048 + col, a[t]);
    }
}
DI void rope_cs(int pos, int i, float& cs, float& sn) {
    const double cf[8] = {0.15915494309189535, 0.03086376340470123, 0.005985185712713705, 0.001160663641240061, 0.00022507907903927653, 4.364795279280289e-05, 8.464330808241401e-06, 1.6414262627950345e-06};
    double c = cf[0];
#pragma unroll
    for (int q = 1; q < 8; ++q) c = (i == q) ? cf[q] : c;
    double rv = (double)pos * c; rv -= floor(rv); const float fr = (float)rv; sn = __builtin_amdgcn_sinf(fr); cs = __builtin_amdgcn_cosf(fr);
}
DI void side_mixers(const Params& p, int b, LAS unsigned char* lds) {
    const int tid = opaque_tid();
    const float* P = (const float*)(p.ws + SB_PROJ) + b * 14384; float* Y = (float*)(p.ws + SB_Y) + b * 4096; float* KV = (float*)(p.ws + SB_KV) + (size_t)b * 64 * 2048;
    LAS float* cx = (LAS float*)lds; LAS float* ypre = cx + 3072; LAS float* lg = ypre + 2048; LAS float* pr = lg + 1024; LAS float* red = pr + 1024; LAS float* qr = red + 64;
    const int* pos = (const int*)p.in[1] + b * SEQ;
    __syncthreads();
    if (tid < 4) { float qk = 0.f, vv = 0.f; for (int d = 0; d < 128; ++d) qk += P[tid * 128 + d] * P[512 + tid * 128 + d]; for (int d = 0; d < 256; ++d) { const float v = P[1024 + tid * 256 + d]; vv += v * v; }
        red[tid] = qk * 0.08838834764831845f; red[4 + tid] = vv * (1.f / 256.f); }
    for (int c = tid; c < 3072; c += 512) cx[c] = siluf_(p.in[9][c] + p.in[8][3 * 3072 + c] * P[5136 + c]);
    if (tid < 32) red[8 + tid] = softplusf_(P[8208 + tid] + p.in[10][tid]);
    __syncthreads();
    for (int i = tid; i < 1024; i += 512) { const int h = i >> 8; const float p00 = red[h], o = p00 * P[1024 + i];
        Y[i] = o * rsqrtf(p00 * p00 * red[4 + h] + EPS) * p.in[7][i & 255] * siluf_(P[2064 + i]); }
    if (tid < 4) { float cb = 0.f; for (int n = 0; n < 128; ++n) cb += cx[2560 + tid * 128 + n] * cx[2048 + tid * 128 + n]; red[40 + tid] = cb; }
    __syncthreads();
    for (int i = tid; i < 2048; i += 512) { const int head = i >> 6; ypre[i] = (red[40 + (head >> 3)] * red[8 + head] + p.in[12][head]) * cx[i] * siluf_(P[3088 + i]); }
    __syncthreads();
    if (tid < 4) { float ss = 0.f; for (int i = 0; i < 512; ++i) ss += ypre[tid * 512 + i] * ypre[tid * 512 + i]; red[44 + tid] = rsqrtf(ss * (1.f / 512.f) + EPS); }
    __syncthreads();
    for (int i = tid; i < 2048; i += 512) Y[1024 + i] = ypre[i] * red[44 + (i >> 9)] * p.in[13][i];
    for (int i = tid; i < 1024; i += 512) { const int d = i & 63; float v = P[8240 + i];
        if (d < 16) { float cs, sn; rope_cs(pos[0], d & 7, cs, sn); const float o = (d < 8) ? P[8240 + i + 8] : P[8240 + i - 8]; v = (d < 8) ? v * cs - o * sn : v * cs + o * sn; }
        qr[i] = v; }
    for (int it = tid; it < 8192; it += 512) { const int j = it >> 7, hs = (it >> 3) & 15, d = it & 7; float cs, sn; rope_cs(pos[j], d, cs, sn);
        float* kp = KV + (size_t)j * 2048 + hs * 64 + d; const float k1 = kp[0], k2 = kp[8]; kp[0] = k1 * cs - k2 * sn; kp[8] = k2 * cs + k1 * sn; }
    __threadfence_block();
    __syncthreads();
    for (int i = tid; i < 1024; i += 512) { const int hs = i >> 6, j = i & 63; const float* kp = KV + (size_t)j * 2048 + hs * 64; float sacc = 0.f;
        for (int d = 0; d < 64; ++d) sacc += qr[hs * 64 + d] * kp[d];
        lg[i] = sacc * 0.125f; }
    __syncthreads();
    if (tid < 16) { float m = -1e30f; for (int j = 0; j < 64; ++j) m = fmaxf(m, lg[tid * 64 + j]); float sum = 0.f; for (int j = 0; j < 64; ++j) { const float e = expf(lg[tid * 64 + j] - m); pr[tid * 64 + j] = e; sum += e; }
        const float inv = 1.f / sum; for (int j = 0; j < 64; ++j) pr[tid * 64 + j] *= inv; }
    __syncthreads();
    float d1 = 0.f, d2 = 0.f;
    for (int i = 0; i < 64; ++i) { d1 += p.in[14][i] * p.in[15][i]; d2 += p.in[16][i] * p.in[17][i]; }
    const float lam = expf(d1) - expf(d2) + 0.2f;
    for (int i = tid; i < 1024; i += 512) { const int h = i >> 7; float o = 0.f;
        for (int j = 0; j < 64; ++j) o += (pr[(2 * h) * 64 + j] - lam * pr[(2 * h + 1) * 64 + j]) * KV[(size_t)j * 2048 + 1024 + i];
        ypre[i] = o; }
    __syncthreads();
    if (tid < 8) { float ss = 0.f; for (int i = 0; i < 128; ++i) ss += ypre[tid * 128 + i] * ypre[tid * 128 + i]; red[48 + tid] = rsqrtf(ss * (1.f / 128.f) + 1e-5f) * 0.8f; }
    __syncthreads();
    for (int i = tid; i < 1024; i += 512) Y[3072 + i] = ypre[i] * red[48 + (i >> 7)] * p.in[18][i & 127];
    float* G = (float*)(p.ws + SB_GATE) + b * 3072;
    for (int i = tid; i < 3072; i += 512) G[i] = sigmoidf_(P[11312 + i] + p.in[4][i]);
    __syncthreads();
}
DI void side_glue(const Params& p, int step, int b, LAS unsigned char* lds) {
    const int tid = opaque_tid(); unsigned char* ws = p.ws; LAS float* red = (LAS float*)lds;
    if (step == 4) {
        const float* G = (const float*)(ws + SB_GATE) + b * 3072; const float* BR = (const float*)(ws + SB_BR) + b * 3072;
        for (int c = tid; c < 1024; c += 512) { ((float*)(ws + SB_MIX))[b * 1024 + c] = G[c] * BR[c] + G[1024 + c] * BR[1024 + c] + G[2048 + c] * BR[2048 + c];
            ((float*)(ws + SB_XM))[b * 1024 + c] = p.in[0][(size_t)b * SEQ * 1024 + c]; }
    } else if (step == 6 || step == 100) {
        const float* src = (const float*)(ws + (step == 6 ? SB_XM : SB_X1)) + b * 1024; float* dst = (float*)(ws + (step == 6 ? SB_H2 : SB_HN1)) + b * 1024;
        const float* g = step == 6 ? p.in[23] : p.in[2] + 1024;
        __syncthreads();
        float s2 = 0.f; for (int c = tid; c < 1024; c += 512) s2 += src[c] * src[c];
        s2 = wave_sum(s2); if ((tid & 63) == 0) red[tid >> 6] = s2;
        __syncthreads();
        float tot = 0.f; for (int w = 0; w < 8; ++w) tot += red[w];
        const float rs = rsqrtf(tot * (1.f / 1024.f) + EPS);
        for (int c = tid; c < 1024; c += 512) dst[c] = src[c] * rs * g[c];
        if (step == 100) { const size_t row = (size_t)b * SEQ; bf16_t* xb = (bf16_t*)(ws + WS_XB);
            for (int c = tid; c < 1024; c += 512) { p.out[row * 1024 + c] = src[c]; xb[row * 1024 + c] = f2bf(src[c]); }
            if (tid == 0) ((float*)(ws + WS_ROWSQ))[2 * T + row] = tot; }
        __syncthreads();
    } else if (step == 8) {
        const float* up = (const float*)(ws + SB_UP) + b * 4096; float* hh = (float*)(ws + SB_HH) + b * 4096;
        for (int c = tid; c < 4096; c += 512) { const float r = fmaxf(up[c], 0.f); hh[c] = r * r; }
        for (int c = tid; c < 1024; c += 512) ((float*)(ws + SB_X1))[b * 1024 + c] = ((const float*)(ws + SB_XM))[b * 1024 + c];
    }
}
DI void side_phase(const Params& p, int l, int k, LAS unsigned char* lds) {
    unsigned char* ws = p.ws; const int bid = blockIdx.x;
    if (l == 0) {
        if (k == 0) side_init(p);
        else if (k == 1) { gemv2((float*)(ws + SB_PROJ), 14384, (const float*)(ws + SB_HN), 64 * 1024, p.in[3], INC, 1024, INC, 128); side_kv(p); }
        else if (k == 2) { if (bid < 2) side_mixers(p, bid, lds); }
        else if (k == 3) { float* br = (float*)(ws + SB_BR); const float* y = (const float*)(ws + SB_Y);
            gemv2(br, 3072, y, 4096, p.in[19], 1024, 1024, 1024, 128); gemv2(br + 1024, 3072, y + 1024, 4096, p.in[20], 1024, 2048, 1024, 128); gemv2(br + 2048, 3072, y + 3072, 4096, p.in[21], 1024, 1024, 1024, 128); }
        else if (k == 4) { if (bid < 2) side_glue(p, 4, bid, lds); }
        else if (k == 5) gemv2((float*)(ws + SB_XM), 1024, (const float*)(ws + SB_MIX), 1024, p.in[22], 1024, 1024, 1024, 128);
        else if (k == 6) { if (bid < 2) side_glue(p, 6, bid, lds); }
        else if (k == 7) gemv2((float*)(ws + SB_UP), 4096, (const float*)(ws + SB_H2), 1024, p.in[24], 4096, 1024, 4096, 128);
        else if (k == 8) { if (bid < 2) side_glue(p, 8, bid, lds); }
        else if (k == 9) gemv2((float*)(ws + SB_X1), 1024, (const float*)(ws + SB_HH), 4096, p.in[25], 1024, 4096, 1024, 128);
    } else {
        if (k == 0) { if (bid < 2) side_glue(p, 100, bid, lds); }
        else if (k == 1) gemv2((float*)(ws + SB_QK1), 1024, (const float*)(ws + SB_HN1), 1024, p.in[3] + (size_t)1024 * INC, INC, 1024, 1024, 128);
    }
}


DI void grid_bar(unsigned* ctr, unsigned target) {
    asm volatile("s_waitcnt vmcnt(0)" ::: "memory");
    __syncthreads();
    if (threadIdx.x == 0) {
        __builtin_amdgcn_fence(__ATOMIC_RELEASE, "agent");
        asm volatile("s_waitcnt vmcnt(0)" ::: "memory");
        __hip_atomic_fetch_add(ctr, 1u, __ATOMIC_RELAXED, __HIP_MEMORY_SCOPE_AGENT);
        while (__hip_atomic_load(ctr, __ATOMIC_RELAXED, __HIP_MEMORY_SCOPE_AGENT) < target) __builtin_amdgcn_s_sleep(8);
        __builtin_amdgcn_fence(__ATOMIC_ACQUIRE, "agent");
        asm volatile("s_waitcnt vmcnt(0)" ::: "memory");
    }
    __syncthreads();
}

constexpr int NPHASE = 31, PPL = 15;
#ifndef PH_MASK
#define PH_MASK 0xFFFFFFFFu
#endif
#define EN(k_) ((PH_MASK >> (k_)) & 1u)
constexpr int LDS_BYTES = 147456;
template <bool COOP> __global__ void __launch_bounds__(512, 2) mk(Params p) {
    extern __shared__ __attribute__((aligned(16))) unsigned char lds_raw[];
    LAS unsigned char* lds = (LAS unsigned char*)lds_raw;
    unsigned char* ws = p.ws;
    float* rowsq = (float*)(ws + WS_ROWSQ);
    bf16_t* xb = (bf16_t*)(ws + WS_XB); bf16_t* mixb = (bf16_t*)(ws + WS_MIXB); bf16_t* R = (bf16_t*)(ws + WS_R);
    const unsigned char* wt = ws + WS_WT;
    const int G = gridDim.x, bid = blockIdx.x;
    const int vcu = (G % 8 == 0) ? (bid % 8) * (G / 8) + bid / 8 : bid;
    for (int ph = p.ph_lo; ph < p.ph_hi; ++ph) {
        if (ph == 30) { final_norm(p); }
        else {
            const int l = ph / PPL, k = ph % PPL;
            if (EN(0) && k == 0) phase_prep(p, l, lds);
            else if (k == 1 || k == 6) {
                const bool gd = (k == 1);
                pg8::Gemm g{xb, (const bf16_t*)(wt + (gd ? WT_GD : WT_S)), T, gd ? 8448 : 6144, 1024, 1024, 1024};
                pg8::StaticOrder S; S.init(T, g.N, G, bid);
                EpiIn E{R, rowsq + (2 * l) * T, (float*)(ws + WS_SMALL), gd ? 32 : -1, gd ? 3 : 5, gd ? 7 : -1,
                        p.in[4] + l * 3072 + (gd ? 0 : 1024), p.in[4] + l * 3072 + 2048};
                pg8::gemm_phase(lds, g, S, E);
            }
            else if (EN(2) && k == 2) { rope_pass(p); for (int un = vcu; un < 256; un += G) gla_unit<1>(p, l, un, lds); }
            else if (EN(3) && k == 3) { gla_scan(p); attn_phase(p, l, lds, vcu); }
            else if (EN(4) && k == 4) { for (int un = vcu; un < 256; un += G) gla_unit<3>(p, l, un, lds); }
            else if (k == 5 || k == 11) {
                const int nrun = (k == 5) ? 2 : 4;
                for (int r = 0; r < nrun; ++r) {
                    pg8::Gemm g; EpiMix E;
                    if (k == 5) {
                        g = pg8::Gemm{R + (size_t)(r == 0 ? 2 : 4) * (BLK / 2), (const bf16_t*)(wt + (r == 0 ? WT_GLA : WT_DIFF)), T, 1024, 1024, 1024, 1024};
                        E = EpiMix{mixb, R + (size_t)(r == 0 ? 3 : 7) * (BLK / 2), nullptr, 0, r == 0 ? 1 : 0};
                    } else {
                        g = pg8::Gemm{R + (size_t)(r >> 1) * (BLK / 2) + (r & 1) * 512, (const bf16_t*)(wt + WT_SSM) + r * 512, T, 1024, 512, 1024, 2048};
                        E = EpiMix{mixb, R + (size_t)5 * (BLK / 2), (const float*)(ws + WS_SSQ), r, 0};
                    }
                    pg8::StaticOrder S; S.init(T, 1024, G, bid);
                    pg8::gemm_phase(lds, g, S, E);
                }
            }
            else if (k == 7) { conv_bc(p, l); }
            else if (k == 8) { for (int un = vcu; un < 2048; un += G) ssd_local(p, l, un, lds); }
            else if (k == 9) { ssd_scan(p); }
            else if (k == 10) { for (int un = vcu; un < 2048; un += G) ssd_unit<3>(p, l, un, lds); }
            else if (k == 12 || k == 14) {
                const bool dn = (k == 14);
                pg8::Gemm g{dn ? R : mixb, (const bf16_t*)(wt + (dn ? WT_DOWN : WT_OUT)), T, 1024, dn ? 4096 : 1024, dn ? 4096 : 1024, dn ? 4096 : 1024};
                pg8::StaticOrder S; S.init(T, 1024, G, bid);
                EpiRes E{(l == 0 && !dn) ? p.in[0] : p.out, p.out, xb, rowsq + (2 * l + (dn ? 2 : 1)) * T};
                pg8::gemm_phase(lds, g, S, E);
            }
            else if (k == 13) {
                pg8::Gemm g{xb, (const bf16_t*)(wt + WT_UP), T, 4096, 1024, 1024, 1024};
                pg8::StaticOrder S; S.init(T, 4096, G, bid);
                EpiUp E{R, rowsq + (2 * l + 1) * T};
                pg8::gemm_phase(lds, g, S, E);
            }
        }
        if (ph < 30) side_phase(p, ph / PPL, ph % PPL, lds);
        if (COOP) { if (ph + 1 < p.ph_hi) { if (ph == p.ph_lo) cg::this_grid().sync(); else grid_bar((unsigned*)(ws + WS_BAR), (unsigned)(ph - p.ph_lo) * (unsigned)gridDim.x); } }
    }
}

extern "C" void kernel_launch(void* const* d_in, const int* in_sizes, int n_in, void* d_out, int out_size, void* d_ws, size_t ws_size, hipStream_t stream) {
    static int grid = 0;
    if (grid == 0) {
        if (n_in != 27 || out_size != T * 1024 || ws_size < WS_END) { fprintf(stderr, "kernel_launch: unexpected shapes/ws (n_in %d out %d ws %zu need %zu)\n", n_in, out_size, ws_size, (size_t)WS_END); grid = -1; return; }
        int dev = 0, cus = 0, per_cu = 0;
        (void)hipGetDevice(&dev); (void)hipDeviceGetAttribute(&cus, hipDeviceAttributeMultiprocessorCount, dev);
        (void)hipFuncSetAttribute((const void*)mk<true>, hipFuncAttributeMaxDynamicSharedMemorySize, LDS_BYTES);
        (void)hipOccupancyMaxActiveBlocksPerMultiprocessor(&per_cu, (const void*)mk<true>, 512, LDS_BYTES);
        if (per_cu < 1) fprintf(stderr, "kernel_launch: occupancy query says %d blocks/CU\n", per_cu);
        (void)hipGetLastError();
        grid = cus;
    }
    if (grid < 0) return;
    Params p{};
    for (int i = 0; i < 27; ++i) p.in[i] = (const float*)d_in[i];
    p.out = (float*)d_out; p.ws = (unsigned char*)d_ws;
    p.ph_lo = 0; p.ph_hi = NPHASE;
    (void)hipMemsetAsync((unsigned char*)d_ws + WS_BAR, 0, 256, stream);
    void* args[] = {&p};
    hipError_t e = hipLaunchCooperativeKernel((const void*)mk<true>, dim3(grid), dim3(512), args, LDS_BYTES, stream);
    if (e != hipSuccess) fprintf(stderr, "cooperative launch failed: %s (grid %d)\n", hipGetErrorString(e), grid);
}
```

```cpp
#include <hip/hip_runtime.h>
#include <hip/hip_cooperative_groups.h>
#include <cstdio>
#include <cstdint>
namespace cg = cooperative_groups;

#define LAS __attribute__((address_space(3)))
#define DI __device__ __forceinline__
typedef unsigned short bf16_t;
typedef short bf16x8 __attribute__((ext_vector_type(8)));
typedef short s16x4 __attribute__((ext_vector_type(4)));
typedef float f32x4 __attribute__((ext_vector_type(4)));
typedef float f32x16 __attribute__((ext_vector_type(16)));
typedef unsigned u32x4 __attribute__((ext_vector_type(4)));
typedef unsigned u32x2 __attribute__((ext_vector_type(2)));
typedef float f32x2_t __attribute__((ext_vector_type(2)));
typedef __bf16 bf16x2_t __attribute__((ext_vector_type(2)));

DI unsigned pk2(float lo, float hi) { f32x2_t v = {lo, hi}; bf16x2_t b = __builtin_convertvector(v, bf16x2_t); return __builtin_bit_cast(unsigned, b); }
DI bf16_t f2bf(float f) { return (bf16_t)(pk2(f, 0.f) & 0xffffu); }
DI float bf2f(unsigned b) { return __uint_as_float(b << 16); }
DI float bflo(unsigned w) { return __uint_as_float(w << 16); }
DI float bfhi(unsigned w) { return __uint_as_float(w & 0xffff0000u); }
DI f32x4 mfma16(bf16x8 a, bf16x8 b, f32x4 c) { return __builtin_amdgcn_mfma_f32_16x16x32_bf16(a, b, c, 0, 0, 0); }
DI f32x16 mfma32(bf16x8 a, bf16x8 b, f32x16 c) { return __builtin_amdgcn_mfma_f32_32x32x16_bf16(a, b, c, 0, 0, 0); }
DI float sigmoidf_(float x) { return __builtin_amdgcn_rcpf(1.f + __expf(-x)); }
DI float siluf_(float x) { return x * __builtin_amdgcn_rcpf(1.f + __expf(-x)); }
DI int opaque_tid() { int t = threadIdx.x; asm volatile("" : "+v"(t)); return t; }
DI int crow(int r, int hi) { return (r & 3) + 8 * (r >> 2) + 4 * hi; }

constexpr int T = 16384, SEQ = 8192, DM = 1024, DFF = 4096, INC = 14384;
constexpr float EPS = 1e-6f;
constexpr size_t MiB = 1u << 20;
constexpr size_t WS_ROWSQ = 0;
constexpr size_t WS_BAR = 448 * 1024;
constexpr size_t WS_DECG = 512 * 1024;
constexpr size_t WS_DECS = 768 * 1024;
constexpr size_t WS_SSQ = 1 * MiB;
constexpr size_t WS_SMALL = 2 * MiB;
constexpr size_t WS_XB = 6 * MiB;
constexpr size_t WS_MIXB = 38 * MiB;
constexpr size_t WS_WT = 70 * MiB;
constexpr size_t WT_GD = 0, WT_S = WT_GD + (size_t)8448 * 1024 * 2, WT_GLA = WT_S + (size_t)6144 * 1024 * 2, WT_SSM = WT_GLA + 2 * MiB,
                 WT_DIFF = WT_SSM + 4 * MiB, WT_OUT = WT_DIFF + 2 * MiB, WT_UP = WT_OUT + 2 * MiB, WT_DOWN = WT_UP + 8 * MiB, WT_END = WT_DOWN + 8 * MiB;
static_assert(WT_END <= 56 * MiB, "wt");
constexpr size_t WS_R = 126 * MiB;
constexpr size_t BLK = 32 * MiB;
constexpr size_t WS_STG = WS_R + 8 * BLK;
constexpr size_t WS_STS = WS_R + 6 * BLK;
constexpr size_t WS_SIDE = WS_R + 9 * BLK;
constexpr size_t SB_HN = WS_SIDE, SB_PROJ = SB_HN + 512 * 1024, SB_KV = SB_PROJ + 128 * 1024, SB_Y = SB_KV + 1024 * 1024, SB_GATE = SB_Y + 32 * 1024,
                 SB_BR = SB_GATE + 32 * 1024, SB_MIX = SB_BR + 32 * 1024, SB_XM = SB_MIX + 8192, SB_H2 = SB_XM + 8192, SB_UP = SB_H2 + 8192,
                 SB_HH = SB_UP + 32768, SB_X1 = SB_HH + 32768, SB_HN1 = SB_X1 + 8192, SB_QK1 = SB_HN1 + 8192, SB_END = SB_QK1 + 8192;
constexpr size_t WS_END = WS_SIDE + 2 * MiB;
static_assert(SB_END <= WS_END, "side");

struct Params {
    const float* in[27];
    float* out; unsigned char* ws;
    int ph_lo, ph_hi;
};

namespace pg8 {
constexpr int BM = 256, BK = 64, HALF = 128, HTB = HALF * BK * 2, STAGE_BYTES = 8 * HTB, NXCD = 8, WGM = 8;
__host__ __device__ __forceinline__ int lds_byte(int r, int c) { const int st = (r >> 4) * 2 + (c >> 5), rr = r & 15, cc = c & 31, ob = rr * 64 + cc * 2; return st * 1024 + (ob ^ (((ob >> 9) & 1) << 5)); }
__host__ __device__ __forceinline__ void stage_rc(int b, int& R, int& C) { const int st = b / 1024, sb = b % 1024, swz = sb ^ (((sb >> 9) & 1) << 5); R = (st >> 1) * 16 + swz / 64; C = (st & 1) * 32 + (swz % 64) / 2; }
__host__ __device__ __forceinline__ int perm32(int rho) { const int n = rho >> 4, i = rho & 15; return 8 * (i >> 2) + 4 * n + (i & 3); }
struct Unit { int pm, pn; };
struct Gemm { const bf16_t* A; const bf16_t* Bt; int M, N, K, lda, ldb; };
struct StaticOrder {
    int nM, nN, nwg, G, c;
    __host__ __device__ void init(int M, int N, int G_, int c_) { nM = M / BM; nN = N / BM; nwg = nM * nN; G = G_; c = c_; }
    __host__ __device__ bool next(int i, Unit& u) const {
        const long L = (long)i * G + c; if (L >= nwg) return false;
        int wgid = (int)L; { const int q = nwg / NXCD, r = nwg % NXCD, xcd = wgid % NXCD, off = wgid / NXCD; wgid = (xcd < r ? xcd * (q + 1) : r * (q + 1) + (xcd - r) * q) + off; }
        const int nig = WGM * nN, gid = wgid / nig, fm = gid * WGM, gsz = (nM - fm) < WGM ? (nM - fm) : WGM;
        u.pm = fm + ((wgid % nig) % gsz); u.pn = (wgid % nig) / gsz; return true;
    }
};
template <class Epi, class Sched>
__device__ __forceinline__ void gemm_phase(LAS unsigned char* lds, const Gemm g, const Sched& S, const Epi& E) {
    const int tid = opaque_tid(), wid = __builtin_amdgcn_readfirstlane(tid >> 6), lane = tid & 63, wr = wid >> 2, wc = wid & 3, fr = lane & 15, fq = lane >> 4;
    const int K = g.K, nt = K / BK;
    unsigned voffA[2], voffB[2];
#pragma unroll
    for (int i = 0; i < 2; ++i) { int R, C; stage_rc(tid * 16 + i * 8192, R, C);
        const int Rb = (R & ~31) + perm32(R & 31);
        voffA[i] = (unsigned)(R * g.lda + C) * 2u; voffB[i] = (unsigned)(Rb * g.ldb + C) * 2u; }
    const size_t kstep = (size_t)(BK * 2);
    const size_t hstepA = (size_t)HALF * g.lda * 2, hstepB = (size_t)HALF * g.ldb * 2;
    const size_t tstepA = 2 * hstepA, tstepB = 2 * hstepB;
    const unsigned ldsw = (unsigned)wid * 1024u;
    const int aoff = lds_byte(wr * 64 + fr, fq * 8), boff = lds_byte(wc * 32 + fr, fq * 8);
#define PG8_SA(b, h) (((b) * 2 + (h)) * HTB)
#define PG8_SB(b, h) ((4 + (b) * 2 + (h)) * HTB)
#define PG8_STAGE(bufoff, gbase, voff) do { _Pragma("unroll") for (int _i = 0; _i < 2; ++_i) \
        __builtin_amdgcn_global_load_lds((const unsigned*)((const char*)(gbase) + (voff)[_i]), (LAS unsigned*)(lds + (bufoff) + ldsw + _i * 8192), 16, 0, 0); } while (0)
#define PG8_LDA(dst, b, h) do { _Pragma("unroll") for (int m = 0; m < 4; ++m) _Pragma("unroll") for (int k = 0; k < 2; ++k) dst[m][k] = *(const LAS bf16x8*)(lds + PG8_SA(b, h) + aoff + m * 2048 + k * 1024); } while (0)
#define PG8_LDB(dst, b, h) do { _Pragma("unroll") for (int n = 0; n < 2; ++n) _Pragma("unroll") for (int k = 0; k < 2; ++k) dst[n][k] = *(const LAS bf16x8*)(lds + PG8_SB(b, h) + boff + n * 2048 + k * 1024); } while (0)
#define PG8_MMA(ai, bj, At, Bt) do { __builtin_amdgcn_s_setprio(1); _Pragma("unroll") for (int m = 0; m < 4; ++m) _Pragma("unroll") for (int n = 0; n < 2; ++n) _Pragma("unroll") for (int k = 0; k < 2; ++k) \
        acc[ai][bj][m][n] = __builtin_amdgcn_mfma_f32_16x16x32_bf16(Bt[n][k], At[m][k], acc[ai][bj][m][n], 0, 0, 0); __builtin_amdgcn_s_setprio(0); } while (0)
#define PG8_WAIT_V(n) asm volatile("s_waitcnt vmcnt(" #n ")" ::: "memory")
#define PG8_WAIT_L(n) asm volatile("s_waitcnt lgkmcnt(" #n ")" ::: "memory")
#define PG8_BAR __builtin_amdgcn_s_barrier()
#define PG8_SCHED __builtin_amdgcn_sched_barrier(0)
    Unit cur, nxt; int ui = 0;
    if (!S.next(0, cur)) return;
    f32x4 acc[2][2][4][2];
#pragma unroll
    for (int a = 0; a < 2; ++a)
#pragma unroll
        for (int b = 0; b < 2; ++b)
#pragma unroll
            for (int m = 0; m < 4; ++m)
#pragma unroll
                for (int n = 0; n < 2; ++n) acc[a][b][m][n] = (f32x4){0.f, 0.f, 0.f, 0.f};
    bf16x8 At[4][2], B0[2][2], B1[2][2];
    const char* cA = (const char*)g.A + (size_t)cur.pm * tstepA; const char* cB = (const char*)g.Bt + (size_t)cur.pn * tstepB;
    PG8_STAGE(PG8_SB(0, 0), cB, voffB); PG8_STAGE(PG8_SB(0, 1), cB + hstepB, voffB); PG8_STAGE(PG8_SA(0, 0), cA, voffA); PG8_STAGE(PG8_SA(0, 1), cA + hstepA, voffA);
    if (wr == 1) PG8_BAR;
    PG8_WAIT_V(2); PG8_BAR;
    PG8_STAGE(PG8_SB(1, 0), cB + kstep, voffB); PG8_STAGE(PG8_SA(1, 0), cA + kstep, voffA); PG8_STAGE(PG8_SB(1, 1), cB + hstepB + kstep, voffB);
    PG8_WAIT_V(6); PG8_BAR;
    for (;;) {
        const bool has_next = S.next(ui + 1, nxt);
        const char* nA = has_next ? (const char*)g.A + (size_t)nxt.pm * tstepA : cA; const char* nB = has_next ? (const char*)g.Bt + (size_t)nxt.pn * tstepB : cB;
        for (int t = 0; t < nt; t += 2) {
            const bool last = (t == nt - 2);
            const char* a1 = cA + (size_t)(t + 1) * kstep;
            const char* a2 = last ? nA : cA + (size_t)(t + 2) * kstep; const char* b2 = last ? nB : cB + (size_t)(t + 2) * kstep;
            const char* a3 = a2 + kstep; const char* b3 = b2 + kstep;
            PG8_LDB(B0, 0, 0); PG8_LDB(B1, 0, 1); PG8_SCHED; PG8_LDA(At, 0, 0); PG8_STAGE(PG8_SA(1, 1), a1 + hstepA, voffA);
            PG8_WAIT_V(8); PG8_WAIT_L(0); PG8_BAR; PG8_MMA(0, 0, At, B0); PG8_MMA(0, 1, At, B1); PG8_BAR; PG8_SCHED;
            PG8_LDA(At, 0, 1); PG8_STAGE(PG8_SB(0, 0), b2, voffB); PG8_STAGE(PG8_SB(0, 1), b2 + hstepB, voffB); PG8_STAGE(PG8_SA(0, 0), a2, voffA);
            PG8_WAIT_V(8); PG8_WAIT_L(0); PG8_BAR; PG8_MMA(1, 0, At, B0); PG8_MMA(1, 1, At, B1); PG8_BAR; PG8_SCHED;
            PG8_LDB(B0, 1, 0); PG8_LDB(B1, 1, 1); PG8_SCHED; PG8_LDA(At, 1, 0); PG8_STAGE(PG8_SA(0, 1), a2 + hstepA, voffA);
            PG8_WAIT_V(8); PG8_WAIT_L(0); PG8_BAR; PG8_MMA(0, 0, At, B0); PG8_MMA(0, 1, At, B1); PG8_BAR; PG8_SCHED;
            PG8_LDA(At, 1, 1); PG8_STAGE(PG8_SB(1, 0), b3, voffB); PG8_STAGE(PG8_SB(1, 1), b3 + hstepB, voffB); PG8_STAGE(PG8_SA(1, 0), a3, voffA);
            PG8_WAIT_V(8); PG8_WAIT_L(0); PG8_BAR; PG8_MMA(1, 0, At, B0); PG8_MMA(1, 1, At, B1); PG8_BAR; PG8_SCHED;
        }
        if (wr == 0) PG8_BAR;
        E(acc, cur, wr, wc, fr, fq);
        if (!has_next) break;
#pragma unroll
        for (int a = 0; a < 2; ++a)
#pragma unroll
            for (int b = 0; b < 2; ++b)
#pragma unroll
                for (int m = 0; m < 4; ++m)
#pragma unroll
                    for (int n = 0; n < 2; ++n) acc[a][b][m][n] = (f32x4){0.f, 0.f, 0.f, 0.f};
        cur = nxt; cA = nA; cB = nB; ++ui;
        if (wr == 1) PG8_BAR;
    }
    PG8_WAIT_V(0);
    PG8_BAR;
#undef PG8_SA
#undef PG8_SB
#undef PG8_STAGE
#undef PG8_LDA
#undef PG8_LDB
#undef PG8_MMA
#undef PG8_WAIT_V
#undef PG8_WAIT_L
#undef PG8_BAR
#undef PG8_SCHED
}
}

typedef f32x4 Acc[2][2][4][2];
#define EPI_ROWS(...) _Pragma("unroll") for (int ai = 0; ai < 2; ++ai) _Pragma("unroll") for (int m = 0; m < 4; ++m) { const int row = u.pm * 256 + ai * 128 + wr * 64 + m * 16 + fr; __VA_ARGS__ }
#define EPI_COLS(...) _Pragma("unroll") for (int bj = 0; bj < 2; ++bj) _Pragma("unroll") for (int n = 0; n < 2; ++n) { const int ct = bj * 128 + wc * 32 + fq * 8 + n * 4; __VA_ARGS__ }

struct EpiIn {
    bf16_t* R; const float* rowsq; float* small; int small_tile; int gblkA, gblkB; const float* biasA; const float* biasB;
    DI void operator()(const Acc& acc, const pg8::Unit& u, int wr, int wc, int fr, int fq) const {
        const int blk = u.pn >> 2, cb = (u.pn & 3) * 256;
        float rs[2][4];
        EPI_ROWS( rs[ai][m] = rsqrtf(rowsq[row] * (1.f / 1024.f) + EPS); )
        if (u.pn == small_tile) {
            asm volatile("" ::: "memory");
            EPI_ROWS( EPI_COLS( if (ct < 64) *(f32x4*)(small + (size_t)row * 64 + ct) = acc[ai][bj][m][n] * rs[ai][m]; ) )
            return;
        }
        bf16_t* dst = R + (size_t)blk * (BLK / 2);
        const float* bias = (blk == gblkA) ? biasA : ((blk == gblkB) ? biasB : nullptr);
        if (bias) {
            f32x4 bv[2][2];
            EPI_COLS( bv[bj][n] = *(const f32x4*)(bias + cb + ct); )
            asm volatile("" ::: "memory");
            EPI_ROWS( EPI_COLS( const f32x4 v = acc[ai][bj][m][n] * rs[ai][m] + bv[bj][n];
                u32x2 w; w.x = pk2(sigmoidf_(v[0]), sigmoidf_(v[1])); w.y = pk2(sigmoidf_(v[2]), sigmoidf_(v[3])); *(u32x2*)(dst + (size_t)row * 1024 + cb + ct) = w; ) )
        } else {
            asm volatile("" ::: "memory");
            EPI_ROWS( EPI_COLS( const f32x4 v = acc[ai][bj][m][n] * rs[ai][m];
                u32x2 w; w.x = pk2(v[0], v[1]); w.y = pk2(v[2], v[3]); *(u32x2*)(dst + (size_t)row * 1024 + cb + ct) = w; ) )
        }
    }
};
struct EpiMix {
    bf16_t* mixb; const bf16_t* gate; const float* ssq; int grp; int first;
    DI void operator()(const Acc& acc, const pg8::Unit& u, int wr, int wc, int fr, int fq) const {
        float rs[8];
#pragma unroll
        for (int r = 0; r < 8; ++r) { const int row = u.pm * 256 + (r >> 2) * 128 + wr * 64 + (r & 3) * 16 + fr; rs[r] = ssq ? rsqrtf(ssq[(size_t)row * 4 + grp] * (1.f / 512.f) + EPS) : 1.f; }
        u32x2 gw[2][4], mw[2][4];
#define MIX_LOAD(r, buf) do { const int row_ = u.pm * 256 + ((r) >> 2) * 128 + wr * 64 + ((r) & 3) * 16 + fr; _Pragma("unroll") for (int c_ = 0; c_ < 4; ++c_) { \
            const size_t o_ = (size_t)row_ * 1024 + u.pn * 256 + (c_ >> 1) * 128 + wc * 32 + fq * 8 + (c_ & 1) * 4; gw[buf][c_] = *(const u32x2*)(gate + o_); mw[buf][c_] = first ? (u32x2){0u, 0u} : *(const u32x2*)(mixb + o_); } } while (0)
        MIX_LOAD(0, 0);
#pragma unroll
        for (int r = 0; r < 8; ++r) { const int cur = r & 1;
            if (r < 7) MIX_LOAD(r + 1, cur ^ 1);
            asm volatile("" ::: "memory");
            const int row = u.pm * 256 + (r >> 2) * 128 + wr * 64 + (r & 3) * 16 + fr;
#pragma unroll
            for (int c = 0; c < 4; ++c) { const size_t o = (size_t)row * 1024 + u.pn * 256 + (c >> 1) * 128 + wc * 32 + fq * 8 + (c & 1) * 4;
                const f32x4 v = acc[r >> 2][c >> 1][r & 3][c & 1] * rs[r]; const u32x2 g2 = gw[cur][c], m2 = mw[cur][c];
                f32x4 q; q[0] = bflo(g2.x) * v[0] + bflo(m2.x); q[1] = bfhi(g2.x) * v[1] + bfhi(m2.x); q[2] = bflo(g2.y) * v[2] + bflo(m2.y); q[3] = bfhi(g2.y) * v[3] + bfhi(m2.y);
                u32x2 w; w.x = pk2(q[0], q[1]); w.y = pk2(q[2], q[3]); *(u32x2*)(mixb + o) = w; } }
#undef MIX_LOAD
    }
};
struct EpiRes {
    const float* xold; float* xnew; bf16_t* xb; float* rowsq;
    DI void operator()(const Acc& acc, const pg8::Unit& u, int wr, int wc, int fr, int fq) const {
        f32x4 xo[2][4];
#define RES_LOAD(r, buf) do { const int row_ = u.pm * 256 + ((r) >> 2) * 128 + wr * 64 + ((r) & 3) * 16 + fr; _Pragma("unroll") for (int c_ = 0; c_ < 4; ++c_) \
            xo[buf][c_] = *(const f32x4*)(xold + (size_t)row_ * 1024 + u.pn * 256 + (c_ >> 1) * 128 + wc * 32 + fq * 8 + (c_ & 1) * 4); } while (0)
        RES_LOAD(0, 0);
#pragma unroll
        for (int r = 0; r < 8; ++r) { const int cur = r & 1;
            if (r < 7) RES_LOAD(r + 1, cur ^ 1);
            asm volatile("" ::: "memory");
            const int row = u.pm * 256 + (r >> 2) * 128 + wr * 64 + (r & 3) * 16 + fr; float ss = 0.f;
#pragma unroll
            for (int c = 0; c < 4; ++c) { const size_t o = (size_t)row * 1024 + u.pn * 256 + (c >> 1) * 128 + wc * 32 + fq * 8 + (c & 1) * 4;
                const f32x4 v = acc[r >> 2][c >> 1][r & 3][c & 1] + xo[cur][c]; *(f32x4*)(xnew + o) = v;
                u32x2 w; w.x = pk2(v[0], v[1]); w.y = pk2(v[2], v[3]); *(u32x2*)(xb + o) = w;
                ss += v[0] * v[0] + v[1] * v[1] + v[2] * v[2] + v[3] * v[3]; }
            ss += __shfl_xor(ss, 16); ss += __shfl_xor(ss, 32);
            if (fq == 0) atomicAdd(rowsq + row, ss); }
#undef RES_LOAD
    }
};
struct EpiUp {
    bf16_t* h; const float* rowsq;
    DI void operator()(const Acc& acc, const pg8::Unit& u, int wr, int wc, int fr, int fq) const {
        float rs[2][4];
        EPI_ROWS( rs[ai][m] = rsqrtf(rowsq[row] * (1.f / 1024.f) + EPS); )
        asm volatile("" ::: "memory");
        EPI_ROWS( EPI_COLS( const f32x4 v = acc[ai][bj][m][n] * rs[ai][m];
            f32x4 r; r[0] = fmaxf(v[0], 0.f); r[1] = fmaxf(v[1], 0.f); r[2] = fmaxf(v[2], 0.f); r[3] = fmaxf(v[3], 0.f); r = r * r;
            u32x2 w; w.x = pk2(r[0], r[1]); w.y = pk2(r[2], r[3]); *(u32x2*)(h + (size_t)row * 4096 + u.pn * 256 + ct) = w; ) )
    }
};

DI int colmap(int kind, int n) {
    if (kind == 1) {
        if (n < 2048) return n;
        if (n < 3072) return 2064 + (n - 2048);
        if (n < 4096) return 11312 + (n - 3072);
        if (n < 5120) return 8240 + (n - 4096);
        if (n < 6144) return 9264 + (n - 5120);
        if (n < 7168) return 10288 + (n - 6144);
        if (n < 8192) return 13360 + (n - 7168);
        const int i = n - 8192; if (i < 16) return 2048 + i; if (i < 48) return 8208 + (i - 16); return -1;
    }
    if (kind == 2) {
        if (n < 2048) return 3088 + n;
        if (n < 5120) return 5136 + (n - 2048);
        return 12336 + (n - 5120);
    }
    return n;
}
DI void tr_item(const float* W, int ldw, int K, bf16_t* WT, const float* kscale, int kind, int kb, int nb, LAS float* scr, int lane) {
    const int k0 = 64 * kb, n0 = 32 * nb; const int sc = colmap(kind, n0 + (lane & 31));
#pragma unroll 8
    for (int i = 0; i < 32; ++i) { const int kk = 2 * i + (lane >> 5); float v = 0.f; if (sc >= 0) { v = W[(size_t)(k0 + kk) * ldw + sc]; if (kscale) v *= kscale[k0 + kk]; } scr[kk * 33 + (lane & 31)] = v; }
    asm volatile("s_waitcnt lgkmcnt(0)" ::: "memory");
    const int c = lane & 7;
#pragma unroll
    for (int j = 0; j < 4; ++j) { const int n = (lane >> 3) + 8 * j; const LAS float* s = scr + (8 * c) * 33 + n;
        u32x4 o; o.x = pk2(s[0 * 33], s[1 * 33]); o.y = pk2(s[2 * 33], s[3 * 33]); o.z = pk2(s[4 * 33], s[5 * 33]); o.w = pk2(s[6 * 33], s[7 * 33]);
        *(u32x4*)(WT + (size_t)(n0 + n) * K + k0 + 8 * c) = o; }
    asm volatile("s_waitcnt lgkmcnt(0)" ::: "memory");
}
DI float wave_sum(float v) {
#pragma unroll
    for (int o = 1; o < 64; o <<= 1) v += __shfl_xor(v, o);
    return v;
}
DI void phase_prep(const Params& p, int l, LAS unsigned char* lds) {
    const int tid = opaque_tid(), lane = tid & 63, wave = __builtin_amdgcn_readfirstlane(tid >> 6);
    const int gw = blockIdx.x * 8 + wave, NGW = gridDim.x * 8;
    LAS float* scr = (LAS float*)(lds + wave * 8704);
    unsigned char* ws = p.ws; bf16_t* wt = (bf16_t*)(ws + WS_WT);
    const float* w_in = p.in[3] + (size_t)l * 1024 * INC;
    constexpr int I0 = 16 * 264, I1 = 16 * 192, I2 = 16 * 32, I3 = 32 * 32, I4 = 16 * 32, I5 = 16 * 32, I6 = 16 * 128, I7 = 64 * 32;
    constexpr int NIT = I0 + I1 + I2 + I3 + I4 + I5 + I6 + I7;
    for (int it = gw; it < NIT; it += NGW) {
        int r = it;
        if (r < I0) { tr_item(w_in, INC, 1024, (bf16_t*)((char*)wt + WT_GD), p.in[2] + l * 1024, 1, r / 264, r % 264, scr, lane); continue; } r -= I0;
        if (r < I1) { tr_item(w_in, INC, 1024, (bf16_t*)((char*)wt + WT_S), p.in[2] + l * 1024, 2, r / 192, r % 192, scr, lane); continue; } r -= I1;
        if (r < I2) { tr_item(p.in[19] + (size_t)l * 1024 * 1024, 1024, 1024, (bf16_t*)((char*)wt + WT_GLA), nullptr, 0, r / 32, r % 32, scr, lane); continue; } r -= I2;
        if (r < I3) { tr_item(p.in[20] + (size_t)l * 2048 * 1024, 1024, 2048, (bf16_t*)((char*)wt + WT_SSM), p.in[13] + l * 2048, 0, r / 32, r % 32, scr, lane); continue; } r -= I3;
        if (r < I4) { tr_item(p.in[21] + (size_t)l * 1024 * 1024, 1024, 1024, (bf16_t*)((char*)wt + WT_DIFF), nullptr, 0, r / 32, r % 32, scr, lane); continue; } r -= I4;
        if (r < I5) { tr_item(p.in[22] + (size_t)l * 1024 * 1024, 1024, 1024, (bf16_t*)((char*)wt + WT_OUT), nullptr, 0, r / 32, r % 32, scr, lane); continue; } r -= I5;
        if (r < I6) { tr_item(p.in[24] + (size_t)l * 1024 * 4096, 4096, 1024, (bf16_t*)((char*)wt + WT_UP), p.in[23] + l * 1024, 0, r / 128, r % 128, scr, lane); continue; } r -= I6;
        tr_item(p.in[25] + (size_t)l * 4096 * 1024, 1024, 4096, (bf16_t*)((char*)wt + WT_DOWN), nullptr, 0, r / 32, r % 32, scr, lane);
    }
    const int gt = blockIdx.x * 512 + tid, NT_ = gridDim.x * 512;
    float* ssq = (float*)(ws + WS_SSQ);
    for (int i = gt; i < T * 4; i += NT_) ssq[i] = 0.f;
    if (l == 0) {
        float* rowsq = (float*)(ws + WS_ROWSQ);
        for (int i = gt; i < 4 * T; i += NT_) rowsq[T + i] = 0.f;
        bf16_t* xb = (bf16_t*)(ws + WS_XB); const float* x = p.in[0];
        for (int m = gw; m < T; m += NGW) {
            const f32x4* xr = (const f32x4*)(x + (size_t)m * 1024) + lane; float s = 0.f;
            u32x2* o = (u32x2*)(xb + (size_t)m * 1024) + lane;
#pragma unroll
            for (int j = 0; j < 4; ++j) { const f32x4 v = xr[64 * j]; s += v[0] * v[0] + v[1] * v[1] + v[2] * v[2] + v[3] * v[3]; u32x2 w; w.x = pk2(v[0], v[1]); w.y = pk2(v[2], v[3]); o[64 * j] = w; }
            s = wave_sum(s); if (lane == 0) rowsq[m] = s;
        }
    }
}

DI void rope_pass(const Params& p) {
    const int* pos = (const int*)p.in[1];
    bf16_t* Qd = (bf16_t*)(p.ws + WS_R + 4 * BLK); bf16_t* Kd = (bf16_t*)(p.ws + WS_R + 5 * BLK);
    const double cf[8] = {0.15915494309189535, 0.03086376340470123, 0.005985185712713705, 0.001160663641240061, 0.00022507907903927653, 4.364795279280289e-05, 8.464330808241401e-06, 1.6414262627950345e-06};
    const int gt = blockIdx.x * 512 + opaque_tid(), NTH = gridDim.x * 512;
    for (int it = gt; it < T * 32; it += NTH) {
        const int t = it >> 5, w = it & 31; bf16_t* base = ((w & 16) ? Kd : Qd) + (size_t)t * 1024 + (w & 15) * 64;
        const double ps = (double)pos[t];
        u32x4 a = *(u32x4*)base, b = *(u32x4*)(base + 8);
        float t1[8], t2[8];
#pragma unroll
        for (int i = 0; i < 4; ++i) { t1[2 * i] = bflo(a[i]); t1[2 * i + 1] = bfhi(a[i]); t2[2 * i] = bflo(b[i]); t2[2 * i + 1] = bfhi(b[i]); }
        float o1[8], o2[8];
#pragma unroll
        for (int i = 0; i < 8; ++i) { double rv = ps * cf[i]; rv -= floor(rv); const float fr = (float)rv; const float sn = __builtin_amdgcn_sinf(fr), cs = __builtin_amdgcn_cosf(fr);
            o1[i] = t1[i] * cs - t2[i] * sn; o2[i] = t2[i] * cs + t1[i] * sn; }
#pragma unroll
        for (int i = 0; i < 4; ++i) { a[i] = pk2(o1[2 * i], o1[2 * i + 1]); b[i] = pk2(o2[2 * i], o2[2 * i + 1]); }
        *(u32x4*)base = a; *(u32x4*)(base + 8) = b;
    }
}

template <int KS> DI f32x4 mm16(f32x4 acc, const LAS unsigned char* A, int lda_b, const LAS unsigned char* B, int ldb_b, int lane) {
    const int r = lane & 15, q = lane >> 4;
    const LAS unsigned char* ap = A + r * lda_b + q * 16; const LAS unsigned char* bp = B + r * ldb_b + q * 16;
#pragma unroll
    for (int s = 0; s < KS; ++s) acc = mfma16(*(const LAS bf16x8*)(ap + s * 64), *(const LAS bf16x8*)(bp + s * 64), acc);
    return acc;
}
DI float logsigmoidf_(float x) { return fminf(x, 0.f) - __logf(1.f + __expf(-fabsf(x))); }

constexpr int G_GKL = 0, G_QTOT = 4096, G_BLAST = 6144, G_PART = 6656, G_QT = 8704, G_KT = 26112, G_KHT = 43520, G_VT = 61952, G_P = 98816;
template <int MODE> DI void gla_unit(const Params& p, int l, int un, LAS unsigned char* lds) {
    const int tid = opaque_tid(), lane = tid & 63, w = __builtin_amdgcn_readfirstlane(tid >> 6), r16 = lane & 15, quad = lane >> 4;
    const int sc = un >> 2, h = un & 3, tok0 = sc * 256;
    unsigned char* ws = p.ws;
    const bf16_t* QK = (const bf16_t*)(ws + WS_R); const bf16_t* Vg = (const bf16_t*)(ws + WS_R + BLK); bf16_t* Gg = (bf16_t*)(ws + WS_R + 2 * BLK);
    const float* small = (const float*)(ws + WS_SMALL);
    float* states = (float*)(ws + WS_STG) + (size_t)un * 32768;
    const int d = tid & 127, qr = tid >> 7;
    float wk[16];
#pragma unroll
    for (int r = 0; r < 16; ++r) wk[r] = p.in[5][(size_t)l * 16 * 512 + r * 512 + h * 128 + d];
    const float bk = p.in[6][l * 512 + h * 128 + d];
    f32x4 S[8][2];
    if (MODE == 3) {
#pragma unroll
        for (int mb = 0; mb < 8; ++mb)
#pragma unroll
            for (int nb = 0; nb < 2; ++nb) S[mb][nb] = *(const f32x4*)(states + ((size_t)(w * 16 + mb * 2 + nb) * 64 + lane) * 4);
    } else {
#pragma unroll
        for (int mb = 0; mb < 8; ++mb)
#pragma unroll
            for (int nb = 0; nb < 2; ++nb) S[mb][nb] = (f32x4){0.f, 0.f, 0.f, 0.f};
    }
    float ng[2] = {0.f, 0.f};
    if (MODE == 3) { ng[0] = p.in[7][l * 256 + 32 * w + r16]; ng[1] = p.in[7][l * 256 + 32 * w + 16 + r16]; }
    float dtot = 1.f;
    for (int j = 0; j < 4; ++j) {
        const int t0 = tok0 + 64 * j;
        if (tid < 256) { const int row = tid >> 2, c4 = (tid & 3) * 4; *(LAS f32x4*)(lds + G_GKL + (row * 16 + c4) * 4) = *(const f32x4*)(small + (size_t)(t0 + row) * 64 + c4); }
        if (tid < 64) ((LAS float*)(lds + G_PART))[tid] = 0.f;
        __syncthreads();
        float c[16]; float run = 0.f;
#pragma unroll
        for (int i = 0; i < 16; ++i) { const LAS f32x4* gr = (const LAS f32x4*)(lds + G_GKL) + (qr * 16 + i) * 4; float x = bk;
#pragma unroll
            for (int r = 0; r < 4; ++r) { const f32x4 g4 = gr[r]; x += g4[0] * wk[4 * r] + g4[1] * wk[4 * r + 1] + g4[2] * wk[4 * r + 2] + g4[3] * wk[4 * r + 3]; }
            run += logsigmoidf_(x) * (1.f / 16.f); c[i] = run; }
        ((LAS float*)(lds + G_QTOT))[qr * 128 + d] = run;
        __syncthreads();
        {
            float off = 0.f, bl = 0.f;
#pragma unroll
            for (int q2 = 0; q2 < 4; ++q2) { const float v = ((const LAS float*)(lds + G_QTOT))[q2 * 128 + d]; bl += v; if (q2 < qr) off += v; }
            unsigned khp[8]; const float ebl = __expf(bl);
#pragma unroll
            for (int i = 0; i < 16; i += 2) {
                float kh2[2];
#pragma unroll
                for (int e = 0; e < 2; ++e) { const int t = qr * 16 + i + e; const float b = off + c[i + e];
                    const float k = bf2f(QK[(size_t)(t0 + t) * 1024 + 512 + h * 128 + d]);
                    const float enb = __expf(-b), kt_ = k * enb;
                    kh2[e] = kt_ * ebl;
                    if (MODE == 3) { const float q = bf2f(QK[(size_t)(t0 + t) * 1024 + h * 128 + d]);
                        ((LAS bf16_t*)(lds + G_QT))[t * 136 + d] = f2bf(q * 0.08838834764831845f * __builtin_amdgcn_rcpf(enb));
                        ((LAS bf16_t*)(lds + G_KT))[t * 136 + d] = f2bf(kt_); } }
                khp[i >> 1] = pk2(kh2[0], kh2[1]);
            }
            *(LAS u32x4*)(lds + G_KHT + d * 144 + qr * 32) = (u32x4){khp[0], khp[1], khp[2], khp[3]};
            *(LAS u32x4*)(lds + G_KHT + d * 144 + qr * 32 + 16) = (u32x4){khp[4], khp[5], khp[6], khp[7]};
            if (qr == 0) { ((LAS float*)(lds + G_BLAST))[d] = bl; dtot *= ebl; }
#pragma unroll
            for (int i = 0; i < 4; ++i) { const int pid = tid + 512 * i, g8 = pid >> 6, t = pid & 63;
                const u32x4 v = *(const u32x4*)(Vg + (size_t)(t0 + t) * 1024 + h * 256 + g8 * 8);
                LAS bf16_t* vt = (LAS bf16_t*)(lds + G_VT) + (g8 * 8) * 72 + t;
#pragma unroll
                for (int e = 0; e < 4; ++e) { vt[(2 * e) * 72] = (bf16_t)(v[e] & 0xffffu); vt[(2 * e + 1) * 72] = (bf16_t)(v[e] >> 16); } }
        }
        __syncthreads();
        if (MODE == 3) {
#pragma unroll
            for (int e = 0; e < 2; ++e) { const int x = 2 * w + e, tb = x >> 2, sb = x & 3;
                f32x4 a = (f32x4){0.f, 0.f, 0.f, 0.f};
                if (sb <= tb) a = mm16<4>(a, lds + G_KT + sb * 16 * 272, 272, lds + G_QT + tb * 16 * 272, 272, lane);
                const int t = 16 * tb + r16, s0 = 16 * sb + quad * 4;
                float v[4];
#pragma unroll
                for (int jj = 0; jj < 4; ++jj) v[jj] = (s0 + jj <= t) ? a[jj] : 0.f;
                if (x == 0 && lane == 0 && j == 0 && (tok0 & (SEQ - 1)) == 0) { const float* qk_ = (l == 0) ? (const float*)(ws + SB_PROJ) + (tok0 >> 13) * 14384 : (const float*)(ws + SB_QK1) + (tok0 >> 13) * 1024;
                    float acc_ = 0.f; for (int d_ = 0; d_ < 128; ++d_) acc_ += qk_[h * 128 + d_] * qk_[512 + h * 128 + d_]; v[0] = acc_ * 0.08838834764831845f; }
                *(LAS u32x2*)(lds + G_P + t * 144 + s0 * 2) = (u32x2){pk2(v[0], v[1]), pk2(v[2], v[3])}; }
            f32x4 o[4][2];
#pragma unroll
            for (int mb = 0; mb < 4; ++mb) { o[mb][0] = (f32x4){0.f, 0.f, 0.f, 0.f}; o[mb][1] = (f32x4){0.f, 0.f, 0.f, 0.f}; }
#pragma unroll
            for (int ks = 0; ks < 4; ++ks) {
                bf16x8 bf[2];
#pragma unroll
                for (int nb = 0; nb < 2; ++nb) { const f32x4 s0v = S[2 * ks][nb], s1v = S[2 * ks + 1][nb];
                    u32x4 pk; pk.x = pk2(s0v[0], s0v[1]); pk.y = pk2(s0v[2], s0v[3]); pk.z = pk2(s1v[0], s1v[1]); pk.w = pk2(s1v[2], s1v[3]); bf[nb] = __builtin_bit_cast(bf16x8, pk); }
#pragma unroll
                for (int mb = 0; mb < 4; ++mb) { const LAS unsigned char* ap = lds + G_QT + (16 * mb + r16) * 272 + (32 * ks + quad * 4) * 2;
                    const u32x2 lo = *(const LAS u32x2*)ap, hi = *(const LAS u32x2*)(ap + 32);
                    const bf16x8 af = __builtin_bit_cast(bf16x8, (u32x4){lo.x, lo.y, hi.x, hi.y});
                    o[mb][0] = mfma16(af, bf[0], o[mb][0]); o[mb][1] = mfma16(af, bf[1], o[mb][1]); }
            }
            __syncthreads();
#pragma unroll
            for (int mb = 0; mb < 4; ++mb)
#pragma unroll
                for (int nb = 0; nb < 2; ++nb) o[mb][nb] = mm16<2>(o[mb][nb], lds + G_P + mb * 16 * 144, 144, lds + G_VT + (32 * w + 16 * nb) * 144, 144, lane);
#pragma unroll
            for (int mb = 0; mb < 4; ++mb)
#pragma unroll
                for (int jj = 0; jj < 4; ++jj) { float ss = o[mb][0][jj] * o[mb][0][jj] + o[mb][1][jj] * o[mb][1][jj];
                    ss += __shfl_xor(ss, 1); ss += __shfl_xor(ss, 2); ss += __shfl_xor(ss, 4); ss += __shfl_xor(ss, 8);
                    if (r16 == 0) __hip_atomic_fetch_add((LAS float*)(lds + G_PART) + 16 * mb + quad * 4 + jj, ss, __ATOMIC_RELAXED, __HIP_MEMORY_SCOPE_WORKGROUP); }
            __syncthreads();
            bf16_t gin[4][4][2];
#pragma unroll
            for (int mb = 0; mb < 4; ++mb)
#pragma unroll
                for (int jj = 0; jj < 4; ++jj)
#pragma unroll
                    for (int nb = 0; nb < 2; ++nb) gin[mb][jj][nb] = Gg[(size_t)(t0 + 16 * mb + quad * 4 + jj) * 1024 + h * 256 + 32 * w + 16 * nb + r16];
            asm volatile("" ::: "memory");
#pragma unroll
            for (int mb = 0; mb < 4; ++mb)
#pragma unroll
                for (int jj = 0; jj < 4; ++jj) { const int t = 16 * mb + quad * 4 + jj; const float rs = rsqrtf(((const LAS float*)(lds + G_PART))[t] * (1.f / 256.f) + EPS);
#pragma unroll
                    for (int nb = 0; nb < 2; ++nb) { bf16_t* gp = Gg + (size_t)(t0 + t) * 1024 + h * 256 + 32 * w + 16 * nb + r16;
                        *gp = f2bf(o[mb][nb][jj] * rs * ng[nb] * siluf_(bf2f(gin[mb][jj][nb]))); } }
        }
#pragma unroll
        for (int mb = 0; mb < 8; ++mb) { const f32x4 bl4 = *(const LAS f32x4*)(lds + G_BLAST + (16 * mb + quad * 4) * 4);
            const f32x4 dc = (f32x4){__expf(bl4[0]), __expf(bl4[1]), __expf(bl4[2]), __expf(bl4[3])};
#pragma unroll
            for (int nb = 0; nb < 2; ++nb) { S[mb][nb] = S[mb][nb] * dc;
                S[mb][nb] = mm16<2>(S[mb][nb], lds + G_KHT + mb * 16 * 144, 144, lds + G_VT + (32 * w + 16 * nb) * 144, 144, lane); } }
        __syncthreads();
    }
    if (MODE == 1) {
#pragma unroll
        for (int mb = 0; mb < 8; ++mb)
#pragma unroll
            for (int nb = 0; nb < 2; ++nb) *(f32x4*)(states + ((size_t)(w * 16 + mb * 2 + nb) * 64 + lane) * 4) = S[mb][nb];
        if (tid < 128) ((float*)(ws + WS_DECG))[un * 128 + tid] = dtot;
    }
}
DI void gla_scan(const Params& p) {
    const int gid = blockIdx.x * 512 + opaque_tid();
    for (int it = gid; it < 65536; it += gridDim.x * 512) {
        const int chain = it >> 13, e = it & 8191, b = chain >> 2, h = chain & 3;
        const int tile = (e >> 6) & 15, lane = e & 63, d0 = 16 * (tile >> 1) + (lane >> 4) * 4;
        f32x4* st = (f32x4*)(p.ws + WS_STG); const float* dec = (const float*)(p.ws + WS_DECG);
        f32x4 run = (f32x4){0.f, 0.f, 0.f, 0.f};
        for (int hb = 0; hb < 4; ++hb) {
            f32x4 u[8];
#pragma unroll
            for (int s = 0; s < 8; ++s) u[s] = st[(size_t)((b * 32 + hb * 8 + s) * 4 + h) * 8192 + e];
            asm volatile("" ::: "memory");
#pragma unroll
            for (int s = 0; s < 8; ++s) { const int un = (b * 32 + hb * 8 + s) * 4 + h; const f32x4 dc = *(const f32x4*)(dec + un * 128 + d0);
                st[(size_t)un * 8192 + e] = run; run = run * dc + u[s]; }
        }
    }
}

constexpr int S_ACUM = 0, S_DTV = 256, S_MISC = 512, S_XDT = 1024, S_XD2 = 10240, S_BN = 19456, S_BT = 36864, S_CN = 55296, S_GL = 72704, S_SB = 81920;
DI float softplusf_(float x) { const float e = __expf(x); return x > 20.f ? x : (x < -10.f ? e : __logf(1.f + e)); }
template <int MODE> DI void ssd_unit(const Params& p, int l, int un, LAS unsigned char* lds) {
    const int tid = opaque_tid(), lane = tid & 63, w = __builtin_amdgcn_readfirstlane(tid >> 6), r16 = lane & 15, quad = lane >> 4;
    const int sc = un >> 5, head = un & 31, g = head >> 3, tok0 = sc * 256;
    unsigned char* ws = p.ws;
    bf16_t* Zb = (bf16_t*)(ws + WS_R + (size_t)(head >> 4) * BLK) + (head & 15) * 64;
    const bf16_t* Xb = (const bf16_t*)(ws + WS_R + (size_t)(2 + (head >> 4)) * BLK) + (head & 15) * 64;
    const bf16_t* BCb = (const bf16_t*)(ws + WS_R + 4 * BLK);
    const float* small = (const float*)(ws + WS_SMALL);
    float* ssq = (float*)(ws + WS_SSQ);
    float* states = (float*)(ws + WS_STS) + (size_t)un * 8192;
    const float* cw = p.in[8] + (size_t)l * 4 * 3072; const float* cbias = p.in[9] + l * 3072;
    const float dtb = p.in[10][l * 32 + head], aneg = -__expf(p.in[11][l * 32 + head]), Dh = p.in[12][l * 32 + head];
    f32x4 st[4];
    if (MODE == 3) {
#pragma unroll
        for (int pb = 0; pb < 4; ++pb) { st[pb] = *(const f32x4*)(states + ((size_t)(w * 4 + pb) * 64 + lane) * 4);
            *(LAS u32x2*)(lds + S_SB + (16 * pb + r16) * 272 + (16 * w + quad * 4) * 2) = (u32x2){pk2(st[pb][0], st[pb][1]), pk2(st[pb][2], st[pb][3])}; }
    } else {
#pragma unroll
        for (int pb = 0; pb < 4; ++pb) st[pb] = (f32x4){0.f, 0.f, 0.f, 0.f};
    }
    const int px = tid & 63, tq = tid >> 6;
    float wx[4];
#pragma unroll
    for (int i = 0; i < 4; ++i) wx[i] = cw[i * 3072 + head * 64 + px];
    const float bx = cbias[head * 64 + px];
    float atot = 0.f;
    for (int j = 0; j < 4; ++j) {
        const int t0 = tok0 + 64 * j, s0 = t0 & (SEQ - 1);
        if (w == 0) {
            const float dt = softplusf_(small[(size_t)(t0 + lane) * 64 + 16 + head] + dtb);
            float cs = dt * aneg;
#pragma unroll
            for (int o = 1; o < 64; o <<= 1) { const float v = __shfl_up(cs, o); if (lane >= o) cs += v; }
            ((LAS float*)(lds + S_ACUM))[lane] = cs; ((LAS float*)(lds + S_DTV))[lane] = dt;
            if (lane == 63) ((LAS float*)(lds + S_MISC))[0] = cs;
        }
        __syncthreads();
        const float alast = ((const LAS float*)(lds + S_MISC))[0];
        atot += alast;
        {
            float xv[11];
#pragma unroll
            for (int k = 0; k < 11; ++k) { const int tt = tq * 8 - 3 + k; xv[k] = (s0 + tt >= 0) ? bf2f(Xb[(size_t)(t0 + tt) * 1024 + px]) : 0.f; }
            unsigned a1[4], a2[4]; float e1[2], e2[2];
#pragma unroll
            for (int i = 0; i < 8; ++i) { const int t = tq * 8 + i;
                const float cv = bx + xv[i] * wx[0] + xv[i + 1] * wx[1] + xv[i + 2] * wx[2] + xv[i + 3] * wx[3];
                const float xd = siluf_(cv) * ((const LAS float*)(lds + S_DTV))[t];
                e1[i & 1] = xd; e2[i & 1] = xd * __expf(alast - ((const LAS float*)(lds + S_ACUM))[t]);
                if (i & 1) { a1[i >> 1] = pk2(e1[0], e1[1]); a2[i >> 1] = pk2(e2[0], e2[1]); } }
            *(LAS u32x4*)(lds + S_XDT + px * 144 + tq * 16) = (u32x4){a1[0], a1[1], a1[2], a1[3]};
            *(LAS u32x4*)(lds + S_XD2 + px * 144 + tq * 16) = (u32x4){a2[0], a2[1], a2[2], a2[3]};
        }
        {
            const bf16_t* BCc = (const bf16_t*)(ws + WS_STG);
#pragma unroll
            for (int i = 0; i < 2; ++i) { const int pid = tid + 512 * i, c8 = pid >> 6, t = pid & 63;
                const u32x4 v = *(const u32x4*)(BCc + (size_t)(t0 + t) * 1024 + g * 128 + c8 * 8);
                if (MODE == 3) *(LAS u32x4*)(lds + S_BN + t * 272 + c8 * 16) = v;
                LAS bf16_t* bt = (LAS bf16_t*)(lds + S_BT) + (c8 * 8) * 72 + t;
#pragma unroll
                for (int e = 0; e < 4; ++e) { bt[(2 * e) * 72] = (bf16_t)(v[e] & 0xffffu); bt[(2 * e + 1) * 72] = (bf16_t)(v[e] >> 16); }
                if (MODE == 3) { const u32x4 cv = *(const u32x4*)(BCc + (size_t)(t0 + t) * 1024 + 512 + g * 128 + c8 * 8); *(LAS u32x4*)(lds + S_CN + t * 272 + c8 * 16) = cv; } }
        }
        __syncthreads();
        if (MODE == 3) {
            f32x4 y[2];
#pragma unroll
            for (int e = 0; e < 2; ++e) { const int x = 2 * w + e, tb = x >> 2, sb = x & 3;
                f32x4 a = (f32x4){0.f, 0.f, 0.f, 0.f};
                if (sb <= tb) a = mm16<4>(a, lds + S_BN + sb * 16 * 272, 272, lds + S_CN + tb * 16 * 272, 272, lane);
                const int t = 16 * tb + r16, sb0 = 16 * sb + quad * 4;
                const float act = ((const LAS float*)(lds + S_ACUM))[t], dtt = ((const LAS float*)(lds + S_DTV))[t];
                float v[4];
#pragma unroll
                for (int jj = 0; jj < 4; ++jj) { const int s = sb0 + jj; float val = 0.f;
                    if (s <= t) val = a[jj] * __expf(act - ((const LAS float*)(lds + S_ACUM))[s]);
                    if (s == t) val += Dh * __builtin_amdgcn_rcpf(dtt);
                    v[jj] = val; }
                *(LAS u32x2*)(lds + S_GL + t * 144 + sb0 * 2) = (u32x2){pk2(v[0], v[1]), pk2(v[2], v[3])};
                const int pb = sb;
                y[e] = mm16<4>((f32x4){0.f, 0.f, 0.f, 0.f}, lds + S_SB + pb * 16 * 272, 272, lds + S_CN + tb * 16 * 272, 272, lane);
                y[e] = y[e] * __expf(act);
            }
            __syncthreads();
            u32x2 zin[2];
#pragma unroll
            for (int e = 0; e < 2; ++e) { const int x = 2 * w + e; zin[e] = *(const u32x2*)(Zb + (size_t)(t0 + 16 * (x >> 2) + r16) * 1024 + 16 * (x & 3) + quad * 4); }
            asm volatile("" ::: "memory");
#pragma unroll
            for (int e = 0; e < 2; ++e) { const int x = 2 * w + e, tb = x >> 2, pb = x & 3;
                y[e] = mm16<2>(y[e], lds + S_XDT + pb * 16 * 144, 144, lds + S_GL + tb * 16 * 144, 144, lane);
                const int t = 16 * tb + r16; bf16_t* zp = Zb + (size_t)(t0 + t) * 1024 + 16 * pb + quad * 4;
                const u32x2 zw = zin[e];
                f32x4 r; r[0] = y[e][0] * siluf_(bflo(zw.x)); r[1] = y[e][1] * siluf_(bfhi(zw.x)); r[2] = y[e][2] * siluf_(bflo(zw.y)); r[3] = y[e][3] * siluf_(bfhi(zw.y));
                float ss = r[0] * r[0] + r[1] * r[1] + r[2] * r[2] + r[3] * r[3];
                ss += __shfl_xor(ss, 16); ss += __shfl_xor(ss, 32);
                if (quad == 0) atomicAdd(ssq + (size_t)(t0 + t) * 4 + g, ss);
                *(u32x2*)zp = (u32x2){pk2(r[0], r[1]), pk2(r[2], r[3])}; }
        }
        {
            const float da = __expf(alast);
#pragma unroll
            for (int pb = 0; pb < 4; ++pb) { st[pb] = st[pb] * da;
                st[pb] = mm16<2>(st[pb], lds + S_BT + w * 16 * 144, 144, lds + S_XD2 + pb * 16 * 144, 144, lane);
                if (MODE == 3) *(LAS u32x2*)(lds + S_SB + (16 * pb + r16) * 272 + (16 * w + quad * 4) * 2) = (u32x2){pk2(st[pb][0], st[pb][1]), pk2(st[pb][2], st[pb][3])}; }
        }
        __syncthreads();
    }
    if (MODE == 1) {
#pragma unroll
        for (int pb = 0; pb < 4; ++pb) *(f32x4*)(states + ((size_t)(w * 4 + pb) * 64 + lane) * 4) = st[pb];
        if (tid == 0) ((float*)(ws + WS_DECS))[un] = __expf(atot);
    }
}

DI void conv_bc(const Params& p, int l) {
    const bf16_t* BC = (const bf16_t*)(p.ws + WS_R + 4 * BLK); bf16_t* O = (bf16_t*)(p.ws + WS_STG);
    const float* cw = p.in[8] + (size_t)l * 4 * 3072 + 2048; const float* cb = p.in[9] + l * 3072 + 2048;
    const int gt = blockIdx.x * 512 + opaque_tid();
    for (int it = gt; it < 1024 * 256; it += gridDim.x * 512) {
        const int c = it & 1023, r0 = (it >> 10) * 64;
        const float w0 = cw[c], w1 = cw[3072 + c], w2 = cw[2 * 3072 + c], w3 = cw[3 * 3072 + c], b = cb[c];
        float xin[67];
        const bool hist = (r0 & (SEQ - 1)) != 0;
#pragma unroll
        for (int i = 0; i < 67; ++i) xin[i] = (i >= 3 || hist) ? bf2f(BC[(size_t)(r0 - 3 + i) * 1024 + c]) : 0.f;
        asm volatile("" ::: "memory");
#pragma unroll
        for (int i = 0; i < 64; ++i) { const float cv = b + xin[i] * w0 + xin[i + 1] * w1 + xin[i + 2] * w2 + xin[i + 3] * w3; O[(size_t)(r0 + i) * 1024 + c] = f2bf(siluf_(cv)); }
    }
}

constexpr int L_ACUM = 0, L_DTV = 1024, L_TOT = 2048, L_XD2 = 2304, L_BT = 36096;
DI void ssd_local(const Params& p, int l, int un, LAS unsigned char* lds) {
    const int tid = opaque_tid(), lane = tid & 63, w = __builtin_amdgcn_readfirstlane(tid >> 6);
    const int sc = un >> 5, head = un & 31, g = head >> 3, tok0 = sc * 256, s0 = tok0 & (SEQ - 1);
    unsigned char* ws = p.ws;
    const bf16_t* Xb = (const bf16_t*)(ws + WS_R + (size_t)(2 + (head >> 4)) * BLK) + (head & 15) * 64;
    const bf16_t* BCc = (const bf16_t*)(ws + WS_STG);
    const float* small = (const float*)(ws + WS_SMALL);
    float* states = (float*)(ws + WS_STS) + (size_t)un * 8192;
    const float* cw = p.in[8] + (size_t)l * 4 * 3072; const float* cbias = p.in[9] + l * 3072;
    const float dtb = p.in[10][l * 32 + head], aneg = -__expf(p.in[11][l * 32 + head]);
    if (w < 4) {
        const int t = w * 64 + lane; const float dt = softplusf_(small[(size_t)(tok0 + t) * 64 + 16 + head] + dtb);
        float cs = dt * aneg;
#pragma unroll
        for (int o = 1; o < 64; o <<= 1) { const float v = __shfl_up(cs, o); if (lane >= o) cs += v; }
        ((LAS float*)(lds + L_ACUM))[t] = cs; ((LAS float*)(lds + L_DTV))[t] = dt;
        if (lane == 63) ((LAS float*)(lds + L_TOT))[w] = cs;
    }
    __syncthreads();
    const float t0_ = ((const LAS float*)(lds + L_TOT))[0], t1_ = ((const LAS float*)(lds + L_TOT))[1], t2_ = ((const LAS float*)(lds + L_TOT))[2], t3_ = ((const LAS float*)(lds + L_TOT))[3];
    const float atot = t0_ + t1_ + t2_ + t3_;
    {
        const int px = tid & 63, tq = tid >> 6;
        float wx[4];
#pragma unroll
        for (int i = 0; i < 4; ++i) wx[i] = cw[i * 3072 + head * 64 + px];
        const float bx = cbias[head * 64 + px];
        const float offq = (tq >= 6) ? t0_ + t1_ + t2_ : (tq >= 4) ? t0_ + t1_ : (tq >= 2) ? t0_ : 0.f;
#pragma unroll
        for (int c4 = 0; c4 < 4; ++c4) { const int tb = tq * 32 + c4 * 8;
            float xv[11];
#pragma unroll
            for (int k = 0; k < 11; ++k) { const int tt = tb - 3 + k; xv[k] = (s0 + tt >= 0) ? bf2f(Xb[(size_t)(tok0 + tt) * 1024 + px]) : 0.f; }
            unsigned a2[4]; float e2[2];
#pragma unroll
            for (int i = 0; i < 8; ++i) { const int t = tb + i;
                const float cv = bx + xv[i] * wx[0] + xv[i + 1] * wx[1] + xv[i + 2] * wx[2] + xv[i + 3] * wx[3];
                e2[i & 1] = siluf_(cv) * ((const LAS float*)(lds + L_DTV))[t] * __expf(atot - offq - ((const LAS float*)(lds + L_ACUM))[t]);
                if (i & 1) a2[i >> 1] = pk2(e2[0], e2[1]); }
            *(LAS u32x4*)(lds + L_XD2 + px * 528 + tb * 2) = (u32x4){a2[0], a2[1], a2[2], a2[3]}; }
    }
#pragma unroll
    for (int i = 0; i < 8; ++i) { const int pid = tid + 512 * i, c8 = pid >> 8, t = pid & 255;
        const u32x4 v = *(const u32x4*)(BCc + (size_t)(tok0 + t) * 1024 + g * 128 + c8 * 8);
        LAS bf16_t* bt = (LAS bf16_t*)(lds + L_BT) + (c8 * 8) * 264 + t;
#pragma unroll
        for (int e = 0; e < 4; ++e) { bt[(2 * e) * 264] = (bf16_t)(v[e] & 0xffffu); bt[(2 * e + 1) * 264] = (bf16_t)(v[e] >> 16); } }
    __syncthreads();
#pragma unroll
    for (int pb = 0; pb < 4; ++pb) { const f32x4 st = mm16<8>((f32x4){0.f, 0.f, 0.f, 0.f}, lds + L_BT + w * 16 * 528, 528, lds + L_XD2 + pb * 16 * 528, 528, lane);
        *(f32x4*)(states + ((size_t)(w * 4 + pb) * 64 + lane) * 4) = st; }
    if (tid == 0) ((float*)(ws + WS_DECS))[un] = __expf(atot);
    __syncthreads();
}
DI void ssd_scan(const Params& p) {
    const int gid = blockIdx.x * 512 + opaque_tid();
    for (int it = gid; it < 131072; it += gridDim.x * 512) {
        const int chain = it >> 11, e = it & 2047, b = chain >> 5, head = chain & 31;
        f32x4* st = (f32x4*)(p.ws + WS_STS); const float* dec = (const float*)(p.ws + WS_DECS);
        f32x4 run = (f32x4){0.f, 0.f, 0.f, 0.f};
        for (int hb = 0; hb < 4; ++hb) {
            f32x4 u[8];
#pragma unroll
            for (int s = 0; s < 8; ++s) u[s] = st[(size_t)((b * 32 + hb * 8 + s) * 32 + head) * 2048 + e];
            asm volatile("" ::: "memory");
#pragma unroll
            for (int s = 0; s < 8; ++s) { const int un = (b * 32 + hb * 8 + s) * 32 + head; const float dc = dec[un];
                st[(size_t)un * 2048 + e] = run; run = run * dc + u[s]; }
        }
    }
}

typedef short v4i16_t __attribute__((ext_vector_type(4)));
DI s16x4 vtr(const LAS unsigned char* p) { return __builtin_bit_cast(s16x4, __builtin_amdgcn_ds_read_tr16_b64_v4i16((LAS v4i16_t*)p)); }
constexpr int A_K = 0, A_V = 34816, A_X = 0, A_Y = 65536, A_NG = 100352;
DI void attn_unit(const Params& p, int b, int h, int qb, float lam, float oscale, LAS unsigned char* lds) {
    const int tid = opaque_tid(), lane = tid & 63, w = __builtin_amdgcn_readfirstlane(tid >> 6), rg = w & 3, sub = w >> 2, q = lane & 31, hh = lane >> 5;
    bf16_t* Qd = (bf16_t*)(p.ws + WS_R + 4 * BLK); const bf16_t* Kd = (const bf16_t*)(p.ws + WS_R + 5 * BLK); const bf16_t* Vd = (const bf16_t*)(p.ws + WS_R + 6 * BLK);
    const int tok0 = b * SEQ + qb * 128;
    bf16x8 qf[4];
    { const bf16_t* qp = Qd + (size_t)(tok0 + rg * 32 + q) * 1024 + h * 128 + sub * 64 + hh * 8;
#pragma unroll
      for (int ks = 0; ks < 4; ++ks) qf[ks] = *(const bf16x8*)(qp + ks * 16); }
    const int NT = 2 * qb + 2;
    u32x4 kr[2], vr[2];
    const int prow = tid >> 4, pc16 = tid & 15;
#define ATT_LOAD(t) do { _Pragma("unroll") for (int i_ = 0; i_ < 2; ++i_) { const size_t off_ = (size_t)(b * SEQ + (t) * 64 + prow + 32 * i_) * 1024 + h * 128 + pc16 * 8; \
        kr[i_] = *(const u32x4*)(Kd + off_); vr[i_] = *(const u32x4*)(Vd + off_); } } while (0)
#define ATT_STORE(buf) do { _Pragma("unroll") for (int i_ = 0; i_ < 2; ++i_) { const int o_ = (buf) * 17408 + (prow + 32 * i_) * 272 + pc16 * 16; \
        *(LAS u32x4*)(lds + A_K + o_) = kr[i_]; *(LAS u32x4*)(lds + A_V + (buf) * 18432 + (prow + 32 * i_) * 288 + pc16 * 16) = vr[i_]; } } while (0)
    f32x16 o[4];
#pragma unroll
    for (int db = 0; db < 4; ++db)
#pragma unroll
        for (int i = 0; i < 16; ++i) o[db][i] = 0.f;
    float m_run = -1e30f, l_run = 0.f;
    const float C2 = 0.18033688011112042f;
    ATT_LOAD(0); ATT_STORE(0); ATT_LOAD(1);
    __syncthreads();
    const int i16 = lane & 15, blk = (lane >> 4) & 1;
    for (int t = 0; t < NT; ++t) {
        if (t + 1 < NT) ATT_STORE((t + 1) & 1);
        if (t + 2 < NT) ATT_LOAD(t + 2);
        if (t <= 2 * qb + (rg >> 1)) {
            const LAS unsigned char* Kb = lds + A_K + (t & 1) * 17408; const LAS unsigned char* Vb = lds + A_V + (t & 1) * 18432;
            f32x16 s0, s1;
#pragma unroll
            for (int i = 0; i < 16; ++i) { s0[i] = 0.f; s1[i] = 0.f; }
#pragma unroll
            for (int ks = 0; ks < 4; ++ks) { const LAS unsigned char* kp = Kb + q * 272 + (sub * 64 + ks * 16 + hh * 8) * 2;
                s0 = mfma32(*(const LAS bf16x8*)kp, qf[ks], s0); s1 = mfma32(*(const LAS bf16x8*)(kp + 32 * 272), qf[ks], s1); }
            float mx = fmaxf(s0[0], s1[0]);
#pragma unroll
            for (int i = 1; i < 16; ++i) mx = fmaxf(mx, fmaxf(s0[i], s1[i]));
            mx = fmaxf(mx, __shfl_xor(mx, 32));
            const float m_new = fmaxf(m_run, mx), negm = -m_new * C2;
            if (__any(m_new > m_run)) {
                const float alpha = __builtin_amdgcn_exp2f((m_run - m_new) * C2);
                l_run *= alpha;
#pragma unroll
                for (int db = 0; db < 4; ++db)
#pragma unroll
                    for (int i = 0; i < 16; ++i) o[db][i] *= alpha;
            }
            float sum = 0.f;
#pragma unroll
            for (int i = 0; i < 16; ++i) { s0[i] = __builtin_amdgcn_exp2f(fmaf(s0[i], C2, negm)); s1[i] = __builtin_amdgcn_exp2f(fmaf(s1[i], C2, negm)); sum += s0[i] + s1[i]; }
            l_run += sum; m_run = m_new;
            bf16x8 pf[2][2];
#pragma unroll
            for (int s = 0; s < 2; ++s) {
                pf[0][s] = __builtin_bit_cast(bf16x8, (u32x4){pk2(s0[8 * s], s0[8 * s + 1]), pk2(s0[8 * s + 2], s0[8 * s + 3]), pk2(s0[8 * s + 4], s0[8 * s + 5]), pk2(s0[8 * s + 6], s0[8 * s + 7])});
                pf[1][s] = __builtin_bit_cast(bf16x8, (u32x4){pk2(s1[8 * s], s1[8 * s + 1]), pk2(s1[8 * s + 2], s1[8 * s + 3]), pk2(s1[8 * s + 4], s1[8 * s + 5]), pk2(s1[8 * s + 6], s1[8 * s + 7])}); }
#pragma unroll
            for (int kb = 0; kb < 2; ++kb)
#pragma unroll
                for (int s = 0; s < 2; ++s) { const LAS unsigned char* vp = Vb + (32 * kb + 16 * s + 4 * hh + (i16 >> 2)) * 288 + blk * 32 + (i16 & 3) * 8;
#pragma unroll
                    for (int db = 0; db < 4; ++db) { const s16x4 lo = vtr(vp + db * 64), hi = vtr(vp + db * 64 + 8 * 288);
                        const bf16x8 vf = (bf16x8){lo[0], lo[1], lo[2], lo[3], hi[0], hi[1], hi[2], hi[3]};
                        o[db] = mfma32(vf, pf[kb][s], o[db]); } }
        }
        __syncthreads();
    }
#undef ATT_LOAD
#undef ATT_STORE
    const float l_tot = l_run + __shfl_xor(l_run, 32);
    LAS float* X = (LAS float*)(lds + A_X) + rg * 4096;
    if (sub == 1) { const float inv = lam / l_tot;
#pragma unroll
        for (int db = 0; db < 4; ++db)
#pragma unroll
            for (int i = 0; i < 16; ++i) X[(db * 16 + i) * 64 + lane] = o[db][i] * inv; }
    __syncthreads();
    if (sub == 0) { const float inv = 1.f / l_tot; float ss = 0.f;
#pragma unroll
        for (int db = 0; db < 4; ++db)
#pragma unroll
            for (int i = 0; i < 16; ++i) { const float v = o[db][i] * inv - X[(db * 16 + i) * 64 + lane]; o[db][i] = v; ss += v * v; }
        ss += __shfl_xor(ss, 32);
        const float rs = rsqrtf(ss * (1.f / 128.f) + 1e-5f) * oscale;
        LAS bf16_t* Y = (LAS bf16_t*)(lds + A_Y) + rg * (32 * 136);
        const LAS float* ngl = (const LAS float*)(lds + A_NG);
#pragma unroll
        for (int db = 0; db < 4; ++db)
#pragma unroll
            for (int i = 0; i < 16; ++i) { const int dv = 32 * db + crow(i, hh); Y[q * 136 + dv] = f2bf(o[db][i] * rs * ngl[dv]); }
        asm volatile("s_waitcnt lgkmcnt(0)" ::: "memory");
#pragma unroll
        for (int k = 0; k < 8; ++k) { const int piece = lane + 64 * k, row = piece >> 4, c16 = piece & 15;
            const u32x4 v = *(const LAS u32x4*)((const LAS unsigned char*)Y + row * 272 + c16 * 16);
            *(u32x4*)(Qd + (size_t)(tok0 + rg * 32 + row) * 1024 + h * 128 + c16 * 8) = v; }
    }
    __syncthreads();
}
DI void attn_phase(const Params& p, int l, LAS unsigned char* lds, int vcu) {
    const int tid = opaque_tid();
    float d1 = 0.f, d2 = 0.f;
    for (int i = 0; i < 64; ++i) { d1 += p.in[14][l * 64 + i] * p.in[15][l * 64 + i]; d2 += p.in[16][l * 64 + i] * p.in[17][l * 64 + i]; }
    const float lambda_init = (l == 0) ? 0.2f : 0.35550906759096934f;
    const float lam = expf(d1) - expf(d2) + lambda_init;
    if (tid < 128) ((LAS float*)(lds + A_NG))[tid] = p.in[18][l * 128 + tid];
    __syncthreads();
    for (int i = 0; i < 4; ++i)
        for (int vc = vcu; vc < 256; vc += gridDim.x) {
            const int bh = vc >> 4, s = vc & 15; const int qb = (i == 0) ? s : (i == 1) ? 31 - s : (i == 2) ? 32 + s : 63 - s;
            attn_unit(p, bh >> 3, bh & 7, qb, lam, 1.f - lambda_init, lds);
        }
}

DI void final_norm(const Params& p) {
    const float* rowsq = (const float*)(p.ws + WS_ROWSQ) + 4 * T; const float* g = p.in[26];
    const int gt = blockIdx.x * 512 + opaque_tid(), NTH = gridDim.x * 512;
    for (int i0 = gt; i0 < T * 256; i0 += 4 * NTH) {
        f32x4 v[4];
#pragma unroll
        for (int k = 0; k < 4; ++k) { const int i = i0 + k * NTH; if (i < T * 256) v[k] = *(const f32x4*)(p.out + (size_t)(i >> 8) * 1024 + (i & 255) * 4); }
        asm volatile("" ::: "memory");
#pragma unroll
        for (int k = 0; k < 4; ++k) { const int i = i0 + k * NTH; if (i < T * 256) { const int row = i >> 8, c = (i & 255) * 4;
            const float rs = rsqrtf(rowsq[row] * (1.f / 1024.f) + EPS); const f32x4 gv = *(const f32x4*)(g + c);
            *(f32x4*)(p.out + (size_t)row * 1024 + c) = v[k] * rs * gv; } }
    }
}


DI void gemv2(float* out, int ldo, const float* in, int ldi, const float* W, int ldw, int K, int N, int kchunk) {
    const int tid = opaque_tid(), lane = tid & 63, wave = __builtin_amdgcn_readfirstlane(tid >> 6);
    const int gw = blockIdx.x * 8 + wave, NGW = gridDim.x * 8, nstrip = (N + 63) / 64, nk = K / 128;
    for (int job = gw; job < nstrip * nk; job += NGW) {
        const int strip = job % nstrip, kq = job / nstrip, col = strip * 64 + lane; const bool ok = col < N;
        const float* wp = W + (size_t)(kq * 128) * ldw + (ok ? col : 0);
        const float* i0 = in + kq * 128; const float* i1 = in + ldi + kq * 128;
        float a0 = 0.f, a1 = 0.f;
        for (int kk = 0; kk < 2; ++kk) {
            const float h0 = i0[kk * 64 + lane], h1 = i1[kk * 64 + lane];
#pragma unroll
            for (int k = 0; k < 64; ++k) { const float wv = wp[(size_t)(kk * 64 + k) * ldw];
                a0 += __uint_as_float(__builtin_amdgcn_readlane(__float_as_uint(h0), k)) * wv; a1 += __uint_as_float(__builtin_amdgcn_readlane(__float_as_uint(h1), k)) * wv; }
        }
        if (ok) { atomicAdd(out + col, a0); atomicAdd(out + ldo + col, a1); }
    }
}
DI void side_init(const Params& p) {
    const int tid = opaque_tid(), lane = tid & 63, wave = __builtin_amdgcn_readfirstlane(tid >> 6);
    const int gt = blockIdx.x * 512 + tid, NTH = gridDim.x * 512, gw = blockIdx.x * 8 + wave, NGW = gridDim.x * 8;
    float* z = (float*)(p.ws + SB_PROJ);
    for (int i = gt; i < (int)((SB_END - SB_PROJ) / 4); i += NTH) z[i] = 0.f;
    float* hn = (float*)(p.ws + SB_HN);
    for (int r = gw; r < 128; r += NGW) { const int row = (r >> 6) * SEQ + (r & 63);
        const f32x4* xr = (const f32x4*)(p.in[0] + (size_t)row * 1024) + lane; f32x4 v[4]; float s2 = 0.f;
#pragma unroll
        for (int j = 0; j < 4; ++j) { v[j] = xr[64 * j]; s2 += v[j][0] * v[j][0] + v[j][1] * v[j][1] + v[j][2] * v[j][2] + v[j][3] * v[j][3]; }
        const float rs = rsqrtf(wave_sum(s2) * (1.f / 1024.f) + EPS);
#pragma unroll
        for (int j = 0; j < 4; ++j) { const f32x4 g = *((const f32x4*)p.in[2] + lane + 64 * j); *((f32x4*)(hn + (size_t)r * 1024) + lane + 64 * j) = v[j] * rs * g; } }
}
DI void side_kv(const Params& p) {
    const int tid = opaque_tid(), lane = tid & 63, wave = __builtin_amdgcn_readfirstlane(tid >> 6);
    const int gw = blockIdx.x * 8 + wave, NGW = gridDim.x * 8;
    const float* hn = (const float*)(p.ws + SB_HN); float* kv = (float*)(p.ws + SB_KV);
    for (int job = gw; job < 4096; job += NGW) {
        const int strip = job & 31, grp = (job >> 5) & 15, kq = job >> 9, col = strip * 64 + lane;
        const float* wp = p.in[3] + (size_t)(kq * 128) * INC + 9264 + col; const float* hp = hn + (size_t)(grp * 8) * 1024 + kq * 128;
        float a[8];
#pragma unroll
        for (int t = 0; t < 8; ++t) a[t] = 0.f;
        for (int kk = 0; kk < 2; ++kk) {
            float h[8];
#pragma unroll
            for (int t = 0; t < 8; ++t) h[t] = hp[t * 1024 + kk * 64 + lane];
#pragma unroll 16
            for (int k = 0; k < 64; ++k) { const float wv = wp[(size_t)(kk * 64 + k) * INC];
#pragma unroll
                for (int t = 0; t < 8; ++t) a[t] += __uint_as_float(__builtin_amdgcn_readlane(__float_as_uint(h[t]), k)) * wv; }
        }
#pragma unroll
        for (int t = 0; t < 8; ++t) atomicAdd(kv + (size_t)(grp * 8 + t) * 2048 + col, a[t]);
    }
}
DI void rope_cs(int pos, int i, float& cs, float& sn) {
    const double cf[8] = {0.15915494309189535, 0.03086376340470123, 0.005985185712713705, 0.001160663641240061, 0.00022507907903927653, 4.364795279280289e-05, 8.464330808241401e-06, 1.6414262627950345e-06};
    double c = cf[0];
#pragma unroll
    for (int q = 1; q < 8; ++q) c = (i == q) ? cf[q] : c;
    double rv = (double)pos * c; rv -= floor(rv); const float fr = (float)rv; sn = __builtin_amdgcn_sinf(fr); cs = __builtin_amdgcn_cosf(fr);
}
DI void side_mixers(const Params& p, int b, LAS unsigned char* lds) {
    const int tid = opaque_tid();
    const float* P = (const float*)(p.ws + SB_PROJ) + b * 14384; float* Y = (float*)(p.ws + SB_Y) + b * 4096; float* KV = (float*)(p.ws + SB_KV) + (size_t)b * 64 * 2048;
    LAS float* cx = (LAS float*)lds; LAS float* ypre = cx + 3072; LAS float* lg = ypre + 2048; LAS float* pr = lg + 1024; LAS float* red = pr + 1024; LAS float* qr = red + 64;
    const int* pos = (const int*)p.in[1] + b * SEQ;
    __syncthreads();
    if (tid < 4) { float qk = 0.f, vv = 0.f; for (int d = 0; d < 128; ++d) qk += P[tid * 128 + d] * P[512 + tid * 128 + d]; for (int d = 0; d < 256; ++d) { const float v = P[1024 + tid * 256 + d]; vv += v * v; }
        red[tid] = qk * 0.08838834764831845f; red[4 + tid] = vv * (1.f / 256.f); }
    for (int c = tid; c < 3072; c += 512) cx[c] = siluf_(p.in[9][c] + p.in[8][3 * 3072 + c] * P[5136 + c]);
    if (tid < 32) red[8 + tid] = softplusf_(P[8208 + tid] + p.in[10][tid]);
    __syncthreads();
    for (int i = tid; i < 1024; i += 512) { const int h = i >> 8; const float p00 = red[h], o = p00 * P[1024 + i];
        Y[i] = o * rsqrtf(p00 * p00 * red[4 + h] + EPS) * p.in[7][i & 255] * siluf_(P[2064 + i]); }
    if (tid < 4) { float cb = 0.f; for (int n = 0; n < 128; ++n) cb += cx[2560 + tid * 128 + n] * cx[2048 + tid * 128 + n]; red[40 + tid] = cb; }
    __syncthreads();
    for (int i = tid; i < 2048; i += 512) { const int head = i >> 6; ypre[i] = (red[40 + (head >> 3)] * red[8 + head] + p.in[12][head]) * cx[i] * siluf_(P[3088 + i]); }
    __syncthreads();
    if (tid < 4) { float ss = 0.f; for (int i = 0; i < 512; ++i) ss += ypre[tid * 512 + i] * ypre[tid * 512 + i]; red[44 + tid] = rsqrtf(ss * (1.f / 512.f) + EPS); }
    __syncthreads();
    for (int i = tid; i < 2048; i += 512) Y[1024 + i] = ypre[i] * red[44 + (i >> 9)] * p.in[13][i];
    for (int i = tid; i < 1024; i += 512) { const int d = i & 63; float v = P[8240 + i];
        if (d < 16) { float cs, sn; rope_cs(pos[0], d & 7, cs, sn); const float o = (d < 8) ? P[8240 + i + 8] : P[8240 + i - 8]; v = (d < 8) ? v * cs - o * sn : v * cs + o * sn; }
        qr[i] = v; }
    for (int it = tid; it < 8192; it += 512) { const int j = it >> 7, hs = (it >> 3) & 15, d = it & 7; float cs, sn; rope_cs(pos[j], d, cs, sn);
        float* kp = KV + (size_t)j * 2048 + hs * 64 + d; const float k1 = kp[0], k2 = kp[8]; kp[0] = k1 * cs - k2 * sn; kp[8] = k2 * cs + k1 * sn; }
    __threadfence_block();
    __syncthreads();
    for (int i = tid; i < 1024; i += 512) { const int hs = i >> 6, j = i & 63; const float* kp = KV + (size_t)j * 2048 + hs * 64; float sacc = 0.f;
        for (int d = 0; d < 64; ++d) sacc += qr[hs * 64 + d] * kp[d];
        lg[i] = sacc * 0.125f; }
    __syncthreads();
    if (tid < 16) { float m = -1e30f; for (int j = 0; j < 64; ++j) m = fmaxf(m, lg[tid * 64 + j]); float sum = 0.f; for (int j = 0; j < 64; ++j) { const float e = expf(lg[tid * 64 + j] - m); pr[tid * 64 + j] = e; sum += e; }
        const float inv = 1.f / sum; for (int j = 0; j < 64; ++j) pr[tid * 64 + j] *= inv; }
    __syncthreads();
    float d1 = 0.f, d2 = 0.f;
    for (int i = 0; i < 64; ++i) { d1 += p.in[14][i] * p.in[15][i]; d2 += p.in[16][i] * p.in[17][i]; }
    const float lam = expf(d1) - expf(d2) + 0.2f;
    for (int i = tid; i < 1024; i += 512) { const int h = i >> 7; float o = 0.f;
        for (int j = 0; j < 64; ++j) o += (pr[(2 * h) * 64 + j] - lam * pr[(2 * h + 1) * 64 + j]) * KV[(size_t)j * 2048 + 1024 + i];
        ypre[i] = o; }
    __syncthreads();
    if (tid < 8) { float ss = 0.f; for (int i = 0; i < 128; ++i) ss += ypre[tid * 128 + i] * ypre[tid * 128 + i]; red[48 + tid] = rsqrtf(ss * (1.f / 128.f) + 1e-5f) * 0.8f; }
    __syncthreads();
    for (int i = tid; i < 1024; i += 512) Y[3072 + i] = ypre[i] * red[48 + (i >> 7)] * p.in[18][i & 127];
    float* G = (float*)(p.ws + SB_GATE) + b * 3072;
    for (int i = tid; i < 3072; i += 512) G[i] = sigmoidf_(P[11312 + i] + p.in[4][i]);
    __syncthreads();
}
DI void side_glue(const Params& p, int step, int b, LAS unsigned char* lds) {
    const int tid = opaque_tid(); unsigned char* ws = p.ws; LAS float* red = (LAS float*)lds;
    if (step == 4) {
        const float* G = (const float*)(ws + SB_GATE) + b * 3072; const float* BR = (const float*)(ws + SB_BR) + b * 3072;
        for (int c = tid; c < 1024; c += 512) { ((float*)(ws + SB_MIX))[b * 1024 + c] = G[c] * BR[c] + G[1024 + c] * BR[1024 + c] + G[2048 + c] * BR[2048 + c];
            ((float*)(ws + SB_XM))[b * 1024 + c] = p.in[0][(size_t)b * SEQ * 1024 + c]; }
    } else if (step == 6 || step == 100) {
        const float* src = (const float*)(ws + (step == 6 ? SB_XM : SB_X1)) + b * 1024; float* dst = (float*)(ws + (step == 6 ? SB_H2 : SB_HN1)) + b * 1024;
        const float* g = step == 6 ? p.in[23] : p.in[2] + 1024;
        __syncthreads();
        float s2 = 0.f; for (int c = tid; c < 1024; c += 512) s2 += src[c] * src[c];
        s2 = wave_sum(s2); if ((tid & 63) == 0) red[tid >> 6] = s2;
        __syncthreads();
        float tot = 0.f; for (int w = 0; w < 8; ++w) tot += red[w];
        const float rs = rsqrtf(tot * (1.f / 1024.f) + EPS);
        for (int c = tid; c < 1024; c += 512) dst[c] = src[c] * rs * g[c];
        if (step == 100) { const size_t row = (size_t)b * SEQ; bf16_t* xb = (bf16_t*)(ws + WS_XB);
            for (int c = tid; c < 1024; c += 512) { p.out[row * 1024 + c] = src[c]; xb[row * 1024 + c] = f2bf(src[c]); }
            if (tid == 0) ((float*)(ws + WS_ROWSQ))[2 * T + row] = tot; }
        __syncthreads();
    } else if (step == 8) {
        const float* up = (const float*)(ws + SB_UP) + b * 4096; float* hh = (float*)(ws + SB_HH) + b * 4096;
        for (int c = tid; c < 4096; c += 512) { const float r = fmaxf(up[c], 0.f); hh[c] = r * r; }
        for (int c = tid; c < 1024; c += 512) ((float*)(ws + SB_X1))[b * 1024 + c] = ((const float*)(ws + SB_XM))[b * 1024 + c];
    }
}
DI void side_phase(const Params& p, int l, int k, LAS unsigned char* lds) {
    unsigned char* ws = p.ws; const int bid = blockIdx.x;
    if (l == 0) {
        if (k == 0) side_init(p);
        else if (k == 1) { gemv2((float*)(ws + SB_PROJ), 14384, (const float*)(ws + SB_HN), 64 * 1024, p.in[3], INC, 1024, INC, 128); side_kv(p); }
        else if (k == 2) { if (bid < 2) side_mixers(p, bid, lds); }
        else if (k == 3) { float* br = (float*)(ws + SB_BR); const float* y = (const float*)(ws + SB_Y);
            gemv2(br, 3072, y, 4096, p.in[19], 1024, 1024, 1024, 128); gemv2(br + 1024, 3072, y + 1024, 4096, p.in[20], 1024, 2048, 1024, 128); gemv2(br + 2048, 3072, y + 3072, 4096, p.in[21], 1024, 1024, 1024, 128); }
        else if (k == 4) { if (bid < 2) side_glue(p, 4, bid, lds); }
        else if (k == 5) gemv2((float*)(ws + SB_XM), 1024, (const float*)(ws + SB_MIX), 1024, p.in[22], 1024, 1024, 1024, 128);
        else if (k == 6) { if (bid < 2) side_glue(p, 6, bid, lds); }
        else if (k == 7) gemv2((float*)(ws + SB_UP), 4096, (const float*)(ws + SB_H2), 1024, p.in[24], 4096, 1024, 4096, 128);
        else if (k == 8) { if (bid < 2) side_glue(p, 8, bid, lds); }
        else if (k == 9) gemv2((float*)(ws + SB_X1), 1024, (const float*)(ws + SB_HH), 4096, p.in[25], 1024, 4096, 1024, 128);
    } else {
        if (k == 0) { if (bid < 2) side_glue(p, 100, bid, lds); }
        else if (k == 1) gemv2((float*)(ws + SB_QK1), 1024, (const float*)(ws + SB_HN1), 1024, p.in[3] + (size_t)1024 * INC, INC, 1024, 1024, 128);
    }
}


DI void grid_bar(unsigned* ctr, unsigned target) {
    asm volatile("s_waitcnt vmcnt(0)" ::: "memory");
    __syncthreads();
    if (threadIdx.x == 0) {
        __builtin_amdgcn_fence(__ATOMIC_RELEASE, "agent");
        asm volatile("s_waitcnt vmcnt(0)" ::: "memory");
        __hip_atomic_fetch_add(ctr, 1u, __ATOMIC_RELAXED, __HIP_MEMORY_SCOPE_AGENT);
        while (__hip_atomic_load(ctr, __ATOMIC_RELAXED, __HIP_MEMORY_SCOPE_AGENT) < target) __builtin_amdgcn_s_sleep(8);
        __builtin_amdgcn_fence(__ATOMIC_ACQUIRE, "agent");
        asm volatile("s_waitcnt vmcnt(0)" ::: "memory");
    }
    __syncthreads();
}

constexpr int NPHASE = 31, PPL = 15;
#ifndef PH_MASK
#define PH_MASK 0xFFFFFFFFu
#endif
#define EN(k_) ((PH_MASK >> (k_)) & 1u)
constexpr int LDS_BYTES = 147456;
template <bool COOP> __global__ void __launch_bounds__(512, 2) mk(Params p) {
    extern __shared__ __attribute__((aligned(16))) unsigned char lds_raw[];
    LAS unsigned char* lds = (LAS unsigned char*)lds_raw;
    unsigned char* ws = p.ws;
    float* rowsq = (float*)(ws + WS_ROWSQ);
    bf16_t* xb = (bf16_t*)(ws + WS_XB); bf16_t* mixb = (bf16_t*)(ws + WS_MIXB); bf16_t* R = (bf16_t*)(ws + WS_R);
    const unsigned char* wt = ws + WS_WT;
    const int G = gridDim.x, bid = blockIdx.x;
    const int vcu = (G % 8 == 0) ? (bid % 8) * (G / 8) + bid / 8 : bid;
    for (int ph = p.ph_lo; ph < p.ph_hi; ++ph) {
        if (ph == 30) { final_norm(p); }
        else {
            const int l = ph / PPL, k = ph % PPL;
            if (EN(0) && k == 0) phase_prep(p, l, lds);
            else if (k == 1 || k == 6) {
                const bool gd = (k == 1);
                pg8::Gemm g{xb, (const bf16_t*)(wt + (gd ? WT_GD : WT_S)), T, gd ? 8448 : 6144, 1024, 1024, 1024};
                pg8::StaticOrder S; S.init(T, g.N, G, bid);
                EpiIn E{R, rowsq + (2 * l) * T, (float*)(ws + WS_SMALL), gd ? 32 : -1, gd ? 3 : 5, gd ? 7 : -1,
                        p.in[4] + l * 3072 + (gd ? 0 : 1024), p.in[4] + l * 3072 + 2048};
                pg8::gemm_phase(lds, g, S, E);
            }
            else if (EN(2) && k == 2) { rope_pass(p); for (int un = vcu; un < 256; un += G) gla_unit<1>(p, l, un, lds); }
            else if (EN(3) && k == 3) { gla_scan(p); attn_phase(p, l, lds, vcu); }
            else if (EN(4) && k == 4) { for (int un = vcu; un < 256; un += G) gla_unit<3>(p, l, un, lds); }
            else if (k == 5 || k == 11) {
                const int nrun = (k == 5) ? 2 : 4;
                for (int r = 0; r < nrun; ++r) {
                    pg8::Gemm g; EpiMix E;
                    if (k == 5) {
                        g = pg8::Gemm{R + (size_t)(r == 0 ? 2 : 4) * (BLK / 2), (const bf16_t*)(wt + (r == 0 ? WT_GLA : WT_DIFF)), T, 1024, 1024, 1024, 1024};
                        E = EpiMix{mixb, R + (size_t)(r == 0 ? 3 : 7) * (BLK / 2), nullptr, 0, r == 0 ? 1 : 0};
                    } else {
                        g = pg8::Gemm{R + (size_t)(r >> 1) * (BLK / 2) + (r & 1) * 512, (const bf16_t*)(wt + WT_SSM) + r * 512, T, 1024, 512, 1024, 2048};
                        E = EpiMix{mixb, R + (size_t)5 * (BLK / 2), (const float*)(ws + WS_SSQ), r, 0};
                    }
                    pg8::StaticOrder S; S.init(T, 1024, G, bid);
                    pg8::gemm_phase(lds, g, S, E);
                }
            }
            else if (k == 7) { conv_bc(p, l); }
            else if (k == 8) { for (int un = vcu; un < 2048; un += G) ssd_local(p, l, un, lds); }
            else if (k == 9) { ssd_scan(p); }
            else if (k == 10) { for (int un = vcu; un < 2048; un += G) ssd_unit<3>(p, l, un, lds); }
            else if (k == 12 || k == 14) {
                const bool dn = (k == 14);
                pg8::Gemm g{dn ? R : mixb, (const bf16_t*)(wt + (dn ? WT_DOWN : WT_OUT)), T, 1024, dn ? 4096 : 1024, dn ? 4096 : 1024, dn ? 4096 : 1024};
                pg8::StaticOrder S; S.init(T, 1024, G, bid);
                EpiRes E{(l == 0 && !dn) ? p.in[0] : p.out, p.out, xb, rowsq + (2 * l + (dn ? 2 : 1)) * T};
                pg8::gemm_phase(lds, g, S, E);
            }
            else if (k == 13) {
                pg8::Gemm g{xb, (const bf16_t*)(wt + WT_UP), T, 4096, 1024, 1024, 1024};
                pg8::StaticOrder S; S.init(T, 4096, G, bid);
                EpiUp E{R, rowsq + (2 * l + 1) * T};
                pg8::gemm_phase(lds, g, S, E);
            }
        }
        if (ph < 30) side_phase(p, ph / PPL, ph % PPL, lds);
        if (COOP) { if (ph + 1 < p.ph_hi) { if (ph == p.ph_lo) cg::this_grid().sync(); else grid_bar((unsigned*)(ws + WS_BAR), (unsigned)(ph - p.ph_lo) * (unsigned)gridDim.x); } }
    }
}

extern "C" void kernel_launch(void* const* d_in, const int* in_sizes, int n_in, void* d_out, int out_size, void* d_ws, size_t ws_size, hipStream_t stream) {
    static int grid = 0;
    if (grid == 0) {
        if (n_in != 27 || out_size != T * 1024 || ws_size < WS_END) { fprintf(stderr, "kernel_launch: unexpected shapes/ws (n_in %d out %d ws %zu need %zu)\n", n_in, out_size, ws_size, (size_t)WS_END); grid = -1; return; }
        int dev = 0, cus = 0, per_cu = 0;
        (void)hipGetDevice(&dev); (void)hipDeviceGetAttribute(&cus, hipDeviceAttributeMultiprocessorCount, dev);
        (void)hipFuncSetAttribute((const void*)mk<true>, hipFuncAttributeMaxDynamicSharedMemorySize, LDS_BYTES);
        (void)hipOccupancyMaxActiveBlocksPerMultiprocessor(&per_cu, (const void*)mk<true>, 512, LDS_BYTES);
        if (per_cu < 1) fprintf(stderr, "kernel_launch: occupancy query says %d blocks/CU\n", per_cu);
        (void)hipGetLastError();
        grid = cus;
    }
    if (grid < 0) return;
    Params p{};
    for (int i = 0; i < 27; ++i) p.in[i] = (const float*)d_in[i];
    p.out = (float*)d_out; p.ws = (unsigned char*)d_ws;
    p.ph_lo = 0; p.ph_hi = NPHASE;
    (void)hipMemsetAsync((unsigned char*)d_ws + WS_BAR, 0, 256, stream);
    void* args[] = {&p};
    hipError_t e = hipLaunchCooperativeKernel((const void*)mk<true>, dim3(grid), dim3(512), args, LDS_BYTES, stream);
    if (e != hipSuccess) fprintf(stderr, "cooperative launch failed: %s (grid %d)\n", hipGetErrorString(e), grid);
}
```

```cpp
#include <hip/hip_runtime.h>
#include <hip/hip_cooperative_groups.h>
#include <cstdio>
#include <cstdint>
namespace cg = cooperative_groups;

#define LAS __attribute__((address_space(3)))
#define DI __device__ __forceinline__
typedef unsigned short bf16_t;
typedef short bf16x8 __attribute__((ext_vector_type(8)));
typedef short s16x4 __attribute__((ext_vector_type(4)));
typedef float f32x4 __attribute__((ext_vector_type(4)));
typedef float f32x16 __attribute__((ext_vector_type(16)));
typedef unsigned u32x4 __attribute__((ext_vector_type(4)));
typedef unsigned u32x2 __attribute__((ext_vector_type(2)));
typedef float f32x2_t __attribute__((ext_vector_type(2)));
typedef __bf16 bf16x2_t __attribute__((ext_vector_type(2)));

DI unsigned pk2(float lo, float hi) { f32x2_t v = {lo, hi}; bf16x2_t b = __builtin_convertvector(v, bf16x2_t); return __builtin_bit_cast(unsigned, b); }
DI bf16_t f2bf(float f) { return (bf16_t)(pk2(f, 0.f) & 0xffffu); }
DI float bf2f(unsigned b) { return __uint_as_float(b << 16); }
DI float bflo(unsigned w) { return __uint_as_float(w << 16); }
DI float bfhi(unsigned w) { return __uint_as_float(w & 0xffff0000u); }
DI f32x4 mfma16(bf16x8 a, bf16x8 b, f32x4 c) { return __builtin_amdgcn_mfma_f32_16x16x32_bf16(a, b, c, 0, 0, 0); }
DI f32x16 mfma32(bf16x8 a, bf16x8 b, f32x16 c) { return __builtin_amdgcn_mfma_f32_32x32x16_bf16(a, b, c, 0, 0, 0); }
DI float sigmoidf_(float x) { return __builtin_amdgcn_rcpf(1.f + __expf(-x)); }
DI float siluf_(float x) { return x * __builtin_amdgcn_rcpf(1.f + __expf(-x)); }
DI int opaque_tid() { int t = threadIdx.x; asm volatile("" : "+v"(t)); return t; }
DI int crow(int r, int hi) { return (r & 3) + 8 * (r >> 2) + 4 * hi; }

constexpr int T = 16384, SEQ = 8192, DM = 1024, DFF = 4096, INC = 14384;
constexpr float EPS = 1e-6f;
constexpr size_t MiB = 1u << 20;
constexpr size_t WS_ROWSQ = 0;
constexpr size_t WS_BAR = 448 * 1024;
constexpr size_t WS_DECG = 512 * 1024;
constexpr size_t WS_DECS = 768 * 1024;
constexpr size_t WS_SSQ = 1 * MiB;
constexpr size_t WS_SMALL = 2 * MiB;
constexpr size_t WS_XB = 6 * MiB;
constexpr size_t WS_MIXB = 38 * MiB;
constexpr size_t WS_WT = 70 * MiB;
constexpr size_t WT_GD = 0, WT_S = WT_GD + (size_t)8448 * 1024 * 2, WT_GLA = WT_S + (size_t)6144 * 1024 * 2, WT_SSM = WT_GLA + 2 * MiB,
                 WT_DIFF = WT_SSM + 4 * MiB, WT_OUT = WT_DIFF + 2 * MiB, WT_UP = WT_OUT + 2 * MiB, WT_DOWN = WT_UP + 8 * MiB, WT_END = WT_DOWN + 8 * MiB;
static_assert(WT_END <= 56 * MiB, "wt");
constexpr size_t WS_R = 126 * MiB;
constexpr size_t BLK = 32 * MiB;
constexpr size_t WS_STG = WS_R + 8 * BLK;
constexpr size_t WS_STS = WS_R + 6 * BLK;
constexpr size_t WS_SIDE = WS_R + 9 * BLK;
constexpr size_t SB_HN = WS_SIDE, SB_PROJ = SB_HN + 512 * 1024, SB_KV = SB_PROJ + 128 * 1024, SB_Y = SB_KV + 1024 * 1024, SB_GATE = SB_Y + 32 * 1024,
                 SB_BR = SB_GATE + 32 * 1024, SB_MIX = SB_BR + 32 * 1024, SB_XM = SB_MIX + 8192, SB_H2 = SB_XM + 8192, SB_UP = SB_H2 + 8192,
                 SB_HH = SB_UP + 32768, SB_X1 = SB_HH + 32768, SB_HN1 = SB_X1 + 8192, SB_QK1 = SB_HN1 + 8192, SB_END = SB_QK1 + 8192;
constexpr size_t WS_END = WS_SIDE + 2 * MiB;
static_assert(SB_END <= WS_END, "side");

struct Params {
    const float* in[27];
    float* out; unsigned char* ws;
    int ph_lo, ph_hi;
};

namespace pg8 {
constexpr int BM = 256, BK = 64, HALF = 128, HTB = HALF * BK * 2, STAGE_BYTES = 8 * HTB, NXCD = 8, WGM = 8;
__host__ __device__ __forceinline__ int lds_byte(int r, int c) { const int st = (r >> 4) * 2 + (c >> 5), rr = r & 15, cc = c & 31, ob = rr * 64 + cc * 2; return st * 1024 + (ob ^ (((ob >> 9) & 1) << 5)); }
__host__ __device__ __forceinline__ void stage_rc(int b, int& R, int& C) { const int st = b / 1024, sb = b % 1024, swz = sb ^ (((sb >> 9) & 1) << 5); R = (st >> 1) * 16 + swz / 64; C = (st & 1) * 32 + (swz % 64) / 2; }
__host__ __device__ __forceinline__ int perm32(int rho) { const int n = rho >> 4, i = rho & 15; return 8 * (i >> 2) + 4 * n + (i & 3); }
struct Unit { int pm, pn; };
struct Gemm { const bf16_t* A; const bf16_t* Bt; int M, N, K, lda, ldb; };
struct StaticOrder {
    int nM, nN, nwg, G, c;
    __host__ __device__ void init(int M, int N, int G_, int c_) { nM = M / BM; nN = N / BM; nwg = nM * nN; G = G_; c = c_; }
    __host__ __device__ bool next(int i, Unit& u) const {
        const long L = (long)i * G + c; if (L >= nwg) return false;
        int wgid = (int)L; { const int q = nwg / NXCD, r = nwg % NXCD, xcd = wgid % NXCD, off = wgid / NXCD; wgid = (xcd < r ? xcd * (q + 1) : r * (q + 1) + (xcd - r) * q) + off; }
        const int nig = WGM * nN, gid = wgid / nig, fm = gid * WGM, gsz = (nM - fm) < WGM ? (nM - fm) : WGM;
        u.pm = fm + ((wgid % nig) % gsz); u.pn = (wgid % nig) / gsz; return true;
    }
};
template <class Epi, class Sched>
__device__ __forceinline__ void gemm_phase(LAS unsigned char* lds, const Gemm g, const Sched& S, const Epi& E) {
    const int tid = opaque_tid(), wid = __builtin_amdgcn_readfirstlane(tid >> 6), lane = tid & 63, wr = wid >> 2, wc = wid & 3, fr = lane & 15, fq = lane >> 4;
    const int K = g.K, nt = K / BK;
    unsigned voffA[2], voffB[2];
#pragma unroll
    for (int i = 0; i < 2; ++i) { int R, C; stage_rc(tid * 16 + i * 8192, R, C);
        const int Rb = (R & ~31) + perm32(R & 31);
        voffA[i] = (unsigned)(R * g.lda + C) * 2u; voffB[i] = (unsigned)(Rb * g.ldb + C) * 2u; }
    const size_t kstep = (size_t)(BK * 2);
    const size_t hstepA = (size_t)HALF * g.lda * 2, hstepB = (size_t)HALF * g.ldb * 2;
    const size_t tstepA = 2 * hstepA, tstepB = 2 * hstepB;
    const unsigned ldsw = (unsigned)wid * 1024u;
    const int aoff = lds_byte(wr * 64 + fr, fq * 8), boff = lds_byte(wc * 32 + fr, fq * 8);
#define PG8_SA(b, h) (((b) * 2 + (h)) * HTB)
#define PG8_SB(b, h) ((4 + (b) * 2 + (h)) * HTB)
#define PG8_STAGE(bufoff, gbase, voff) do { _Pragma("unroll") for (int _i = 0; _i < 2; ++_i) \
        __builtin_amdgcn_global_load_lds((const unsigned*)((const char*)(gbase) + (voff)[_i]), (LAS unsigned*)(lds + (bufoff) + ldsw + _i * 8192), 16, 0, 0); } while (0)
#define PG8_LDA(dst, b, h) do { _Pragma("unroll") for (int m = 0; m < 4; ++m) _Pragma("unroll") for (int k = 0; k < 2; ++k) dst[m][k] = *(const LAS bf16x8*)(lds + PG8_SA(b, h) + aoff + m * 2048 + k * 1024); } while (0)
#define PG8_LDB(dst, b, h) do { _Pragma("unroll") for (int n = 0; n < 2; ++n) _Pragma("unroll") for (int k = 0; k < 2; ++k) dst[n][k] = *(const LAS bf16x8*)(lds + PG8_SB(b, h) + boff + n * 2048 + k * 1024); } while (0)
#define PG8_MMA(ai, bj, At, Bt) do { __builtin_amdgcn_s_setprio(1); _Pragma("unroll") for (int m = 0; m < 4; ++m) _Pragma("unroll") for (int n = 0; n < 2; ++n) _Pragma("unroll") for (int k = 0; k < 2; ++k) \
        acc[ai][bj][m][n] = __builtin_amdgcn_mfma_f32_16x16x32_bf16(Bt[n][k], At[m][k], acc[ai][bj][m][n], 0, 0, 0); __builtin_amdgcn_s_setprio(0); } while (0)
#define PG8_WAIT_V(n) asm volatile("s_waitcnt vmcnt(" #n ")" ::: "memory")
#define PG8_WAIT_L(n) asm volatile("s_waitcnt lgkmcnt(" #n ")" ::: "memory")
#define PG8_BAR __builtin_amdgcn_s_barrier()
#define PG8_SCHED __builtin_amdgcn_sched_barrier(0)
    Unit cur, nxt; int ui = 0;
    if (!S.next(0, cur)) return;
    f32x4 acc[2][2][4][2];
#pragma unroll
    for (int a = 0; a < 2; ++a)
#pragma unroll
        for (int b = 0; b < 2; ++b)
#pragma unroll
            for (int m = 0; m < 4; ++m)
#pragma unroll
                for (int n = 0; n < 2; ++n) acc[a][b][m][n] = (f32x4){0.f, 0.f, 0.f, 0.f};
    bf16x8 At[4][2], B0[2][2], B1[2][2];
    const char* cA = (const char*)g.A + (size_t)cur.pm * tstepA; const char* cB = (const char*)g.Bt + (size_t)cur.pn * tstepB;
    PG8_STAGE(PG8_SB(0, 0), cB, voffB); PG8_STAGE(PG8_SB(0, 1), cB + hstepB, voffB); PG8_STAGE(PG8_SA(0, 0), cA, voffA); PG8_STAGE(PG8_SA(0, 1), cA + hstepA, voffA);
    if (wr == 1) PG8_BAR;
    PG8_WAIT_V(2); PG8_BAR;
    PG8_STAGE(PG8_SB(1, 0), cB + kstep, voffB); PG8_STAGE(PG8_SA(1, 0), cA + kstep, voffA); PG8_STAGE(PG8_SB(1, 1), cB + hstepB + kstep, voffB);
    PG8_WAIT_V(6); PG8_BAR;
    for (;;) {
        const bool has_next = S.next(ui + 1, nxt);
        const char* nA = has_next ? (const char*)g.A + (size_t)nxt.pm * tstepA : cA; const char* nB = has_next ? (const char*)g.Bt + (size_t)nxt.pn * tstepB : cB;
        for (int t = 0; t < nt; t += 2) {
            const bool last = (t == nt - 2);
            const char* a1 = cA + (size_t)(t + 1) * kstep;
            const char* a2 = last ? nA : cA + (size_t)(t + 2) * kstep; const char* b2 = last ? nB : cB + (size_t)(t + 2) * kstep;
            const char* a3 = a2 + kstep; const char* b3 = b2 + kstep;
            PG8_LDB(B0, 0, 0); PG8_LDB(B1, 0, 1); PG8_SCHED; PG8_LDA(At, 0, 0); PG8_STAGE(PG8_SA(1, 1), a1 + hstepA, voffA);
            PG8_WAIT_V(8); PG8_WAIT_L(0); PG8_BAR; PG8_MMA(0, 0, At, B0); PG8_MMA(0, 1, At, B1); PG8_BAR; PG8_SCHED;
            PG8_LDA(At, 0, 1); PG8_STAGE(PG8_SB(0, 0), b2, voffB); PG8_STAGE(PG8_SB(0, 1), b2 + hstepB, voffB); PG8_STAGE(PG8_SA(0, 0), a2, voffA);
            PG8_WAIT_V(8); PG8_WAIT_L(0); PG8_BAR; PG8_MMA(1, 0, At, B0); PG8_MMA(1, 1, At, B1); PG8_BAR; PG8_SCHED;
            PG8_LDB(B0, 1, 0); PG8_LDB(B1, 1, 1); PG8_SCHED; PG8_LDA(At, 1, 0); PG8_STAGE(PG8_SA(0, 1), a2 + hstepA, voffA);
            PG8_WAIT_V(8); PG8_WAIT_L(0); PG8_BAR; PG8_MMA(0, 0, At, B0); PG8_MMA(0, 1, At, B1); PG8_BAR; PG8_SCHED;
            PG8_LDA(At, 1, 1); PG8_STAGE(PG8_SB(1, 0), b3, voffB); PG8_STAGE(PG8_SB(1, 1), b3 + hstepB, voffB); PG8_STAGE(PG8_SA(1, 0), a3, voffA);
            PG8_WAIT_V(8); PG8_WAIT_L(0); PG8_BAR; PG8_MMA(1, 0, At, B0); PG8_MMA(1, 1, At, B1); PG8_BAR; PG8_SCHED;
        }
        if (wr == 0) PG8_BAR;
        E(acc, cur, wr, wc, fr, fq);
        if (!has_next) break;
#pragma unroll
        for (int a = 0; a < 2; ++a)
#pragma unroll
            for (int b = 0; b < 2; ++b)
#pragma unroll
                for (int m = 0; m < 4; ++m)
#pragma unroll
                    for (int n = 0; n < 2; ++n) acc[a][b][m][n] = (f32x4){0.f, 0.f, 0.f, 0.f};
        cur = nxt; cA = nA; cB = nB; ++ui;
        if (wr == 1) PG8_BAR;
    }
    PG8_WAIT_V(0);
    PG8_BAR;
#undef PG8_SA
#undef PG8_SB
#undef PG8_STAGE
#undef PG8_LDA
#undef PG8_LDB
#undef PG8_MMA
#undef PG8_WAIT_V
#undef PG8_WAIT_L
#undef PG8_BAR
#undef PG8_SCHED
}
}

typedef f32x4 Acc[2][2][4][2];
#define EPI_ROWS(...) _Pragma("unroll") for (int ai = 0; ai < 2; ++ai) _Pragma("unroll") for (int m = 0; m < 4; ++m) { const int row = u.pm * 256 + ai * 128 + wr * 64 + m * 16 + fr; __VA_ARGS__ }
#define EPI_COLS(...) _Pragma("unroll") for (int bj = 0; bj < 2; ++bj) _Pragma("unroll") for (int n = 0; n < 2; ++n) { const int ct = bj * 128 + wc * 32 + fq * 8 + n * 4; __VA_ARGS__ }

struct EpiIn {
    bf16_t* R; const float* rowsq; float* small; int small_tile; int gblkA, gblkB; const float* biasA; const float* biasB;
    DI void operator()(const Acc& acc, const pg8::Unit& u, int wr, int wc, int fr, int fq) const {
        const int blk = u.pn >> 2, cb = (u.pn & 3) * 256;
        float rs[2][4];
        EPI_ROWS( rs[ai][m] = rsqrtf(rowsq[row] * (1.f / 1024.f) + EPS); )
        if (u.pn == small_tile) {
            asm volatile("" ::: "memory");
            EPI_ROWS( EPI_COLS( if (ct < 64) *(f32x4*)(small + (size_t)row * 64 + ct) = acc[ai][bj][m][n] * rs[ai][m]; ) )
            return;
        }
        bf16_t* dst = R + (size_t)blk * (BLK / 2);
        const float* bias = (blk == gblkA) ? biasA : ((blk == gblkB) ? biasB : nullptr);
        if (bias) {
            f32x4 bv[2][2];
            EPI_COLS( bv[bj][n] = *(const f32x4*)(bias + cb + ct); )
            asm volatile("" ::: "memory");
            EPI_ROWS( EPI_COLS( const f32x4 v = acc[ai][bj][m][n] * rs[ai][m] + bv[bj][n];
                u32x2 w; w.x = pk2(sigmoidf_(v[0]), sigmoidf_(v[1])); w.y = pk2(sigmoidf_(v[2]), sigmoidf_(v[3])); *(u32x2*)(dst + (size_t)row * 1024 + cb + ct) = w; ) )
        } else {
            asm volatile("" ::: "memory");
            EPI_ROWS( EPI_COLS( const f32x4 v = acc[ai][bj][m][n] * rs[ai][m];
                u32x2 w; w.x = pk2(v[0], v[1]); w.y = pk2(v[2], v[3]); *(u32x2*)(dst + (size_t)row * 1024 + cb + ct) = w; ) )
        }
    }
};
struct EpiMix {
    bf16_t* mixb; const bf16_t* gate; const float* ssq; int grp; int first;
    DI void operator()(const Acc& acc, const pg8::Unit& u, int wr, int wc, int fr, int fq) const {
        float rs[8];
#pragma unroll
        for (int r = 0; r < 8; ++r) { const int row = u.pm * 256 + (r >> 2) * 128 + wr * 64 + (r & 3) * 16 + fr; rs[r] = ssq ? rsqrtf(ssq[(size_t)row * 4 + grp] * (1.f / 512.f) + EPS) : 1.f; }
        u32x2 gw[2][4], mw[2][4];
#define MIX_LOAD(r, buf) do { const int row_ = u.pm * 256 + ((r) >> 2) * 128 + wr * 64 + ((r) & 3) * 16 + fr; _Pragma("unroll") for (int c_ = 0; c_ < 4; ++c_) { \
            const size_t o_ = (size_t)row_ * 1024 + u.pn * 256 + (c_ >> 1) * 128 + wc * 32 + fq * 8 + (c_ & 1) * 4; gw[buf][c_] = *(const u32x2*)(gate + o_); mw[buf][c_] = first ? (u32x2){0u, 0u} : *(const u32x2*)(mixb + o_); } } while (0)
        MIX_LOAD(0, 0);
#pragma unroll
        for (int r = 0; r < 8; ++r) { const int cur = r & 1;
            if (r < 7) MIX_LOAD(r + 1, cur ^ 1);
            asm volatile("" ::: "memory");
            const int row = u.pm * 256 + (r >> 2) * 128 + wr * 64 + (r & 3) * 16 + fr;
#pragma unroll
            for (int c = 0; c < 4; ++c) { const size_t o = (size_t)row * 1024 + u.pn * 256 + (c >> 1) * 128 + wc * 32 + fq * 8 + (c & 1) * 4;
                const f32x4 v = acc[r >> 2][c >> 1][r & 3][c & 1] * rs[r]; const u32x2 g2 = gw[cur][c], m2 = mw[cur][c];
                f32x4 q; q[0] = bflo(g2.x) * v[0] + bflo(m2.x); q[1] = bfhi(g2.x) * v[1] + bfhi(m2.x); q[2] = bflo(g2.y) * v[2] + bflo(m2.y); q[3] = bfhi(g2.y) * v[3] + bfhi(m2.y);
                u32x2 w; w.x = pk2(q[0], q[1]); w.y = pk2(q[2], q[3]); *(u32x2*)(mixb + o) = w; } }
#undef MIX_LOAD
    }
};
struct EpiRes {
    const float* xold; float* xnew; bf16_t* xb; float* rowsq;
    DI void operator()(const Acc& acc, const pg8::Unit& u, int wr, int wc, int fr, int fq) const {
        f32x4 xo[2][4];
#define RES_LOAD(r, buf) do { const int row_ = u.pm * 256 + ((r) >> 2) * 128 + wr * 64 + ((r) & 3) * 16 + fr; _Pragma("unroll") for (int c_ = 0; c_ < 4; ++c_) \
            xo[buf][c_] = *(const f32x4*)(xold + (size_t)row_ * 1024 + u.pn * 256 + (c_ >> 1) * 128 + wc * 32 + fq * 8 + (c_ & 1) * 4); } while (0)
        RES_LOAD(0, 0);
#pragma unroll
        for (int r = 0; r < 8; ++r) { const int cur = r & 1;
            if (r < 7) RES_LOAD(r + 1, cur ^ 1);
            asm volatile("" ::: "memory");
            const int row = u.pm * 256 + (r >> 2) * 128 + wr * 64 + (r & 3) * 16 + fr; float ss = 0.f;
#pragma unroll
            for (int c = 0; c < 4; ++c) { const size_t o = (size_t)row * 1024 + u.pn * 256 + (c >> 1) * 128 + wc * 32 + fq * 8 + (c & 1) * 4;
                const f32x4 v = acc[r >> 2][c >> 1][r & 3][c & 1] + xo[cur][c]; *(f32x4*)(xnew + o) = v;
                u32x2 w; w.x = pk2(v[0], v[1]); w.y = pk2(v[2], v[3]); *(u32x2*)(xb + o) = w;
                ss += v[0] * v[0] + v[1] * v[1] + v[2] * v[2] + v[3] * v[3]; }
            ss += __shfl_xor(ss, 16); ss += __shfl_xor(ss, 32);
            if (fq == 0) atomicAdd(rowsq + row, ss); }
#undef RES_LOAD
    }
};
struct EpiUp {
    bf16_t* h; const float* rowsq;
    DI void operator()(const Acc& acc, const pg8::Unit& u, int wr, int wc, int fr, int fq) const {
        float rs[2][4];
        EPI_ROWS( rs[ai][m] = rsqrtf(rowsq[row] * (1.f / 1024.f) + EPS); )
        asm volatile("" ::: "memory");
        EPI_ROWS( EPI_COLS( const f32x4 v = acc[ai][bj][m][n] * rs[ai][m];
            f32x4 r; r[0] = fmaxf(v[0], 0.f); r[1] = fmaxf(v[1], 0.f); r[2] = fmaxf(v[2], 0.f); r[3] = fmaxf(v[3], 0.f); r = r * r;
            u32x2 w; w.x = pk2(r[0], r[1]); w.y = pk2(r[2], r[3]); *(u32x2*)(h + (size_t)row * 4096 + u.pn * 256 + ct) = w; ) )
    }
};

DI int colmap(int kind, int n) {
    if (kind == 1) {
        if (n < 2048) return n;
        if (n < 3072) return 2064 + (n - 2048);
        if (n < 4096) return 11312 + (n - 3072);
        if (n < 5120) return 8240 + (n - 4096);
        if (n < 6144) return 9264 + (n - 5120);
        if (n < 7168) return 10288 + (n - 6144);
        if (n < 8192) return 13360 + (n - 7168);
        const int i = n - 8192; if (i < 16) return 2048 + i; if (i < 48) return 8208 + (i - 16); return -1;
    }
    if (kind == 2) {
        if (n < 2048) return 3088 + n;
        if (n < 5120) return 5136 + (n - 2048);
        return 12336 + (n - 5120);
    }
    return n;
}
DI void tr_item(const float* W, int ldw, int K, bf16_t* WT, const float* kscale, int kind, int kb, int nb, LAS float* scr, int lane) {
    const int k0 = 64 * kb, n0 = 32 * nb, cg = lane & 7, sub = lane >> 3; const int sc = colmap(kind, n0 + 4 * cg);
    f32x4 v[8];
#pragma unroll
    for (int i = 0; i < 8; ++i) { const int kk = 8 * i + sub; v[i] = (sc >= 0) ? *(const f32x4*)(W + (size_t)(k0 + kk) * ldw + sc) : (f32x4){0.f, 0.f, 0.f, 0.f}; }
#pragma unroll
    for (int i = 0; i < 8; ++i) { const int kk = 8 * i + sub; const float ks = kscale ? kscale[k0 + kk] : 1.f;
        scr[kk * 33 + 4 * cg + 0] = v[i][0] * ks; scr[kk * 33 + 4 * cg + 1] = v[i][1] * ks; scr[kk * 33 + 4 * cg + 2] = v[i][2] * ks; scr[kk * 33 + 4 * cg + 3] = v[i][3] * ks; }
    asm volatile("s_waitcnt lgkmcnt(0)" ::: "memory");
    const int c = lane & 7;
#pragma unroll
    for (int j = 0; j < 4; ++j) { const int n = (lane >> 3) + 8 * j; const LAS float* s = scr + (8 * c) * 33 + n;
        u32x4 o; o.x = pk2(s[0 * 33], s[1 * 33]); o.y = pk2(s[2 * 33], s[3 * 33]); o.z = pk2(s[4 * 33], s[5 * 33]); o.w = pk2(s[6 * 33], s[7 * 33]);
        *(u32x4*)(WT + (size_t)(n0 + n) * K + k0 + 8 * c) = o; }
    asm volatile("s_waitcnt lgkmcnt(0)" ::: "memory");
}
DI float wave_sum(float v) {
#pragma unroll
    for (int o = 1; o < 64; o <<= 1) v += __shfl_xor(v, o);
    return v;
}
DI void phase_prep(const Params& p, int l, LAS unsigned char* lds) {
    const int tid = opaque_tid(), lane = tid & 63, wave = __builtin_amdgcn_readfirstlane(tid >> 6);
    const int gw = blockIdx.x * 8 + wave, NGW = gridDim.x * 8;
    LAS float* scr = (LAS float*)(lds + wave * 8704);
    unsigned char* ws = p.ws; bf16_t* wt = (bf16_t*)(ws + WS_WT);
    const float* w_in = p.in[3] + (size_t)l * 1024 * INC;
    constexpr int I0 = 16 * 264, I1 = 16 * 192, I2 = 16 * 32, I3 = 32 * 32, I4 = 16 * 32, I5 = 16 * 32, I6 = 16 * 128, I7 = 64 * 32;
    constexpr int NIT = I0 + I1 + I2 + I3 + I4 + I5 + I6 + I7;
    for (int it = gw; it < NIT; it += NGW) {
        int r = it;
        if (r < I0) { tr_item(w_in, INC, 1024, (bf16_t*)((char*)wt + WT_GD), p.in[2] + l * 1024, 1, r / 264, r % 264, scr, lane); continue; } r -= I0;
        if (r < I1) { tr_item(w_in, INC, 1024, (bf16_t*)((char*)wt + WT_S), p.in[2] + l * 1024, 2, r / 192, r % 192, scr, lane); continue; } r -= I1;
        if (r < I2) { tr_item(p.in[19] + (size_t)l * 1024 * 1024, 1024, 1024, (bf16_t*)((char*)wt + WT_GLA), nullptr, 0, r / 32, r % 32, scr, lane); continue; } r -= I2;
        if (r < I3) { tr_item(p.in[20] + (size_t)l * 2048 * 1024, 1024, 2048, (bf16_t*)((char*)wt + WT_SSM), p.in[13] + l * 2048, 0, r / 32, r % 32, scr, lane); continue; } r -= I3;
        if (r < I4) { tr_item(p.in[21] + (size_t)l * 1024 * 1024, 1024, 1024, (bf16_t*)((char*)wt + WT_DIFF), nullptr, 0, r / 32, r % 32, scr, lane); continue; } r -= I4;
        if (r < I5) { tr_item(p.in[22] + (size_t)l * 1024 * 1024, 1024, 1024, (bf16_t*)((char*)wt + WT_OUT), nullptr, 0, r / 32, r % 32, scr, lane); continue; } r -= I5;
        if (r < I6) { tr_item(p.in[24] + (size_t)l * 1024 * 4096, 4096, 1024, (bf16_t*)((char*)wt + WT_UP), p.in[23] + l * 1024, 0, r / 128, r % 128, scr, lane); continue; } r -= I6;
        tr_item(p.in[25] + (size_t)l * 4096 * 1024, 1024, 4096, (bf16_t*)((char*)wt + WT_DOWN), nullptr, 0, r / 32, r % 32, scr, lane);
    }
    const int gt = blockIdx.x * 512 + tid, NT_ = gridDim.x * 512;
    float* ssq = (float*)(ws + WS_SSQ);
    for (int i = gt; i < T * 4; i += NT_) ssq[i] = 0.f;
    if (l == 0) {
        float* rowsq = (float*)(ws + WS_ROWSQ);
        for (int i = gt; i < 4 * T; i += NT_) rowsq[T + i] = 0.f;
        bf16_t* xb = (bf16_t*)(ws + WS_XB); const float* x = p.in[0];
        for (int m = gw; m < T; m += NGW) {
            const f32x4* xr = (const f32x4*)(x + (size_t)m * 1024) + lane; float s = 0.f;
            u32x2* o = (u32x2*)(xb + (size_t)m * 1024) + lane;
#pragma unroll
            for (int j = 0; j < 4; ++j) { const f32x4 v = xr[64 * j]; s += v[0] * v[0] + v[1] * v[1] + v[2] * v[2] + v[3] * v[3]; u32x2 w; w.x = pk2(v[0], v[1]); w.y = pk2(v[2], v[3]); o[64 * j] = w; }
            s = wave_sum(s); if (lane == 0) rowsq[m] = s;
        }
    }
}

DI void rope_pass(const Params& p) {
    const int* pos = (const int*)p.in[1];
    bf16_t* Qd = (bf16_t*)(p.ws + WS_R + 4 * BLK); bf16_t* Kd = (bf16_t*)(p.ws + WS_R + 5 * BLK);
    const double cf[8] = {0.15915494309189535, 0.03086376340470123, 0.005985185712713705, 0.001160663641240061, 0.00022507907903927653, 4.364795279280289e-05, 8.464330808241401e-06, 1.6414262627950345e-06};
    const int gt = blockIdx.x * 512 + opaque_tid(), NTH = gridDim.x * 512;
    for (int it0 = gt; it0 < T * 32; it0 += 4 * NTH) {
        u32x4 av[4], bv[4];
#pragma unroll
        for (int k = 0; k < 4; ++k) { const int it = it0 + k * NTH; if (it < T * 32) { const int t = it >> 5, w = it & 31; const bf16_t* base = ((w & 16) ? Kd : Qd) + (size_t)t * 1024 + (w & 15) * 64; av[k] = *(const u32x4*)base; bv[k] = *(const u32x4*)(base + 8); } }
        asm volatile("" ::: "memory");
#pragma unroll
        for (int k = 0; k < 4; ++k) { const int it = it0 + k * NTH; if (it < T * 32) {
            const int t = it >> 5, w = it & 31; bf16_t* base = ((w & 16) ? Kd : Qd) + (size_t)t * 1024 + (w & 15) * 64;
            const double ps = (double)pos[t];
            u32x4 a = av[k], b = bv[k];
            float t1[8], t2[8];
#pragma unroll
            for (int i = 0; i < 4; ++i) { t1[2 * i] = bflo(a[i]); t1[2 * i + 1] = bfhi(a[i]); t2[2 * i] = bflo(b[i]); t2[2 * i + 1] = bfhi(b[i]); }
            float o1[8], o2[8];
#pragma unroll
            for (int i = 0; i < 8; ++i) { double rv = ps * cf[i]; rv -= floor(rv); const float fr = (float)rv; const float sn = __builtin_amdgcn_sinf(fr), cs = __builtin_amdgcn_cosf(fr);
                o1[i] = t1[i] * cs - t2[i] * sn; o2[i] = t2[i] * cs + t1[i] * sn; }
#pragma unroll
            for (int i = 0; i < 4; ++i) { a[i] = pk2(o1[2 * i], o1[2 * i + 1]); b[i] = pk2(o2[2 * i], o2[2 * i + 1]); }
            *(u32x4*)base = a; *(u32x4*)(base + 8) = b; } }
    }
}

template <int KS> DI f32x4 mm16(f32x4 acc, const LAS unsigned char* A, int lda_b, const LAS unsigned char* B, int ldb_b, int lane) {
    const int r = lane & 15, q = lane >> 4;
    const LAS unsigned char* ap = A + r * lda_b + q * 16; const LAS unsigned char* bp = B + r * ldb_b + q * 16;
#pragma unroll
    for (int s = 0; s < KS; ++s) acc = mfma16(*(const LAS bf16x8*)(ap + s * 64), *(const LAS bf16x8*)(bp + s * 64), acc);
    return acc;
}
DI float logsigmoidf_(float x) { return fminf(x, 0.f) - __logf(1.f + __expf(-fabsf(x))); }

constexpr int G_GKL = 0, G_QTOT = 4096, G_BLAST = 6144, G_PART = 6656, G_QT = 8704, G_KT = 26112, G_KHT = 43520, G_VT = 61952, G_P = 98816;
template <int MODE> DI void gla_unit(const Params& p, int l, int un, LAS unsigned char* lds) {
    const int tid = opaque_tid(), lane = tid & 63, w = __builtin_amdgcn_readfirstlane(tid >> 6), r16 = lane & 15, quad = lane >> 4;
    const int sc = un >> 2, h = un & 3, tok0 = sc * 256;
    unsigned char* ws = p.ws;
    const bf16_t* QK = (const bf16_t*)(ws + WS_R); const bf16_t* Vg = (const bf16_t*)(ws + WS_R + BLK); bf16_t* Gg = (bf16_t*)(ws + WS_R + 2 * BLK);
    const float* small = (const float*)(ws + WS_SMALL);
    float* states = (float*)(ws + WS_STG) + (size_t)un * 32768;
    const int d = tid & 127, qr = tid >> 7;
    float wk[16];
#pragma unroll
    for (int r = 0; r < 16; ++r) wk[r] = p.in[5][(size_t)l * 16 * 512 + r * 512 + h * 128 + d];
    const float bk = p.in[6][l * 512 + h * 128 + d];
    f32x4 S[8][2];
    if (MODE == 3) {
#pragma unroll
        for (int mb = 0; mb < 8; ++mb)
#pragma unroll
            for (int nb = 0; nb < 2; ++nb) S[mb][nb] = *(const f32x4*)(states + ((size_t)(w * 16 + mb * 2 + nb) * 64 + lane) * 4);
    } else {
#pragma unroll
        for (int mb = 0; mb < 8; ++mb)
#pragma unroll
            for (int nb = 0; nb < 2; ++nb) S[mb][nb] = (f32x4){0.f, 0.f, 0.f, 0.f};
    }
    float ng[2] = {0.f, 0.f};
    if (MODE == 3) { ng[0] = p.in[7][l * 256 + 32 * w + r16]; ng[1] = p.in[7][l * 256 + 32 * w + 16 + r16]; }
    float dtot = 1.f;
    for (int j = 0; j < 4; ++j) {
        const int t0 = tok0 + 64 * j;
        if (tid < 256) { const int row = tid >> 2, c4 = (tid & 3) * 4; *(LAS f32x4*)(lds + G_GKL + (row * 16 + c4) * 4) = *(const f32x4*)(small + (size_t)(t0 + row) * 64 + c4); }
        if (tid < 64) ((LAS float*)(lds + G_PART))[tid] = 0.f;
        __syncthreads();
        float c[16]; float run = 0.f;
#pragma unroll
        for (int i = 0; i < 16; ++i) { const LAS f32x4* gr = (const LAS f32x4*)(lds + G_GKL) + (qr * 16 + i) * 4; float x = bk;
#pragma unroll
            for (int r = 0; r < 4; ++r) { const f32x4 g4 = gr[r]; x += g4[0] * wk[4 * r] + g4[1] * wk[4 * r + 1] + g4[2] * wk[4 * r + 2] + g4[3] * wk[4 * r + 3]; }
            run += logsigmoidf_(x) * (1.f / 16.f); c[i] = run; }
        ((LAS float*)(lds + G_QTOT))[qr * 128 + d] = run;
        __syncthreads();
        {
            float off = 0.f, bl = 0.f;
#pragma unroll
            for (int q2 = 0; q2 < 4; ++q2) { const float v = ((const LAS float*)(lds + G_QTOT))[q2 * 128 + d]; bl += v; if (q2 < qr) off += v; }
            unsigned khp[8]; const float ebl = __expf(bl);
#pragma unroll
            for (int i = 0; i < 16; i += 2) {
                float kh2[2];
#pragma unroll
                for (int e = 0; e < 2; ++e) { const int t = qr * 16 + i + e; const float b = off + c[i + e];
                    const float k = bf2f(QK[(size_t)(t0 + t) * 1024 + 512 + h * 128 + d]);
                    const float enb = __expf(-b), kt_ = k * enb;
                    kh2[e] = kt_ * ebl;
                    if (MODE == 3) { const float q = bf2f(QK[(size_t)(t0 + t) * 1024 + h * 128 + d]);
                        ((LAS bf16_t*)(lds + G_QT))[t * 136 + d] = f2bf(q * 0.08838834764831845f * __builtin_amdgcn_rcpf(enb));
                        ((LAS bf16_t*)(lds + G_KT))[t * 136 + d] = f2bf(kt_); } }
                khp[i >> 1] = pk2(kh2[0], kh2[1]);
            }
            *(LAS u32x4*)(lds + G_KHT + d * 144 + qr * 32) = (u32x4){khp[0], khp[1], khp[2], khp[3]};
            *(LAS u32x4*)(lds + G_KHT + d * 144 + qr * 32 + 16) = (u32x4){khp[4], khp[5], khp[6], khp[7]};
            if (qr == 0) { ((LAS float*)(lds + G_BLAST))[d] = bl; dtot *= ebl; }
#pragma unroll
            for (int i = 0; i < 4; ++i) { const int pid = tid + 512 * i, g8 = pid >> 6, t = pid & 63;
                const u32x4 v = *(const u32x4*)(Vg + (size_t)(t0 + t) * 1024 + h * 256 + g8 * 8);
                LAS bf16_t* vt = (LAS bf16_t*)(lds + G_VT) + (g8 * 8) * 72 + t;
#pragma unroll
                for (int e = 0; e < 4; ++e) { vt[(2 * e) * 72] = (bf16_t)(v[e] & 0xffffu); vt[(2 * e + 1) * 72] = (bf16_t)(v[e] >> 16); } }
        }
        __syncthreads();
        if (MODE == 3) {
#pragma unroll
            for (int e = 0; e < 2; ++e) { const int x = 2 * w + e, tb = x >> 2, sb = x & 3;
                f32x4 a = (f32x4){0.f, 0.f, 0.f, 0.f};
                if (sb <= tb) a = mm16<4>(a, lds + G_KT + sb * 16 * 272, 272, lds + G_QT + tb * 16 * 272, 272, lane);
                const int t = 16 * tb + r16, s0 = 16 * sb + quad * 4;
                float v[4];
#pragma unroll
                for (int jj = 0; jj < 4; ++jj) v[jj] = (s0 + jj <= t) ? a[jj] : 0.f;
                if (x == 0 && lane == 0 && j == 0 && (tok0 & (SEQ - 1)) == 0) { const float* qk_ = (l == 0) ? (const float*)(ws + SB_PROJ) + (tok0 >> 13) * 14384 : (const float*)(ws + SB_QK1) + (tok0 >> 13) * 1024;
                    float acc_ = 0.f; for (int d_ = 0; d_ < 128; ++d_) acc_ += qk_[h * 128 + d_] * qk_[512 + h * 128 + d_]; v[0] = acc_ * 0.08838834764831845f; }
                *(LAS u32x2*)(lds + G_P + t * 144 + s0 * 2) = (u32x2){pk2(v[0], v[1]), pk2(v[2], v[3])}; }
            f32x4 o[4][2];
#pragma unroll
            for (int mb = 0; mb < 4; ++mb) { o[mb][0] = (f32x4){0.f, 0.f, 0.f, 0.f}; o[mb][1] = (f32x4){0.f, 0.f, 0.f, 0.f}; }
#pragma unroll
            for (int ks = 0; ks < 4; ++ks) {
                bf16x8 bf[2];
#pragma unroll
                for (int nb = 0; nb < 2; ++nb) { const f32x4 s0v = S[2 * ks][nb], s1v = S[2 * ks + 1][nb];
                    u32x4 pk; pk.x = pk2(s0v[0], s0v[1]); pk.y = pk2(s0v[2], s0v[3]); pk.z = pk2(s1v[0], s1v[1]); pk.w = pk2(s1v[2], s1v[3]); bf[nb] = __builtin_bit_cast(bf16x8, pk); }
#pragma unroll
                for (int mb = 0; mb < 4; ++mb) { const LAS unsigned char* ap = lds + G_QT + (16 * mb + r16) * 272 + (32 * ks + quad * 4) * 2;
                    const u32x2 lo = *(const LAS u32x2*)ap, hi = *(const LAS u32x2*)(ap + 32);
                    const bf16x8 af = __builtin_bit_cast(bf16x8, (u32x4){lo.x, lo.y, hi.x, hi.y});
                    o[mb][0] = mfma16(af, bf[0], o[mb][0]); o[mb][1] = mfma16(af, bf[1], o[mb][1]); }
            }
            __syncthreads();
#pragma unroll
            for (int mb = 0; mb < 4; ++mb)
#pragma unroll
                for (int nb = 0; nb < 2; ++nb) o[mb][nb] = mm16<2>(o[mb][nb], lds + G_P + mb * 16 * 144, 144, lds + G_VT + (32 * w + 16 * nb) * 144, 144, lane);
#pragma unroll
            for (int mb = 0; mb < 4; ++mb)
#pragma unroll
                for (int jj = 0; jj < 4; ++jj) { float ss = o[mb][0][jj] * o[mb][0][jj] + o[mb][1][jj] * o[mb][1][jj];
                    ss += __shfl_xor(ss, 1); ss += __shfl_xor(ss, 2); ss += __shfl_xor(ss, 4); ss += __shfl_xor(ss, 8);
                    if (r16 == 0) __hip_atomic_fetch_add((LAS float*)(lds + G_PART) + 16 * mb + quad * 4 + jj, ss, __ATOMIC_RELAXED, __HIP_MEMORY_SCOPE_WORKGROUP); }
            __syncthreads();
            bf16_t gin[4][4][2];
#pragma unroll
            for (int mb = 0; mb < 4; ++mb)
#pragma unroll
                for (int jj = 0; jj < 4; ++jj)
#pragma unroll
                    for (int nb = 0; nb < 2; ++nb) gin[mb][jj][nb] = Gg[(size_t)(t0 + 16 * mb + quad * 4 + jj) * 1024 + h * 256 + 32 * w + 16 * nb + r16];
            asm volatile("" ::: "memory");
#pragma unroll
            for (int mb = 0; mb < 4; ++mb)
#pragma unroll
                for (int jj = 0; jj < 4; ++jj) { const int t = 16 * mb + quad * 4 + jj; const float rs = rsqrtf(((const LAS float*)(lds + G_PART))[t] * (1.f / 256.f) + EPS);
#pragma unroll
                    for (int nb = 0; nb < 2; ++nb) { bf16_t* gp = Gg + (size_t)(t0 + t) * 1024 + h * 256 + 32 * w + 16 * nb + r16;
                        *gp = f2bf(o[mb][nb][jj] * rs * ng[nb] * siluf_(bf2f(gin[mb][jj][nb]))); } }
        }
#pragma unroll
        for (int mb = 0; mb < 8; ++mb) { const f32x4 bl4 = *(const LAS f32x4*)(lds + G_BLAST + (16 * mb + quad * 4) * 4);
            const f32x4 dc = (f32x4){__expf(bl4[0]), __expf(bl4[1]), __expf(bl4[2]), __expf(bl4[3])};
#pragma unroll
            for (int nb = 0; nb < 2; ++nb) { S[mb][nb] = S[mb][nb] * dc;
                S[mb][nb] = mm16<2>(S[mb][nb], lds + G_KHT + mb * 16 * 144, 144, lds + G_VT + (32 * w + 16 * nb) * 144, 144, lane); } }
        __syncthreads();
    }
    if (MODE == 1) {
#pragma unroll
        for (int mb = 0; mb < 8; ++mb)
#pragma unroll
            for (int nb = 0; nb < 2; ++nb) *(f32x4*)(states + ((size_t)(w * 16 + mb * 2 + nb) * 64 + lane) * 4) = S[mb][nb];
        if (tid < 128) ((float*)(ws + WS_DECG))[un * 128 + tid] = dtot;
    }
}
DI void gla_scan(const Params& p) {
    const int gid = blockIdx.x * 512 + opaque_tid();
    for (int it = gid; it < 65536; it += gridDim.x * 512) {
        const int chain = it >> 13, e = it & 8191, b = chain >> 2, h = chain & 3;
        const int tile = (e >> 6) & 15, lane = e & 63, d0 = 16 * (tile >> 1) + (lane >> 4) * 4;
        f32x4* st = (f32x4*)(p.ws + WS_STG); const float* dec = (const float*)(p.ws + WS_DECG);
        f32x4 run = (f32x4){0.f, 0.f, 0.f, 0.f};
        for (int hb = 0; hb < 4; ++hb) {
            f32x4 u[8];
#pragma unroll
            for (int s = 0; s < 8; ++s) u[s] = st[(size_t)((b * 32 + hb * 8 + s) * 4 + h) * 8192 + e];
            asm volatile("" ::: "memory");
#pragma unroll
            for (int s = 0; s < 8; ++s) { const int un = (b * 32 + hb * 8 + s) * 4 + h; const f32x4 dc = *(const f32x4*)(dec + un * 128 + d0);
                st[(size_t)un * 8192 + e] = run; run = run * dc + u[s]; }
        }
    }
}

constexpr int S_ACUM = 0, S_DTV = 256, S_MISC = 512, S_XDT = 1024, S_XD2 = 10240, S_BN = 19456, S_BT = 36864, S_CN = 55296, S_GL = 72704, S_SB = 81920;
DI float softplusf_(float x) { const float e = __expf(x); return x > 20.f ? x : (x < -10.f ? e : __logf(1.f + e)); }
template <int MODE> DI void ssd_unit(const Params& p, int l, int un, LAS unsigned char* lds) {
    const int tid = opaque_tid(), lane = tid & 63, w = __builtin_amdgcn_readfirstlane(tid >> 6), r16 = lane & 15, quad = lane >> 4;
    const int sc = un >> 5, head = un & 31, g = head >> 3, tok0 = sc * 256;
    unsigned char* ws = p.ws;
    bf16_t* Zb = (bf16_t*)(ws + WS_R + (size_t)(head >> 4) * BLK) + (head & 15) * 64;
    const bf16_t* Xb = (const bf16_t*)(ws + WS_R + (size_t)(2 + (head >> 4)) * BLK) + (head & 15) * 64;
    const bf16_t* BCb = (const bf16_t*)(ws + WS_R + 4 * BLK);
    const float* small = (const float*)(ws + WS_SMALL);
    float* ssq = (float*)(ws + WS_SSQ);
    float* states = (float*)(ws + WS_STS) + (size_t)un * 8192;
    const float* cw = p.in[8] + (size_t)l * 4 * 3072; const float* cbias = p.in[9] + l * 3072;
    const float dtb = p.in[10][l * 32 + head], aneg = -__expf(p.in[11][l * 32 + head]), Dh = p.in[12][l * 32 + head];
    f32x4 st[4];
    if (MODE == 3) {
#pragma unroll
        for (int pb = 0; pb < 4; ++pb) { st[pb] = *(const f32x4*)(states + ((size_t)(w * 4 + pb) * 64 + lane) * 4);
            *(LAS u32x2*)(lds + S_SB + (16 * pb + r16) * 272 + (16 * w + quad * 4) * 2) = (u32x2){pk2(st[pb][0], st[pb][1]), pk2(st[pb][2], st[pb][3])}; }
    } else {
#pragma unroll
        for (int pb = 0; pb < 4; ++pb) st[pb] = (f32x4){0.f, 0.f, 0.f, 0.f};
    }
    const int px = tid & 63, tq = tid >> 6;
    float wx[4];
#pragma unroll
    for (int i = 0; i < 4; ++i) wx[i] = cw[i * 3072 + head * 64 + px];
    const float bx = cbias[head * 64 + px];
    float atot = 0.f;
    for (int j = 0; j < 4; ++j) {
        const int t0 = tok0 + 64 * j, s0 = t0 & (SEQ - 1);
        if (w == 0) {
            const float dt = softplusf_(small[(size_t)(t0 + lane) * 64 + 16 + head] + dtb);
            float cs = dt * aneg;
#pragma unroll
            for (int o = 1; o < 64; o <<= 1) { const float v = __shfl_up(cs, o); if (lane >= o) cs += v; }
            ((LAS float*)(lds + S_ACUM))[lane] = cs; ((LAS float*)(lds + S_DTV))[lane] = dt;
            if (lane == 63) ((LAS float*)(lds + S_MISC))[0] = cs;
        }
        __syncthreads();
        const float alast = ((const LAS float*)(lds + S_MISC))[0];
        atot += alast;
        {
            float xv[11];
#pragma unroll
            for (int k = 0; k < 11; ++k) { const int tt = tq * 8 - 3 + k; xv[k] = (s0 + tt >= 0) ? bf2f(Xb[(size_t)(t0 + tt) * 1024 + px]) : 0.f; }
            unsigned a1[4], a2[4]; float e1[2], e2[2];
#pragma unroll
            for (int i = 0; i < 8; ++i) { const int t = tq * 8 + i;
                const float cv = bx + xv[i] * wx[0] + xv[i + 1] * wx[1] + xv[i + 2] * wx[2] + xv[i + 3] * wx[3];
                const float xd = siluf_(cv) * ((const LAS float*)(lds + S_DTV))[t];
                e1[i & 1] = xd; e2[i & 1] = xd * __expf(alast - ((const LAS float*)(lds + S_ACUM))[t]);
                if (i & 1) { a1[i >> 1] = pk2(e1[0], e1[1]); a2[i >> 1] = pk2(e2[0], e2[1]); } }
            *(LAS u32x4*)(lds + S_XDT + px * 144 + tq * 16) = (u32x4){a1[0], a1[1], a1[2], a1[3]};
            *(LAS u32x4*)(lds + S_XD2 + px * 144 + tq * 16) = (u32x4){a2[0], a2[1], a2[2], a2[3]};
        }
        {
            const bf16_t* BCc = (const bf16_t*)(ws + WS_STG);
#pragma unroll
            for (int i = 0; i < 2; ++i) { const int pid = tid + 512 * i, c8 = pid >> 6, t = pid & 63;
                const u32x4 v = *(const u32x4*)(BCc + (size_t)(t0 + t) * 1024 + g * 128 + c8 * 8);
                if (MODE == 3) *(LAS u32x4*)(lds + S_BN + t * 272 + c8 * 16) = v;
                LAS bf16_t* bt = (LAS bf16_t*)(lds + S_BT) + (c8 * 8) * 72 + t;
#pragma unroll
                for (int e = 0; e < 4; ++e) { bt[(2 * e) * 72] = (bf16_t)(v[e] & 0xffffu); bt[(2 * e + 1) * 72] = (bf16_t)(v[e] >> 16); }
                if (MODE == 3) { const u32x4 cv = *(const u32x4*)(BCc + (size_t)(t0 + t) * 1024 + 512 + g * 128 + c8 * 8); *(LAS u32x4*)(lds + S_CN + t * 272 + c8 * 16) = cv; } }
        }
        __syncthreads();
        if (MODE == 3) {
            f32x4 y[2];
#pragma unroll
            for (int e = 0; e < 2; ++e) { const int x = 2 * w + e, tb = x >> 2, sb = x & 3;
                f32x4 a = (f32x4){0.f, 0.f, 0.f, 0.f};
                if (sb <= tb) a = mm16<4>(a, lds + S_BN + sb * 16 * 272, 272, lds + S_CN + tb * 16 * 272, 272, lane);
                const int t = 16 * tb + r16, sb0 = 16 * sb + quad * 4;
                const float act = ((const LAS float*)(lds + S_ACUM))[t], dtt = ((const LAS float*)(lds + S_DTV))[t];
                float v[4];
#pragma unroll
                for (int jj = 0; jj < 4; ++jj) { const int s = sb0 + jj; float val = 0.f;
                    if (s <= t) val = a[jj] * __expf(act - ((const LAS float*)(lds + S_ACUM))[s]);
                    if (s == t) val += Dh * __builtin_amdgcn_rcpf(dtt);
                    v[jj] = val; }
                *(LAS u32x2*)(lds + S_GL + t * 144 + sb0 * 2) = (u32x2){pk2(v[0], v[1]), pk2(v[2], v[3])};
                const int pb = sb;
                y[e] = mm16<4>((f32x4){0.f, 0.f, 0.f, 0.f}, lds + S_SB + pb * 16 * 272, 272, lds + S_CN + tb * 16 * 272, 272, lane);
                y[e] = y[e] * __expf(act);
            }
            __syncthreads();
            u32x2 zin[2];
#pragma unroll
            for (int e = 0; e < 2; ++e) { const int x = 2 * w + e; zin[e] = *(const u32x2*)(Zb + (size_t)(t0 + 16 * (x >> 2) + r16) * 1024 + 16 * (x & 3) + quad * 4); }
            asm volatile("" ::: "memory");
#pragma unroll
            for (int e = 0; e < 2; ++e) { const int x = 2 * w + e, tb = x >> 2, pb = x & 3;
                y[e] = mm16<2>(y[e], lds + S_XDT + pb * 16 * 144, 144, lds + S_GL + tb * 16 * 144, 144, lane);
                const int t = 16 * tb + r16; bf16_t* zp = Zb + (size_t)(t0 + t) * 1024 + 16 * pb + quad * 4;
                const u32x2 zw = zin[e];
                f32x4 r; r[0] = y[e][0] * siluf_(bflo(zw.x)); r[1] = y[e][1] * siluf_(bfhi(zw.x)); r[2] = y[e][2] * siluf_(bflo(zw.y)); r[3] = y[e][3] * siluf_(bfhi(zw.y));
                float ss = r[0] * r[0] + r[1] * r[1] + r[2] * r[2] + r[3] * r[3];
                ss += __shfl_xor(ss, 16); ss += __shfl_xor(ss, 32);
                if (quad == 0) atomicAdd(ssq + (size_t)(t0 + t) * 4 + g, ss);
                *(u32x2*)zp = (u32x2){pk2(r[0], r[1]), pk2(r[2], r[3])}; }
        }
        {
            const float da = __expf(alast);
#pragma unroll
            for (int pb = 0; pb < 4; ++pb) { st[pb] = st[pb] * da;
                st[pb] = mm16<2>(st[pb], lds + S_BT + w * 16 * 144, 144, lds + S_XD2 + pb * 16 * 144, 144, lane);
                if (MODE == 3) *(LAS u32x2*)(lds + S_SB + (16 * pb + r16) * 272 + (16 * w + quad * 4) * 2) = (u32x2){pk2(st[pb][0], st[pb][1]), pk2(st[pb][2], st[pb][3])}; }
        }
        __syncthreads();
    }
    if (MODE == 1) {
#pragma unroll
        for (int pb = 0; pb < 4; ++pb) *(f32x4*)(states + ((size_t)(w * 4 + pb) * 64 + lane) * 4) = st[pb];
        if (tid == 0) ((float*)(ws + WS_DECS))[un] = __expf(atot);
    }
}

DI void conv_bc(const Params& p, int l) {
    const bf16_t* BC = (const bf16_t*)(p.ws + WS_R + 4 * BLK); bf16_t* O = (bf16_t*)(p.ws + WS_STG);
    const float* cw = p.in[8] + (size_t)l * 4 * 3072 + 2048; const float* cb = p.in[9] + l * 3072 + 2048;
    const int gt = blockIdx.x * 512 + opaque_tid();
    for (int it = gt; it < 1024 * 256; it += gridDim.x * 512) {
        const int c = it & 1023, r0 = (it >> 10) * 64;
        const float w0 = cw[c], w1 = cw[3072 + c], w2 = cw[2 * 3072 + c], w3 = cw[3 * 3072 + c], b = cb[c];
        float xin[67];
        const bool hist = (r0 & (SEQ - 1)) != 0;
#pragma unroll
        for (int i = 0; i < 67; ++i) xin[i] = (i >= 3 || hist) ? bf2f(BC[(size_t)(r0 - 3 + i) * 1024 + c]) : 0.f;
        asm volatile("" ::: "memory");
#pragma unroll
        for (int i = 0; i < 64; ++i) { const float cv = b + xin[i] * w0 + xin[i + 1] * w1 + xin[i + 2] * w2 + xin[i + 3] * w3; O[(size_t)(r0 + i) * 1024 + c] = f2bf(siluf_(cv)); }
    }
}

constexpr int L_ACUM = 0, L_DTV = 1024, L_TOT = 2048, L_XD2 = 2304, L_BT = 36096;
DI void ssd_local(const Params& p, int l, int un, LAS unsigned char* lds) {
    const int tid = opaque_tid(), lane = tid & 63, w = __builtin_amdgcn_readfirstlane(tid >> 6);
    const int sc = un >> 5, head = un & 31, g = head >> 3, tok0 = sc * 256, s0 = tok0 & (SEQ - 1);
    unsigned char* ws = p.ws;
    const bf16_t* Xb = (const bf16_t*)(ws + WS_R + (size_t)(2 + (head >> 4)) * BLK) + (head & 15) * 64;
    const bf16_t* BCc = (const bf16_t*)(ws + WS_STG);
    const float* small = (const float*)(ws + WS_SMALL);
    float* states = (float*)(ws + WS_STS) + (size_t)un * 8192;
    const float* cw = p.in[8] + (size_t)l * 4 * 3072; const float* cbias = p.in[9] + l * 3072;
    const float dtb = p.in[10][l * 32 + head], aneg = -__expf(p.in[11][l * 32 + head]);
    if (w < 4) {
        const int t = w * 64 + lane; const float dt = softplusf_(small[(size_t)(tok0 + t) * 64 + 16 + head] + dtb);
        float cs = dt * aneg;
#pragma unroll
        for (int o = 1; o < 64; o <<= 1) { const float v = __shfl_up(cs, o); if (lane >= o) cs += v; }
        ((LAS float*)(lds + L_ACUM))[t] = cs; ((LAS float*)(lds + L_DTV))[t] = dt;
        if (lane == 63) ((LAS float*)(lds + L_TOT))[w] = cs;
    }
    __syncthreads();
    const float t0_ = ((const LAS float*)(lds + L_TOT))[0], t1_ = ((const LAS float*)(lds + L_TOT))[1], t2_ = ((const LAS float*)(lds + L_TOT))[2], t3_ = ((const LAS float*)(lds + L_TOT))[3];
    const float atot = t0_ + t1_ + t2_ + t3_;
    {
        const int px = tid & 63, tq = tid >> 6;
        float wx[4];
#pragma unroll
        for (int i = 0; i < 4; ++i) wx[i] = cw[i * 3072 + head * 64 + px];
        const float bx = cbias[head * 64 + px];
        const float offq = (tq >= 6) ? t0_ + t1_ + t2_ : (tq >= 4) ? t0_ + t1_ : (tq >= 2) ? t0_ : 0.f;
#pragma unroll
        for (int c4 = 0; c4 < 4; ++c4) { const int tb = tq * 32 + c4 * 8;
            float xv[11];
#pragma unroll
            for (int k = 0; k < 11; ++k) { const int tt = tb - 3 + k; xv[k] = (s0 + tt >= 0) ? bf2f(Xb[(size_t)(tok0 + tt) * 1024 + px]) : 0.f; }
            unsigned a2[4]; float e2[2];
#pragma unroll
            for (int i = 0; i < 8; ++i) { const int t = tb + i;
                const float cv = bx + xv[i] * wx[0] + xv[i + 1] * wx[1] + xv[i + 2] * wx[2] + xv[i + 3] * wx[3];
                e2[i & 1] = siluf_(cv) * ((const LAS float*)(lds + L_DTV))[t] * __expf(atot - offq - ((const LAS float*)(lds + L_ACUM))[t]);
                if (i & 1) a2[i >> 1] = pk2(e2[0], e2[1]); }
            *(LAS u32x4*)(lds + L_XD2 + px * 528 + tb * 2) = (u32x4){a2[0], a2[1], a2[2], a2[3]}; }
    }
#pragma unroll
    for (int i = 0; i < 8; ++i) { const int pid = tid + 512 * i, c8 = pid >> 8, t = pid & 255;
        const u32x4 v = *(const u32x4*)(BCc + (size_t)(tok0 + t) * 1024 + g * 128 + c8 * 8);
        LAS bf16_t* bt = (LAS bf16_t*)(lds + L_BT) + (c8 * 8) * 264 + t;
#pragma unroll
        for (int e = 0; e < 4; ++e) { bt[(2 * e) * 264] = (bf16_t)(v[e] & 0xffffu); bt[(2 * e + 1) * 264] = (bf16_t)(v[e] >> 16); } }
    __syncthreads();
#pragma unroll
    for (int pb = 0; pb < 4; ++pb) { const f32x4 st = mm16<8>((f32x4){0.f, 0.f, 0.f, 0.f}, lds + L_BT + w * 16 * 528, 528, lds + L_XD2 + pb * 16 * 528, 528, lane);
        *(f32x4*)(states + ((size_t)(w * 4 + pb) * 64 + lane) * 4) = st; }
    if (tid == 0) ((float*)(ws + WS_DECS))[un] = __expf(atot);
    __syncthreads();
}
DI void ssd_scan(const Params& p) {
    const int gid = blockIdx.x * 512 + opaque_tid();
    for (int it = gid; it < 131072; it += gridDim.x * 512) {
        const int chain = it >> 11, e = it & 2047, b = chain >> 5, head = chain & 31;
        f32x4* st = (f32x4*)(p.ws + WS_STS); const float* dec = (const float*)(p.ws + WS_DECS);
        f32x4 run = (f32x4){0.f, 0.f, 0.f, 0.f};
        for (int hb = 0; hb < 4; ++hb) {
            f32x4 u[8];
#pragma unroll
            for (int s = 0; s < 8; ++s) u[s] = st[(size_t)((b * 32 + hb * 8 + s) * 32 + head) * 2048 + e];
            asm volatile("" ::: "memory");
#pragma unroll
            for (int s = 0; s < 8; ++s) { const int un = (b * 32 + hb * 8 + s) * 32 + head; const float dc = dec[un];
                st[(size_t)un * 2048 + e] = run; run = run * dc + u[s]; }
        }
    }
}

typedef short v4i16_t __attribute__((ext_vector_type(4)));
DI s16x4 vtr(const LAS unsigned char* p) { return __builtin_bit_cast(s16x4, __builtin_amdgcn_ds_read_tr16_b64_v4i16((LAS v4i16_t*)p)); }
constexpr int A_K = 0, A_V = 34816, A_X = 0, A_Y = 65536, A_NG = 100352;
DI void attn_unit(const Params& p, int b, int h, int qb, float lam, float oscale, LAS unsigned char* lds) {
    const int tid = opaque_tid(), lane = tid & 63, w = __builtin_amdgcn_readfirstlane(tid >> 6), rg = w & 3, sub = w >> 2, q = lane & 31, hh = lane >> 5;
    bf16_t* Qd = (bf16_t*)(p.ws + WS_R + 4 * BLK); const bf16_t* Kd = (const bf16_t*)(p.ws + WS_R + 5 * BLK); const bf16_t* Vd = (const bf16_t*)(p.ws + WS_R + 6 * BLK);
    const int tok0 = b * SEQ + qb * 128;
    bf16x8 qf[4];
    { const bf16_t* qp = Qd + (size_t)(tok0 + rg * 32 + q) * 1024 + h * 128 + sub * 64 + hh * 8;
#pragma unroll
      for (int ks = 0; ks < 4; ++ks) qf[ks] = *(const bf16x8*)(qp + ks * 16); }
    const int NT = 2 * qb + 2;
    u32x4 kr[2], vr[2];
    const int prow = tid >> 4, pc16 = tid & 15;
#define ATT_LOAD(t) do { _Pragma("unroll") for (int i_ = 0; i_ < 2; ++i_) { const size_t off_ = (size_t)(b * SEQ + (t) * 64 + prow + 32 * i_) * 1024 + h * 128 + pc16 * 8; \
        kr[i_] = *(const u32x4*)(Kd + off_); vr[i_] = *(const u32x4*)(Vd + off_); } } while (0)
#define ATT_STORE(buf) do { _Pragma("unroll") for (int i_ = 0; i_ < 2; ++i_) { const int o_ = (buf) * 17408 + (prow + 32 * i_) * 272 + pc16 * 16; \
        *(LAS u32x4*)(lds + A_K + o_) = kr[i_]; *(LAS u32x4*)(lds + A_V + (buf) * 18432 + (prow + 32 * i_) * 288 + pc16 * 16) = vr[i_]; } } while (0)
    f32x16 o[4];
#pragma unroll
    for (int db = 0; db < 4; ++db)
#pragma unroll
        for (int i = 0; i < 16; ++i) o[db][i] = 0.f;
    float m_run = -1e30f, l_run = 0.f;
    const float C2 = 0.18033688011112042f;
    ATT_LOAD(0); ATT_STORE(0); ATT_LOAD(1);
    __syncthreads();
    const int i16 = lane & 15, blk = (lane >> 4) & 1;
    for (int t = 0; t < NT; ++t) {
        if (t + 1 < NT) ATT_STORE((t + 1) & 1);
        if (t + 2 < NT) ATT_LOAD(t + 2);
        if (t <= 2 * qb + (rg >> 1)) {
            const LAS unsigned char* Kb = lds + A_K + (t & 1) * 17408; const LAS unsigned char* Vb = lds + A_V + (t & 1) * 18432;
            f32x16 s0, s1;
#pragma unroll
            for (int i = 0; i < 16; ++i) { s0[i] = 0.f; s1[i] = 0.f; }
#pragma unroll
            for (int ks = 0; ks < 4; ++ks) { const LAS unsigned char* kp = Kb + q * 272 + (sub * 64 + ks * 16 + hh * 8) * 2;
                s0 = mfma32(*(const LAS bf16x8*)kp, qf[ks], s0); s1 = mfma32(*(const LAS bf16x8*)(kp + 32 * 272), qf[ks], s1); }
            float mx = fmaxf(s0[0], s1[0]);
#pragma unroll
            for (int i = 1; i < 16; ++i) mx = fmaxf(mx, fmaxf(s0[i], s1[i]));
            mx = fmaxf(mx, __shfl_xor(mx, 32));
            const float m_new = fmaxf(m_run, mx), negm = -m_new * C2;
            if (__any(m_new > m_run)) {
                const float alpha = __builtin_amdgcn_exp2f((m_run - m_new) * C2);
                l_run *= alpha;
#pragma unroll
                for (int db = 0; db < 4; ++db)
#pragma unroll
                    for (int i = 0; i < 16; ++i) o[db][i] *= alpha;
            }
            float sum = 0.f;
#pragma unroll
            for (int i = 0; i < 16; ++i) { s0[i] = __builtin_amdgcn_exp2f(fmaf(s0[i], C2, negm)); s1[i] = __builtin_amdgcn_exp2f(fmaf(s1[i], C2, negm)); sum += s0[i] + s1[i]; }
            l_run += sum; m_run = m_new;
            bf16x8 pf[2][2];
#pragma unroll
            for (int s = 0; s < 2; ++s) {
                pf[0][s] = __builtin_bit_cast(bf16x8, (u32x4){pk2(s0[8 * s], s0[8 * s + 1]), pk2(s0[8 * s + 2], s0[8 * s + 3]), pk2(s0[8 * s + 4], s0[8 * s + 5]), pk2(s0[8 * s + 6], s0[8 * s + 7])});
                pf[1][s] = __builtin_bit_cast(bf16x8, (u32x4){pk2(s1[8 * s], s1[8 * s + 1]), pk2(s1[8 * s + 2], s1[8 * s + 3]), pk2(s1[8 * s + 4], s1[8 * s + 5]), pk2(s1[8 * s + 6], s1[8 * s + 7])}); }
#pragma unroll
            for (int kb = 0; kb < 2; ++kb)
#pragma unroll
                for (int s = 0; s < 2; ++s) { const LAS unsigned char* vp = Vb + (32 * kb + 16 * s + 4 * hh + (i16 >> 2)) * 288 + blk * 32 + (i16 & 3) * 8;
#pragma unroll
                    for (int db = 0; db < 4; ++db) { const s16x4 lo = vtr(vp + db * 64), hi = vtr(vp + db * 64 + 8 * 288);
                        const bf16x8 vf = (bf16x8){lo[0], lo[1], lo[2], lo[3], hi[0], hi[1], hi[2], hi[3]};
                        o[db] = mfma32(vf, pf[kb][s], o[db]); } }
        }
        __syncthreads();
    }
#undef ATT_LOAD
#undef ATT_STORE
    const float l_tot = l_run + __shfl_xor(l_run, 32);
    LAS float* X = (LAS float*)(lds + A_X) + rg * 4096;
    if (sub == 1) { const float inv = lam / l_tot;
#pragma unroll
        for (int db = 0; db < 4; ++db)
#pragma unroll
            for (int i = 0; i < 16; ++i) X[(db * 16 + i) * 64 + lane] = o[db][i] * inv; }
    __syncthreads();
    if (sub == 0) { const float inv = 1.f / l_tot; float ss = 0.f;
#pragma unroll
        for (int db = 0; db < 4; ++db)
#pragma unroll
            for (int i = 0; i < 16; ++i) { const float v = o[db][i] * inv - X[(db * 16 + i) * 64 + lane]; o[db][i] = v; ss += v * v; }
        ss += __shfl_xor(ss, 32);
        const float rs = rsqrtf(ss * (1.f / 128.f) + 1e-5f) * oscale;
        LAS bf16_t* Y = (LAS bf16_t*)(lds + A_Y) + rg * (32 * 136);
        const LAS float* ngl = (const LAS float*)(lds + A_NG);
#pragma unroll
        for (int db = 0; db < 4; ++db)
#pragma unroll
            for (int i = 0; i < 16; ++i) { const int dv = 32 * db + crow(i, hh); Y[q * 136 + dv] = f2bf(o[db][i] * rs * ngl[dv]); }
        asm volatile("s_waitcnt lgkmcnt(0)" ::: "memory");
#pragma unroll
        for (int k = 0; k < 8; ++k) { const int piece = lane + 64 * k, row = piece >> 4, c16 = piece & 15;
            const u32x4 v = *(const LAS u32x4*)((const LAS unsigned char*)Y + row * 272 + c16 * 16);
            *(u32x4*)(Qd + (size_t)(tok0 + rg * 32 + row) * 1024 + h * 128 + c16 * 8) = v; }
    }
    __syncthreads();
}
DI void attn_phase(const Params& p, int l, LAS unsigned char* lds, int vcu) {
    const int tid = opaque_tid();
    float d1 = 0.f, d2 = 0.f;
    for (int i = 0; i < 64; ++i) { d1 += p.in[14][l * 64 + i] * p.in[15][l * 64 + i]; d2 += p.in[16][l * 64 + i] * p.in[17][l * 64 + i]; }
    const float lambda_init = (l == 0) ? 0.2f : 0.35550906759096934f;
    const float lam = expf(d1) - expf(d2) + lambda_init;
    if (tid < 128) ((LAS float*)(lds + A_NG))[tid] = p.in[18][l * 128 + tid];
    __syncthreads();
    for (int i = 0; i < 4; ++i)
        for (int vc = vcu; vc < 256; vc += gridDim.x) {
            const int bh = vc >> 4, s = vc & 15; const int qb = (i == 0) ? s : (i == 1) ? 31 - s : (i == 2) ? 32 + s : 63 - s;
            attn_unit(p, bh >> 3, bh & 7, qb, lam, 1.f - lambda_init, lds);
        }
}

DI void final_norm(const Params& p) {
    const float* rowsq = (const float*)(p.ws + WS_ROWSQ) + 4 * T; const float* g = p.in[26];
    const int gt = blockIdx.x * 512 + opaque_tid(), NTH = gridDim.x * 512;
    for (int i0 = gt; i0 < T * 256; i0 += 4 * NTH) {
        f32x4 v[4];
#pragma unroll
        for (int k = 0; k < 4; ++k) { const int i = i0 + k * NTH; if (i < T * 256) v[k] = *(const f32x4*)(p.out + (size_t)(i >> 8) * 1024 + (i & 255) * 4); }
        asm volatile("" ::: "memory");
#pragma unroll
        for (int k = 0; k < 4; ++k) { const int i = i0 + k * NTH; if (i < T * 256) { const int row = i >> 8, c = (i & 255) * 4;
            const float rs = rsqrtf(rowsq[row] * (1.f / 1024.f) + EPS); const f32x4 gv = *(const f32x4*)(g + c);
            *(f32x4*)(p.out + (size_t)row * 1024 + c) = v[k] * rs * gv; } }
    }
}


DI void gemv2(float* out, int ldo, const float* in, int ldi, const float* W, int ldw, int K, int N, int kchunk) {
    const int tid = opaque_tid(), lane = tid & 63, wave = __builtin_amdgcn_readfirstlane(tid >> 6);
    const int gw = blockIdx.x * 8 + wave, NGW = gridDim.x * 8, nstrip = (N + 63) / 64, nk = K / 128;
    for (int job = gw; job < nstrip * nk; job += NGW) {
        const int strip = job % nstrip, kq = job / nstrip, col = strip * 64 + lane; const bool ok = col < N;
        const float* wp = W + (size_t)(kq * 128) * ldw + (ok ? col : 0);
        const float* i0 = in + kq * 128; const float* i1 = in + ldi + kq * 128;
        float a0 = 0.f, a1 = 0.f;
        for (int kk = 0; kk < 2; ++kk) {
            const float h0 = i0[kk * 64 + lane], h1 = i1[kk * 64 + lane];
#pragma unroll
            for (int k = 0; k < 64; ++k) { const float wv = wp[(size_t)(kk * 64 + k) * ldw];
                a0 += __uint_as_float(__builtin_amdgcn_readlane(__float_as_uint(h0), k)) * wv; a1 += __uint_as_float(__builtin_amdgcn_readlane(__float_as_uint(h1), k)) * wv; }
        }
        if (ok) { atomicAdd(out + col, a0); atomicAdd(out + ldo + col, a1); }
    }
}
DI void side_init(const Params& p) {
    const int tid = opaque_tid(), lane = tid & 63, wave = __builtin_amdgcn_readfirstlane(tid >> 6);
    const int gt = blockIdx.x * 512 + tid, NTH = gridDim.x * 512, gw = blockIdx.x * 8 + wave, NGW = gridDim.x * 8;
    float* z = (float*)(p.ws + SB_PROJ);
    for (int i = gt; i < (int)((SB_END - SB_PROJ) / 4); i += NTH) z[i] = 0.f;
    float* hn = (float*)(p.ws + SB_HN);
    for (int r = gw; r < 128; r += NGW) { const int row = (r >> 6) * SEQ + (r & 63);
        const f32x4* xr = (const f32x4*)(p.in[0] + (size_t)row * 1024) + lane; f32x4 v[4]; float s2 = 0.f;
#pragma unroll
        for (int j = 0; j < 4; ++j) { v[j] = xr[64 * j]; s2 += v[j][0] * v[j][0] + v[j][1] * v[j][1] + v[j][2] * v[j][2] + v[j][3] * v[j][3]; }
        const float rs = rsqrtf(wave_sum(s2) * (1.f / 1024.f) + EPS);
#pragma unroll
        for (int j = 0; j < 4; ++j) { const f32x4 g = *((const f32x4*)p.in[2] + lane + 64 * j); *((f32x4*)(hn + (size_t)r * 1024) + lane + 64 * j) = v[j] * rs * g; } }
}
DI void side_kv(const Params& p) {
    const int tid = opaque_tid(), lane = tid & 63, wave = __builtin_amdgcn_readfirstlane(tid >> 6);
    const int gw = blockIdx.x * 8 + wave, NGW = gridDim.x * 8;
    const float* hn = (const float*)(p.ws + SB_HN); float* kv = (float*)(p.ws + SB_KV);
    for (int job = gw; job < 4096; job += NGW) {
        const int strip = job & 31, grp = (job >> 5) & 15, kq = job >> 9, col = strip * 64 + lane;
        const float* wp = p.in[3] + (size_t)(kq * 128) * INC + 9264 + col; const float* hp = hn + (size_t)(grp * 8) * 1024 + kq * 128;
        float a[8];
#pragma unroll
        for (int t = 0; t < 8; ++t) a[t] = 0.f;
        for (int kk = 0; kk < 2; ++kk) {
            float h[8];
#pragma unroll
            for (int t = 0; t < 8; ++t) h[t] = hp[t * 1024 + kk * 64 + lane];
#pragma unroll 16
            for (int k = 0; k < 64; ++k) { const float wv = wp[(size_t)(kk * 64 + k) * INC];
#pragma unroll
                for (int t = 0; t < 8; ++t) a[t] += __uint_as_float(__builtin_amdgcn_readlane(__float_as_uint(h[t]), k)) * wv; }
        }
#pragma unroll
        for (int t = 0; t < 8; ++t) atomicAdd(kv + (size_t)(grp * 8 + t) * 2048 + col, a[t]);
    }
}
DI void rope_cs(int pos, int i, float& cs, float& sn) {
    const double cf[8] = {0.15915494309189535, 0.03086376340470123, 0.005985185712713705, 0.001160663641240061, 0.00022507907903927653, 4.364795279280289e-05, 8.464330808241401e-06, 1.6414262627950345e-06};
    double c = cf[0];
#pragma unroll
    for (int q = 1; q < 8; ++q) c = (i == q) ? cf[q] : c;
    double rv = (double)pos * c; rv -= floor(rv); const float fr = (float)rv; sn = __builtin_amdgcn_sinf(fr); cs = __builtin_amdgcn_cosf(fr);
}
DI float wave_max(float v) {
#pragma unroll
    for (int o = 1; o < 64; o <<= 1) v = fmaxf(v, __shfl_xor(v, o));
    return v;
}
DI void side_mixers(const Params& p, int b, LAS unsigned char* lds) {
    const int tid = opaque_tid(), lane = tid & 63, w = __builtin_amdgcn_readfirstlane(tid >> 6);
    const float* P = (const float*)(p.ws + SB_PROJ) + b * 14384; float* Y = (float*)(p.ws + SB_Y) + b * 4096; float* KV = (float*)(p.ws + SB_KV) + (size_t)b * 64 * 2048;
    LAS float* cx = (LAS float*)lds; LAS float* ypre = cx + 3072; LAS float* lg = ypre + 2048; LAS float* pr = lg + 1024; LAS float* red = pr + 1024; LAS float* qr = red + 64;
    const int* pos = (const int*)p.in[1] + b * SEQ;
    __syncthreads();
    if (w < 4) { float qk = P[w * 128 + lane] * P[512 + w * 128 + lane] + P[w * 128 + 64 + lane] * P[512 + w * 128 + 64 + lane]; float vv = 0.f;
#pragma unroll
        for (int k = 0; k < 4; ++k) { const float v = P[1024 + w * 256 + k * 64 + lane]; vv += v * v; }
        qk = wave_sum(qk); vv = wave_sum(vv);
        if (lane == 0) { red[w] = qk * 0.08838834764831845f; red[4 + w] = vv * (1.f / 256.f); } }
    for (int c = tid; c < 3072; c += 512) cx[c] = siluf_(p.in[9][c] + p.in[8][3 * 3072 + c] * P[5136 + c]);
    if (tid < 32) red[8 + tid] = softplusf_(P[8208 + tid] + p.in[10][tid]);
    __syncthreads();
    for (int i = tid; i < 1024; i += 512) { const int h = i >> 8; const float p00 = red[h], o = p00 * P[1024 + i];
        Y[i] = o * rsqrtf(p00 * p00 * red[4 + h] + EPS) * p.in[7][i & 255] * siluf_(P[2064 + i]); }
    if (w < 4) { float cb = cx[2560 + w * 128 + lane] * cx[2048 + w * 128 + lane] + cx[2560 + w * 128 + 64 + lane] * cx[2048 + w * 128 + 64 + lane]; cb = wave_sum(cb); if (lane == 0) red[40 + w] = cb; }
    __syncthreads();
    for (int i = tid; i < 2048; i += 512) { const int head = i >> 6; ypre[i] = (red[40 + (head >> 3)] * red[8 + head] + p.in[12][head]) * cx[i] * siluf_(P[3088 + i]); }
    __syncthreads();
    if (w < 4) { float ss = 0.f;
#pragma unroll
        for (int k = 0; k < 8; ++k) { const float v = ypre[w * 512 + k * 64 + lane]; ss += v * v; }
        ss = wave_sum(ss); if (lane == 0) red[44 + w] = rsqrtf(ss * (1.f / 512.f) + EPS); }
    __syncthreads();
    for (int i = tid; i < 2048; i += 512) Y[1024 + i] = ypre[i] * red[44 + (i >> 9)] * p.in[13][i];
    for (int i = tid; i < 1024; i += 512) { const int d = i & 63; float v = P[8240 + i];
        if (d < 16) { float cs, sn; rope_cs(pos[0], d & 7, cs, sn); const float o = (d < 8) ? P[8240 + i + 8] : P[8240 + i - 8]; v = (d < 8) ? v * cs - o * sn : v * cs + o * sn; }
        qr[i] = v; }
    {
        float k1[16], k2[16];
#pragma unroll
        for (int q = 0; q < 16; ++q) { const int it = tid + 512 * q, j = it >> 7, hs = (it >> 3) & 15, d = it & 7; const float* kp = KV + (size_t)j * 2048 + hs * 64 + d; k1[q] = kp[0]; k2[q] = kp[8]; }
        asm volatile("" ::: "memory");
#pragma unroll
        for (int q = 0; q < 16; ++q) { const int it = tid + 512 * q, j = it >> 7, hs = (it >> 3) & 15, d = it & 7; float cs, sn; rope_cs(pos[j], d, cs, sn);
            float* kp = KV + (size_t)j * 2048 + hs * 64 + d; kp[0] = k1[q] * cs - k2[q] * sn; kp[8] = k2[q] * cs + k1[q] * sn; }
    }
    __threadfence_block();
    __syncthreads();
    for (int i = tid; i < 1024; i += 512) { const int hs = i >> 6, j = i & 63; const f32x4* kp = (const f32x4*)(KV + (size_t)j * 2048 + hs * 64); float sacc = 0.f;
#pragma unroll
        for (int d4 = 0; d4 < 16; ++d4) { const f32x4 kv4 = kp[d4]; sacc += qr[hs * 64 + 4 * d4] * kv4[0] + qr[hs * 64 + 4 * d4 + 1] * kv4[1] + qr[hs * 64 + 4 * d4 + 2] * kv4[2] + qr[hs * 64 + 4 * d4 + 3] * kv4[3]; }
        lg[i] = sacc * 0.125f; }
    __syncthreads();
#pragma unroll
    for (int rr = 0; rr < 2; ++rr) { const int row = 2 * w + rr; const float x = lg[row * 64 + lane]; const float m = wave_max(x); const float e = expf(x - m); const float sum = wave_sum(e); pr[row * 64 + lane] = e / sum; }
    __syncthreads();
    float d1 = 0.f, d2 = 0.f;
    for (int i = 0; i < 64; ++i) { d1 += p.in[14][i] * p.in[15][i]; d2 += p.in[16][i] * p.in[17][i]; }
    const float lam = expf(d1) - expf(d2) + 0.2f;
    for (int i = tid; i < 1024; i += 512) { const int h = i >> 7; float o = 0.f;
#pragma unroll 16
        for (int j = 0; j < 64; ++j) o += (pr[(2 * h) * 64 + j] - lam * pr[(2 * h + 1) * 64 + j]) * KV[(size_t)j * 2048 + 1024 + i];
        ypre[i] = o; }
    __syncthreads();
    { const float v0 = ypre[w * 128 + lane], v1 = ypre[w * 128 + 64 + lane]; const float ss = wave_sum(v0 * v0 + v1 * v1); if (lane == 0) red[48 + w] = rsqrtf(ss * (1.f / 128.f) + 1e-5f) * 0.8f; }
    __syncthreads();
    for (int i = tid; i < 1024; i += 512) Y[3072 + i] = ypre[i] * red[48 + (i >> 7)] * p.in[18][i & 127];
    float* G = (float*)(p.ws + SB_GATE) + b * 3072;
    for (int i = tid; i < 3072; i += 512) G[i] = sigmoidf_(P[11312 + i] + p.in[4][i]);
    __syncthreads();
}
DI void side_glue(const Params& p, int step, int b, LAS unsigned char* lds) {
    const int tid = opaque_tid(); unsigned char* ws = p.ws; LAS float* red = (LAS float*)lds;
    if (step == 4) {
        const float* G = (const float*)(ws + SB_GATE) + b * 3072; const float* BR = (const float*)(ws + SB_BR) + b * 3072;
        for (int c = tid; c < 1024; c += 512) { ((float*)(ws + SB_MIX))[b * 1024 + c] = G[c] * BR[c] + G[1024 + c] * BR[1024 + c] + G[2048 + c] * BR[2048 + c];
            ((float*)(ws + SB_XM))[b * 1024 + c] = p.in[0][(size_t)b * SEQ * 1024 + c]; }
    } else if (step == 6 || step == 100) {
        const float* src = (const float*)(ws + (step == 6 ? SB_XM : SB_X1)) + b * 1024; float* dst = (float*)(ws + (step == 6 ? SB_H2 : SB_HN1)) + b * 1024;
        const float* g = step == 6 ? p.in[23] : p.in[2] + 1024;
        __syncthreads();
        float s2 = 0.f; for (int c = tid; c < 1024; c += 512) s2 += src[c] * src[c];
        s2 = wave_sum(s2); if ((tid & 63) == 0) red[tid >> 6] = s2;
        __syncthreads();
        float tot = 0.f; for (int w = 0; w < 8; ++w) tot += red[w];
        const float rs = rsqrtf(tot * (1.f / 1024.f) + EPS);
        for (int c = tid; c < 1024; c += 512) dst[c] = src[c] * rs * g[c];
        if (step == 100) { const size_t row = (size_t)b * SEQ; bf16_t* xb = (bf16_t*)(ws + WS_XB);
            for (int c = tid; c < 1024; c += 512) { p.out[row * 1024 + c] = src[c]; xb[row * 1024 + c] = f2bf(src[c]); }
            if (tid == 0) ((float*)(ws + WS_ROWSQ))[2 * T + row] = tot; }
        __syncthreads();
    } else if (step == 8) {
        const float* up = (const float*)(ws + SB_UP) + b * 4096; float* hh = (float*)(ws + SB_HH) + b * 4096;
        for (int c = tid; c < 4096; c += 512) { const float r = fmaxf(up[c], 0.f); hh[c] = r * r; }
        for (int c = tid; c < 1024; c += 512) ((float*)(ws + SB_X1))[b * 1024 + c] = ((const float*)(ws + SB_XM))[b * 1024 + c];
    }
}
DI void side_phase(const Params& p, int l, int k, LAS unsigned char* lds) {
    unsigned char* ws = p.ws; const int bid = blockIdx.x;
    if (l == 0) {
        if (k == 0) side_init(p);
        else if (k == 1) { gemv2((float*)(ws + SB_PROJ), 14384, (const float*)(ws + SB_HN), 64 * 1024, p.in[3], INC, 1024, INC, 128); side_kv(p); }
        else if (k == 2) { if (bid < 2) side_mixers(p, bid, lds); }
        else if (k == 3) { float* br = (float*)(ws + SB_BR); const float* y = (const float*)(ws + SB_Y);
            gemv2(br, 3072, y, 4096, p.in[19], 1024, 1024, 1024, 128); gemv2(br + 1024, 3072, y + 1024, 4096, p.in[20], 1024, 2048, 1024, 128); gemv2(br + 2048, 3072, y + 3072, 4096, p.in[21], 1024, 1024, 1024, 128); }
        else if (k == 4) { if (bid < 2) side_glue(p, 4, bid, lds); }
        else if (k == 5) gemv2((float*)(ws + SB_XM), 1024, (const float*)(ws + SB_MIX), 1024, p.in[22], 1024, 1024, 1024, 128);
        else if (k == 6) { if (bid < 2) side_glue(p, 6, bid, lds); }
        else if (k == 7) gemv2((float*)(ws + SB_UP), 4096, (const float*)(ws + SB_H2), 1024, p.in[24], 4096, 1024, 4096, 128);
        else if (k == 8) { if (bid < 2) side_glue(p, 8, bid, lds); }
        else if (k == 9) gemv2((float*)(ws + SB_X1), 1024, (const float*)(ws + SB_HH), 4096, p.in[25], 1024, 4096, 1024, 128);
    } else {
        if (k == 0) { if (bid < 2) side_glue(p, 100, bid, lds); }
        else if (k == 1) gemv2((float*)(ws + SB_QK1), 1024, (const float*)(ws + SB_HN1), 1024, p.in[3] + (size_t)1024 * INC, INC, 1024, 1024, 128);
    }
}


DI void grid_bar(unsigned* ctr, unsigned target) {
    asm volatile("s_waitcnt vmcnt(0)" ::: "memory");
    __syncthreads();
    if (threadIdx.x == 0) {
        __builtin_amdgcn_fence(__ATOMIC_RELEASE, "agent");
        asm volatile("s_waitcnt vmcnt(0)" ::: "memory");
        __hip_atomic_fetch_add(ctr, 1u, __ATOMIC_RELAXED, __HIP_MEMORY_SCOPE_AGENT);
        while (__hip_atomic_load(ctr, __ATOMIC_RELAXED, __HIP_MEMORY_SCOPE_AGENT) < target) __builtin_amdgcn_s_sleep(8);
        __builtin_amdgcn_fence(__ATOMIC_ACQUIRE, "agent");
        asm volatile("s_waitcnt vmcnt(0)" ::: "memory");
    }
    __syncthreads();
}


#define XB_TMO      128
#define XB_XCNT(j)  (256  + 64 * (j))
#define XB_XSUB(j)  (1280 + 64 * (j))
#define XB_XGEN(j)  (2304 + 64 * (j))
#define XB_TOP      3328
#define XB_TOPGEN   3392
#define XCD_BAR_WORDS 3456
#define XB_SPIN_CAP (1u << 22)
DI unsigned xb_ld(unsigned* p)              { return __hip_atomic_load(p, __ATOMIC_RELAXED, __HIP_MEMORY_SCOPE_AGENT); }
DI unsigned xb_add(unsigned* p, unsigned v) { return __hip_atomic_fetch_add(p, v, __ATOMIC_RELAXED, __HIP_MEMORY_SCOPE_AGENT); }
DI unsigned xb_xcc_id() { return (unsigned)__builtin_amdgcn_s_getreg((3 << 11) | 20) & 0xFu; }
#define XB_SPIN(cond, bar) do { unsigned _sp = 0; while (cond) { __builtin_amdgcn_s_sleep(1); \
    if ((++_sp & 255u) == 0u) { if (xb_ld(&(bar)[XB_TMO])) break; if (_sp > XB_SPIN_CAP) { atomicAdd(&(bar)[XB_TMO], 1u); break; } } } } while (0)
DI void xcd_barrier_complete(unsigned* bar, unsigned x, unsigned& nloc, unsigned& nx) {
    const unsigned G = gridDim.x;
    unsigned sum, cnt, mine, sp = 0u;
    for (;;) {
        sum = 0u; cnt = 0u; mine = 0u;
#pragma unroll
        for (unsigned j = 0; j < 16; ++j) { const unsigned c = xb_ld(&bar[XB_XCNT(j)]); sum += c; cnt += (c > 0u) ? 1u : 0u; mine = (j == x) ? c : mine; }
        if (sum == G) break;
        __builtin_amdgcn_s_sleep(1);
        if ((++sp & 255u) == 0u) { if (xb_ld(&bar[XB_TMO])) break; if (sp > XB_SPIN_CAP) { atomicAdd(&bar[XB_TMO], 1u); break; } }
    }
    nloc = mine > 0u ? mine : 1u; nx = cnt > 0u ? cnt : 1u;
}
DI void xcd_barrier(unsigned* bar, volatile LAS unsigned* st) {
    asm volatile("s_waitcnt vmcnt(0)" ::: "memory");
    __syncthreads();
    if (threadIdx.x == 0) {
        const unsigned x = xb_xcc_id();
        __builtin_amdgcn_s_waitcnt(0);
        unsigned nloc = st[0], nx = st[1];
        if (nloc == 0u) { xcd_barrier_complete(bar, x, nloc, nx); st[0] = nloc; st[1] = nx; }
        const unsigned old = xb_add(&bar[XB_XSUB(x)], 1u);
        const unsigned gen = old / nloc;
        if (old + 1u == (gen + 1u) * nloc) {
            __builtin_amdgcn_fence(__ATOMIC_RELEASE, "agent");
            asm volatile("s_waitcnt vmcnt(0)" ::: "memory");
            const unsigned og = xb_add(&bar[XB_TOP], 1u);
            const unsigned tg = og / nx;
            if (og + 1u == (tg + 1u) * nx) xb_add(&bar[XB_TOPGEN], 1u);
            else XB_SPIN(xb_ld(&bar[XB_TOPGEN]) == tg, bar);
            __builtin_amdgcn_fence(__ATOMIC_ACQUIRE, "agent");
            xb_add(&bar[XB_XGEN(x)], 1u);
            asm volatile("s_waitcnt vmcnt(0)" ::: "memory");
        } else {
            XB_SPIN(xb_ld(&bar[XB_XGEN(x)]) == gen, bar);
            __builtin_amdgcn_fence(__ATOMIC_ACQUIRE, "agent");
            asm volatile("s_waitcnt vmcnt(0)" ::: "memory");
        }
    }
    __syncthreads();
}

constexpr int NPHASE = 31, PPL = 15;
#ifndef PH_MASK
#define PH_MASK 0xFFFFFFFFu
#endif
#define EN(k_) ((PH_MASK >> (k_)) & 1u)
constexpr int LDS_BYTES = 147456;
template <bool COOP> __global__ void __launch_bounds__(512, 2) mk(Params p) {
    extern __shared__ __attribute__((aligned(16))) unsigned char lds_raw[];
    LAS unsigned char* lds = (LAS unsigned char*)lds_raw;
    unsigned char* ws = p.ws;
    float* rowsq = (float*)(ws + WS_ROWSQ);
    bf16_t* xb = (bf16_t*)(ws + WS_XB); bf16_t* mixb = (bf16_t*)(ws + WS_MIXB); bf16_t* R = (bf16_t*)(ws + WS_R);
    const unsigned char* wt = ws + WS_WT;
    const int G = gridDim.x, bid = blockIdx.x;
    volatile LAS unsigned* xst = (volatile LAS unsigned*)(lds + LDS_BYTES - 16);
    if (threadIdx.x == 0) { xst[0] = 0u; xst[1] = 0u; (void)xb_add((unsigned*)(ws + WS_BAR) + XB_XCNT(xb_xcc_id()), 1u); }
    __syncthreads();
    const int vcu = (G % 8 == 0) ? (bid % 8) * (G / 8) + bid / 8 : bid;
    for (int ph = p.ph_lo; ph < p.ph_hi; ++ph) {
        if (ph == 30) { final_norm(p); }
        else {
            const int l = ph / PPL, k = ph % PPL;
            if (EN(0) && k == 0) phase_prep(p, l, lds);
            else if (k == 1 || k == 6) {
                const bool gd = (k == 1);
                pg8::Gemm g{xb, (const bf16_t*)(wt + (gd ? WT_GD : WT_S)), T, gd ? 8448 : 6144, 1024, 1024, 1024};
                pg8::StaticOrder S; S.init(T, g.N, G, bid);
                EpiIn E{R, rowsq + (2 * l) * T, (float*)(ws + WS_SMALL), gd ? 32 : -1, gd ? 3 : 5, gd ? 7 : -1,
                        p.in[4] + l * 3072 + (gd ? 0 : 1024), p.in[4] + l * 3072 + 2048};
                pg8::gemm_phase(lds, g, S, E);
            }
            else if (EN(2) && k == 2) { rope_pass(p); for (int un = vcu; un < 256; un += G) gla_unit<1>(p, l, un, lds); }
            else if (EN(3) && k == 3) { gla_scan(p); attn_phase(p, l, lds, vcu); }
            else if (EN(4) && k == 4) { for (int un = vcu; un < 256; un += G) gla_unit<3>(p, l, un, lds); }
            else if (k == 5 || k == 11) {
                const int nrun = (k == 5) ? 2 : 4;
                for (int r = 0; r < nrun; ++r) {
                    pg8::Gemm g; EpiMix E;
                    if (k == 5) {
                        g = pg8::Gemm{R + (size_t)(r == 0 ? 2 : 4) * (BLK / 2), (const bf16_t*)(wt + (r == 0 ? WT_GLA : WT_DIFF)), T, 1024, 1024, 1024, 1024};
                        E = EpiMix{mixb, R + (size_t)(r == 0 ? 3 : 7) * (BLK / 2), nullptr, 0, r == 0 ? 1 : 0};
                    } else {
                        g = pg8::Gemm{R + (size_t)(r >> 1) * (BLK / 2) + (r & 1) * 512, (const bf16_t*)(wt + WT_SSM) + r * 512, T, 1024, 512, 1024, 2048};
                        E = EpiMix{mixb, R + (size_t)5 * (BLK / 2), (const float*)(ws + WS_SSQ), r, 0};
                    }
                    pg8::StaticOrder S; S.init(T, 1024, G, bid);
                    pg8::gemm_phase(lds, g, S, E);
                }
            }
            else if (k == 7) { conv_bc(p, l); }
            else if (k == 8) { for (int un = vcu; un < 2048; un += G) ssd_local(p, l, un, lds); }
            else if (k == 9) { ssd_scan(p); }
            else if (k == 10) { for (int un = vcu; un < 2048; un += G) ssd_unit<3>(p, l, un, lds); }
            else if (k == 12 || k == 14) {
                const bool dn = (k == 14);
                pg8::Gemm g{dn ? R : mixb, (const bf16_t*)(wt + (dn ? WT_DOWN : WT_OUT)), T, 1024, dn ? 4096 : 1024, dn ? 4096 : 1024, dn ? 4096 : 1024};
                pg8::StaticOrder S; S.init(T, 1024, G, bid);
                EpiRes E{(l == 0 && !dn) ? p.in[0] : p.out, p.out, xb, rowsq + (2 * l + (dn ? 2 : 1)) * T};
                pg8::gemm_phase(lds, g, S, E);
            }
            else if (k == 13) {
                pg8::Gemm g{xb, (const bf16_t*)(wt + WT_UP), T, 4096, 1024, 1024, 1024};
                pg8::StaticOrder S; S.init(T, 4096, G, bid);
                EpiUp E{R, rowsq + (2 * l + 1) * T};
                pg8::gemm_phase(lds, g, S, E);
            }
        }
        if (ph < 30) side_phase(p, ph / PPL, ph % PPL, lds);
        if (COOP) { if (ph + 1 < p.ph_hi) { if (p.ph_hi < 0) cg::this_grid().sync();
            xcd_barrier((unsigned*)(ws + WS_BAR), xst); } }
    }
}

extern "C" void kernel_launch(void* const* d_in, const int* in_sizes, int n_in, void* d_out, int out_size, void* d_ws, size_t ws_size, hipStream_t stream) {
    static int grid = 0;
    if (grid == 0) {
        if (n_in != 27 || out_size != T * 1024 || ws_size < WS_END) { fprintf(stderr, "kernel_launch: unexpected shapes/ws (n_in %d out %d ws %zu need %zu)\n", n_in, out_size, ws_size, (size_t)WS_END); grid = -1; return; }
        int dev = 0, cus = 0, per_cu = 0;
        (void)hipGetDevice(&dev); (void)hipDeviceGetAttribute(&cus, hipDeviceAttributeMultiprocessorCount, dev);
        (void)hipFuncSetAttribute((const void*)mk<true>, hipFuncAttributeMaxDynamicSharedMemorySize, LDS_BYTES);
        (void)hipOccupancyMaxActiveBlocksPerMultiprocessor(&per_cu, (const void*)mk<true>, 512, LDS_BYTES);
        if (per_cu < 1) fprintf(stderr, "kernel_launch: occupancy query says %d blocks/CU\n", per_cu);
        (void)hipGetLastError();
        grid = cus;
    }
    if (grid < 0) return;
    Params p{};
    for (int i = 0; i < 27; ++i) p.in[i] = (const float*)d_in[i];
    p.out = (float*)d_out; p.ws = (unsigned char*)d_ws;
    p.ph_lo = 0; p.ph_hi = NPHASE;
    (void)hipMemsetAsync((unsigned char*)d_ws + WS_BAR, 0, 16384, stream);
    void* args[] = {&p};
    hipError_t e = hipLaunchCooperativeKernel((const void*)mk<true>, dim3(grid), dim3(512), args, LDS_BYTES, stream);
    if (e != hipSuccess) fprintf(stderr, "cooperative launch failed: %s (grid %d)\n", hipGetErrorString(e), grid);
}
```

```cpp
#include <hip/hip_runtime.h>
#include <hip/hip_cooperative_groups.h>
#include <cstdio>
#include <cstdint>
namespace cg = cooperative_groups;

#define LAS __attribute__((address_space(3)))
#define DI __device__ __forceinline__
typedef unsigned short bf16_t;
typedef short bf16x8 __attribute__((ext_vector_type(8)));
typedef short s16x4 __attribute__((ext_vector_type(4)));
typedef float f32x4 __attribute__((ext_vector_type(4)));
typedef float f32x16 __attribute__((ext_vector_type(16)));
typedef unsigned u32x4 __attribute__((ext_vector_type(4)));
typedef unsigned u32x2 __attribute__((ext_vector_type(2)));
typedef float f32x2_t __attribute__((ext_vector_type(2)));
typedef __bf16 bf16x2_t __attribute__((ext_vector_type(2)));

DI unsigned pk2(float lo, float hi) { f32x2_t v = {lo, hi}; bf16x2_t b = __builtin_convertvector(v, bf16x2_t); return __builtin_bit_cast(unsigned, b); }
DI bf16_t f2bf(float f) { return (bf16_t)(pk2(f, 0.f) & 0xffffu); }
DI float bf2f(unsigned b) { return __uint_as_float(b << 16); }
DI float bflo(unsigned w) { return __uint_as_float(w << 16); }
DI float bfhi(unsigned w) { return __uint_as_float(w & 0xffff0000u); }
DI f32x4 mfma16(bf16x8 a, bf16x8 b, f32x4 c) { return __builtin_amdgcn_mfma_f32_16x16x32_bf16(a, b, c, 0, 0, 0); }
DI f32x16 mfma32(bf16x8 a, bf16x8 b, f32x16 c) { return __builtin_amdgcn_mfma_f32_32x32x16_bf16(a, b, c, 0, 0, 0); }
DI float sigmoidf_(float x) { return __builtin_amdgcn_rcpf(1.f + __expf(-x)); }
DI float siluf_(float x) { return x * __builtin_amdgcn_rcpf(1.f + __expf(-x)); }
DI int opaque_tid() { int t = threadIdx.x; asm volatile("" : "+v"(t)); return t; }
DI int crow(int r, int hi) { return (r & 3) + 8 * (r >> 2) + 4 * hi; }

constexpr int T = 16384, SEQ = 8192, DM = 1024, DFF = 4096, INC = 14384;
constexpr float EPS = 1e-6f;
constexpr size_t MiB = 1u << 20;
constexpr size_t WS_ROWSQ = 0;
constexpr size_t WS_BAR = 448 * 1024;
constexpr size_t WS_DECG = 512 * 1024;
constexpr size_t WS_DECS = 768 * 1024;
constexpr size_t WS_SSQ = 1 * MiB;
constexpr size_t WS_SMALL = 2 * MiB;
constexpr size_t WS_XB = 6 * MiB;
constexpr size_t WS_MIXB = 38 * MiB;
constexpr size_t WS_WT = 70 * MiB;
constexpr size_t WT_GD = 0, WT_S = WT_GD + (size_t)8448 * 1024 * 2, WT_GLA = WT_S + (size_t)6144 * 1024 * 2, WT_SSM = WT_GLA + 2 * MiB,
                 WT_DIFF = WT_SSM + 4 * MiB, WT_OUT = WT_DIFF + 2 * MiB, WT_UP = WT_OUT + 2 * MiB, WT_DOWN = WT_UP + 8 * MiB, WT_END = WT_DOWN + 8 * MiB;
static_assert(WT_END <= 56 * MiB, "wt");
constexpr size_t WS_R = 126 * MiB;
constexpr size_t BLK = 32 * MiB;
constexpr size_t WS_STG = WS_R + 8 * BLK;
constexpr size_t WS_STS = WS_R + 6 * BLK;
constexpr size_t WS_SIDE = WS_R + 9 * BLK;
constexpr size_t SB_HN = WS_SIDE, SB_PROJ = SB_HN + 512 * 1024, SB_KV = SB_PROJ + 128 * 1024, SB_Y = SB_KV + 1024 * 1024, SB_GATE = SB_Y + 32 * 1024,
                 SB_BR = SB_GATE + 32 * 1024, SB_MIX = SB_BR + 32 * 1024, SB_XM = SB_MIX + 8192, SB_H2 = SB_XM + 8192, SB_UP = SB_H2 + 8192,
                 SB_HH = SB_UP + 32768, SB_X1 = SB_HH + 32768, SB_HN1 = SB_X1 + 8192, SB_QK1 = SB_HN1 + 8192, SB_END = SB_QK1 + 8192;
constexpr size_t WS_END = WS_SIDE + 2 * MiB;
static_assert(SB_END <= WS_END, "side");

struct Params {
    const float* in[27];
    float* out; unsigned char* ws;
    int ph_lo, ph_hi;
};

namespace pg8 {
constexpr int BM = 256, BK = 64, HALF = 128, HTB = HALF * BK * 2, STAGE_BYTES = 8 * HTB, NXCD = 8, WGM = 8;
__host__ __device__ __forceinline__ int lds_byte(int r, int c) { const int st = (r >> 4) * 2 + (c >> 5), rr = r & 15, cc = c & 31, ob = rr * 64 + cc * 2; return st * 1024 + (ob ^ (((ob >> 9) & 1) << 5)); }
__host__ __device__ __forceinline__ void stage_rc(int b, int& R, int& C) { const int st = b / 1024, sb = b % 1024, swz = sb ^ (((sb >> 9) & 1) << 5); R = (st >> 1) * 16 + swz / 64; C = (st & 1) * 32 + (swz % 64) / 2; }
__host__ __device__ __forceinline__ int perm32(int rho) { const int n = rho >> 4, i = rho & 15; return 8 * (i >> 2) + 4 * n + (i & 3); }
struct Unit { int pm, pn; };
struct Gemm { const bf16_t* A; const bf16_t* Bt; int M, N, K, lda, ldb; };
struct StaticOrder {
    int nM, nN, nwg, G, c;
    __host__ __device__ void init(int M, int N, int G_, int c_) { nM = M / BM; nN = N / BM; nwg = nM * nN; G = G_; c = c_; }
    __host__ __device__ bool next(int i, Unit& u) const {
        const long L = (long)i * G + c; if (L >= nwg) return false;
        int wgid = (int)L; { const int q = nwg / NXCD, r = nwg % NXCD, xcd = wgid % NXCD, off = wgid / NXCD; wgid = (xcd < r ? xcd * (q + 1) : r * (q + 1) + (xcd - r) * q) + off; }
        const int nig = WGM * nN, gid = wgid / nig, fm = gid * WGM, gsz = (nM - fm) < WGM ? (nM - fm) : WGM;
        u.pm = fm + ((wgid % nig) % gsz); u.pn = (wgid % nig) / gsz; return true;
    }
};
template <class Epi, class Sched>
__device__ __forceinline__ void gemm_phase(LAS unsigned char* lds, const Gemm g, const Sched& S, const Epi& E) {
    const int tid = opaque_tid(), wid = __builtin_amdgcn_readfirstlane(tid >> 6), lane = tid & 63, wr = wid >> 2, wc = wid & 3, fr = lane & 15, fq = lane >> 4;
    const int K = g.K, nt = K / BK;
    unsigned voffA[2], voffB[2];
#pragma unroll
    for (int i = 0; i < 2; ++i) { int R, C; stage_rc(tid * 16 + i * 8192, R, C);
        const int Rb = (R & ~31) + perm32(R & 31);
        voffA[i] = (unsigned)(R * g.lda + C) * 2u; voffB[i] = (unsigned)(Rb * g.ldb + C) * 2u; }
    const size_t kstep = (size_t)(BK * 2);
    const size_t hstepA = (size_t)HALF * g.lda * 2, hstepB = (size_t)HALF * g.ldb * 2;
    const size_t tstepA = 2 * hstepA, tstepB = 2 * hstepB;
    const unsigned ldsw = (unsigned)wid * 1024u;
    const int aoff = lds_byte(wr * 64 + fr, fq * 8), boff = lds_byte(wc * 32 + fr, fq * 8);
#define PG8_SA(b, h) (((b) * 2 + (h)) * HTB)
#define PG8_SB(b, h) ((4 + (b) * 2 + (h)) * HTB)
#define PG8_STAGE(bufoff, gbase, voff) do { _Pragma("unroll") for (int _i = 0; _i < 2; ++_i) \
        __builtin_amdgcn_global_load_lds((const unsigned*)((const char*)(gbase) + (voff)[_i]), (LAS unsigned*)(lds + (bufoff) + ldsw + _i * 8192), 16, 0, 0); } while (0)
#define PG8_LDA(dst, b, h) do { _Pragma("unroll") for (int m = 0; m < 4; ++m) _Pragma("unroll") for (int k = 0; k < 2; ++k) dst[m][k] = *(const LAS bf16x8*)(lds + PG8_SA(b, h) + aoff + m * 2048 + k * 1024); } while (0)
#define PG8_LDB(dst, b, h) do { _Pragma("unroll") for (int n = 0; n < 2; ++n) _Pragma("unroll") for (int k = 0; k < 2; ++k) dst[n][k] = *(const LAS bf16x8*)(lds + PG8_SB(b, h) + boff + n * 2048 + k * 1024); } while (0)
#define PG8_MMA(ai, bj, At, Bt) do { __builtin_amdgcn_s_setprio(1); _Pragma("unroll") for (int m = 0; m < 4; ++m) _Pragma("unroll") for (int n = 0; n < 2; ++n) _Pragma("unroll") for (int k = 0; k < 2; ++k) \
        acc[ai][bj][m][n] = __builtin_amdgcn_mfma_f32_16x16x32_bf16(Bt[n][k], At[m][k], acc[ai][bj][m][n], 0, 0, 0); __builtin_amdgcn_s_setprio(0); } while (0)
#define PG8_WAIT_V(n) asm volatile("s_waitcnt vmcnt(" #n ")" ::: "memory")
#define PG8_WAIT_L(n) asm volatile("s_waitcnt lgkmcnt(" #n ")" ::: "memory")
#define PG8_BAR __builtin_amdgcn_s_barrier()
#define PG8_SCHED __builtin_amdgcn_sched_barrier(0)
    Unit cur, nxt; int ui = 0;
    if (!S.next(0, cur)) return;
    f32x4 acc[2][2][4][2];
#pragma unroll
    for (int a = 0; a < 2; ++a)
#pragma unroll
        for (int b = 0; b < 2; ++b)
#pragma unroll
            for (int m = 0; m < 4; ++m)
#pragma unroll
                for (int n = 0; n < 2; ++n) acc[a][b][m][n] = (f32x4){0.f, 0.f, 0.f, 0.f};
    bf16x8 At[4][2], B0[2][2], B1[2][2];
    const char* cA = (const char*)g.A + (size_t)cur.pm * tstepA; const char* cB = (const char*)g.Bt + (size_t)cur.pn * tstepB;
    PG8_STAGE(PG8_SB(0, 0), cB, voffB); PG8_STAGE(PG8_SB(0, 1), cB + hstepB, voffB); PG8_STAGE(PG8_SA(0, 0), cA, voffA); PG8_STAGE(PG8_SA(0, 1), cA + hstepA, voffA);
    if (wr == 1) PG8_BAR;
    PG8_WAIT_V(2); PG8_BAR;
    PG8_STAGE(PG8_SB(1, 0), cB + kstep, voffB); PG8_STAGE(PG8_SA(1, 0), cA + kstep, voffA); PG8_STAGE(PG8_SB(1, 1), cB + hstepB + kstep, voffB);
    PG8_WAIT_V(6); PG8_BAR;
    for (;;) {
        const bool has_next = S.next(ui + 1, nxt);
        const char* nA = has_next ? (const char*)g.A + (size_t)nxt.pm * tstepA : cA; const char* nB = has_next ? (const char*)g.Bt + (size_t)nxt.pn * tstepB : cB;
        for (int t = 0; t < nt; t += 2) {
            const bool last = (t == nt - 2);
            const char* a1 = cA + (size_t)(t + 1) * kstep;
            const char* a2 = last ? nA : cA + (size_t)(t + 2) * kstep; const char* b2 = last ? nB : cB + (size_t)(t + 2) * kstep;
            const char* a3 = a2 + kstep; const char* b3 = b2 + kstep;
            PG8_LDB(B0, 0, 0); PG8_LDB(B1, 0, 1); PG8_SCHED; PG8_LDA(At, 0, 0); PG8_STAGE(PG8_SA(1, 1), a1 + hstepA, voffA);
            PG8_WAIT_V(8); PG8_WAIT_L(0); PG8_BAR; PG8_MMA(0, 0, At, B0); PG8_MMA(0, 1, At, B1); PG8_BAR; PG8_SCHED;
            PG8_LDA(At, 0, 1); PG8_STAGE(PG8_SB(0, 0), b2, voffB); PG8_STAGE(PG8_SB(0, 1), b2 + hstepB, voffB); PG8_STAGE(PG8_SA(0, 0), a2, voffA);
            PG8_WAIT_V(8); PG8_WAIT_L(0); PG8_BAR; PG8_MMA(1, 0, At, B0); PG8_MMA(1, 1, At, B1); PG8_BAR; PG8_SCHED;
            PG8_LDB(B0, 1, 0); PG8_LDB(B1, 1, 1); PG8_SCHED; PG8_LDA(At, 1, 0); PG8_STAGE(PG8_SA(0, 1), a2 + hstepA, voffA);
            PG8_WAIT_V(8); PG8_WAIT_L(0); PG8_BAR; PG8_MMA(0, 0, At, B0); PG8_MMA(0, 1, At, B1); PG8_BAR; PG8_SCHED;
            PG8_LDA(At, 1, 1); PG8_STAGE(PG8_SB(1, 0), b3, voffB); PG8_STAGE(PG8_SB(1, 1), b3 + hstepB, voffB); PG8_STAGE(PG8_SA(1, 0), a3, voffA);
            PG8_WAIT_V(8); PG8_WAIT_L(0); PG8_BAR; PG8_MMA(1, 0, At, B0); PG8_MMA(1, 1, At, B1); PG8_BAR; PG8_SCHED;
        }
        if (wr == 0) PG8_BAR;
        E(acc, cur, wr, wc, fr, fq);
        if (!has_next) break;
#pragma unroll
        for (int a = 0; a < 2; ++a)
#pragma unroll
            for (int b = 0; b < 2; ++b)
#pragma unroll
                for (int m = 0; m < 4; ++m)
#pragma unroll
                    for (int n = 0; n < 2; ++n) acc[a][b][m][n] = (f32x4){0.f, 0.f, 0.f, 0.f};
        cur = nxt; cA = nA; cB = nB; ++ui;
        if (wr == 1) PG8_BAR;
    }
    PG8_WAIT_V(0);
    PG8_BAR;
#undef PG8_SA
#undef PG8_SB
#undef PG8_STAGE
#undef PG8_LDA
#undef PG8_LDB
#undef PG8_MMA
#undef PG8_WAIT_V
#undef PG8_WAIT_L
#undef PG8_BAR
#undef PG8_SCHED
}
}

typedef f32x4 Acc[2][2][4][2];
#define EPI_ROWS(...) _Pragma("unroll") for (int ai = 0; ai < 2; ++ai) _Pragma("unroll") for (int m = 0; m < 4; ++m) { const int row = u.pm * 256 + ai * 128 + wr * 64 + m * 16 + fr; __VA_ARGS__ }
#define EPI_COLS(...) _Pragma("unroll") for (int bj = 0; bj < 2; ++bj) _Pragma("unroll") for (int n = 0; n < 2; ++n) { const int ct = bj * 128 + wc * 32 + fq * 8 + n * 4; __VA_ARGS__ }

struct EpiIn {
    bf16_t* R; const float* rowsq; float* small; int small_tile; int gblkA, gblkB; const float* biasA; const float* biasB;
    DI void operator()(const Acc& acc, const pg8::Unit& u, int wr, int wc, int fr, int fq) const {
        const int blk = u.pn >> 2, cb = (u.pn & 3) * 256;
        float rs[2][4];
        EPI_ROWS( rs[ai][m] = rsqrtf(rowsq[row] * (1.f / 1024.f) + EPS); )
        if (u.pn == small_tile) {
            asm volatile("" ::: "memory");
            EPI_ROWS( EPI_COLS( if (ct < 64) *(f32x4*)(small + (size_t)row * 64 + ct) = acc[ai][bj][m][n] * rs[ai][m]; ) )
            return;
        }
        bf16_t* dst = R + (size_t)blk * (BLK / 2);
        const float* bias = (blk == gblkA) ? biasA : ((blk == gblkB) ? biasB : nullptr);
        if (bias) {
            f32x4 bv[2][2];
            EPI_COLS( bv[bj][n] = *(const f32x4*)(bias + cb + ct); )
            asm volatile("" ::: "memory");
            EPI_ROWS( EPI_COLS( const f32x4 v = acc[ai][bj][m][n] * rs[ai][m] + bv[bj][n];
                u32x2 w; w.x = pk2(sigmoidf_(v[0]), sigmoidf_(v[1])); w.y = pk2(sigmoidf_(v[2]), sigmoidf_(v[3])); *(u32x2*)(dst + (size_t)row * 1024 + cb + ct) = w; ) )
        } else {
            asm volatile("" ::: "memory");
            EPI_ROWS( EPI_COLS( const f32x4 v = acc[ai][bj][m][n] * rs[ai][m];
                u32x2 w; w.x = pk2(v[0], v[1]); w.y = pk2(v[2], v[3]); *(u32x2*)(dst + (size_t)row * 1024 + cb + ct) = w; ) )
        }
    }
};
struct EpiMix {
    bf16_t* mixb; const bf16_t* gate; const float* ssq; int grp; int first;
    DI void operator()(const Acc& acc, const pg8::Unit& u, int wr, int wc, int fr, int fq) const {
        float rs[8];
#pragma unroll
        for (int r = 0; r < 8; ++r) { const int row = u.pm * 256 + (r >> 2) * 128 + wr * 64 + (r & 3) * 16 + fr; rs[r] = ssq ? rsqrtf(ssq[(size_t)row * 4 + grp] * (1.f / 512.f) + EPS) : 1.f; }
        u32x2 gw[2][4], mw[2][4];
#define MIX_LOAD(r, buf) do { const int row_ = u.pm * 256 + ((r) >> 2) * 128 + wr * 64 + ((r) & 3) * 16 + fr; _Pragma("unroll") for (int c_ = 0; c_ < 4; ++c_) { \
            const size_t o_ = (size_t)row_ * 1024 + u.pn * 256 + (c_ >> 1) * 128 + wc * 32 + fq * 8 + (c_ & 1) * 4; gw[buf][c_] = *(const u32x2*)(gate + o_); mw[buf][c_] = first ? (u32x2){0u, 0u} : *(const u32x2*)(mixb + o_); } } while (0)
        MIX_LOAD(0, 0);
#pragma unroll
        for (int r = 0; r < 8; ++r) { const int cur = r & 1;
            if (r < 7) MIX_LOAD(r + 1, cur ^ 1);
            asm volatile("" ::: "memory");
            const int row = u.pm * 256 + (r >> 2) * 128 + wr * 64 + (r & 3) * 16 + fr;
#pragma unroll
            for (int c = 0; c < 4; ++c) { const size_t o = (size_t)row * 1024 + u.pn * 256 + (c >> 1) * 128 + wc * 32 + fq * 8 + (c & 1) * 4;
                const f32x4 v = acc[r >> 2][c >> 1][r & 3][c & 1] * rs[r]; const u32x2 g2 = gw[cur][c], m2 = mw[cur][c];
                f32x4 q; q[0] = bflo(g2.x) * v[0] + bflo(m2.x); q[1] = bfhi(g2.x) * v[1] + bfhi(m2.x); q[2] = bflo(g2.y) * v[2] + bflo(m2.y); q[3] = bfhi(g2.y) * v[3] + bfhi(m2.y);
                u32x2 w; w.x = pk2(q[0], q[1]); w.y = pk2(q[2], q[3]); *(u32x2*)(mixb + o) = w; } }
#undef MIX_LOAD
    }
};
struct EpiRes {
    const float* xold; float* xnew; bf16_t* xb; float* rowsq;
    DI void operator()(const Acc& acc, const pg8::Unit& u, int wr, int wc, int fr, int fq) const {
        f32x4 xo[2][4];
#define RES_LOAD(r, buf) do { const int row_ = u.pm * 256 + ((r) >> 2) * 128 + wr * 64 + ((r) & 3) * 16 + fr; _Pragma("unroll") for (int c_ = 0; c_ < 4; ++c_) \
            xo[buf][c_] = *(const f32x4*)(xold + (size_t)row_ * 1024 + u.pn * 256 + (c_ >> 1) * 128 + wc * 32 + fq * 8 + (c_ & 1) * 4); } while (0)
        RES_LOAD(0, 0);
#pragma unroll
        for (int r = 0; r < 8; ++r) { const int cur = r & 1;
            if (r < 7) RES_LOAD(r + 1, cur ^ 1);
            asm volatile("" ::: "memory");
            const int row = u.pm * 256 + (r >> 2) * 128 + wr * 64 + (r & 3) * 16 + fr; float ss = 0.f;
#pragma unroll
            for (int c = 0; c < 4; ++c) { const size_t o = (size_t)row * 1024 + u.pn * 256 + (c >> 1) * 128 + wc * 32 + fq * 8 + (c & 1) * 4;
                const f32x4 v = acc[r >> 2][c >> 1][r & 3][c & 1] + xo[cur][c]; *(f32x4*)(xnew + o) = v;
                u32x2 w; w.x = pk2(v[0], v[1]); w.y = pk2(v[2], v[3]); *(u32x2*)(xb + o) = w;
                ss += v[0] * v[0] + v[1] * v[1] + v[2] * v[2] + v[3] * v[3]; }
            ss += __shfl_xor(ss, 16); ss += __shfl_xor(ss, 32);
            if (fq == 0) atomicAdd(rowsq + row, ss); }
#undef RES_LOAD
    }
};
struct EpiUp {
    bf16_t* h; const float* rowsq;
    DI void operator()(const Acc& acc, const pg8::Unit& u, int wr, int wc, int fr, int fq) const {
        float rs[2][4];
        EPI_ROWS( rs[ai][m] = rsqrtf(rowsq[row] * (1.f / 1024.f) + EPS); )
        asm volatile("" ::: "memory");
        EPI_ROWS( EPI_COLS( const f32x4 v = acc[ai][bj][m][n] * rs[ai][m];
            f32x4 r; r[0] = fmaxf(v[0], 0.f); r[1] = fmaxf(v[1], 0.f); r[2] = fmaxf(v[2], 0.f); r[3] = fmaxf(v[3], 0.f); r = r * r;
            u32x2 w; w.x = pk2(r[0], r[1]); w.y = pk2(r[2], r[3]); *(u32x2*)(h + (size_t)row * 4096 + u.pn * 256 + ct) = w; ) )
    }
};

DI int colmap(int kind, int n) {
    if (kind == 1) {
        if (n < 2048) return n;
        if (n < 3072) return 2064 + (n - 2048);
        if (n < 4096) return 11312 + (n - 3072);
        if (n < 5120) return 8240 + (n - 4096);
        if (n < 6144) return 9264 + (n - 5120);
        if (n < 7168) return 10288 + (n - 6144);
        if (n < 8192) return 13360 + (n - 7168);
        const int i = n - 8192; if (i < 16) return 2048 + i; if (i < 48) return 8208 + (i - 16); return -1;
    }
    if (kind == 2) {
        if (n < 2048) return 3088 + n;
        if (n < 5120) return 5136 + (n - 2048);
        return 12336 + (n - 5120);
    }
    return n;
}
DI void tr_item(const float* W, int ldw, int K, bf16_t* WT, const float* kscale, int kind, int kb, int nb, LAS float* scr, int lane) {
    const int k0 = 64 * kb, n0 = 32 * nb, cg = lane & 7, sub = lane >> 3; const int sc = colmap(kind, n0 + 4 * cg);
    f32x4 v[8];
#pragma unroll
    for (int i = 0; i < 8; ++i) { const int kk = 8 * i + sub; v[i] = (sc >= 0) ? *(const f32x4*)(W + (size_t)(k0 + kk) * ldw + sc) : (f32x4){0.f, 0.f, 0.f, 0.f}; }
#pragma unroll
    for (int i = 0; i < 8; ++i) { const int kk = 8 * i + sub; const float ks = kscale ? kscale[k0 + kk] : 1.f;
        scr[kk * 33 + 4 * cg + 0] = v[i][0] * ks; scr[kk * 33 + 4 * cg + 1] = v[i][1] * ks; scr[kk * 33 + 4 * cg + 2] = v[i][2] * ks; scr[kk * 33 + 4 * cg + 3] = v[i][3] * ks; }
    asm volatile("s_waitcnt lgkmcnt(0)" ::: "memory");
    const int c = lane & 7;
#pragma unroll
    for (int j = 0; j < 4; ++j) { const int n = (lane >> 3) + 8 * j; const LAS float* s = scr + (8 * c) * 33 + n;
        u32x4 o; o.x = pk2(s[0 * 33], s[1 * 33]); o.y = pk2(s[2 * 33], s[3 * 33]); o.z = pk2(s[4 * 33], s[5 * 33]); o.w = pk2(s[6 * 33], s[7 * 33]);
        *(u32x4*)(WT + (size_t)(n0 + n) * K + k0 + 8 * c) = o; }
    asm volatile("s_waitcnt lgkmcnt(0)" ::: "memory");
}
DI float wave_sum(float v) {
#pragma unroll
    for (int o = 1; o < 64; o <<= 1) v += __shfl_xor(v, o);
    return v;
}
DI void phase_prep(const Params& p, int l, LAS unsigned char* lds) {
    const int tid = opaque_tid(), lane = tid & 63, wave = __builtin_amdgcn_readfirstlane(tid >> 6);
    const int gw = blockIdx.x * 8 + wave, NGW = gridDim.x * 8;
    LAS float* scr = (LAS float*)(lds + wave * 8704);
    unsigned char* ws = p.ws; bf16_t* wt = (bf16_t*)(ws + WS_WT);
    const float* w_in = p.in[3] + (size_t)l * 1024 * INC;
    constexpr int I0 = 16 * 264, I1 = 16 * 192, I2 = 16 * 32, I3 = 32 * 32, I4 = 16 * 32, I5 = 16 * 32, I6 = 16 * 128, I7 = 64 * 32;
    constexpr int NIT = I0 + I1 + I2 + I3 + I4 + I5 + I6 + I7;
    for (int it = gw; it < NIT; it += NGW) {
        int r = it;
        if (r < I0) { tr_item(w_in, INC, 1024, (bf16_t*)((char*)wt + WT_GD), p.in[2] + l * 1024, 1, r / 264, r % 264, scr, lane); continue; } r -= I0;
        if (r < I1) { tr_item(w_in, INC, 1024, (bf16_t*)((char*)wt + WT_S), p.in[2] + l * 1024, 2, r / 192, r % 192, scr, lane); continue; } r -= I1;
        if (r < I2) { tr_item(p.in[19] + (size_t)l * 1024 * 1024, 1024, 1024, (bf16_t*)((char*)wt + WT_GLA), nullptr, 0, r / 32, r % 32, scr, lane); continue; } r -= I2;
        if (r < I3) { tr_item(p.in[20] + (size_t)l * 2048 * 1024, 1024, 2048, (bf16_t*)((char*)wt + WT_SSM), p.in[13] + l * 2048, 0, r / 32, r % 32, scr, lane); continue; } r -= I3;
        if (r < I4) { tr_item(p.in[21] + (size_t)l * 1024 * 1024, 1024, 1024, (bf16_t*)((char*)wt + WT_DIFF), nullptr, 0, r / 32, r % 32, scr, lane); continue; } r -= I4;
        if (r < I5) { tr_item(p.in[22] + (size_t)l * 1024 * 1024, 1024, 1024, (bf16_t*)((char*)wt + WT_OUT), nullptr, 0, r / 32, r % 32, scr, lane); continue; } r -= I5;
        if (r < I6) { tr_item(p.in[24] + (size_t)l * 1024 * 4096, 4096, 1024, (bf16_t*)((char*)wt + WT_UP), p.in[23] + l * 1024, 0, r / 128, r % 128, scr, lane); continue; } r -= I6;
        tr_item(p.in[25] + (size_t)l * 4096 * 1024, 1024, 4096, (bf16_t*)((char*)wt + WT_DOWN), nullptr, 0, r / 32, r % 32, scr, lane);
    }
    const int gt = blockIdx.x * 512 + tid, NT_ = gridDim.x * 512;
    float* ssq = (float*)(ws + WS_SSQ);
    for (int i = gt; i < T * 4; i += NT_) ssq[i] = 0.f;
    if (l == 0) {
        float* rowsq = (float*)(ws + WS_ROWSQ);
        for (int i = gt; i < 4 * T; i += NT_) rowsq[T + i] = 0.f;
        bf16_t* xb = (bf16_t*)(ws + WS_XB); const float* x = p.in[0];
        for (int m = gw; m < T; m += NGW) {
            const f32x4* xr = (const f32x4*)(x + (size_t)m * 1024) + lane; float s = 0.f;
            u32x2* o = (u32x2*)(xb + (size_t)m * 1024) + lane;
#pragma unroll
            for (int j = 0; j < 4; ++j) { const f32x4 v = xr[64 * j]; s += v[0] * v[0] + v[1] * v[1] + v[2] * v[2] + v[3] * v[3]; u32x2 w; w.x = pk2(v[0], v[1]); w.y = pk2(v[2], v[3]); o[64 * j] = w; }
            s = wave_sum(s); if (lane == 0) rowsq[m] = s;
        }
    }
}

DI void rope_pass(const Params& p) {
    const int* pos = (const int*)p.in[1];
    bf16_t* Qd = (bf16_t*)(p.ws + WS_R + 4 * BLK); bf16_t* Kd = (bf16_t*)(p.ws + WS_R + 5 * BLK);
    const double cf[8] = {0.15915494309189535, 0.03086376340470123, 0.005985185712713705, 0.001160663641240061, 0.00022507907903927653, 4.364795279280289e-05, 8.464330808241401e-06, 1.6414262627950345e-06};
    const int gt = blockIdx.x * 512 + opaque_tid(), NTH = gridDim.x * 512;
    for (int it0 = gt; it0 < T * 32; it0 += 4 * NTH) {
        u32x4 av[4], bv[4];
#pragma unroll
        for (int k = 0; k < 4; ++k) { const int it = it0 + k * NTH; if (it < T * 32) { const int t = it >> 5, w = it & 31; const bf16_t* base = ((w & 16) ? Kd : Qd) + (size_t)t * 1024 + (w & 15) * 64; av[k] = *(const u32x4*)base; bv[k] = *(const u32x4*)(base + 8); } }
        asm volatile("" ::: "memory");
#pragma unroll
        for (int k = 0; k < 4; ++k) { const int it = it0 + k * NTH; if (it < T * 32) {
            const int t = it >> 5, w = it & 31; bf16_t* base = ((w & 16) ? Kd : Qd) + (size_t)t * 1024 + (w & 15) * 64;
            const double ps = (double)pos[t];
            u32x4 a = av[k], b = bv[k];
            float t1[8], t2[8];
#pragma unroll
            for (int i = 0; i < 4; ++i) { t1[2 * i] = bflo(a[i]); t1[2 * i + 1] = bfhi(a[i]); t2[2 * i] = bflo(b[i]); t2[2 * i + 1] = bfhi(b[i]); }
            float o1[8], o2[8];
#pragma unroll
            for (int i = 0; i < 8; ++i) { double rv = ps * cf[i]; rv -= floor(rv); const float fr = (float)rv; const float sn = __builtin_amdgcn_sinf(fr), cs = __builtin_amdgcn_cosf(fr);
                o1[i] = t1[i] * cs - t2[i] * sn; o2[i] = t2[i] * cs + t1[i] * sn; }
#pragma unroll
            for (int i = 0; i < 4; ++i) { a[i] = pk2(o1[2 * i], o1[2 * i + 1]); b[i] = pk2(o2[2 * i], o2[2 * i + 1]); }
            *(u32x4*)base = a; *(u32x4*)(base + 8) = b; } }
    }
}

template <int KS> DI f32x4 mm16(f32x4 acc, const LAS unsigned char* A, int lda_b, const LAS unsigned char* B, int ldb_b, int lane) {
    const int r = lane & 15, q = lane >> 4;
    const LAS unsigned char* ap = A + r * lda_b + q * 16; const LAS unsigned char* bp = B + r * ldb_b + q * 16;
#pragma unroll
    for (int s = 0; s < KS; ++s) acc = mfma16(*(const LAS bf16x8*)(ap + s * 64), *(const LAS bf16x8*)(bp + s * 64), acc);
    return acc;
}
DI float logsigmoidf_(float x) { return fminf(x, 0.f) - __logf(1.f + __expf(-fabsf(x))); }

constexpr int G_GKL = 0, G_QTOT = 4096, G_BLAST = 6144, G_PART = 6656, G_QT = 8704, G_KT = 26112, G_KHT = 43520, G_VT = 61952, G_P = 98816;
template <int MODE> DI void gla_unit(const Params& p, int l, int un, LAS unsigned char* lds) {
    const int tid = opaque_tid(), lane = tid & 63, w = __builtin_amdgcn_readfirstlane(tid >> 6), r16 = lane & 15, quad = lane >> 4;
    const int sc = un >> 2, h = un & 3, tok0 = sc * 256;
    unsigned char* ws = p.ws;
    const bf16_t* QK = (const bf16_t*)(ws + WS_R); const bf16_t* Vg = (const bf16_t*)(ws + WS_R + BLK); bf16_t* Gg = (bf16_t*)(ws + WS_R + 2 * BLK);
    const float* small = (const float*)(ws + WS_SMALL);
    float* states = (float*)(ws + WS_STG) + (size_t)un * 32768;
    const int d = tid & 127, qr = tid >> 7;
    float wk[16];
#pragma unroll
    for (int r = 0; r < 16; ++r) wk[r] = p.in[5][(size_t)l * 16 * 512 + r * 512 + h * 128 + d];
    const float bk = p.in[6][l * 512 + h * 128 + d];
    f32x4 S[8][2];
    if (MODE == 3) {
#pragma unroll
        for (int mb = 0; mb < 8; ++mb)
#pragma unroll
            for (int nb = 0; nb < 2; ++nb) S[mb][nb] = *(const f32x4*)(states + ((size_t)(w * 16 + mb * 2 + nb) * 64 + lane) * 4);
    } else {
#pragma unroll
        for (int mb = 0; mb < 8; ++mb)
#pragma unroll
            for (int nb = 0; nb < 2; ++nb) S[mb][nb] = (f32x4){0.f, 0.f, 0.f, 0.f};
    }
    float ng[2] = {0.f, 0.f};
    if (MODE == 3) { ng[0] = p.in[7][l * 256 + 32 * w + r16]; ng[1] = p.in[7][l * 256 + 32 * w + 16 + r16]; }
    float dtot = 1.f;
    for (int j = 0; j < 4; ++j) {
        const int t0 = tok0 + 64 * j;
        if (tid < 256) { const int row = tid >> 2, c4 = (tid & 3) * 4; *(LAS f32x4*)(lds + G_GKL + (row * 16 + c4) * 4) = *(const f32x4*)(small + (size_t)(t0 + row) * 64 + c4); }
        if (tid < 64) ((LAS float*)(lds + G_PART))[tid] = 0.f;
        __syncthreads();
        float c[16]; float run = 0.f;
#pragma unroll
        for (int i = 0; i < 16; ++i) { const LAS f32x4* gr = (const LAS f32x4*)(lds + G_GKL) + (qr * 16 + i) * 4; float x = bk;
#pragma unroll
            for (int r = 0; r < 4; ++r) { const f32x4 g4 = gr[r]; x += g4[0] * wk[4 * r] + g4[1] * wk[4 * r + 1] + g4[2] * wk[4 * r + 2] + g4[3] * wk[4 * r + 3]; }
            run += logsigmoidf_(x) * (1.f / 16.f); c[i] = run; }
        ((LAS float*)(lds + G_QTOT))[qr * 128 + d] = run;
        __syncthreads();
        {
            float off = 0.f, bl = 0.f;
#pragma unroll
            for (int q2 = 0; q2 < 4; ++q2) { const float v = ((const LAS float*)(lds + G_QTOT))[q2 * 128 + d]; bl += v; if (q2 < qr) off += v; }
            unsigned khp[8]; const float ebl = __expf(bl);
#pragma unroll
            for (int i = 0; i < 16; i += 2) {
                float kh2[2];
#pragma unroll
                for (int e = 0; e < 2; ++e) { const int t = qr * 16 + i + e; const float b = off + c[i + e];
                    const float k = bf2f(QK[(size_t)(t0 + t) * 1024 + 512 + h * 128 + d]);
                    const float enb = __expf(-b), kt_ = k * enb;
                    kh2[e] = kt_ * ebl;
                    if (MODE == 3) { const float q = bf2f(QK[(size_t)(t0 + t) * 1024 + h * 128 + d]);
                        ((LAS bf16_t*)(lds + G_QT))[t * 136 + d] = f2bf(q * 0.08838834764831845f * __builtin_amdgcn_rcpf(enb));
                        ((LAS bf16_t*)(lds + G_KT))[t * 136 + d] = f2bf(kt_); } }
                khp[i >> 1] = pk2(kh2[0], kh2[1]);
            }
            *(LAS u32x4*)(lds + G_KHT + d * 144 + qr * 32) = (u32x4){khp[0], khp[1], khp[2], khp[3]};
            *(LAS u32x4*)(lds + G_KHT + d * 144 + qr * 32 + 16) = (u32x4){khp[4], khp[5], khp[6], khp[7]};
            if (qr == 0) { ((LAS float*)(lds + G_BLAST))[d] = bl; dtot *= ebl; }
#pragma unroll
            for (int i = 0; i < 4; ++i) { const int pid = tid + 512 * i, g8 = pid >> 6, t = pid & 63;
                const u32x4 v = *(const u32x4*)(Vg + (size_t)(t0 + t) * 1024 + h * 256 + g8 * 8);
                LAS bf16_t* vt = (LAS bf16_t*)(lds + G_VT) + (g8 * 8) * 72 + t;
#pragma unroll
                for (int e = 0; e < 4; ++e) { vt[(2 * e) * 72] = (bf16_t)(v[e] & 0xffffu); vt[(2 * e + 1) * 72] = (bf16_t)(v[e] >> 16); } }
        }
        __syncthreads();
        if (MODE == 3) {
#pragma unroll
            for (int e = 0; e < 2; ++e) { const int x = 2 * w + e, tb = x >> 2, sb = x & 3;
                f32x4 a = (f32x4){0.f, 0.f, 0.f, 0.f};
                if (sb <= tb) a = mm16<4>(a, lds + G_KT + sb * 16 * 272, 272, lds + G_QT + tb * 16 * 272, 272, lane);
                const int t = 16 * tb + r16, s0 = 16 * sb + quad * 4;
                float v[4];
#pragma unroll
                for (int jj = 0; jj < 4; ++jj) v[jj] = (s0 + jj <= t) ? a[jj] : 0.f;
                if (x == 0 && lane == 0 && j == 0 && (tok0 & (SEQ - 1)) == 0) { const float* qk_ = (l == 0) ? (const float*)(ws + SB_PROJ) + (tok0 >> 13) * 14384 : (const float*)(ws + SB_QK1) + (tok0 >> 13) * 1024;
                    float acc_ = 0.f; for (int d_ = 0; d_ < 128; ++d_) acc_ += qk_[h * 128 + d_] * qk_[512 + h * 128 + d_]; v[0] = acc_ * 0.08838834764831845f; }
                *(LAS u32x2*)(lds + G_P + t * 144 + s0 * 2) = (u32x2){pk2(v[0], v[1]), pk2(v[2], v[3])}; }
            f32x4 o[4][2];
#pragma unroll
            for (int mb = 0; mb < 4; ++mb) { o[mb][0] = (f32x4){0.f, 0.f, 0.f, 0.f}; o[mb][1] = (f32x4){0.f, 0.f, 0.f, 0.f}; }
#pragma unroll
            for (int ks = 0; ks < 4; ++ks) {
                bf16x8 bf[2];
#pragma unroll
                for (int nb = 0; nb < 2; ++nb) { const f32x4 s0v = S[2 * ks][nb], s1v = S[2 * ks + 1][nb];
                    u32x4 pk; pk.x = pk2(s0v[0], s0v[1]); pk.y = pk2(s0v[2], s0v[3]); pk.z = pk2(s1v[0], s1v[1]); pk.w = pk2(s1v[2], s1v[3]); bf[nb] = __builtin_bit_cast(bf16x8, pk); }
#pragma unroll
                for (int mb = 0; mb < 4; ++mb) { const LAS unsigned char* ap = lds + G_QT + (16 * mb + r16) * 272 + (32 * ks + quad * 4) * 2;
                    const u32x2 lo = *(const LAS u32x2*)ap, hi = *(const LAS u32x2*)(ap + 32);
                    const bf16x8 af = __builtin_bit_cast(bf16x8, (u32x4){lo.x, lo.y, hi.x, hi.y});
                    o[mb][0] = mfma16(af, bf[0], o[mb][0]); o[mb][1] = mfma16(af, bf[1], o[mb][1]); }
            }
            __syncthreads();
#pragma unroll
            for (int mb = 0; mb < 4; ++mb)
#pragma unroll
                for (int nb = 0; nb < 2; ++nb) o[mb][nb] = mm16<2>(o[mb][nb], lds + G_P + mb * 16 * 144, 144, lds + G_VT + (32 * w + 16 * nb) * 144, 144, lane);
#pragma unroll
            for (int mb = 0; mb < 4; ++mb)
#pragma unroll
                for (int jj = 0; jj < 4; ++jj) { float ss = o[mb][0][jj] * o[mb][0][jj] + o[mb][1][jj] * o[mb][1][jj];
                    ss += __shfl_xor(ss, 1); ss += __shfl_xor(ss, 2); ss += __shfl_xor(ss, 4); ss += __shfl_xor(ss, 8);
                    if (r16 == 0) __hip_atomic_fetch_add((LAS float*)(lds + G_PART) + 16 * mb + quad * 4 + jj, ss, __ATOMIC_RELAXED, __HIP_MEMORY_SCOPE_WORKGROUP); }
            __syncthreads();
            bf16_t gin[4][4][2];
#pragma unroll
            for (int mb = 0; mb < 4; ++mb)
#pragma unroll
                for (int jj = 0; jj < 4; ++jj)
#pragma unroll
                    for (int nb = 0; nb < 2; ++nb) gin[mb][jj][nb] = Gg[(size_t)(t0 + 16 * mb + quad * 4 + jj) * 1024 + h * 256 + 32 * w + 16 * nb + r16];
            asm volatile("" ::: "memory");
#pragma unroll
            for (int mb = 0; mb < 4; ++mb)
#pragma unroll
                for (int jj = 0; jj < 4; ++jj) { const int t = 16 * mb + quad * 4 + jj; const float rs = rsqrtf(((const LAS float*)(lds + G_PART))[t] * (1.f / 256.f) + EPS);
#pragma unroll
                    for (int nb = 0; nb < 2; ++nb) { bf16_t* gp = Gg + (size_t)(t0 + t) * 1024 + h * 256 + 32 * w + 16 * nb + r16;
                        *gp = f2bf(o[mb][nb][jj] * rs * ng[nb] * siluf_(bf2f(gin[mb][jj][nb]))); } }
        }
#pragma unroll
        for (int mb = 0; mb < 8; ++mb) { const f32x4 bl4 = *(const LAS f32x4*)(lds + G_BLAST + (16 * mb + quad * 4) * 4);
            const f32x4 dc = (f32x4){__expf(bl4[0]), __expf(bl4[1]), __expf(bl4[2]), __expf(bl4[3])};
#pragma unroll
            for (int nb = 0; nb < 2; ++nb) { S[mb][nb] = S[mb][nb] * dc;
                S[mb][nb] = mm16<2>(S[mb][nb], lds + G_KHT + mb * 16 * 144, 144, lds + G_VT + (32 * w + 16 * nb) * 144, 144, lane); } }
        __syncthreads();
    }
    if (MODE == 1) {
#pragma unroll
        for (int mb = 0; mb < 8; ++mb)
#pragma unroll
            for (int nb = 0; nb < 2; ++nb) *(f32x4*)(states + ((size_t)(w * 16 + mb * 2 + nb) * 64 + lane) * 4) = S[mb][nb];
        if (tid < 128) ((float*)(ws + WS_DECG))[un * 128 + tid] = dtot;
    }
}
DI void gla_scan(const Params& p) {
    const int gid = blockIdx.x * 512 + opaque_tid();
    for (int it = gid; it < 65536; it += gridDim.x * 512) {
        const int chain = it >> 13, e = it & 8191, b = chain >> 2, h = chain & 3;
        const int tile = (e >> 6) & 15, lane = e & 63, d0 = 16 * (tile >> 1) + (lane >> 4) * 4;
        f32x4* st = (f32x4*)(p.ws + WS_STG); const float* dec = (const float*)(p.ws + WS_DECG);
        f32x4 run = (f32x4){0.f, 0.f, 0.f, 0.f};
        for (int hb = 0; hb < 4; ++hb) {
            f32x4 u[8];
#pragma unroll
            for (int s = 0; s < 8; ++s) u[s] = st[(size_t)((b * 32 + hb * 8 + s) * 4 + h) * 8192 + e];
            asm volatile("" ::: "memory");
#pragma unroll
            for (int s = 0; s < 8; ++s) { const int un = (b * 32 + hb * 8 + s) * 4 + h; const f32x4 dc = *(const f32x4*)(dec + un * 128 + d0);
                st[(size_t)un * 8192 + e] = run; run = run * dc + u[s]; }
        }
    }
}

constexpr int S_ACUM = 0, S_DTV = 256, S_MISC = 512, S_XDT = 1024, S_XD2 = 10240, S_BN = 19456, S_BT = 36864, S_CN = 55296, S_GL = 72704, S_SB = 81920;
DI float softplusf_(float x) { const float e = __expf(x); return x > 20.f ? x : (x < -10.f ? e : __logf(1.f + e)); }
template <int MODE> DI void ssd_unit(const Params& p, int l, int un, LAS unsigned char* lds) {
    const int tid = opaque_tid(), lane = tid & 63, w = __builtin_amdgcn_readfirstlane(tid >> 6), r16 = lane & 15, quad = lane >> 4;
    const int sc = un >> 5, head = un & 31, g = head >> 3, tok0 = sc * 256;
    unsigned char* ws = p.ws;
    bf16_t* Zb = (bf16_t*)(ws + WS_R + (size_t)(head >> 4) * BLK) + (head & 15) * 64;
    const bf16_t* Xb = (const bf16_t*)(ws + WS_R + (size_t)(2 + (head >> 4)) * BLK) + (head & 15) * 64;
    const bf16_t* BCb = (const bf16_t*)(ws + WS_R + 4 * BLK);
    const float* small = (const float*)(ws + WS_SMALL);
    float* ssq = (float*)(ws + WS_SSQ);
    float* states = (float*)(ws + WS_STS) + (size_t)un * 8192;
    const float* cw = p.in[8] + (size_t)l * 4 * 3072; const float* cbias = p.in[9] + l * 3072;
    const float dtb = p.in[10][l * 32 + head], aneg = -__expf(p.in[11][l * 32 + head]), Dh = p.in[12][l * 32 + head];
    f32x4 st[4];
    if (MODE == 3) {
#pragma unroll
        for (int pb = 0; pb < 4; ++pb) { st[pb] = *(const f32x4*)(states + ((size_t)(w * 4 + pb) * 64 + lane) * 4);
            *(LAS u32x2*)(lds + S_SB + (16 * pb + r16) * 272 + (16 * w + quad * 4) * 2) = (u32x2){pk2(st[pb][0], st[pb][1]), pk2(st[pb][2], st[pb][3])}; }
    } else {
#pragma unroll
        for (int pb = 0; pb < 4; ++pb) st[pb] = (f32x4){0.f, 0.f, 0.f, 0.f};
    }
    const int px = tid & 63, tq = tid >> 6;
    float wx[4];
#pragma unroll
    for (int i = 0; i < 4; ++i) wx[i] = cw[i * 3072 + head * 64 + px];
    const float bx = cbias[head * 64 + px];
    float atot = 0.f;
    for (int j = 0; j < 4; ++j) {
        const int t0 = tok0 + 64 * j, s0 = t0 & (SEQ - 1);
        if (w == 0) {
            const float dt = softplusf_(small[(size_t)(t0 + lane) * 64 + 16 + head] + dtb);
            float cs = dt * aneg;
#pragma unroll
            for (int o = 1; o < 64; o <<= 1) { const float v = __shfl_up(cs, o); if (lane >= o) cs += v; }
            ((LAS float*)(lds + S_ACUM))[lane] = cs; ((LAS float*)(lds + S_DTV))[lane] = dt;
            if (lane == 63) ((LAS float*)(lds + S_MISC))[0] = cs;
        }
        __syncthreads();
        const float alast = ((const LAS float*)(lds + S_MISC))[0];
        atot += alast;
        {
            float xv[11];
#pragma unroll
            for (int k = 0; k < 11; ++k) { const int tt = tq * 8 - 3 + k; xv[k] = (s0 + tt >= 0) ? bf2f(Xb[(size_t)(t0 + tt) * 1024 + px]) : 0.f; }
            unsigned a1[4], a2[4]; float e1[2], e2[2];
#pragma unroll
            for (int i = 0; i < 8; ++i) { const int t = tq * 8 + i;
                const float cv = bx + xv[i] * wx[0] + xv[i + 1] * wx[1] + xv[i + 2] * wx[2] + xv[i + 3] * wx[3];
                const float xd = siluf_(cv) * ((const LAS float*)(lds + S_DTV))[t];
                e1[i & 1] = xd; e2[i & 1] = xd * __expf(alast - ((const LAS float*)(lds + S_ACUM))[t]);
                if (i & 1) { a1[i >> 1] = pk2(e1[0], e1[1]); a2[i >> 1] = pk2(e2[0], e2[1]); } }
            *(LAS u32x4*)(lds + S_XDT + px * 144 + tq * 16) = (u32x4){a1[0], a1[1], a1[2], a1[3]};
            *(LAS u32x4*)(lds + S_XD2 + px * 144 + tq * 16) = (u32x4){a2[0], a2[1], a2[2], a2[3]};
        }
        {
            const bf16_t* BCc = (const bf16_t*)(ws + WS_STG);
#pragma unroll
            for (int i = 0; i < 2; ++i) { const int pid = tid + 512 * i, c8 = pid >> 6, t = pid & 63;
                const u32x4 v = *(const u32x4*)(BCc + (size_t)(t0 + t) * 1024 + g * 128 + c8 * 8);
                if (MODE == 3) *(LAS u32x4*)(lds + S_BN + t * 272 + c8 * 16) = v;
                LAS bf16_t* bt = (LAS bf16_t*)(lds + S_BT) + (c8 * 8) * 72 + t;
#pragma unroll
                for (int e = 0; e < 4; ++e) { bt[(2 * e) * 72] = (bf16_t)(v[e] & 0xffffu); bt[(2 * e + 1) * 72] = (bf16_t)(v[e] >> 16); }
                if (MODE == 3) { const u32x4 cv = *(const u32x4*)(BCc + (size_t)(t0 + t) * 1024 + 512 + g * 128 + c8 * 8); *(LAS u32x4*)(lds + S_CN + t * 272 + c8 * 16) = cv; } }
        }
        __syncthreads();
        if (MODE == 3) {
            f32x4 y[2];
#pragma unroll
            for (int e = 0; e < 2; ++e) { const int x = 2 * w + e, tb = x >> 2, sb = x & 3;
                f32x4 a = (f32x4){0.f, 0.f, 0.f, 0.f};
                if (sb <= tb) a = mm16<4>(a, lds + S_BN + sb * 16 * 272, 272, lds + S_CN + tb * 16 * 272, 272, lane);
                const int t = 16 * tb + r16, sb0 = 16 * sb + quad * 4;
                const float act = ((const LAS float*)(lds + S_ACUM))[t], dtt = ((const LAS float*)(lds + S_DTV))[t];
                float v[4];
#pragma unroll
                for (int jj = 0; jj < 4; ++jj) { const int s = sb0 + jj; float val = 0.f;
                    if (s <= t) val = a[jj] * __expf(act - ((const LAS float*)(lds + S_ACUM))[s]);
                    if (s == t) val += Dh * __builtin_amdgcn_rcpf(dtt);
                    v[jj] = val; }
                *(LAS u32x2*)(lds + S_GL + t * 144 + sb0 * 2) = (u32x2){pk2(v[0], v[1]), pk2(v[2], v[3])};
                const int pb = sb;
                y[e] = mm16<4>((f32x4){0.f, 0.f, 0.f, 0.f}, lds + S_SB + pb * 16 * 272, 272, lds + S_CN + tb * 16 * 272, 272, lane);
                y[e] = y[e] * __expf(act);
            }
            __syncthreads();
            u32x2 zin[2];
#pragma unroll
            for (int e = 0; e < 2; ++e) { const int x = 2 * w + e; zin[e] = *(const u32x2*)(Zb + (size_t)(t0 + 16 * (x >> 2) + r16) * 1024 + 16 * (x & 3) + quad * 4); }
            asm volatile("" ::: "memory");
#pragma unroll
            for (int e = 0; e < 2; ++e) { const int x = 2 * w + e, tb = x >> 2, pb = x & 3;
                y[e] = mm16<2>(y[e], lds + S_XDT + pb * 16 * 144, 144, lds + S_GL + tb * 16 * 144, 144, lane);
                const int t = 16 * tb + r16; bf16_t* zp = Zb + (size_t)(t0 + t) * 1024 + 16 * pb + quad * 4;
                const u32x2 zw = zin[e];
                f32x4 r; r[0] = y[e][0] * siluf_(bflo(zw.x)); r[1] = y[e][1] * siluf_(bfhi(zw.x)); r[2] = y[e][2] * siluf_(bflo(zw.y)); r[3] = y[e][3] * siluf_(bfhi(zw.y));
                float ss = r[0] * r[0] + r[1] * r[1] + r[2] * r[2] + r[3] * r[3];
                ss += __shfl_xor(ss, 16); ss += __shfl_xor(ss, 32);
                if (quad == 0) atomicAdd(ssq + (size_t)(t0 + t) * 4 + g, ss);
                *(u32x2*)zp = (u32x2){pk2(r[0], r[1]), pk2(r[2], r[3])}; }
        }
        {
            const float da = __expf(alast);
#pragma unroll
            for (int pb = 0; pb < 4; ++pb) { st[pb] = st[pb] * da;
                st[pb] = mm16<2>(st[pb], lds + S_BT + w * 16 * 144, 144, lds + S_XD2 + pb * 16 * 144, 144, lane);
                if (MODE == 3) *(LAS u32x2*)(lds + S_SB + (16 * pb + r16) * 272 + (16 * w + quad * 4) * 2) = (u32x2){pk2(st[pb][0], st[pb][1]), pk2(st[pb][2], st[pb][3])}; }
        }
        __syncthreads();
    }
    if (MODE == 1) {
#pragma unroll
        for (int pb = 0; pb < 4; ++pb) *(f32x4*)(states + ((size_t)(w * 4 + pb) * 64 + lane) * 4) = st[pb];
        if (tid == 0) ((float*)(ws + WS_DECS))[un] = __expf(atot);
    }
}

DI void conv_bc(const Params& p, int l) {
    const bf16_t* BC = (const bf16_t*)(p.ws + WS_R + 4 * BLK); bf16_t* O = (bf16_t*)(p.ws + WS_STG);
    const float* cw = p.in[8] + (size_t)l * 4 * 3072 + 2048; const float* cb = p.in[9] + l * 3072 + 2048;
    const int gt = blockIdx.x * 512 + opaque_tid();
    for (int it = gt; it < 1024 * 256; it += gridDim.x * 512) {
        const int c = it & 1023, r0 = (it >> 10) * 64;
        const float w0 = cw[c], w1 = cw[3072 + c], w2 = cw[2 * 3072 + c], w3 = cw[3 * 3072 + c], b = cb[c];
        float xin[67];
        const bool hist = (r0 & (SEQ - 1)) != 0;
#pragma unroll
        for (int i = 0; i < 67; ++i) xin[i] = (i >= 3 || hist) ? bf2f(BC[(size_t)(r0 - 3 + i) * 1024 + c]) : 0.f;
        asm volatile("" ::: "memory");
#pragma unroll
        for (int i = 0; i < 64; ++i) { const float cv = b + xin[i] * w0 + xin[i + 1] * w1 + xin[i + 2] * w2 + xin[i + 3] * w3; O[(size_t)(r0 + i) * 1024 + c] = f2bf(siluf_(cv)); }
    }
}


constexpr int H2_GRP = 46080, H2_ACUM = 0, H2_DTV = 256, H2_MISC = 512, H2_XDT = 1024, H2_XD2 = 10240, H2_GL = 19456, H2_SB = 28672, H2_BN = 92160, H2_BT = 109568, H2_CN = 128000;
DI void ssd_unit2(const Params& p, int l, int un, LAS unsigned char* lds) {
    const int tid = opaque_tid(), lane = tid & 63, w = __builtin_amdgcn_readfirstlane(tid >> 6), r16 = lane & 15, quad = lane >> 4;
    const int gI = w >> 2, wl = w & 3, tl = tid & 255;
    const int sc = un >> 4, head = 2 * (un & 15) + gI, g = head >> 3, tok0 = sc * 256;
    unsigned char* ws = p.ws;
    LAS unsigned char* gl = lds + gI * H2_GRP;
    bf16_t* Zb = (bf16_t*)(ws + WS_R + (size_t)(head >> 4) * BLK) + (head & 15) * 64;
    const bf16_t* Xb = (const bf16_t*)(ws + WS_R + (size_t)(2 + (head >> 4)) * BLK) + (head & 15) * 64;
    const bf16_t* BCc = (const bf16_t*)(ws + WS_STG);
    const float* small = (const float*)(ws + WS_SMALL);
    float* ssq = (float*)(ws + WS_SSQ);
    const float* states = (const float*)(ws + WS_STS) + (size_t)(sc * 32 + head) * 8192;
    const float* cw = p.in[8] + (size_t)l * 4 * 3072; const float* cbias = p.in[9] + l * 3072;
    const float dtb = p.in[10][l * 32 + head], aneg = -__expf(p.in[11][l * 32 + head]), Dh = p.in[12][l * 32 + head];
    f32x4 st[2][4];
#pragma unroll
    for (int nbl = 0; nbl < 2; ++nbl)
#pragma unroll
        for (int pb = 0; pb < 4; ++pb) { const int nbk = 2 * wl + nbl; st[nbl][pb] = *(const f32x4*)(states + ((size_t)(nbk * 4 + pb) * 64 + lane) * 4);
            *(LAS u32x2*)(gl + H2_SB + (16 * pb + r16) * 272 + (16 * nbk + quad * 4) * 2) = (u32x2){pk2(st[nbl][pb][0], st[nbl][pb][1]), pk2(st[nbl][pb][2], st[nbl][pb][3])}; }
    const int px = tl & 63, tq = tl >> 6;
    float wx[4];
#pragma unroll
    for (int i = 0; i < 4; ++i) wx[i] = cw[i * 3072 + head * 64 + px];
    const float bx = cbias[head * 64 + px];
    for (int j = 0; j < 4; ++j) {
        const int t0 = tok0 + 64 * j, s0 = t0 & (SEQ - 1);
        if (wl == 0) {
            const float dt = softplusf_(small[(size_t)(t0 + lane) * 64 + 16 + head] + dtb);
            float cs = dt * aneg;
#pragma unroll
            for (int o = 1; o < 64; o <<= 1) { const float v = __shfl_up(cs, o); if (lane >= o) cs += v; }
            ((LAS float*)(gl + H2_ACUM))[lane] = cs; ((LAS float*)(gl + H2_DTV))[lane] = dt;
            if (lane == 63) ((LAS float*)(gl + H2_MISC))[0] = cs;
        }
        __syncthreads();
        const float alast = ((const LAS float*)(gl + H2_MISC))[0];
        {
            float xv[19];
#pragma unroll
            for (int k = 0; k < 19; ++k) { const int tt = tq * 16 - 3 + k; xv[k] = (s0 + tt >= 0) ? bf2f(Xb[(size_t)(t0 + tt) * 1024 + px]) : 0.f; }
            unsigned a1[8], a2[8]; float e1[2], e2[2];
#pragma unroll
            for (int i = 0; i < 16; ++i) { const int t = tq * 16 + i;
                const float cv = bx + xv[i] * wx[0] + xv[i + 1] * wx[1] + xv[i + 2] * wx[2] + xv[i + 3] * wx[3];
                const float xd = siluf_(cv) * ((const LAS float*)(gl + H2_DTV))[t];
                e1[i & 1] = xd; e2[i & 1] = xd * __expf(alast - ((const LAS float*)(gl + H2_ACUM))[t]);
                if (i & 1) { a1[i >> 1] = pk2(e1[0], e1[1]); a2[i >> 1] = pk2(e2[0], e2[1]); } }
            *(LAS u32x4*)(gl + H2_XDT + px * 144 + tq * 32) = (u32x4){a1[0], a1[1], a1[2], a1[3]}; *(LAS u32x4*)(gl + H2_XDT + px * 144 + tq * 32 + 16) = (u32x4){a1[4], a1[5], a1[6], a1[7]};
            *(LAS u32x4*)(gl + H2_XD2 + px * 144 + tq * 32) = (u32x4){a2[0], a2[1], a2[2], a2[3]}; *(LAS u32x4*)(gl + H2_XD2 + px * 144 + tq * 32 + 16) = (u32x4){a2[4], a2[5], a2[6], a2[7]};
        }
#pragma unroll
        for (int i = 0; i < 2; ++i) { const int pid = tid + 512 * i, c8 = pid >> 6, t = pid & 63;
            const u32x4 v = *(const u32x4*)(BCc + (size_t)(t0 + t) * 1024 + g * 128 + c8 * 8);
            *(LAS u32x4*)(lds + H2_BN + t * 272 + c8 * 16) = v;
            LAS bf16_t* bt = (LAS bf16_t*)(lds + H2_BT) + (c8 * 8) * 72 + t;
#pragma unroll
            for (int e = 0; e < 4; ++e) { bt[(2 * e) * 72] = (bf16_t)(v[e] & 0xffffu); bt[(2 * e + 1) * 72] = (bf16_t)(v[e] >> 16); }
            const u32x4 cv = *(const u32x4*)(BCc + (size_t)(t0 + t) * 1024 + 512 + g * 128 + c8 * 8); *(LAS u32x4*)(lds + H2_CN + t * 272 + c8 * 16) = cv; }
        __syncthreads();
        f32x4 y[4];
        const int tb = wl, t = 16 * tb + r16;
        const float act = ((const LAS float*)(gl + H2_ACUM))[t], dtt = ((const LAS float*)(gl + H2_DTV))[t];
#pragma unroll
        for (int e = 0; e < 4; ++e) { const int sb = e;
            f32x4 a = (f32x4){0.f, 0.f, 0.f, 0.f};
            if (sb <= tb) a = mm16<4>(a, lds + H2_BN + sb * 16 * 272, 272, lds + H2_CN + tb * 16 * 272, 272, lane);
            const int sb0 = 16 * sb + quad * 4;
            float v[4];
#pragma unroll
            for (int jj = 0; jj < 4; ++jj) { const int s = sb0 + jj; float val = 0.f;
                if (s <= t) val = a[jj] * __expf(act - ((const LAS float*)(gl + H2_ACUM))[s]);
                if (s == t) val += Dh * __builtin_amdgcn_rcpf(dtt);
                v[jj] = val; }
            *(LAS u32x2*)(gl + H2_GL + t * 144 + sb0 * 2) = (u32x2){pk2(v[0], v[1]), pk2(v[2], v[3])};
            y[e] = mm16<4>((f32x4){0.f, 0.f, 0.f, 0.f}, gl + H2_SB + e * 16 * 272, 272, lds + H2_CN + tb * 16 * 272, 272, lane);
            y[e] = y[e] * __expf(act);
        }
        __syncthreads();
        u32x2 zin[4];
#pragma unroll
        for (int e = 0; e < 4; ++e) zin[e] = *(const u32x2*)(Zb + (size_t)(t0 + t) * 1024 + 16 * e + quad * 4);
        asm volatile("" ::: "memory");
#pragma unroll
        for (int e = 0; e < 4; ++e) { const int pb = e;
            y[e] = mm16<2>(y[e], gl + H2_XDT + pb * 16 * 144, 144, gl + H2_GL + tb * 16 * 144, 144, lane);
            bf16_t* zp = Zb + (size_t)(t0 + t) * 1024 + 16 * pb + quad * 4;
            const u32x2 zw = zin[e];
            f32x4 r; r[0] = y[e][0] * siluf_(bflo(zw.x)); r[1] = y[e][1] * siluf_(bfhi(zw.x)); r[2] = y[e][2] * siluf_(bflo(zw.y)); r[3] = y[e][3] * siluf_(bfhi(zw.y));
            float ss = r[0] * r[0] + r[1] * r[1] + r[2] * r[2] + r[3] * r[3];
            ss += __shfl_xor(ss, 16); ss += __shfl_xor(ss, 32);
            if (quad == 0) atomicAdd(ssq + (size_t)(t0 + t) * 4 + g, ss);
            *(u32x2*)zp = (u32x2){pk2(r[0], r[1]), pk2(r[2], r[3])}; }
        {
            const float da = __expf(alast);
#pragma unroll
            for (int nbl = 0; nbl < 2; ++nbl)
#pragma unroll
                for (int pb = 0; pb < 4; ++pb) { const int nbk = 2 * wl + nbl; st[nbl][pb] = st[nbl][pb] * da;
                    st[nbl][pb] = mm16<2>(st[nbl][pb], lds + H2_BT + nbk * 16 * 144, 144, gl + H2_XD2 + pb * 16 * 144, 144, lane);
                    *(LAS u32x2*)(gl + H2_SB + (16 * pb + r16) * 272 + (16 * nbk + quad * 4) * 2) = (u32x2){pk2(st[nbl][pb][0], st[nbl][pb][1]), pk2(st[nbl][pb][2], st[nbl][pb][3])}; }
        }
        __syncthreads();
    }
}

constexpr int L_ACUM = 0, L_DTV = 1024, L_TOT = 2048, L_XD2 = 2304, L_BT = 36096;
DI void ssd_local(const Params& p, int l, int un, LAS unsigned char* lds) {
    const int tid = opaque_tid(), lane = tid & 63, w = __builtin_amdgcn_readfirstlane(tid >> 6);
    const int sc = un >> 5, head = un & 31, g = head >> 3, tok0 = sc * 256, s0 = tok0 & (SEQ - 1);
    unsigned char* ws = p.ws;
    const bf16_t* Xb = (const bf16_t*)(ws + WS_R + (size_t)(2 + (head >> 4)) * BLK) + (head & 15) * 64;
    const bf16_t* BCc = (const bf16_t*)(ws + WS_STG);
    const float* small = (const float*)(ws + WS_SMALL);
    float* states = (float*)(ws + WS_STS) + (size_t)un * 8192;
    const float* cw = p.in[8] + (size_t)l * 4 * 3072; const float* cbias = p.in[9] + l * 3072;
    const float dtb = p.in[10][l * 32 + head], aneg = -__expf(p.in[11][l * 32 + head]);
    if (w < 4) {
        const int t = w * 64 + lane; const float dt = softplusf_(small[(size_t)(tok0 + t) * 64 + 16 + head] + dtb);
        float cs = dt * aneg;
#pragma unroll
        for (int o = 1; o < 64; o <<= 1) { const float v = __shfl_up(cs, o); if (lane >= o) cs += v; }
        ((LAS float*)(lds + L_ACUM))[t] = cs; ((LAS float*)(lds + L_DTV))[t] = dt;
        if (lane == 63) ((LAS float*)(lds + L_TOT))[w] = cs;
    }
    __syncthreads();
    const float t0_ = ((const LAS float*)(lds + L_TOT))[0], t1_ = ((const LAS float*)(lds + L_TOT))[1], t2_ = ((const LAS float*)(lds + L_TOT))[2], t3_ = ((const LAS float*)(lds + L_TOT))[3];
    const float atot = t0_ + t1_ + t2_ + t3_;
    {
        const int px = tid & 63, tq = tid >> 6;
        float wx[4];
#pragma unroll
        for (int i = 0; i < 4; ++i) wx[i] = cw[i * 3072 + head * 64 + px];
        const float bx = cbias[head * 64 + px];
        const float offq = (tq >= 6) ? t0_ + t1_ + t2_ : (tq >= 4) ? t0_ + t1_ : (tq >= 2) ? t0_ : 0.f;
#pragma unroll
        for (int c4 = 0; c4 < 4; ++c4) { const int tb = tq * 32 + c4 * 8;
            float xv[11];
#pragma unroll
            for (int k = 0; k < 11; ++k) { const int tt = tb - 3 + k; xv[k] = (s0 + tt >= 0) ? bf2f(Xb[(size_t)(tok0 + tt) * 1024 + px]) : 0.f; }
            unsigned a2[4]; float e2[2];
#pragma unroll
            for (int i = 0; i < 8; ++i) { const int t = tb + i;
                const float cv = bx + xv[i] * wx[0] + xv[i + 1] * wx[1] + xv[i + 2] * wx[2] + xv[i + 3] * wx[3];
                e2[i & 1] = siluf_(cv) * ((const LAS float*)(lds + L_DTV))[t] * __expf(atot - offq - ((const LAS float*)(lds + L_ACUM))[t]);
                if (i & 1) a2[i >> 1] = pk2(e2[0], e2[1]); }
            *(LAS u32x4*)(lds + L_XD2 + px * 528 + tb * 2) = (u32x4){a2[0], a2[1], a2[2], a2[3]}; }
    }
#pragma unroll
    for (int i = 0; i < 8; ++i) { const int pid = tid + 512 * i, c8 = pid >> 8, t = pid & 255;
        const u32x4 v = *(const u32x4*)(BCc + (size_t)(tok0 + t) * 1024 + g * 128 + c8 * 8);
        LAS bf16_t* bt = (LAS bf16_t*)(lds + L_BT) + (c8 * 8) * 264 + t;
#pragma unroll
        for (int e = 0; e < 4; ++e) { bt[(2 * e) * 264] = (bf16_t)(v[e] & 0xffffu); bt[(2 * e + 1) * 264] = (bf16_t)(v[e] >> 16); } }
    __syncthreads();
#pragma unroll
    for (int pb = 0; pb < 4; ++pb) { const f32x4 st = mm16<8>((f32x4){0.f, 0.f, 0.f, 0.f}, lds + L_BT + w * 16 * 528, 528, lds + L_XD2 + pb * 16 * 528, 528, lane);
        *(f32x4*)(states + ((size_t)(w * 4 + pb) * 64 + lane) * 4) = st; }
    if (tid == 0) ((float*)(ws + WS_DECS))[un] = __expf(atot);
    __syncthreads();
}
DI void ssd_scan(const Params& p) {
    const int gid = blockIdx.x * 512 + opaque_tid();
    for (int it = gid; it < 131072; it += gridDim.x * 512) {
        const int chain = it >> 11, e = it & 2047, b = chain >> 5, head = chain & 31;
        f32x4* st = (f32x4*)(p.ws + WS_STS); const float* dec = (const float*)(p.ws + WS_DECS);
        f32x4 run = (f32x4){0.f, 0.f, 0.f, 0.f};
        for (int hb = 0; hb < 4; ++hb) {
            f32x4 u[8];
#pragma unroll
            for (int s = 0; s < 8; ++s) u[s] = st[(size_t)((b * 32 + hb * 8 + s) * 32 + head) * 2048 + e];
            asm volatile("" ::: "memory");
#pragma unroll
            for (int s = 0; s < 8; ++s) { const int un = (b * 32 + hb * 8 + s) * 32 + head; const float dc = dec[un];
                st[(size_t)un * 2048 + e] = run; run = run * dc + u[s]; }
        }
    }
}

typedef short v4i16_t __attribute__((ext_vector_type(4)));
DI s16x4 vtr(const LAS unsigned char* p) { return __builtin_bit_cast(s16x4, __builtin_amdgcn_ds_read_tr16_b64_v4i16((LAS v4i16_t*)p)); }
constexpr int A_K = 0, A_V = 34816, A_X = 0, A_Y = 65536, A_NG = 100352;
DI void attn_unit(const Params& p, int b, int h, int qb, float lam, float oscale, LAS unsigned char* lds) {
    const int tid = opaque_tid(), lane = tid & 63, w = __builtin_amdgcn_readfirstlane(tid >> 6), rg = w & 3, sub = w >> 2, q = lane & 31, hh = lane >> 5;
    bf16_t* Qd = (bf16_t*)(p.ws + WS_R + 4 * BLK); const bf16_t* Kd = (const bf16_t*)(p.ws + WS_R + 5 * BLK); const bf16_t* Vd = (const bf16_t*)(p.ws + WS_R + 6 * BLK);
    const int tok0 = b * SEQ + qb * 128;
    bf16x8 qf[4];
    { const bf16_t* qp = Qd + (size_t)(tok0 + rg * 32 + q) * 1024 + h * 128 + sub * 64 + hh * 8;
#pragma unroll
      for (int ks = 0; ks < 4; ++ks) qf[ks] = *(const bf16x8*)(qp + ks * 16); }
    const int NT = 2 * qb + 2;
    u32x4 kr[2], vr[2];
    const int prow = tid >> 4, pc16 = tid & 15;
#define ATT_LOAD(t) do { _Pragma("unroll") for (int i_ = 0; i_ < 2; ++i_) { const size_t off_ = (size_t)(b * SEQ + (t) * 64 + prow + 32 * i_) * 1024 + h * 128 + pc16 * 8; \
        kr[i_] = *(const u32x4*)(Kd + off_); vr[i_] = *(const u32x4*)(Vd + off_); } } while (0)
#define ATT_STORE(buf) do { _Pragma("unroll") for (int i_ = 0; i_ < 2; ++i_) { const int o_ = (buf) * 17408 + (prow + 32 * i_) * 272 + pc16 * 16; \
        *(LAS u32x4*)(lds + A_K + o_) = kr[i_]; *(LAS u32x4*)(lds + A_V + (buf) * 18432 + (prow + 32 * i_) * 288 + pc16 * 16) = vr[i_]; } } while (0)
    f32x16 o[4];
#pragma unroll
    for (int db = 0; db < 4; ++db)
#pragma unroll
        for (int i = 0; i < 16; ++i) o[db][i] = 0.f;
    float m_run = -1e30f, l_run = 0.f;
    const float C2 = 0.18033688011112042f;
    ATT_LOAD(0); ATT_STORE(0); ATT_LOAD(1);
    __syncthreads();
    const int i16 = lane & 15, blk = (lane >> 4) & 1;
    for (int t = 0; t < NT; ++t) {
        if (t + 1 < NT) ATT_STORE((t + 1) & 1);
        if (t + 2 < NT) ATT_LOAD(t + 2);
        if (t <= 2 * qb + (rg >> 1)) {
            const LAS unsigned char* Kb = lds + A_K + (t & 1) * 17408; const LAS unsigned char* Vb = lds + A_V + (t & 1) * 18432;
            f32x16 s0, s1;
#pragma unroll
            for (int i = 0; i < 16; ++i) { s0[i] = 0.f; s1[i] = 0.f; }
#pragma unroll
            for (int ks = 0; ks < 4; ++ks) { const LAS unsigned char* kp = Kb + q * 272 + (sub * 64 + ks * 16 + hh * 8) * 2;
                s0 = mfma32(*(const LAS bf16x8*)kp, qf[ks], s0); s1 = mfma32(*(const LAS bf16x8*)(kp + 32 * 272), qf[ks], s1); }
            float mx = fmaxf(s0[0], s1[0]);
#pragma unroll
            for (int i = 1; i < 16; ++i) mx = fmaxf(mx, fmaxf(s0[i], s1[i]));
            mx = fmaxf(mx, __shfl_xor(mx, 32));
            const float m_new = fmaxf(m_run, mx), negm = -m_new * C2;
            if (__any(m_new > m_run)) {
                const float alpha = __builtin_amdgcn_exp2f((m_run - m_new) * C2);
                l_run *= alpha;
#pragma unroll
                for (int db = 0; db < 4; ++db)
#pragma unroll
                    for (int i = 0; i < 16; ++i) o[db][i] *= alpha;
            }
            float sum = 0.f;
#pragma unroll
            for (int i = 0; i < 16; ++i) { s0[i] = __builtin_amdgcn_exp2f(fmaf(s0[i], C2, negm)); s1[i] = __builtin_amdgcn_exp2f(fmaf(s1[i], C2, negm)); sum += s0[i] + s1[i]; }
            l_run += sum; m_run = m_new;
            bf16x8 pf[2][2];
#pragma unroll
            for (int s = 0; s < 2; ++s) {
                pf[0][s] = __builtin_bit_cast(bf16x8, (u32x4){pk2(s0[8 * s], s0[8 * s + 1]), pk2(s0[8 * s + 2], s0[8 * s + 3]), pk2(s0[8 * s + 4], s0[8 * s + 5]), pk2(s0[8 * s + 6], s0[8 * s + 7])});
                pf[1][s] = __builtin_bit_cast(bf16x8, (u32x4){pk2(s1[8 * s], s1[8 * s + 1]), pk2(s1[8 * s + 2], s1[8 * s + 3]), pk2(s1[8 * s + 4], s1[8 * s + 5]), pk2(s1[8 * s + 6], s1[8 * s + 7])}); }
#pragma unroll
            for (int kb = 0; kb < 2; ++kb)
#pragma unroll
                for (int s = 0; s < 2; ++s) { const LAS unsigned char* vp = Vb + (32 * kb + 16 * s + 4 * hh + (i16 >> 2)) * 288 + blk * 32 + (i16 & 3) * 8;
#pragma unroll
                    for (int db = 0; db < 4; ++db) { const s16x4 lo = vtr(vp + db * 64), hi = vtr(vp + db * 64 + 8 * 288);
                        const bf16x8 vf = (bf16x8){lo[0], lo[1], lo[2], lo[3], hi[0], hi[1], hi[2], hi[3]};
                        o[db] = mfma32(vf, pf[kb][s], o[db]); } }
        }
        __syncthreads();
    }
#undef ATT_LOAD
#undef ATT_STORE
    const float l_tot = l_run + __shfl_xor(l_run, 32);
    LAS float* X = (LAS float*)(lds + A_X) + rg * 4096;
    if (sub == 1) { const float inv = lam / l_tot;
#pragma unroll
        for (int db = 0; db < 4; ++db)
#pragma unroll
            for (int i = 0; i < 16; ++i) X[(db * 16 + i) * 64 + lane] = o[db][i] * inv; }
    __syncthreads();
    if (sub == 0) { const float inv = 1.f / l_tot; float ss = 0.f;
#pragma unroll
        for (int db = 0; db < 4; ++db)
#pragma unroll
            for (int i = 0; i < 16; ++i) { const float v = o[db][i] * inv - X[(db * 16 + i) * 64 + lane]; o[db][i] = v; ss += v * v; }
        ss += __shfl_xor(ss, 32);
        const float rs = rsqrtf(ss * (1.f / 128.f) + 1e-5f) * oscale;
        LAS bf16_t* Y = (LAS bf16_t*)(lds + A_Y) + rg * (32 * 136);
        const LAS float* ngl = (const LAS float*)(lds + A_NG);
#pragma unroll
        for (int db = 0; db < 4; ++db)
#pragma unroll
            for (int i = 0; i < 16; ++i) { const int dv = 32 * db + crow(i, hh); Y[q * 136 + dv] = f2bf(o[db][i] * rs * ngl[dv]); }
        asm volatile("s_waitcnt lgkmcnt(0)" ::: "memory");
#pragma unroll
        for (int k = 0; k < 8; ++k) { const int piece = lane + 64 * k, row = piece >> 4, c16 = piece & 15;
            const u32x4 v = *(const LAS u32x4*)((const LAS unsigned char*)Y + row * 272 + c16 * 16);
            *(u32x4*)(Qd + (size_t)(tok0 + rg * 32 + row) * 1024 + h * 128 + c16 * 8) = v; }
    }
    __syncthreads();
}
DI void attn_phase(const Params& p, int l, LAS unsigned char* lds, int vcu) {
    const int tid = opaque_tid();
    float d1 = 0.f, d2 = 0.f;
    for (int i = 0; i < 64; ++i) { d1 += p.in[14][l * 64 + i] * p.in[15][l * 64 + i]; d2 += p.in[16][l * 64 + i] * p.in[17][l * 64 + i]; }
    const float lambda_init = (l == 0) ? 0.2f : 0.35550906759096934f;
    const float lam = expf(d1) - expf(d2) + lambda_init;
    if (tid < 128) ((LAS float*)(lds + A_NG))[tid] = p.in[18][l * 128 + tid];
    __syncthreads();
    for (int i = 0; i < 4; ++i)
        for (int vc = vcu; vc < 256; vc += gridDim.x) {
            const int bh = vc >> 4, s = vc & 15; const int qb = (i == 0) ? s : (i == 1) ? 31 - s : (i == 2) ? 32 + s : 63 - s;
            attn_unit(p, bh >> 3, bh & 7, qb, lam, 1.f - lambda_init, lds);
        }
}

DI void final_norm(const Params& p) {
    const float* rowsq = (const float*)(p.ws + WS_ROWSQ) + 4 * T; const float* g = p.in[26];
    const int gt = blockIdx.x * 512 + opaque_tid(), NTH = gridDim.x * 512;
    for (int i0 = gt; i0 < T * 256; i0 += 4 * NTH) {
        f32x4 v[4];
#pragma unroll
        for (int k = 0; k < 4; ++k) { const int i = i0 + k * NTH; if (i < T * 256) v[k] = *(const f32x4*)(p.out + (size_t)(i >> 8) * 1024 + (i & 255) * 4); }
        asm volatile("" ::: "memory");
#pragma unroll
        for (int k = 0; k < 4; ++k) { const int i = i0 + k * NTH; if (i < T * 256) { const int row = i >> 8, c = (i & 255) * 4;
            const float rs = rsqrtf(rowsq[row] * (1.f / 1024.f) + EPS); const f32x4 gv = *(const f32x4*)(g + c);
            *(f32x4*)(p.out + (size_t)row * 1024 + c) = v[k] * rs * gv; } }
    }
}


DI void gemv2(float* out, int ldo, const float* in, int ldi, const float* W, int ldw, int K, int N, int kchunk) {
    const int tid = opaque_tid(), lane = tid & 63, wave = __builtin_amdgcn_readfirstlane(tid >> 6);
    const int gw = blockIdx.x * 8 + wave, NGW = gridDim.x * 8, nstrip = (N + 63) / 64, nk = K / 128;
    for (int job = gw; job < nstrip * nk; job += NGW) {
        const int strip = job % nstrip, kq = job / nstrip, col = strip * 64 + lane; const bool ok = col < N;
        const float* wp = W + (size_t)(kq * 128) * ldw + (ok ? col : 0);
        const float* i0 = in + kq * 128; const float* i1 = in + ldi + kq * 128;
        float a0 = 0.f, a1 = 0.f;
        for (int kk = 0; kk < 2; ++kk) {
            const float h0 = i0[kk * 64 + lane], h1 = i1[kk * 64 + lane];
#pragma unroll
            for (int k = 0; k < 64; ++k) { const float wv = wp[(size_t)(kk * 64 + k) * ldw];
                a0 += __uint_as_float(__builtin_amdgcn_readlane(__float_as_uint(h0), k)) * wv; a1 += __uint_as_float(__builtin_amdgcn_readlane(__float_as_uint(h1), k)) * wv; }
        }
        if (ok) { atomicAdd(out + col, a0); atomicAdd(out + ldo + col, a1); }
    }
}
DI void side_init(const Params& p) {
    const int tid = opaque_tid(), lane = tid & 63, wave = __builtin_amdgcn_readfirstlane(tid >> 6);
    const int gt = blockIdx.x * 512 + tid, NTH = gridDim.x * 512, gw = blockIdx.x * 8 + wave, NGW = gridDim.x * 8;
    float* z = (float*)(p.ws + SB_PROJ);
    for (int i = gt; i < (int)((SB_END - SB_PROJ) / 4); i += NTH) z[i] = 0.f;
    float* hn = (float*)(p.ws + SB_HN);
    for (int r = gw; r < 128; r += NGW) { const int row = (r >> 6) * SEQ + (r & 63);
        const f32x4* xr = (const f32x4*)(p.in[0] + (size_t)row * 1024) + lane; f32x4 v[4]; float s2 = 0.f;
#pragma unroll
        for (int j = 0; j < 4; ++j) { v[j] = xr[64 * j]; s2 += v[j][0] * v[j][0] + v[j][1] * v[j][1] + v[j][2] * v[j][2] + v[j][3] * v[j][3]; }
        const float rs = rsqrtf(wave_sum(s2) * (1.f / 1024.f) + EPS);
#pragma unroll
        for (int j = 0; j < 4; ++j) { const f32x4 g = *((const f32x4*)p.in[2] + lane + 64 * j); *((f32x4*)(hn + (size_t)r * 1024) + lane + 64 * j) = v[j] * rs * g; } }
}
DI void side_kv(const Params& p) {
    const int tid = opaque_tid(), lane = tid & 63, wave = __builtin_amdgcn_readfirstlane(tid >> 6);
    const int gw = blockIdx.x * 8 + wave, NGW = gridDim.x * 8;
    const float* hn = (const float*)(p.ws + SB_HN); float* kv = (float*)(p.ws + SB_KV);
    for (int job = gw; job < 4096; job += NGW) {
        const int strip = job & 31, grp = (job >> 5) & 15, kq = job >> 9, col = strip * 64 + lane;
        const float* wp = p.in[3] + (size_t)(kq * 128) * INC + 9264 + col; const float* hp = hn + (size_t)(grp * 8) * 1024 + kq * 128;
        float a[8];
#pragma unroll
        for (int t = 0; t < 8; ++t) a[t] = 0.f;
        for (int kk = 0; kk < 2; ++kk) {
            float h[8];
#pragma unroll
            for (int t = 0; t < 8; ++t) h[t] = hp[t * 1024 + kk * 64 + lane];
#pragma unroll 16
            for (int k = 0; k < 64; ++k) { const float wv = wp[(size_t)(kk * 64 + k) * INC];
#pragma unroll
                for (int t = 0; t < 8; ++t) a[t] += __uint_as_float(__builtin_amdgcn_readlane(__float_as_uint(h[t]), k)) * wv; }
        }
#pragma unroll
        for (int t = 0; t < 8; ++t) atomicAdd(kv + (size_t)(grp * 8 + t) * 2048 + col, a[t]);
    }
}
DI void rope_cs(int pos, int i, float& cs, float& sn) {
    const double cf[8] = {0.15915494309189535, 0.03086376340470123, 0.005985185712713705, 0.001160663641240061, 0.00022507907903927653, 4.364795279280289e-05, 8.464330808241401e-06, 1.6414262627950345e-06};
    double c = cf[0];
#pragma unroll
    for (int q = 1; q < 8; ++q) c = (i == q) ? cf[q] : c;
    double rv = (double)pos * c; rv -= floor(rv); const float fr = (float)rv; sn = __builtin_amdgcn_sinf(fr); cs = __builtin_amdgcn_cosf(fr);
}
DI float wave_max(float v) {
#pragma unroll
    for (int o = 1; o < 64; o <<= 1) v = fmaxf(v, __shfl_xor(v, o));
    return v;
}
DI void side_mixers(const Params& p, int b, LAS unsigned char* lds) {
    const int tid = opaque_tid(), lane = tid & 63, w = __builtin_amdgcn_readfirstlane(tid >> 6);
    const float* P = (const float*)(p.ws + SB_PROJ) + b * 14384; float* Y = (float*)(p.ws + SB_Y) + b * 4096; float* KV = (float*)(p.ws + SB_KV) + (size_t)b * 64 * 2048;
    LAS float* cx = (LAS float*)lds; LAS float* ypre = cx + 3072; LAS float* lg = ypre + 2048; LAS float* pr = lg + 1024; LAS float* red = pr + 1024; LAS float* qr = red + 64;
    const int* pos = (const int*)p.in[1] + b * SEQ;
    __syncthreads();
    if (w < 4) { float qk = P[w * 128 + lane] * P[512 + w * 128 + lane] + P[w * 128 + 64 + lane] * P[512 + w * 128 + 64 + lane]; float vv = 0.f;
#pragma unroll
        for (int k = 0; k < 4; ++k) { const float v = P[1024 + w * 256 + k * 64 + lane]; vv += v * v; }
        qk = wave_sum(qk); vv = wave_sum(vv);
        if (lane == 0) { red[w] = qk * 0.08838834764831845f; red[4 + w] = vv * (1.f / 256.f); } }
    for (int c = tid; c < 3072; c += 512) cx[c] = siluf_(p.in[9][c] + p.in[8][3 * 3072 + c] * P[5136 + c]);
    if (tid < 32) red[8 + tid] = softplusf_(P[8208 + tid] + p.in[10][tid]);
    __syncthreads();
    for (int i = tid; i < 1024; i += 512) { const int h = i >> 8; const float p00 = red[h], o = p00 * P[1024 + i];
        Y[i] = o * rsqrtf(p00 * p00 * red[4 + h] + EPS) * p.in[7][i & 255] * siluf_(P[2064 + i]); }
    if (w < 4) { float cb = cx[2560 + w * 128 + lane] * cx[2048 + w * 128 + lane] + cx[2560 + w * 128 + 64 + lane] * cx[2048 + w * 128 + 64 + lane]; cb = wave_sum(cb); if (lane == 0) red[40 + w] = cb; }
    __syncthreads();
    for (int i = tid; i < 2048; i += 512) { const int head = i >> 6; ypre[i] = (red[40 + (head >> 3)] * red[8 + head] + p.in[12][head]) * cx[i] * siluf_(P[3088 + i]); }
    __syncthreads();
    if (w < 4) { float ss = 0.f;
#pragma unroll
        for (int k = 0; k < 8; ++k) { const float v = ypre[w * 512 + k * 64 + lane]; ss += v * v; }
        ss = wave_sum(ss); if (lane == 0) red[44 + w] = rsqrtf(ss * (1.f / 512.f) + EPS); }
    __syncthreads();
    for (int i = tid; i < 2048; i += 512) Y[1024 + i] = ypre[i] * red[44 + (i >> 9)] * p.in[13][i];
    for (int i = tid; i < 1024; i += 512) { const int d = i & 63; float v = P[8240 + i];
        if (d < 16) { float cs, sn; rope_cs(pos[0], d & 7, cs, sn); const float o = (d < 8) ? P[8240 + i + 8] : P[8240 + i - 8]; v = (d < 8) ? v * cs - o * sn : v * cs + o * sn; }
        qr[i] = v; }
    {
        float k1[16], k2[16];
#pragma unroll
        for (int q = 0; q < 16; ++q) { const int it = tid + 512 * q, j = it >> 7, hs = (it >> 3) & 15, d = it & 7; const float* kp = KV + (size_t)j * 2048 + hs * 64 + d; k1[q] = kp[0]; k2[q] = kp[8]; }
        asm volatile("" ::: "memory");
#pragma unroll
        for (int q = 0; q < 16; ++q) { const int it = tid + 512 * q, j = it >> 7, hs = (it >> 3) & 15, d = it & 7; float cs, sn; rope_cs(pos[j], d, cs, sn);
            float* kp = KV + (size_t)j * 2048 + hs * 64 + d; kp[0] = k1[q] * cs - k2[q] * sn; kp[8] = k2[q] * cs + k1[q] * sn; }
    }
    __threadfence_block();
    __syncthreads();
    for (int i = tid; i < 1024; i += 512) { const int hs = i >> 6, j = i & 63; const f32x4* kp = (const f32x4*)(KV + (size_t)j * 2048 + hs * 64); float sacc = 0.f;
#pragma unroll
        for (int d4 = 0; d4 < 16; ++d4) { const f32x4 kv4 = kp[d4]; sacc += qr[hs * 64 + 4 * d4] * kv4[0] + qr[hs * 64 + 4 * d4 + 1] * kv4[1] + qr[hs * 64 + 4 * d4 + 2] * kv4[2] + qr[hs * 64 + 4 * d4 + 3] * kv4[3]; }
        lg[i] = sacc * 0.125f; }
    __syncthreads();
#pragma unroll
    for (int rr = 0; rr < 2; ++rr) { const int row = 2 * w + rr; const float x = lg[row * 64 + lane]; const float m = wave_max(x); const float e = expf(x - m); const float sum = wave_sum(e); pr[row * 64 + lane] = e / sum; }
    __syncthreads();
    float d1 = 0.f, d2 = 0.f;
    for (int i = 0; i < 64; ++i) { d1 += p.in[14][i] * p.in[15][i]; d2 += p.in[16][i] * p.in[17][i]; }
    const float lam = expf(d1) - expf(d2) + 0.2f;
    for (int i = tid; i < 1024; i += 512) { const int h = i >> 7; float o = 0.f;
#pragma unroll 16
        for (int j = 0; j < 64; ++j) o += (pr[(2 * h) * 64 + j] - lam * pr[(2 * h + 1) * 64 + j]) * KV[(size_t)j * 2048 + 1024 + i];
        ypre[i] = o; }
    __syncthreads();
    { const float v0 = ypre[w * 128 + lane], v1 = ypre[w * 128 + 64 + lane]; const float ss = wave_sum(v0 * v0 + v1 * v1); if (lane == 0) red[48 + w] = rsqrtf(ss * (1.f / 128.f) + 1e-5f) * 0.8f; }
    __syncthreads();
    for (int i = tid; i < 1024; i += 512) Y[3072 + i] = ypre[i] * red[48 + (i >> 7)] * p.in[18][i & 127];
    float* G = (float*)(p.ws + SB_GATE) + b * 3072;
    for (int i = tid; i < 3072; i += 512) G[i] = sigmoidf_(P[11312 + i] + p.in[4][i]);
    __syncthreads();
}
DI void side_glue(const Params& p, int step, int b, LAS unsigned char* lds) {
    const int tid = opaque_tid(); unsigned char* ws = p.ws; LAS float* red = (LAS float*)lds;
    if (step == 4) {
        const float* G = (const float*)(ws + SB_GATE) + b * 3072; const float* BR = (const float*)(ws + SB_BR) + b * 3072;
        for (int c = tid; c < 1024; c += 512) { ((float*)(ws + SB_MIX))[b * 1024 + c] = G[c] * BR[c] + G[1024 + c] * BR[1024 + c] + G[2048 + c] * BR[2048 + c];
            ((float*)(ws + SB_XM))[b * 1024 + c] = p.in[0][(size_t)b * SEQ * 1024 + c]; }
    } else if (step == 6 || step == 100) {
        const float* src = (const float*)(ws + (step == 6 ? SB_XM : SB_X1)) + b * 1024; float* dst = (float*)(ws + (step == 6 ? SB_H2 : SB_HN1)) + b * 1024;
        const float* g = step == 6 ? p.in[23] : p.in[2] + 1024;
        __syncthreads();
        float s2 = 0.f; for (int c = tid; c < 1024; c += 512) s2 += src[c] * src[c];
        s2 = wave_sum(s2); if ((tid & 63) == 0) red[tid >> 6] = s2;
        __syncthreads();
        float tot = 0.f; for (int w = 0; w < 8; ++w) tot += red[w];
        const float rs = rsqrtf(tot * (1.f / 1024.f) + EPS);
        for (int c = tid; c < 1024; c += 512) dst[c] = src[c] * rs * g[c];
        if (step == 100) { const size_t row = (size_t)b * SEQ; bf16_t* xb = (bf16_t*)(ws + WS_XB);
            for (int c = tid; c < 1024; c += 512) { p.out[row * 1024 + c] = src[c]; xb[row * 1024 + c] = f2bf(src[c]); }
            if (tid == 0) ((float*)(ws + WS_ROWSQ))[2 * T + row] = tot; }
        __syncthreads();
    } else if (step == 8) {
        const float* up = (const float*)(ws + SB_UP) + b * 4096; float* hh = (float*)(ws + SB_HH) + b * 4096;
        for (int c = tid; c < 4096; c += 512) { const float r = fmaxf(up[c], 0.f); hh[c] = r * r; }
        for (int c = tid; c < 1024; c += 512) ((float*)(ws + SB_X1))[b * 1024 + c] = ((const float*)(ws + SB_XM))[b * 1024 + c];
    }
}
DI void side_phase(const Params& p, int l, int k, LAS unsigned char* lds) {
    unsigned char* ws = p.ws; const int bid = blockIdx.x;
    if (l == 0) {
        if (k == 0) side_init(p);
        else if (k == 1) { gemv2((float*)(ws + SB_PROJ), 14384, (const float*)(ws + SB_HN), 64 * 1024, p.in[3], INC, 1024, INC, 128); side_kv(p); }
        else if (k == 2) { if (bid < 2) side_mixers(p, bid, lds); }
        else if (k == 3) { float* br = (float*)(ws + SB_BR); const float* y = (const float*)(ws + SB_Y);
            gemv2(br, 3072, y, 4096, p.in[19], 1024, 1024, 1024, 128); gemv2(br + 1024, 3072, y + 1024, 4096, p.in[20], 1024, 2048, 1024, 128); gemv2(br + 2048, 3072, y + 3072, 4096, p.in[21], 1024, 1024, 1024, 128); }
        else if (k == 4) { if (bid < 2) side_glue(p, 4, bid, lds); }
        else if (k == 5) gemv2((float*)(ws + SB_XM), 1024, (const float*)(ws + SB_MIX), 1024, p.in[22], 1024, 1024, 1024, 128);
        else if (k == 6) { if (bid < 2) side_glue(p, 6, bid, lds); }
        else if (k == 7) gemv2((float*)(ws + SB_UP), 4096, (const float*)(ws + SB_H2), 1024, p.in[24], 4096, 1024, 4096, 128);
        else if (k == 8) { if (bid < 2) side_glue(p, 8, bid, lds); }
        else if (k == 9) gemv2((float*)(ws + SB_X1), 1024, (const float*)(ws + SB_HH), 4096, p.in[25], 1024, 4096, 1024, 128);
    } else {
        if (k == 0) { if (bid < 2) side_glue(p, 100, bid, lds); }
        else if (k == 1) gemv2((float*)(ws + SB_QK1), 1024, (const float*)(ws + SB_HN1), 1024, p.in[3] + (size_t)1024 * INC, INC, 1024, 1024, 128);
    }
}


DI void grid_bar(unsigned* ctr, unsigned target) {
    asm volatile("s_waitcnt vmcnt(0)" ::: "memory");
    __syncthreads();
    if (threadIdx.x == 0) {
        __builtin_amdgcn_fence(__ATOMIC_RELEASE, "agent");
        asm volatile("s_waitcnt vmcnt(0)" ::: "memory");
        __hip_atomic_fetch_add(ctr, 1u, __ATOMIC_RELAXED, __HIP_MEMORY_SCOPE_AGENT);
        while (__hip_atomic_load(ctr, __ATOMIC_RELAXED, __HIP_MEMORY_SCOPE_AGENT) < target) __builtin_amdgcn_s_sleep(8);
        __builtin_amdgcn_fence(__ATOMIC_ACQUIRE, "agent");
        asm volatile("s_waitcnt vmcnt(0)" ::: "memory");
    }
    __syncthreads();
}


#define XB_TMO      128
#define XB_XCNT(j)  (256  + 64 * (j))
#define XB_XSUB(j)  (1280 + 64 * (j))
#define XB_XGEN(j)  (2304 + 64 * (j))
#define XB_TOP      3328
#define XB_TOPGEN   3392
#define XCD_BAR_WORDS 3456
#define XB_SPIN_CAP (1u << 22)
DI unsigned xb_ld(unsigned* p)              { return __hip_atomic_load(p, __ATOMIC_RELAXED, __HIP_MEMORY_SCOPE_AGENT); }
DI unsigned xb_add(unsigned* p, unsigned v) { return __hip_atomic_fetch_add(p, v, __ATOMIC_RELAXED, __HIP_MEMORY_SCOPE_AGENT); }
DI unsigned xb_xcc_id() { return (unsigned)__builtin_amdgcn_s_getreg((3 << 11) | 20) & 0xFu; }
#define XB_SPIN(cond, bar) do { unsigned _sp = 0; while (cond) { __builtin_amdgcn_s_sleep(1); \
    if ((++_sp & 255u) == 0u) { if (xb_ld(&(bar)[XB_TMO])) break; if (_sp > XB_SPIN_CAP) { atomicAdd(&(bar)[XB_TMO], 1u); break; } } } } while (0)
DI void xcd_barrier_complete(unsigned* bar, unsigned x, unsigned& nloc, unsigned& nx) {
    const unsigned G = gridDim.x;
    unsigned sum, cnt, mine, sp = 0u;
    for (;;) {
        sum = 0u; cnt = 0u; mine = 0u;
#pragma unroll
        for (unsigned j = 0; j < 16; ++j) { const unsigned c = xb_ld(&bar[XB_XCNT(j)]); sum += c; cnt += (c > 0u) ? 1u : 0u; mine = (j == x) ? c : mine; }
        if (sum == G) break;
        __builtin_amdgcn_s_sleep(1);
        if ((++sp & 255u) == 0u) { if (xb_ld(&bar[XB_TMO])) break; if (sp > XB_SPIN_CAP) { atomicAdd(&bar[XB_TMO], 1u); break; } }
    }
    nloc = mine > 0u ? mine : 1u; nx = cnt > 0u ? cnt : 1u;
}
DI void xcd_barrier(unsigned* bar, volatile LAS unsigned* st) {
    asm volatile("s_waitcnt vmcnt(0)" ::: "memory");
    __syncthreads();
    if (threadIdx.x == 0) {
        const unsigned x = xb_xcc_id();
        __builtin_amdgcn_s_waitcnt(0);
        unsigned nloc = st[0], nx = st[1];
        if (nloc == 0u) { xcd_barrier_complete(bar, x, nloc, nx); st[0] = nloc; st[1] = nx; }
        const unsigned old = xb_add(&bar[XB_XSUB(x)], 1u);
        const unsigned gen = old / nloc;
        if (old + 1u == (gen + 1u) * nloc) {
            __builtin_amdgcn_fence(__ATOMIC_RELEASE, "agent");
            asm volatile("s_waitcnt vmcnt(0)" ::: "memory");
            const unsigned og = xb_add(&bar[XB_TOP], 1u);
            const unsigned tg = og / nx;
            if (og + 1u == (tg + 1u) * nx) xb_add(&bar[XB_TOPGEN], 1u);
            else XB_SPIN(xb_ld(&bar[XB_TOPGEN]) == tg, bar);
            __builtin_amdgcn_fence(__ATOMIC_ACQUIRE, "agent");
            xb_add(&bar[XB_XGEN(x)], 1u);
            asm volatile("s_waitcnt vmcnt(0)" ::: "memory");
        } else {
            XB_SPIN(xb_ld(&bar[XB_XGEN(x)]) == gen, bar);
            __builtin_amdgcn_fence(__ATOMIC_ACQUIRE, "agent");
            asm volatile("s_waitcnt vmcnt(0)" ::: "memory");
        }
    }
    __syncthreads();
}

constexpr int NPHASE = 31, PPL = 15;
#ifndef PH_MASK
#define PH_MASK 0xFFFFFFFFu
#endif
#define EN(k_) ((PH_MASK >> (k_)) & 1u)
constexpr int LDS_BYTES = 147456;
template <bool COOP> __global__ void __launch_bounds__(512, 2) mk(Params p) {
    extern __shared__ __attribute__((aligned(16))) unsigned char lds_raw[];
    LAS unsigned char* lds = (LAS unsigned char*)lds_raw;
    unsigned char* ws = p.ws;
    float* rowsq = (float*)(ws + WS_ROWSQ);
    bf16_t* xb = (bf16_t*)(ws + WS_XB); bf16_t* mixb = (bf16_t*)(ws + WS_MIXB); bf16_t* R = (bf16_t*)(ws + WS_R);
    const unsigned char* wt = ws + WS_WT;
    const int G = gridDim.x, bid = blockIdx.x;
    volatile LAS unsigned* xst = (volatile LAS unsigned*)(lds + LDS_BYTES - 16);
    if (threadIdx.x == 0) { xst[0] = 0u; xst[1] = 0u; (void)xb_add((unsigned*)(ws + WS_BAR) + XB_XCNT(xb_xcc_id()), 1u); }
    __syncthreads();
    const int vcu = (G % 8 == 0) ? (bid % 8) * (G / 8) + bid / 8 : bid;
    for (int ph = p.ph_lo; ph < p.ph_hi; ++ph) {
        if (ph == 30) { final_norm(p); }
        else {
            const int l = ph / PPL, k = ph % PPL;
            if (EN(0) && k == 0) phase_prep(p, l, lds);
            else if (k == 1 || k == 6) {
                const bool gd = (k == 1);
                pg8::Gemm g{xb, (const bf16_t*)(wt + (gd ? WT_GD : WT_S)), T, gd ? 8448 : 6144, 1024, 1024, 1024};
                pg8::StaticOrder S; S.init(T, g.N, G, bid);
                EpiIn E{R, rowsq + (2 * l) * T, (float*)(ws + WS_SMALL), gd ? 32 : -1, gd ? 3 : 5, gd ? 7 : -1,
                        p.in[4] + l * 3072 + (gd ? 0 : 1024), p.in[4] + l * 3072 + 2048};
                pg8::gemm_phase(lds, g, S, E);
            }
            else if (EN(2) && k == 2) { rope_pass(p); for (int un = vcu; un < 256; un += G) gla_unit<1>(p, l, un, lds); }
            else if (EN(3) && k == 3) { gla_scan(p); attn_phase(p, l, lds, vcu); }
            else if (EN(4) && k == 4) { for (int un = vcu; un < 256; un += G) gla_unit<3>(p, l, un, lds); }
            else if (k == 5 || k == 11) {
                const int nrun = (k == 5) ? 2 : 4;
                for (int r = 0; r < nrun; ++r) {
                    pg8::Gemm g; EpiMix E;
                    if (k == 5) {
                        g = pg8::Gemm{R + (size_t)(r == 0 ? 2 : 4) * (BLK / 2), (const bf16_t*)(wt + (r == 0 ? WT_GLA : WT_DIFF)), T, 1024, 1024, 1024, 1024};
                        E = EpiMix{mixb, R + (size_t)(r == 0 ? 3 : 7) * (BLK / 2), nullptr, 0, r == 0 ? 1 : 0};
                    } else {
                        g = pg8::Gemm{R + (size_t)(r >> 1) * (BLK / 2) + (r & 1) * 512, (const bf16_t*)(wt + WT_SSM) + r * 512, T, 1024, 512, 1024, 2048};
                        E = EpiMix{mixb, R + (size_t)5 * (BLK / 2), (const float*)(ws + WS_SSQ), r, 0};
                    }
                    pg8::StaticOrder S; S.init(T, 1024, G, bid);
                    pg8::gemm_phase(lds, g, S, E);
                }
            }
            else if (k == 7) { conv_bc(p, l); }
            else if (k == 8) { for (int un = vcu; un < 2048; un += G) ssd_local(p, l, un, lds); }
            else if (k == 9) { ssd_scan(p); }
            else if (k == 10) { for (int un = vcu; un < 1024; un += G) ssd_unit2(p, l, un, lds); }
            else if (k == 12 || k == 14) {
                const bool dn = (k == 14);
                pg8::Gemm g{dn ? R : mixb, (const bf16_t*)(wt + (dn ? WT_DOWN : WT_OUT)), T, 1024, dn ? 4096 : 1024, dn ? 4096 : 1024, dn ? 4096 : 1024};
                pg8::StaticOrder S; S.init(T, 1024, G, bid);
                EpiRes E{(l == 0 && !dn) ? p.in[0] : p.out, p.out, xb, rowsq + (2 * l + (dn ? 2 : 1)) * T};
                pg8::gemm_phase(lds, g, S, E);
            }
            else if (k == 13) {
                pg8::Gemm g{xb, (const bf16_t*)(wt + WT_UP), T, 4096, 1024, 1024, 1024};
                pg8::StaticOrder S; S.init(T, 4096, G, bid);
                EpiUp E{R, rowsq + (2 * l + 1) * T};
                pg8::gemm_phase(lds, g, S, E);
            }
        }
        if (ph < 30) side_phase(p, ph / PPL, ph % PPL, lds);
        if (COOP) { if (ph + 1 < p.ph_hi) { if (p.ph_hi < 0) cg::this_grid().sync();
            xcd_barrier((unsigned*)(ws + WS_BAR), xst); } }
    }
}

extern "C" void kernel_launch(void* const* d_in, const int* in_sizes, int n_in, void* d_out, int out_size, void* d_ws, size_t ws_size, hipStream_t stream) {
    static int grid = 0;
    if (grid == 0) {
        if (n_in != 27 || out_size != T * 1024 || ws_size < WS_END) { fprintf(stderr, "kernel_launch: unexpected shapes/ws (n_in %d out %d ws %zu need %zu)\n", n_in, out_size, ws_size, (size_t)WS_END); grid = -1; return; }
        int dev = 0, cus = 0, per_cu = 0;
        (void)hipGetDevice(&dev); (void)hipDeviceGetAttribute(&cus, hipDeviceAttributeMultiprocessorCount, dev);
        (void)hipFuncSetAttribute((const void*)mk<true>, hipFuncAttributeMaxDynamicSharedMemorySize, LDS_BYTES);
        (void)hipOccupancyMaxActiveBlocksPerMultiprocessor(&per_cu, (const void*)mk<true>, 512, LDS_BYTES);
        if (per_cu < 1) fprintf(stderr, "kernel_launch: occupancy query says %d blocks/CU\n", per_cu);
        (void)hipGetLastError();
        grid = cus;
    }
    if (grid < 0) return;
    Params p{};
    for (int i = 0; i < 27; ++i) p.in[i] = (const float*)d_in[i];
    p.out = (float*)d_out; p.ws = (unsigned char*)d_ws;
    p.ph_lo = 0; p.ph_hi = NPHASE;
    (void)hipMemsetAsync((unsigned char*)d_ws + WS_BAR, 0, 16384, stream);
    void* args[] = {&p};
    hipError_t e = hipLaunchCooperativeKernel((const void*)mk<true>, dim3(grid), dim3(512), args, LDS_BYTES, stream);
    if (e != hipSuccess) fprintf(stderr, "cooperative launch failed: %s (grid %d)\n", hipGetErrorString(e), grid);
}
```

```cpp
#include <hip/hip_runtime.h>
#include <hip/hip_cooperative_groups.h>
#include <cstdio>
#include <cstdint>
namespace cg = cooperative_groups;

#define LAS __attribute__((address_space(3)))
#define DI __device__ __forceinline__
typedef unsigned short bf16_t;
typedef short bf16x8 __attribute__((ext_vector_type(8)));
typedef short s16x4 __attribute__((ext_vector_type(4)));
typedef float f32x4 __attribute__((ext_vector_type(4)));
typedef float f32x16 __attribute__((ext_vector_type(16)));
typedef unsigned u32x4 __attribute__((ext_vector_type(4)));
typedef unsigned u32x2 __attribute__((ext_vector_type(2)));
typedef float f32x2_t __attribute__((ext_vector_type(2)));
typedef __bf16 bf16x2_t __attribute__((ext_vector_type(2)));

DI unsigned pk2(float lo, float hi) { f32x2_t v = {lo, hi}; bf16x2_t b = __builtin_convertvector(v, bf16x2_t); return __builtin_bit_cast(unsigned, b); }
DI bf16_t f2bf(float f) { return (bf16_t)(pk2(f, 0.f) & 0xffffu); }
DI float bf2f(unsigned b) { return __uint_as_float(b << 16); }
DI float bflo(unsigned w) { return __uint_as_float(w << 16); }
DI float bfhi(unsigned w) { return __uint_as_float(w & 0xffff0000u); }
DI f32x4 mfma16(bf16x8 a, bf16x8 b, f32x4 c) { return __builtin_amdgcn_mfma_f32_16x16x32_bf16(a, b, c, 0, 0, 0); }
DI f32x16 mfma32(bf16x8 a, bf16x8 b, f32x16 c) { return __builtin_amdgcn_mfma_f32_32x32x16_bf16(a, b, c, 0, 0, 0); }
DI float sigmoidf_(float x) { return __builtin_amdgcn_rcpf(1.f + __expf(-x)); }
DI float siluf_(float x) { return x * __builtin_amdgcn_rcpf(1.f + __expf(-x)); }
DI int opaque_tid() { int t = threadIdx.x; asm volatile("" : "+v"(t)); return t; }
DI int crow(int r, int hi) { return (r & 3) + 8 * (r >> 2) + 4 * hi; }

constexpr int T = 16384, SEQ = 8192, DM = 1024, DFF = 4096, INC = 14384;
constexpr float EPS = 1e-6f;
constexpr size_t MiB = 1u << 20;
constexpr size_t WS_ROWSQ = 0;
constexpr size_t WS_BAR = 448 * 1024;
constexpr size_t WS_DECG = 512 * 1024;
constexpr size_t WS_DECS = 768 * 1024;
constexpr size_t WS_SSQ = 1 * MiB;
constexpr size_t WS_SMALL = 2 * MiB;
constexpr size_t WS_XB = 6 * MiB;
constexpr size_t WS_MIXB = 38 * MiB;
constexpr size_t WS_WT = 70 * MiB;
constexpr size_t WT_GD = 0, WT_S = WT_GD + (size_t)8448 * 1024 * 2, WT_GLA = WT_S + (size_t)6144 * 1024 * 2, WT_SSM = WT_GLA + 2 * MiB,
                 WT_DIFF = WT_SSM + 4 * MiB, WT_OUT = WT_DIFF + 2 * MiB, WT_UP = WT_OUT + 2 * MiB, WT_DOWN = WT_UP + 8 * MiB, WT_END = WT_DOWN + 8 * MiB;
static_assert(WT_END <= 56 * MiB, "wt");
constexpr size_t WS_R = 126 * MiB;
constexpr size_t BLK = 32 * MiB;
constexpr size_t WS_STG = WS_R + 8 * BLK;
constexpr size_t WS_STS = WS_R + 6 * BLK;
constexpr size_t WS_SIDE = WS_R + 9 * BLK;
constexpr size_t SB_HN = WS_SIDE, SB_PROJ = SB_HN + 512 * 1024, SB_KV = SB_PROJ + 128 * 1024, SB_Y = SB_KV + 1024 * 1024, SB_GATE = SB_Y + 32 * 1024,
                 SB_BR = SB_GATE + 32 * 1024, SB_MIX = SB_BR + 32 * 1024, SB_XM = SB_MIX + 8192, SB_H2 = SB_XM + 8192, SB_UP = SB_H2 + 8192,
                 SB_HH = SB_UP + 32768, SB_X1 = SB_HH + 32768, SB_HN1 = SB_X1 + 8192, SB_QK1 = SB_HN1 + 8192, SB_END = SB_QK1 + 8192;
constexpr size_t WS_END = WS_SIDE + 2 * MiB;
static_assert(SB_END <= WS_END, "side");

struct Params {
    const float* in[27];
    float* out; unsigned char* ws;
    int ph_lo, ph_hi;
};

namespace pg8 {
constexpr int BM = 256, BK = 64, HALF = 128, HTB = HALF * BK * 2, STAGE_BYTES = 8 * HTB, NXCD = 8, WGM = 8;
__host__ __device__ __forceinline__ int lds_byte(int r, int c) { const int st = (r >> 4) * 2 + (c >> 5), rr = r & 15, cc = c & 31, ob = rr * 64 + cc * 2; return st * 1024 + (ob ^ (((ob >> 9) & 1) << 5)); }
__host__ __device__ __forceinline__ void stage_rc(int b, int& R, int& C) { const int st = b / 1024, sb = b % 1024, swz = sb ^ (((sb >> 9) & 1) << 5); R = (st >> 1) * 16 + swz / 64; C = (st & 1) * 32 + (swz % 64) / 2; }
__host__ __device__ __forceinline__ int perm32(int rho) { const int n = rho >> 4, i = rho & 15; return 8 * (i >> 2) + 4 * n + (i & 3); }
struct Unit { int pm, pn; };
struct Gemm { const bf16_t* A; const bf16_t* Bt; int M, N, K, lda, ldb; };
struct StaticOrder {
    int nM, nN, nwg, G, c;
    __host__ __device__ void init(int M, int N, int G_, int c_) { nM = M / BM; nN = N / BM; nwg = nM * nN; G = G_; c = c_; }
    __host__ __device__ bool next(int i, Unit& u) const {
        const long L = (long)i * G + c; if (L >= nwg) return false;
        int wgid = (int)L; { const int q = nwg / NXCD, r = nwg % NXCD, xcd = wgid % NXCD, off = wgid / NXCD; wgid = (xcd < r ? xcd * (q + 1) : r * (q + 1) + (xcd - r) * q) + off; }
        const int nig = WGM * nN, gid = wgid / nig, fm = gid * WGM, gsz = (nM - fm) < WGM ? (nM - fm) : WGM;
        u.pm = fm + ((wgid % nig) % gsz); u.pn = (wgid % nig) / gsz; return true;
    }
};
template <class Epi, class Sched>
__device__ __forceinline__ void gemm_phase(LAS unsigned char* lds, const Gemm g, const Sched& S, const Epi& E) {
    const int tid = opaque_tid(), wid = __builtin_amdgcn_readfirstlane(tid >> 6), lane = tid & 63, wr = wid >> 2, wc = wid & 3, fr = lane & 15, fq = lane >> 4;
    const int K = g.K, nt = K / BK;
    unsigned voffA[2], voffB[2];
#pragma unroll
    for (int i = 0; i < 2; ++i) { int R, C; stage_rc(tid * 16 + i * 8192, R, C);
        const int Rb = (R & ~31) + perm32(R & 31);
        voffA[i] = (unsigned)(R * g.lda + C) * 2u; voffB[i] = (unsigned)(Rb * g.ldb + C) * 2u; }
    const size_t kstep = (size_t)(BK * 2);
    const size_t hstepA = (size_t)HALF * g.lda * 2, hstepB = (size_t)HALF * g.ldb * 2;
    const size_t tstepA = 2 * hstepA, tstepB = 2 * hstepB;
    const unsigned ldsw = (unsigned)wid * 1024u;
    const int aoff = lds_byte(wr * 64 + fr, fq * 8), boff = lds_byte(wc * 32 + fr, fq * 8);
#define PG8_SA(b, h) (((b) * 2 + (h)) * HTB)
#define PG8_SB(b, h) ((4 + (b) * 2 + (h)) * HTB)
#define PG8_STAGE(bufoff, gbase, voff) do { _Pragma("unroll") for (int _i = 0; _i < 2; ++_i) \
        __builtin_amdgcn_global_load_lds((const unsigned*)((const char*)(gbase) + (voff)[_i]), (LAS unsigned*)(lds + (bufoff) + ldsw + _i * 8192), 16, 0, 0); } while (0)
#define PG8_LDA(dst, b, h) do { _Pragma("unroll") for (int m = 0; m < 4; ++m) _Pragma("unroll") for (int k = 0; k < 2; ++k) dst[m][k] = *(const LAS bf16x8*)(lds + PG8_SA(b, h) + aoff + m * 2048 + k * 1024); } while (0)
#define PG8_LDB(dst, b, h) do { _Pragma("unroll") for (int n = 0; n < 2; ++n) _Pragma("unroll") for (int k = 0; k < 2; ++k) dst[n][k] = *(const LAS bf16x8*)(lds + PG8_SB(b, h) + boff + n * 2048 + k * 1024); } while (0)
#define PG8_MMA(ai, bj, At, Bt) do { __builtin_amdgcn_s_setprio(1); _Pragma("unroll") for (int m = 0; m < 4; ++m) _Pragma("unroll") for (int n = 0; n < 2; ++n) _Pragma("unroll") for (int k = 0; k < 2; ++k) \
        acc[ai][bj][m][n] = __builtin_amdgcn_mfma_f32_16x16x32_bf16(Bt[n][k], At[m][k], acc[ai][bj][m][n], 0, 0, 0); __builtin_amdgcn_s_setprio(0); } while (0)
#define PG8_WAIT_V(n) asm volatile("s_waitcnt vmcnt(" #n ")" ::: "memory")
#define PG8_WAIT_L(n) asm volatile("s_waitcnt lgkmcnt(" #n ")" ::: "memory")
#define PG8_BAR __builtin_amdgcn_s_barrier()
#define PG8_SCHED __builtin_amdgcn_sched_barrier(0)
    Unit cur, nxt; int ui = 0;
    if (!S.next(0, cur)) return;
    f32x4 acc[2][2][4][2];
#pragma unroll
    for (int a = 0; a < 2; ++a)
#pragma unroll
        for (int b = 0; b < 2; ++b)
#pragma unroll
            for (int m = 0; m < 4; ++m)
#pragma unroll
                for (int n = 0; n < 2; ++n) acc[a][b][m][n] = (f32x4){0.f, 0.f, 0.f, 0.f};
    bf16x8 At[4][2], B0[2][2], B1[2][2];
    const char* cA = (const char*)g.A + (size_t)cur.pm * tstepA; const char* cB = (const char*)g.Bt + (size_t)cur.pn * tstepB;
    PG8_STAGE(PG8_SB(0, 0), cB, voffB); PG8_STAGE(PG8_SB(0, 1), cB + hstepB, voffB); PG8_STAGE(PG8_SA(0, 0), cA, voffA); PG8_STAGE(PG8_SA(0, 1), cA + hstepA, voffA);
    if (wr == 1) PG8_BAR;
    PG8_WAIT_V(2); PG8_BAR;
    PG8_STAGE(PG8_SB(1, 0), cB + kstep, voffB); PG8_STAGE(PG8_SA(1, 0), cA + kstep, voffA); PG8_STAGE(PG8_SB(1, 1), cB + hstepB + kstep, voffB);
    PG8_WAIT_V(6); PG8_BAR;
    for (;;) {
        const bool has_next = S.next(ui + 1, nxt);
        const char* nA = has_next ? (const char*)g.A + (size_t)nxt.pm * tstepA : cA; const char* nB = has_next ? (const char*)g.Bt + (size_t)nxt.pn * tstepB : cB;
        for (int t = 0; t < nt; t += 2) {
            const bool last = (t == nt - 2);
            const char* a1 = cA + (size_t)(t + 1) * kstep;
            const char* a2 = last ? nA : cA + (size_t)(t + 2) * kstep; const char* b2 = last ? nB : cB + (size_t)(t + 2) * kstep;
            const char* a3 = a2 + kstep; const char* b3 = b2 + kstep;
            PG8_LDB(B0, 0, 0); PG8_LDB(B1, 0, 1); PG8_SCHED; PG8_LDA(At, 0, 0); PG8_STAGE(PG8_SA(1, 1), a1 + hstepA, voffA);
            PG8_WAIT_V(8); PG8_WAIT_L(0); PG8_BAR; PG8_MMA(0, 0, At, B0); PG8_MMA(0, 1, At, B1); PG8_BAR; PG8_SCHED;
            PG8_LDA(At, 0, 1); PG8_STAGE(PG8_SB(0, 0), b2, voffB); PG8_STAGE(PG8_SB(0, 1), b2 + hstepB, voffB); PG8_STAGE(PG8_SA(0, 0), a2, voffA);
            PG8_WAIT_V(8); PG8_WAIT_L(0); PG8_BAR; PG8_MMA(1, 0, At, B0); PG8_MMA(1, 1, At, B1); PG8_BAR; PG8_SCHED;
            PG8_LDB(B0, 1, 0); PG8_LDB(B1, 1, 1); PG8_SCHED; PG8_LDA(At, 1, 0); PG8_STAGE(PG8_SA(0, 1), a2 + hstepA, voffA);
            PG8_WAIT_V(8); PG8_WAIT_L(0); PG8_BAR; PG8_MMA(0, 0, At, B0); PG8_MMA(0, 1, At, B1); PG8_BAR; PG8_SCHED;
            PG8_LDA(At, 1, 1); PG8_STAGE(PG8_SB(1, 0), b3, voffB); PG8_STAGE(PG8_SB(1, 1), b3 + hstepB, voffB); PG8_STAGE(PG8_SA(1, 0), a3, voffA);
            PG8_WAIT_V(8); PG8_WAIT_L(0); PG8_BAR; PG8_MMA(1, 0, At, B0); PG8_MMA(1, 1, At, B1); PG8_BAR; PG8_SCHED;
        }
        if (wr == 0) PG8_BAR;
        E(acc, cur, wr, wc, fr, fq);
        if (!has_next) break;
#pragma unroll
        for (int a = 0; a < 2; ++a)
#pragma unroll
            for (int b = 0; b < 2; ++b)
#pragma unroll
                for (int m = 0; m < 4; ++m)
#pragma unroll
                    for (int n = 0; n < 2; ++n) acc[a][b][m][n] = (f32x4){0.f, 0.f, 0.f, 0.f};
        cur = nxt; cA = nA; cB = nB; ++ui;
        if (wr == 1) PG8_BAR;
    }
    PG8_WAIT_V(0);
    PG8_BAR;
#undef PG8_SA
#undef PG8_SB
#undef PG8_STAGE
#undef PG8_LDA
#undef PG8_LDB
#undef PG8_MMA
#undef PG8_WAIT_V
#undef PG8_WAIT_L
#undef PG8_BAR
#undef PG8_SCHED
}
}

typedef f32x4 Acc[2][2][4][2];
#define EPI_ROWS(...) _Pragma("unroll") for (int ai = 0; ai < 2; ++ai) _Pragma("unroll") for (int m = 0; m < 4; ++m) { const int row = u.pm * 256 + ai * 128 + wr * 64 + m * 16 + fr; __VA_ARGS__ }
#define EPI_COLS(...) _Pragma("unroll") for (int bj = 0; bj < 2; ++bj) _Pragma("unroll") for (int n = 0; n < 2; ++n) { const int ct = bj * 128 + wc * 32 + fq * 8 + n * 4; __VA_ARGS__ }

struct EpiIn {
    bf16_t* R; const float* rowsq; float* small; int small_tile; int gblkA, gblkB; const float* biasA; const float* biasB;
    DI void operator()(const Acc& acc, const pg8::Unit& u, int wr, int wc, int fr, int fq) const {
        const int blk = u.pn >> 2, cb = (u.pn & 3) * 256;
        float rs[2][4];
        EPI_ROWS( rs[ai][m] = rsqrtf(rowsq[row] * (1.f / 1024.f) + EPS); )
        if (u.pn == small_tile) {
            asm volatile("" ::: "memory");
            EPI_ROWS( EPI_COLS( if (ct < 64) *(f32x4*)(small + (size_t)row * 64 + ct) = acc[ai][bj][m][n] * rs[ai][m]; ) )
            return;
        }
        bf16_t* dst = R + (size_t)blk * (BLK / 2);
        const float* bias = (blk == gblkA) ? biasA : ((blk == gblkB) ? biasB : nullptr);
        if (bias) {
            f32x4 bv[2][2];
            EPI_COLS( bv[bj][n] = *(const f32x4*)(bias + cb + ct); )
            asm volatile("" ::: "memory");
            EPI_ROWS( EPI_COLS( const f32x4 v = acc[ai][bj][m][n] * rs[ai][m] + bv[bj][n];
                u32x2 w; w.x = pk2(sigmoidf_(v[0]), sigmoidf_(v[1])); w.y = pk2(sigmoidf_(v[2]), sigmoidf_(v[3])); *(u32x2*)(dst + (size_t)row * 1024 + cb + ct) = w; ) )
        } else {
            asm volatile("" ::: "memory");
            EPI_ROWS( EPI_COLS( const f32x4 v = acc[ai][bj][m][n] * rs[ai][m];
                u32x2 w; w.x = pk2(v[0], v[1]); w.y = pk2(v[2], v[3]); *(u32x2*)(dst + (size_t)row * 1024 + cb + ct) = w; ) )
        }
    }
};
struct EpiMix {
    bf16_t* mixb; const bf16_t* gate; const float* ssq; int grp; int first;
    DI void operator()(const Acc& acc, const pg8::Unit& u, int wr, int wc, int fr, int fq) const {
        float rs[8];
#pragma unroll
        for (int r = 0; r < 8; ++r) { const int row = u.pm * 256 + (r >> 2) * 128 + wr * 64 + (r & 3) * 16 + fr; rs[r] = ssq ? rsqrtf(ssq[(size_t)row * 4 + grp] * (1.f / 512.f) + EPS) : 1.f; }
        u32x2 gw[2][4], mw[2][4];
#define MIX_LOAD(r, buf) do { const int row_ = u.pm * 256 + ((r) >> 2) * 128 + wr * 64 + ((r) & 3) * 16 + fr; _Pragma("unroll") for (int c_ = 0; c_ < 4; ++c_) { \
            const size_t o_ = (size_t)row_ * 1024 + u.pn * 256 + (c_ >> 1) * 128 + wc * 32 + fq * 8 + (c_ & 1) * 4; gw[buf][c_] = *(const u32x2*)(gate + o_); mw[buf][c_] = first ? (u32x2){0u, 0u} : *(const u32x2*)(mixb + o_); } } while (0)
        MIX_LOAD(0, 0);
#pragma unroll
        for (int r = 0; r < 8; ++r) { const int cur = r & 1;
            if (r < 7) MIX_LOAD(r + 1, cur ^ 1);
            asm volatile("" ::: "memory");
            const int row = u.pm * 256 + (r >> 2) * 128 + wr * 64 + (r & 3) * 16 + fr;
#pragma unroll
            for (int c = 0; c < 4; ++c) { const size_t o = (size_t)row * 1024 + u.pn * 256 + (c >> 1) * 128 + wc * 32 + fq * 8 + (c & 1) * 4;
                const f32x4 v = acc[r >> 2][c >> 1][r & 3][c & 1] * rs[r]; const u32x2 g2 = gw[cur][c], m2 = mw[cur][c];
                f32x4 q; q[0] = bflo(g2.x) * v[0] + bflo(m2.x); q[1] = bfhi(g2.x) * v[1] + bfhi(m2.x); q[2] = bflo(g2.y) * v[2] + bflo(m2.y); q[3] = bfhi(g2.y) * v[3] + bfhi(m2.y);
                u32x2 w; w.x = pk2(q[0], q[1]); w.y = pk2(q[2], q[3]); *(u32x2*)(mixb + o) = w; } }
#undef MIX_LOAD
    }
};
struct EpiRes {
    const float* xold; float* xnew; bf16_t* xb; float* rowsq;
    DI void operator()(const Acc& acc, const pg8::Unit& u, int wr, int wc, int fr, int fq) const {
        f32x4 xo[2][4];
#define RES_LOAD(r, buf) do { const int row_ = u.pm * 256 + ((r) >> 2) * 128 + wr * 64 + ((r) & 3) * 16 + fr; _Pragma("unroll") for (int c_ = 0; c_ < 4; ++c_) \
            xo[buf][c_] = *(const f32x4*)(xold + (size_t)row_ * 1024 + u.pn * 256 + (c_ >> 1) * 128 + wc * 32 + fq * 8 + (c_ & 1) * 4); } while (0)
        RES_LOAD(0, 0);
#pragma unroll
        for (int r = 0; r < 8; ++r) { const int cur = r & 1;
            if (r < 7) RES_LOAD(r + 1, cur ^ 1);
            asm volatile("" ::: "memory");
            const int row = u.pm * 256 + (r >> 2) * 128 + wr * 64 + (r & 3) * 16 + fr; float ss = 0.f;
#pragma unroll
            for (int c = 0; c < 4; ++c) { const size_t o = (size_t)row * 1024 + u.pn * 256 + (c >> 1) * 128 + wc * 32 + fq * 8 + (c & 1) * 4;
                const f32x4 v = acc[r >> 2][c >> 1][r & 3][c & 1] + xo[cur][c]; *(f32x4*)(xnew + o) = v;
                u32x2 w; w.x = pk2(v[0], v[1]); w.y = pk2(v[2], v[3]); *(u32x2*)(xb + o) = w;
                ss += v[0] * v[0] + v[1] * v[1] + v[2] * v[2] + v[3] * v[3]; }
            ss += __shfl_xor(ss, 16); ss += __shfl_xor(ss, 32);
            if (fq == 0) atomicAdd(rowsq + row, ss); }
#undef RES_LOAD
    }
};
struct EpiUp {
    bf16_t* h; const float* rowsq;
    DI void operator()(const Acc& acc, const pg8::Unit& u, int wr, int wc, int fr, int fq) const {
        float rs[2][4];
        EPI_ROWS( rs[ai][m] = rsqrtf(rowsq[row] * (1.f / 1024.f) + EPS); )
        asm volatile("" ::: "memory");
        EPI_ROWS( EPI_COLS( const f32x4 v = acc[ai][bj][m][n] * rs[ai][m];
            f32x4 r; r[0] = fmaxf(v[0], 0.f); r[1] = fmaxf(v[1], 0.f); r[2] = fmaxf(v[2], 0.f); r[3] = fmaxf(v[3], 0.f); r = r * r;
            u32x2 w; w.x = pk2(r[0], r[1]); w.y = pk2(r[2], r[3]); *(u32x2*)(h + (size_t)row * 4096 + u.pn * 256 + ct) = w; ) )
    }
};

DI int colmap(int kind, int n) {
    if (kind == 1) {
        if (n < 2048) return n;
        if (n < 3072) return 2064 + (n - 2048);
        if (n < 4096) return 11312 + (n - 3072);
        if (n < 5120) return 8240 + (n - 4096);
        if (n < 6144) return 9264 + (n - 5120);
        if (n < 7168) return 10288 + (n - 6144);
        if (n < 8192) return 13360 + (n - 7168);
        const int i = n - 8192; if (i < 16) return 2048 + i; if (i < 48) return 8208 + (i - 16); return -1;
    }
    if (kind == 2) {
        if (n < 2048) return 3088 + n;
        if (n < 5120) return 5136 + (n - 2048);
        return 12336 + (n - 5120);
    }
    return n;
}
DI void tr_item(const float* W, int ldw, int K, bf16_t* WT, const float* kscale, int kind, int kb, int nb, LAS float* scr, int lane) {
    const int k0 = 64 * kb, n0 = 32 * nb, cg = lane & 7, sub = lane >> 3; const int sc = colmap(kind, n0 + 4 * cg);
    f32x4 v[8];
#pragma unroll
    for (int i = 0; i < 8; ++i) { const int kk = 8 * i + sub; v[i] = (sc >= 0) ? *(const f32x4*)(W + (size_t)(k0 + kk) * ldw + sc) : (f32x4){0.f, 0.f, 0.f, 0.f}; }
#pragma unroll
    for (int i = 0; i < 8; ++i) { const int kk = 8 * i + sub; const float ks = kscale ? kscale[k0 + kk] : 1.f;
        scr[kk * 33 + 4 * cg + 0] = v[i][0] * ks; scr[kk * 33 + 4 * cg + 1] = v[i][1] * ks; scr[kk * 33 + 4 * cg + 2] = v[i][2] * ks; scr[kk * 33 + 4 * cg + 3] = v[i][3] * ks; }
    asm volatile("s_waitcnt lgkmcnt(0)" ::: "memory");
    const int c = lane & 7;
#pragma unroll
    for (int j = 0; j < 4; ++j) { const int n = (lane >> 3) + 8 * j; const LAS float* s = scr + (8 * c) * 33 + n;
        u32x4 o; o.x = pk2(s[0 * 33], s[1 * 33]); o.y = pk2(s[2 * 33], s[3 * 33]); o.z = pk2(s[4 * 33], s[5 * 33]); o.w = pk2(s[6 * 33], s[7 * 33]);
        *(u32x4*)(WT + (size_t)(n0 + n) * K + k0 + 8 * c) = o; }
    asm volatile("s_waitcnt lgkmcnt(0)" ::: "memory");
}
DI float wave_sum(float v) {
#pragma unroll
    for (int o = 1; o < 64; o <<= 1) v += __shfl_xor(v, o);
    return v;
}
DI void phase_prep(const Params& p, int l, LAS unsigned char* lds) {
    const int tid = opaque_tid(), lane = tid & 63, wave = __builtin_amdgcn_readfirstlane(tid >> 6);
    const int gw = blockIdx.x * 8 + wave, NGW = gridDim.x * 8;
    LAS float* scr = (LAS float*)(lds + wave * 8704);
    unsigned char* ws = p.ws; bf16_t* wt = (bf16_t*)(ws + WS_WT);
    const float* w_in = p.in[3] + (size_t)l * 1024 * INC;
    constexpr int I0 = 16 * 264, I1 = 16 * 192, I2 = 16 * 32, I3 = 32 * 32, I4 = 16 * 32, I5 = 16 * 32, I6 = 16 * 128, I7 = 64 * 32;
    constexpr int NIT = I0 + I1 + I2 + I3 + I4 + I5 + I6 + I7;
    for (int it = gw; it < NIT; it += NGW) {
        int r = it;
        if (r < I0) { tr_item(w_in, INC, 1024, (bf16_t*)((char*)wt + WT_GD), p.in[2] + l * 1024, 1, r / 264, r % 264, scr, lane); continue; } r -= I0;
        if (r < I1) { tr_item(w_in, INC, 1024, (bf16_t*)((char*)wt + WT_S), p.in[2] + l * 1024, 2, r / 192, r % 192, scr, lane); continue; } r -= I1;
        if (r < I2) { tr_item(p.in[19] + (size_t)l * 1024 * 1024, 1024, 1024, (bf16_t*)((char*)wt + WT_GLA), nullptr, 0, r / 32, r % 32, scr, lane); continue; } r -= I2;
        if (r < I3) { tr_item(p.in[20] + (size_t)l * 2048 * 1024, 1024, 2048, (bf16_t*)((char*)wt + WT_SSM), p.in[13] + l * 2048, 0, r / 32, r % 32, scr, lane); continue; } r -= I3;
        if (r < I4) { tr_item(p.in[21] + (size_t)l * 1024 * 1024, 1024, 1024, (bf16_t*)((char*)wt + WT_DIFF), nullptr, 0, r / 32, r % 32, scr, lane); continue; } r -= I4;
        if (r < I5) { tr_item(p.in[22] + (size_t)l * 1024 * 1024, 1024, 1024, (bf16_t*)((char*)wt + WT_OUT), nullptr, 0, r / 32, r % 32, scr, lane); continue; } r -= I5;
        if (r < I6) { tr_item(p.in[24] + (size_t)l * 1024 * 4096, 4096, 1024, (bf16_t*)((char*)wt + WT_UP), p.in[23] + l * 1024, 0, r / 128, r % 128, scr, lane); continue; } r -= I6;
        tr_item(p.in[25] + (size_t)l * 4096 * 1024, 1024, 4096, (bf16_t*)((char*)wt + WT_DOWN), nullptr, 0, r / 32, r % 32, scr, lane);
    }
    const int gt = blockIdx.x * 512 + tid, NT_ = gridDim.x * 512;
    float* ssq = (float*)(ws + WS_SSQ);
    for (int i = gt; i < T * 4; i += NT_) ssq[i] = 0.f;
    if (l == 0) {
        float* rowsq = (float*)(ws + WS_ROWSQ);
        for (int i = gt; i < 4 * T; i += NT_) rowsq[T + i] = 0.f;
        bf16_t* xb = (bf16_t*)(ws + WS_XB); const float* x = p.in[0];
        for (int m = gw; m < T; m += NGW) {
            const f32x4* xr = (const f32x4*)(x + (size_t)m * 1024) + lane; float s = 0.f;
            u32x2* o = (u32x2*)(xb + (size_t)m * 1024) + lane;
#pragma unroll
            for (int j = 0; j < 4; ++j) { const f32x4 v = xr[64 * j]; s += v[0] * v[0] + v[1] * v[1] + v[2] * v[2] + v[3] * v[3]; u32x2 w; w.x = pk2(v[0], v[1]); w.y = pk2(v[2], v[3]); o[64 * j] = w; }
            s = wave_sum(s); if (lane == 0) rowsq[m] = s;
        }
    }
}

DI void rope_pass(const Params& p) {
    const int* pos = (const int*)p.in[1];
    bf16_t* Qd = (bf16_t*)(p.ws + WS_R + 4 * BLK); bf16_t* Kd = (bf16_t*)(p.ws + WS_R + 5 * BLK);
    const double cf[8] = {0.15915494309189535, 0.03086376340470123, 0.005985185712713705, 0.001160663641240061, 0.00022507907903927653, 4.364795279280289e-05, 8.464330808241401e-06, 1.6414262627950345e-06};
    const int gt = blockIdx.x * 512 + opaque_tid(), NTH = gridDim.x * 512;
    for (int it0 = gt; it0 < T * 32; it0 += 4 * NTH) {
        u32x4 av[4], bv[4];
#pragma unroll
        for (int k = 0; k < 4; ++k) { const int it = it0 + k * NTH; if (it < T * 32) { const int t = it >> 5, w = it & 31; const bf16_t* base = ((w & 16) ? Kd : Qd) + (size_t)t * 1024 + (w & 15) * 64; av[k] = *(const u32x4*)base; bv[k] = *(const u32x4*)(base + 8); } }
        asm volatile("" ::: "memory");
#pragma unroll
        for (int k = 0; k < 4; ++k) { const int it = it0 + k * NTH; if (it < T * 32) {
            const int t = it >> 5, w = it & 31; bf16_t* base = ((w & 16) ? Kd : Qd) + (size_t)t * 1024 + (w & 15) * 64;
            const double ps = (double)pos[t];
            u32x4 a = av[k], b = bv[k];
            float t1[8], t2[8];
#pragma unroll
            for (int i = 0; i < 4; ++i) { t1[2 * i] = bflo(a[i]); t1[2 * i + 1] = bfhi(a[i]); t2[2 * i] = bflo(b[i]); t2[2 * i + 1] = bfhi(b[i]); }
            float o1[8], o2[8];
#pragma unroll
            for (int i = 0; i < 8; ++i) { double rv = ps * cf[i]; rv -= floor(rv); const float fr = (float)rv; const float sn = __builtin_amdgcn_sinf(fr), cs = __builtin_amdgcn_cosf(fr);
                o1[i] = t1[i] * cs - t2[i] * sn; o2[i] = t2[i] * cs + t1[i] * sn; }
#pragma unroll
            for (int i = 0; i < 4; ++i) { a[i] = pk2(o1[2 * i], o1[2 * i + 1]); b[i] = pk2(o2[2 * i], o2[2 * i + 1]); }
            *(u32x4*)base = a; *(u32x4*)(base + 8) = b; } }
    }
}

template <int KS> DI f32x4 mm16(f32x4 acc, const LAS unsigned char* A, int lda_b, const LAS unsigned char* B, int ldb_b, int lane) {
    const int r = lane & 15, q = lane >> 4;
    const LAS unsigned char* ap = A + r * lda_b + q * 16; const LAS unsigned char* bp = B + r * ldb_b + q * 16;
#pragma unroll
    for (int s = 0; s < KS; ++s) acc = mfma16(*(const LAS bf16x8*)(ap + s * 64), *(const LAS bf16x8*)(bp + s * 64), acc);
    return acc;
}
DI float logsigmoidf_(float x) { return fminf(x, 0.f) - __logf(1.f + __expf(-fabsf(x))); }

constexpr int G_GKL = 0, G_QTOT = 4096, G_BLAST = 6144, G_PART = 6656, G_QT = 8704, G_KT = 26112, G_KHT = 43520, G_VT = 61952, G_P = 98816;
template <int MODE> DI void gla_unit(const Params& p, int l, int un, LAS unsigned char* lds) {
    const int tid = opaque_tid(), lane = tid & 63, w = __builtin_amdgcn_readfirstlane(tid >> 6), r16 = lane & 15, quad = lane >> 4;
    const int sc = un >> 2, h = un & 3, tok0 = sc * 256;
    unsigned char* ws = p.ws;
    const bf16_t* QK = (const bf16_t*)(ws + WS_R); const bf16_t* Vg = (const bf16_t*)(ws + WS_R + BLK); bf16_t* Gg = (bf16_t*)(ws + WS_R + 2 * BLK);
    const float* small = (const float*)(ws + WS_SMALL);
    float* states = (float*)(ws + WS_STG) + (size_t)un * 32768;
    const int d = tid & 127, qr = tid >> 7;
    float wk[16];
#pragma unroll
    for (int r = 0; r < 16; ++r) wk[r] = p.in[5][(size_t)l * 16 * 512 + r * 512 + h * 128 + d];
    const float bk = p.in[6][l * 512 + h * 128 + d];
    f32x4 S[8][2];
    if (MODE == 3) {
#pragma unroll
        for (int mb = 0; mb < 8; ++mb)
#pragma unroll
            for (int nb = 0; nb < 2; ++nb) S[mb][nb] = *(const f32x4*)(states + ((size_t)(w * 16 + mb * 2 + nb) * 64 + lane) * 4);
    } else {
#pragma unroll
        for (int mb = 0; mb < 8; ++mb)
#pragma unroll
            for (int nb = 0; nb < 2; ++nb) S[mb][nb] = (f32x4){0.f, 0.f, 0.f, 0.f};
    }
    float ng[2] = {0.f, 0.f};
    if (MODE == 3) { ng[0] = p.in[7][l * 256 + 32 * w + r16]; ng[1] = p.in[7][l * 256 + 32 * w + 16 + r16]; }
    float dtot = 1.f;
    for (int j = 0; j < 4; ++j) {
        const int t0 = tok0 + 64 * j;
        if (tid < 256) { const int row = tid >> 2, c4 = (tid & 3) * 4; *(LAS f32x4*)(lds + G_GKL + (row * 16 + c4) * 4) = *(const f32x4*)(small + (size_t)(t0 + row) * 64 + c4); }
        if (tid < 64) ((LAS float*)(lds + G_PART))[tid] = 0.f;
        __syncthreads();
        float c[16]; float run = 0.f;
#pragma unroll
        for (int i = 0; i < 16; ++i) { const LAS f32x4* gr = (const LAS f32x4*)(lds + G_GKL) + (qr * 16 + i) * 4; float x = bk;
#pragma unroll
            for (int r = 0; r < 4; ++r) { const f32x4 g4 = gr[r]; x += g4[0] * wk[4 * r] + g4[1] * wk[4 * r + 1] + g4[2] * wk[4 * r + 2] + g4[3] * wk[4 * r + 3]; }
            run += logsigmoidf_(x) * (1.f / 16.f); c[i] = run; }
        ((LAS float*)(lds + G_QTOT))[qr * 128 + d] = run;
        __syncthreads();
        {
            float off = 0.f, bl = 0.f;
#pragma unroll
            for (int q2 = 0; q2 < 4; ++q2) { const float v = ((const LAS float*)(lds + G_QTOT))[q2 * 128 + d]; bl += v; if (q2 < qr) off += v; }
            unsigned khp[8]; const float ebl = __expf(bl);
#pragma unroll
            for (int i = 0; i < 16; i += 2) {
                float kh2[2];
#pragma unroll
                for (int e = 0; e < 2; ++e) { const int t = qr * 16 + i + e; const float b = off + c[i + e];
                    const float k = bf2f(QK[(size_t)(t0 + t) * 1024 + 512 + h * 128 + d]);
                    const float enb = __expf(-b), kt_ = k * enb;
                    kh2[e] = kt_ * ebl;
                    if (MODE == 3) { const float q = bf2f(QK[(size_t)(t0 + t) * 1024 + h * 128 + d]);
                        ((LAS bf16_t*)(lds + G_QT))[t * 136 + d] = f2bf(q * 0.08838834764831845f * __builtin_amdgcn_rcpf(enb));
                        ((LAS bf16_t*)(lds + G_KT))[t * 136 + d] = f2bf(kt_); } }
                khp[i >> 1] = pk2(kh2[0], kh2[1]);
            }
            *(LAS u32x4*)(lds + G_KHT + d * 144 + qr * 32) = (u32x4){khp[0], khp[1], khp[2], khp[3]};
            *(LAS u32x4*)(lds + G_KHT + d * 144 + qr * 32 + 16) = (u32x4){khp[4], khp[5], khp[6], khp[7]};
            if (qr == 0) { ((LAS float*)(lds + G_BLAST))[d] = bl; dtot *= ebl; }
#pragma unroll
            for (int i = 0; i < 4; ++i) { const int pid = tid + 512 * i, g8 = pid >> 6, t = pid & 63;
                const u32x4 v = *(const u32x4*)(Vg + (size_t)(t0 + t) * 1024 + h * 256 + g8 * 8);
                LAS bf16_t* vt = (LAS bf16_t*)(lds + G_VT) + (g8 * 8) * 72 + t;
#pragma unroll
                for (int e = 0; e < 4; ++e) { vt[(2 * e) * 72] = (bf16_t)(v[e] & 0xffffu); vt[(2 * e + 1) * 72] = (bf16_t)(v[e] >> 16); } }
        }
        __syncthreads();
        if (MODE == 3) {
#pragma unroll
            for (int e = 0; e < 2; ++e) { const int x = 2 * w + e, tb = x >> 2, sb = x & 3;
                f32x4 a = (f32x4){0.f, 0.f, 0.f, 0.f};
                if (sb <= tb) a = mm16<4>(a, lds + G_KT + sb * 16 * 272, 272, lds + G_QT + tb * 16 * 272, 272, lane);
                const int t = 16 * tb + r16, s0 = 16 * sb + quad * 4;
                float v[4];
#pragma unroll
                for (int jj = 0; jj < 4; ++jj) v[jj] = (s0 + jj <= t) ? a[jj] : 0.f;
                if (x == 0 && lane == 0 && j == 0 && (tok0 & (SEQ - 1)) == 0) { const float* qk_ = (l == 0) ? (const float*)(ws + SB_PROJ) + (tok0 >> 13) * 14384 : (const float*)(ws + SB_QK1) + (tok0 >> 13) * 1024;
                    float acc_ = 0.f; for (int d_ = 0; d_ < 128; ++d_) acc_ += qk_[h * 128 + d_] * qk_[512 + h * 128 + d_]; v[0] = acc_ * 0.08838834764831845f; }
                *(LAS u32x2*)(lds + G_P + t * 144 + s0 * 2) = (u32x2){pk2(v[0], v[1]), pk2(v[2], v[3])}; }
            f32x4 o[4][2];
#pragma unroll
            for (int mb = 0; mb < 4; ++mb) { o[mb][0] = (f32x4){0.f, 0.f, 0.f, 0.f}; o[mb][1] = (f32x4){0.f, 0.f, 0.f, 0.f}; }
#pragma unroll
            for (int ks = 0; ks < 4; ++ks) {
                bf16x8 bf[2];
#pragma unroll
                for (int nb = 0; nb < 2; ++nb) { const f32x4 s0v = S[2 * ks][nb], s1v = S[2 * ks + 1][nb];
                    u32x4 pk; pk.x = pk2(s0v[0], s0v[1]); pk.y = pk2(s0v[2], s0v[3]); pk.z = pk2(s1v[0], s1v[1]); pk.w = pk2(s1v[2], s1v[3]); bf[nb] = __builtin_bit_cast(bf16x8, pk); }
#pragma unroll
                for (int mb = 0; mb < 4; ++mb) { const LAS unsigned char* ap = lds + G_QT + (16 * mb + r16) * 272 + (32 * ks + quad * 4) * 2;
                    const u32x2 lo = *(const LAS u32x2*)ap, hi = *(const LAS u32x2*)(ap + 32);
                    const bf16x8 af = __builtin_bit_cast(bf16x8, (u32x4){lo.x, lo.y, hi.x, hi.y});
                    o[mb][0] = mfma16(af, bf[0], o[mb][0]); o[mb][1] = mfma16(af, bf[1], o[mb][1]); }
            }
            __syncthreads();
#pragma unroll
            for (int mb = 0; mb < 4; ++mb)
#pragma unroll
                for (int nb = 0; nb < 2; ++nb) o[mb][nb] = mm16<2>(o[mb][nb], lds + G_P + mb * 16 * 144, 144, lds + G_VT + (32 * w + 16 * nb) * 144, 144, lane);
#pragma unroll
            for (int mb = 0; mb < 4; ++mb)
#pragma unroll
                for (int jj = 0; jj < 4; ++jj) { float ss = o[mb][0][jj] * o[mb][0][jj] + o[mb][1][jj] * o[mb][1][jj];
                    ss += __shfl_xor(ss, 1); ss += __shfl_xor(ss, 2); ss += __shfl_xor(ss, 4); ss += __shfl_xor(ss, 8);
                    if (r16 == 0) __hip_atomic_fetch_add((LAS float*)(lds + G_PART) + 16 * mb + quad * 4 + jj, ss, __ATOMIC_RELAXED, __HIP_MEMORY_SCOPE_WORKGROUP); }
            __syncthreads();
            bf16_t gin[4][4][2];
#pragma unroll
            for (int mb = 0; mb < 4; ++mb)
#pragma unroll
                for (int jj = 0; jj < 4; ++jj)
#pragma unroll
                    for (int nb = 0; nb < 2; ++nb) gin[mb][jj][nb] = Gg[(size_t)(t0 + 16 * mb + quad * 4 + jj) * 1024 + h * 256 + 32 * w + 16 * nb + r16];
            asm volatile("" ::: "memory");
#pragma unroll
            for (int mb = 0; mb < 4; ++mb)
#pragma unroll
                for (int jj = 0; jj < 4; ++jj) { const int t = 16 * mb + quad * 4 + jj; const float rs = rsqrtf(((const LAS float*)(lds + G_PART))[t] * (1.f / 256.f) + EPS);
#pragma unroll
                    for (int nb = 0; nb < 2; ++nb) { bf16_t* gp = Gg + (size_t)(t0 + t) * 1024 + h * 256 + 32 * w + 16 * nb + r16;
                        *gp = f2bf(o[mb][nb][jj] * rs * ng[nb] * siluf_(bf2f(gin[mb][jj][nb]))); } }
        }
#pragma unroll
        for (int mb = 0; mb < 8; ++mb) { const f32x4 bl4 = *(const LAS f32x4*)(lds + G_BLAST + (16 * mb + quad * 4) * 4);
            const f32x4 dc = (f32x4){__expf(bl4[0]), __expf(bl4[1]), __expf(bl4[2]), __expf(bl4[3])};
#pragma unroll
            for (int nb = 0; nb < 2; ++nb) { S[mb][nb] = S[mb][nb] * dc;
                S[mb][nb] = mm16<2>(S[mb][nb], lds + G_KHT + mb * 16 * 144, 144, lds + G_VT + (32 * w + 16 * nb) * 144, 144, lane); } }
        __syncthreads();
    }
    if (MODE == 1) {
#pragma unroll
        for (int mb = 0; mb < 8; ++mb)
#pragma unroll
            for (int nb = 0; nb < 2; ++nb) *(f32x4*)(states + ((size_t)(w * 16 + mb * 2 + nb) * 64 + lane) * 4) = S[mb][nb];
        if (tid < 128) ((float*)(ws + WS_DECG))[un * 128 + tid] = dtot;
    }
}
DI void gla_scan(const Params& p) {
    const int gid = blockIdx.x * 512 + opaque_tid();
    for (int it = gid; it < 65536; it += gridDim.x * 512) {
        const int chain = it >> 13, e = it & 8191, b = chain >> 2, h = chain & 3;
        const int tile = (e >> 6) & 15, lane = e & 63, d0 = 16 * (tile >> 1) + (lane >> 4) * 4;
        f32x4* st = (f32x4*)(p.ws + WS_STG); const float* dec = (const float*)(p.ws + WS_DECG);
        f32x4 run = (f32x4){0.f, 0.f, 0.f, 0.f};
        for (int hb = 0; hb < 4; ++hb) {
            f32x4 u[8];
#pragma unroll
            for (int s = 0; s < 8; ++s) u[s] = st[(size_t)((b * 32 + hb * 8 + s) * 4 + h) * 8192 + e];
            asm volatile("" ::: "memory");
#pragma unroll
            for (int s = 0; s < 8; ++s) { const int un = (b * 32 + hb * 8 + s) * 4 + h; const f32x4 dc = *(const f32x4*)(dec + un * 128 + d0);
                st[(size_t)un * 8192 + e] = run; run = run * dc + u[s]; }
        }
    }
}

constexpr int S_ACUM = 0, S_DTV = 256, S_MISC = 512, S_XDT = 1024, S_XD2 = 10240, S_BN = 19456, S_BT = 36864, S_CN = 55296, S_GL = 72704, S_SB = 81920;
DI float softplusf_(float x) { const float e = __expf(x); return x > 20.f ? x : (x < -10.f ? e : __logf(1.f + e)); }
template <int MODE> DI void ssd_unit(const Params& p, int l, int un, LAS unsigned char* lds) {
    const int tid = opaque_tid(), lane = tid & 63, w = __builtin_amdgcn_readfirstlane(tid >> 6), r16 = lane & 15, quad = lane >> 4;
    const int sc = un >> 5, head = un & 31, g = head >> 3, tok0 = sc * 256;
    unsigned char* ws = p.ws;
    bf16_t* Zb = (bf16_t*)(ws + WS_R + (size_t)(head >> 4) * BLK) + (head & 15) * 64;
    const bf16_t* Xb = (const bf16_t*)(ws + WS_R + (size_t)(2 + (head >> 4)) * BLK) + (head & 15) * 64;
    const bf16_t* BCb = (const bf16_t*)(ws + WS_R + 4 * BLK);
    const float* small = (const float*)(ws + WS_SMALL);
    float* ssq = (float*)(ws + WS_SSQ);
    float* states = (float*)(ws + WS_STS) + (size_t)un * 8192;
    const float* cw = p.in[8] + (size_t)l * 4 * 3072; const float* cbias = p.in[9] + l * 3072;
    const float dtb = p.in[10][l * 32 + head], aneg = -__expf(p.in[11][l * 32 + head]), Dh = p.in[12][l * 32 + head];
    f32x4 st[4];
    if (MODE == 3) {
#pragma unroll
        for (int pb = 0; pb < 4; ++pb) { st[pb] = *(const f32x4*)(states + ((size_t)(w * 4 + pb) * 64 + lane) * 4);
            *(LAS u32x2*)(lds + S_SB + (16 * pb + r16) * 272 + (16 * w + quad * 4) * 2) = (u32x2){pk2(st[pb][0], st[pb][1]), pk2(st[pb][2], st[pb][3])}; }
    } else {
#pragma unroll
        for (int pb = 0; pb < 4; ++pb) st[pb] = (f32x4){0.f, 0.f, 0.f, 0.f};
    }
    const int px = tid & 63, tq = tid >> 6;
    float wx[4];
#pragma unroll
    for (int i = 0; i < 4; ++i) wx[i] = cw[i * 3072 + head * 64 + px];
    const float bx = cbias[head * 64 + px];
    float atot = 0.f;
    for (int j = 0; j < 4; ++j) {
        const int t0 = tok0 + 64 * j, s0 = t0 & (SEQ - 1);
        if (w == 0) {
            const float dt = softplusf_(small[(size_t)(t0 + lane) * 64 + 16 + head] + dtb);
            float cs = dt * aneg;
#pragma unroll
            for (int o = 1; o < 64; o <<= 1) { const float v = __shfl_up(cs, o); if (lane >= o) cs += v; }
            ((LAS float*)(lds + S_ACUM))[lane] = cs; ((LAS float*)(lds + S_DTV))[lane] = dt;
            if (lane == 63) ((LAS float*)(lds + S_MISC))[0] = cs;
        }
        __syncthreads();
        const float alast = ((const LAS float*)(lds + S_MISC))[0];
        atot += alast;
        {
            float xv[11];
#pragma unroll
            for (int k = 0; k < 11; ++k) { const int tt = tq * 8 - 3 + k; xv[k] = (s0 + tt >= 0) ? bf2f(Xb[(size_t)(t0 + tt) * 1024 + px]) : 0.f; }
            unsigned a1[4], a2[4]; float e1[2], e2[2];
#pragma unroll
            for (int i = 0; i < 8; ++i) { const int t = tq * 8 + i;
                const float cv = bx + xv[i] * wx[0] + xv[i + 1] * wx[1] + xv[i + 2] * wx[2] + xv[i + 3] * wx[3];
                const float xd = siluf_(cv) * ((const LAS float*)(lds + S_DTV))[t];
                e1[i & 1] = xd; e2[i & 1] = xd * __expf(alast - ((const LAS float*)(lds + S_ACUM))[t]);
                if (i & 1) { a1[i >> 1] = pk2(e1[0], e1[1]); a2[i >> 1] = pk2(e2[0], e2[1]); } }
            *(LAS u32x4*)(lds + S_XDT + px * 144 + tq * 16) = (u32x4){a1[0], a1[1], a1[2], a1[3]};
            *(LAS u32x4*)(lds + S_XD2 + px * 144 + tq * 16) = (u32x4){a2[0], a2[1], a2[2], a2[3]};
        }
        {
            const bf16_t* BCc = (const bf16_t*)(ws + WS_STG);
#pragma unroll
            for (int i = 0; i < 2; ++i) { const int pid = tid + 512 * i, c8 = pid >> 6, t = pid & 63;
                const u32x4 v = *(const u32x4*)(BCc + (size_t)(t0 + t) * 1024 + g * 128 + c8 * 8);
                if (MODE == 3) *(LAS u32x4*)(lds + S_BN + t * 272 + c8 * 16) = v;
                LAS bf16_t* bt = (LAS bf16_t*)(lds + S_BT) + (c8 * 8) * 72 + t;
#pragma unroll
                for (int e = 0; e < 4; ++e) { bt[(2 * e) * 72] = (bf16_t)(v[e] & 0xffffu); bt[(2 * e + 1) * 72] = (bf16_t)(v[e] >> 16); }
                if (MODE == 3) { const u32x4 cv = *(const u32x4*)(BCc + (size_t)(t0 + t) * 1024 + 512 + g * 128 + c8 * 8); *(LAS u32x4*)(lds + S_CN + t * 272 + c8 * 16) = cv; } }
        }
        __syncthreads();
        if (MODE == 3) {
            f32x4 y[2];
#pragma unroll
            for (int e = 0; e < 2; ++e) { const int x = 2 * w + e, tb = x >> 2, sb = x & 3;
                f32x4 a = (f32x4){0.f, 0.f, 0.f, 0.f};
                if (sb <= tb) a = mm16<4>(a, lds + S_BN + sb * 16 * 272, 272, lds + S_CN + tb * 16 * 272, 272, lane);
                const int t = 16 * tb + r16, sb0 = 16 * sb + quad * 4;
                const float act = ((const LAS float*)(lds + S_ACUM))[t], dtt = ((const LAS float*)(lds + S_DTV))[t];
                float v[4];
#pragma unroll
                for (int jj = 0; jj < 4; ++jj) { const int s = sb0 + jj; float val = 0.f;
                    if (s <= t) val = a[jj] * __expf(act - ((const LAS float*)(lds + S_ACUM))[s]);
                    if (s == t) val += Dh * __builtin_amdgcn_rcpf(dtt);
                    v[jj] = val; }
                *(LAS u32x2*)(lds + S_GL + t * 144 + sb0 * 2) = (u32x2){pk2(v[0], v[1]), pk2(v[2], v[3])};
                const int pb = sb;
                y[e] = mm16<4>((f32x4){0.f, 0.f, 0.f, 0.f}, lds + S_SB + pb * 16 * 272, 272, lds + S_CN + tb * 16 * 272, 272, lane);
                y[e] = y[e] * __expf(act);
            }
            __syncthreads();
            u32x2 zin[2];
#pragma unroll
            for (int e = 0; e < 2; ++e) { const int x = 2 * w + e; zin[e] = *(const u32x2*)(Zb + (size_t)(t0 + 16 * (x >> 2) + r16) * 1024 + 16 * (x & 3) + quad * 4); }
            asm volatile("" ::: "memory");
#pragma unroll
            for (int e = 0; e < 2; ++e) { const int x = 2 * w + e, tb = x >> 2, pb = x & 3;
                y[e] = mm16<2>(y[e], lds + S_XDT + pb * 16 * 144, 144, lds + S_GL + tb * 16 * 144, 144, lane);
                const int t = 16 * tb + r16; bf16_t* zp = Zb + (size_t)(t0 + t) * 1024 + 16 * pb + quad * 4;
                const u32x2 zw = zin[e];
                f32x4 r; r[0] = y[e][0] * siluf_(bflo(zw.x)); r[1] = y[e][1] * siluf_(bfhi(zw.x)); r[2] = y[e][2] * siluf_(bflo(zw.y)); r[3] = y[e][3] * siluf_(bfhi(zw.y));
                float ss = r[0] * r[0] + r[1] * r[1] + r[2] * r[2] + r[3] * r[3];
                ss += __shfl_xor(ss, 16); ss += __shfl_xor(ss, 32);
                if (quad == 0) atomicAdd(ssq + (size_t)(t0 + t) * 4 + g, ss);
                *(u32x2*)zp = (u32x2){pk2(r[0], r[1]), pk2(r[2], r[3])}; }
        }
        {
            const float da = __expf(alast);
#pragma unroll
            for (int pb = 0; pb < 4; ++pb) { st[pb] = st[pb] * da;
                st[pb] = mm16<2>(st[pb], lds + S_BT + w * 16 * 144, 144, lds + S_XD2 + pb * 16 * 144, 144, lane);
                if (MODE == 3) *(LAS u32x2*)(lds + S_SB + (16 * pb + r16) * 272 + (16 * w + quad * 4) * 2) = (u32x2){pk2(st[pb][0], st[pb][1]), pk2(st[pb][2], st[pb][3])}; }
        }
        __syncthreads();
    }
    if (MODE == 1) {
#pragma unroll
        for (int pb = 0; pb < 4; ++pb) *(f32x4*)(states + ((size_t)(w * 4 + pb) * 64 + lane) * 4) = st[pb];
        if (tid == 0) ((float*)(ws + WS_DECS))[un] = __expf(atot);
    }
}

DI void conv_bc(const Params& p, int l) {
    const bf16_t* BC = (const bf16_t*)(p.ws + WS_R + 4 * BLK); bf16_t* O = (bf16_t*)(p.ws + WS_STG);
    const float* cw = p.in[8] + (size_t)l * 4 * 3072 + 2048; const float* cb = p.in[9] + l * 3072 + 2048;
    const int gt = blockIdx.x * 512 + opaque_tid();
    for (int it = gt; it < 1024 * 256; it += gridDim.x * 512) {
        const int c = it & 1023, r0 = (it >> 10) * 64;
        const float w0 = cw[c], w1 = cw[3072 + c], w2 = cw[2 * 3072 + c], w3 = cw[3 * 3072 + c], b = cb[c];
        float xin[67];
        const bool hist = (r0 & (SEQ - 1)) != 0;
#pragma unroll
        for (int i = 0; i < 67; ++i) xin[i] = (i >= 3 || hist) ? bf2f(BC[(size_t)(r0 - 3 + i) * 1024 + c]) : 0.f;
        asm volatile("" ::: "memory");
#pragma unroll
        for (int i = 0; i < 64; ++i) { const float cv = b + xin[i] * w0 + xin[i + 1] * w1 + xin[i + 2] * w2 + xin[i + 3] * w3; O[(size_t)(r0 + i) * 1024 + c] = f2bf(siluf_(cv)); }
    }
}


constexpr int H2_GRP = 46080, H2_ACUM = 0, H2_DTV = 256, H2_MISC = 512, H2_XDT = 1024, H2_XD2 = 10240, H2_GL = 19456, H2_SB = 28672, H2_BN = 92160, H2_BT = 109568, H2_CN = 128000;
DI void ssd_unit2(const Params& p, int l, int un, LAS unsigned char* lds) {
    const int tid = opaque_tid(), lane = tid & 63, w = __builtin_amdgcn_readfirstlane(tid >> 6), r16 = lane & 15, quad = lane >> 4;
    const int gI = w >> 2, wl = w & 3, tl = tid & 255;
    const int sc = un >> 4, head = 2 * (un & 15) + gI, g = head >> 3, tok0 = sc * 256;
    unsigned char* ws = p.ws;
    LAS unsigned char* gl = lds + gI * H2_GRP;
    bf16_t* Zb = (bf16_t*)(ws + WS_R + (size_t)(head >> 4) * BLK) + (head & 15) * 64;
    const bf16_t* Xb = (const bf16_t*)(ws + WS_R + (size_t)(2 + (head >> 4)) * BLK) + (head & 15) * 64;
    const bf16_t* BCc = (const bf16_t*)(ws + WS_STG);
    const float* small = (const float*)(ws + WS_SMALL);
    float* ssq = (float*)(ws + WS_SSQ);
    const float* states = (const float*)(ws + WS_STS) + (size_t)(sc * 32 + head) * 8192;
    const float* cw = p.in[8] + (size_t)l * 4 * 3072; const float* cbias = p.in[9] + l * 3072;
    const float dtb = p.in[10][l * 32 + head], aneg = -__expf(p.in[11][l * 32 + head]), Dh = p.in[12][l * 32 + head];
    f32x4 st[2][4];
#pragma unroll
    for (int nbl = 0; nbl < 2; ++nbl)
#pragma unroll
        for (int pb = 0; pb < 4; ++pb) { const int nbk = 2 * wl + nbl; st[nbl][pb] = *(const f32x4*)(states + ((size_t)(nbk * 4 + pb) * 64 + lane) * 4);
            *(LAS u32x2*)(gl + H2_SB + (16 * pb + r16) * 272 + (16 * nbk + quad * 4) * 2) = (u32x2){pk2(st[nbl][pb][0], st[nbl][pb][1]), pk2(st[nbl][pb][2], st[nbl][pb][3])}; }
    const int px = tl & 63, tq = tl >> 6;
    float wx[4];
#pragma unroll
    for (int i = 0; i < 4; ++i) wx[i] = cw[i * 3072 + head * 64 + px];
    const float bx = cbias[head * 64 + px];
    for (int j = 0; j < 4; ++j) {
        const int t0 = tok0 + 64 * j, s0 = t0 & (SEQ - 1);
        if (wl == 0) {
            const float dt = softplusf_(small[(size_t)(t0 + lane) * 64 + 16 + head] + dtb);
            float cs = dt * aneg;
#pragma unroll
            for (int o = 1; o < 64; o <<= 1) { const float v = __shfl_up(cs, o); if (lane >= o) cs += v; }
            ((LAS float*)(gl + H2_ACUM))[lane] = cs; ((LAS float*)(gl + H2_DTV))[lane] = dt;
            if (lane == 63) ((LAS float*)(gl + H2_MISC))[0] = cs;
        }
        __syncthreads();
        const float alast = ((const LAS float*)(gl + H2_MISC))[0];
        {
            float xv[19];
#pragma unroll
            for (int k = 0; k < 19; ++k) { const int tt = tq * 16 - 3 + k; xv[k] = (s0 + tt >= 0) ? bf2f(Xb[(size_t)(t0 + tt) * 1024 + px]) : 0.f; }
            unsigned a1[8], a2[8]; float e1[2], e2[2];
#pragma unroll
            for (int i = 0; i < 16; ++i) { const int t = tq * 16 + i;
                const float cv = bx + xv[i] * wx[0] + xv[i + 1] * wx[1] + xv[i + 2] * wx[2] + xv[i + 3] * wx[3];
                const float xd = siluf_(cv) * ((const LAS float*)(gl + H2_DTV))[t];
                e1[i & 1] = xd; e2[i & 1] = xd * __expf(alast - ((const LAS float*)(gl + H2_ACUM))[t]);
                if (i & 1) { a1[i >> 1] = pk2(e1[0], e1[1]); a2[i >> 1] = pk2(e2[0], e2[1]); } }
            *(LAS u32x4*)(gl + H2_XDT + px * 144 + tq * 32) = (u32x4){a1[0], a1[1], a1[2], a1[3]}; *(LAS u32x4*)(gl + H2_XDT + px * 144 + tq * 32 + 16) = (u32x4){a1[4], a1[5], a1[6], a1[7]};
            *(LAS u32x4*)(gl + H2_XD2 + px * 144 + tq * 32) = (u32x4){a2[0], a2[1], a2[2], a2[3]}; *(LAS u32x4*)(gl + H2_XD2 + px * 144 + tq * 32 + 16) = (u32x4){a2[4], a2[5], a2[6], a2[7]};
        }
#pragma unroll
        for (int i = 0; i < 2; ++i) { const int pid = tid + 512 * i, c8 = pid >> 6, t = pid & 63;
            const u32x4 v = *(const u32x4*)(BCc + (size_t)(t0 + t) * 1024 + g * 128 + c8 * 8);
            *(LAS u32x4*)(lds + H2_BN + t * 272 + c8 * 16) = v;
            LAS bf16_t* bt = (LAS bf16_t*)(lds + H2_BT) + (c8 * 8) * 72 + t;
#pragma unroll
            for (int e = 0; e < 4; ++e) { bt[(2 * e) * 72] = (bf16_t)(v[e] & 0xffffu); bt[(2 * e + 1) * 72] = (bf16_t)(v[e] >> 16); }
            const u32x4 cv = *(const u32x4*)(BCc + (size_t)(t0 + t) * 1024 + 512 + g * 128 + c8 * 8); *(LAS u32x4*)(lds + H2_CN + t * 272 + c8 * 16) = cv; }
        __syncthreads();
        f32x4 y[4];
        const int tb = wl, t = 16 * tb + r16;
        const float act = ((const LAS float*)(gl + H2_ACUM))[t], dtt = ((const LAS float*)(gl + H2_DTV))[t];
#pragma unroll
        for (int e = 0; e < 4; ++e) { const int sb = e;
            f32x4 a = (f32x4){0.f, 0.f, 0.f, 0.f};
            if (sb <= tb) a = mm16<4>(a, lds + H2_BN + sb * 16 * 272, 272, lds + H2_CN + tb * 16 * 272, 272, lane);
            const int sb0 = 16 * sb + quad * 4;
            float v[4];
#pragma unroll
            for (int jj = 0; jj < 4; ++jj) { const int s = sb0 + jj; float val = 0.f;
                if (s <= t) val = a[jj] * __expf(act - ((const LAS float*)(gl + H2_ACUM))[s]);
                if (s == t) val += Dh * __builtin_amdgcn_rcpf(dtt);
                v[jj] = val; }
            *(LAS u32x2*)(gl + H2_GL + t * 144 + sb0 * 2) = (u32x2){pk2(v[0], v[1]), pk2(v[2], v[3])};
            y[e] = mm16<4>((f32x4){0.f, 0.f, 0.f, 0.f}, gl + H2_SB + e * 16 * 272, 272, lds + H2_CN + tb * 16 * 272, 272, lane);
            y[e] = y[e] * __expf(act);
        }
        __syncthreads();
        u32x2 zin[4];
#pragma unroll
        for (int e = 0; e < 4; ++e) zin[e] = *(const u32x2*)(Zb + (size_t)(t0 + t) * 1024 + 16 * e + quad * 4);
        asm volatile("" ::: "memory");
#pragma unroll
        for (int e = 0; e < 4; ++e) { const int pb = e;
            y[e] = mm16<2>(y[e], gl + H2_XDT + pb * 16 * 144, 144, gl + H2_GL + tb * 16 * 144, 144, lane);
            bf16_t* zp = Zb + (size_t)(t0 + t) * 1024 + 16 * pb + quad * 4;
            const u32x2 zw = zin[e];
            f32x4 r; r[0] = y[e][0] * siluf_(bflo(zw.x)); r[1] = y[e][1] * siluf_(bfhi(zw.x)); r[2] = y[e][2] * siluf_(bflo(zw.y)); r[3] = y[e][3] * siluf_(bfhi(zw.y));
            float ss = r[0] * r[0] + r[1] * r[1] + r[2] * r[2] + r[3] * r[3];
            ss += __shfl_xor(ss, 16); ss += __shfl_xor(ss, 32);
            if (quad == 0) atomicAdd(ssq + (size_t)(t0 + t) * 4 + g, ss);
            *(u32x2*)zp = (u32x2){pk2(r[0], r[1]), pk2(r[2], r[3])}; }
        {
            const float da = __expf(alast);
#pragma unroll
            for (int nbl = 0; nbl < 2; ++nbl)
#pragma unroll
                for (int pb = 0; pb < 4; ++pb) { const int nbk = 2 * wl + nbl; st[nbl][pb] = st[nbl][pb] * da;
                    st[nbl][pb] = mm16<2>(st[nbl][pb], lds + H2_BT + nbk * 16 * 144, 144, gl + H2_XD2 + pb * 16 * 144, 144, lane);
                    *(LAS u32x2*)(gl + H2_SB + (16 * pb + r16) * 272 + (16 * nbk + quad * 4) * 2) = (u32x2){pk2(st[nbl][pb][0], st[nbl][pb][1]), pk2(st[nbl][pb][2], st[nbl][pb][3])}; }
        }
        __syncthreads();
    }
}

constexpr int L_ACUM = 0, L_DTV = 1024, L_TOT = 2048, L_XD2 = 2304, L_BT = 36096;
DI void ssd_local(const Params& p, int l, int un, LAS unsigned char* lds) {
    const int tid = opaque_tid(), lane = tid & 63, w = __builtin_amdgcn_readfirstlane(tid >> 6);
    const int sc = un >> 5, head = un & 31, g = head >> 3, tok0 = sc * 256, s0 = tok0 & (SEQ - 1);
    unsigned char* ws = p.ws;
    const bf16_t* Xb = (const bf16_t*)(ws + WS_R + (size_t)(2 + (head >> 4)) * BLK) + (head & 15) * 64;
    const bf16_t* BCc = (const bf16_t*)(ws + WS_STG);
    const float* small = (const float*)(ws + WS_SMALL);
    float* states = (float*)(ws + WS_STS) + (size_t)un * 8192;
    const float* cw = p.in[8] + (size_t)l * 4 * 3072; const float* cbias = p.in[9] + l * 3072;
    const float dtb = p.in[10][l * 32 + head], aneg = -__expf(p.in[11][l * 32 + head]);
    if (w < 4) {
        const int t = w * 64 + lane; const float dt = softplusf_(small[(size_t)(tok0 + t) * 64 + 16 + head] + dtb);
        float cs = dt * aneg;
#pragma unroll
        for (int o = 1; o < 64; o <<= 1) { const float v = __shfl_up(cs, o); if (lane >= o) cs += v; }
        ((LAS float*)(lds + L_ACUM))[t] = cs; ((LAS float*)(lds + L_DTV))[t] = dt;
        if (lane == 63) ((LAS float*)(lds + L_TOT))[w] = cs;
    }
    __syncthreads();
    const float t0_ = ((const LAS float*)(lds + L_TOT))[0], t1_ = ((const LAS float*)(lds + L_TOT))[1], t2_ = ((const LAS float*)(lds + L_TOT))[2], t3_ = ((const LAS float*)(lds + L_TOT))[3];
    const float atot = t0_ + t1_ + t2_ + t3_;
    {
        const int px = tid & 63, tq = tid >> 6;
        float wx[4];
#pragma unroll
        for (int i = 0; i < 4; ++i) wx[i] = cw[i * 3072 + head * 64 + px];
        const float bx = cbias[head * 64 + px];
        const float offq = (tq >= 6) ? t0_ + t1_ + t2_ : (tq >= 4) ? t0_ + t1_ : (tq >= 2) ? t0_ : 0.f;
#pragma unroll
        for (int c4 = 0; c4 < 4; ++c4) { const int tb = tq * 32 + c4 * 8;
            float xv[11];
#pragma unroll
            for (int k = 0; k < 11; ++k) { const int tt = tb - 3 + k; xv[k] = (s0 + tt >= 0) ? bf2f(Xb[(size_t)(tok0 + tt) * 1024 + px]) : 0.f; }
            unsigned a2[4]; float e2[2];
#pragma unroll
            for (int i = 0; i < 8; ++i) { const int t = tb + i;
                const float cv = bx + xv[i] * wx[0] + xv[i + 1] * wx[1] + xv[i + 2] * wx[2] + xv[i + 3] * wx[3];
                e2[i & 1] = siluf_(cv) * ((const LAS float*)(lds + L_DTV))[t] * __expf(atot - offq - ((const LAS float*)(lds + L_ACUM))[t]);
                if (i & 1) a2[i >> 1] = pk2(e2[0], e2[1]); }
            *(LAS u32x4*)(lds + L_XD2 + px * 528 + tb * 2) = (u32x4){a2[0], a2[1], a2[2], a2[3]}; }
    }
#pragma unroll
    for (int i = 0; i < 8; ++i) { const int pid = tid + 512 * i, c8 = pid >> 8, t = pid & 255;
        const u32x4 v = *(const u32x4*)(BCc + (size_t)(tok0 + t) * 1024 + g * 128 + c8 * 8);
        LAS bf16_t* bt = (LAS bf16_t*)(lds + L_BT) + (c8 * 8) * 264 + t;
#pragma unroll
        for (int e = 0; e < 4; ++e) { bt[(2 * e) * 264] = (bf16_t)(v[e] & 0xffffu); bt[(2 * e + 1) * 264] = (bf16_t)(v[e] >> 16); } }
    __syncthreads();
#pragma unroll
    for (int pb = 0; pb < 4; ++pb) { const f32x4 st = mm16<8>((f32x4){0.f, 0.f, 0.f, 0.f}, lds + L_BT + w * 16 * 528, 528, lds + L_XD2 + pb * 16 * 528, 528, lane);
        *(f32x4*)(states + ((size_t)(w * 4 + pb) * 64 + lane) * 4) = st; }
    if (tid == 0) ((float*)(ws + WS_DECS))[un] = __expf(atot);
    __syncthreads();
}

constexpr int M2_GRP = 36096, M2_ACUM = 0, M2_DTV = 1024, M2_TOT = 2048, M2_XD2 = 2304, M2_BT = 72192;
DI void ssd_local2(const Params& p, int l, int un, LAS unsigned char* lds) {
    const int tid = opaque_tid(), lane = tid & 63, w = __builtin_amdgcn_readfirstlane(tid >> 6);
    const int gI = w >> 2, wl = w & 3, tl = tid & 255;
    const int sc = un >> 4, head = 2 * (un & 15) + gI, g = head >> 3, tok0 = sc * 256, s0 = tok0 & (SEQ - 1);
    unsigned char* ws = p.ws;
    LAS unsigned char* gl = lds + gI * M2_GRP;
    const bf16_t* Xb = (const bf16_t*)(ws + WS_R + (size_t)(2 + (head >> 4)) * BLK) + (head & 15) * 64;
    const bf16_t* BCc = (const bf16_t*)(ws + WS_STG);
    const float* small = (const float*)(ws + WS_SMALL);
    float* states = (float*)(ws + WS_STS) + (size_t)(sc * 32 + head) * 8192;
    const float* cw = p.in[8] + (size_t)l * 4 * 3072; const float* cbias = p.in[9] + l * 3072;
    const float dtb = p.in[10][l * 32 + head], aneg = -__expf(p.in[11][l * 32 + head]);
    {
        const int t = wl * 64 + lane; const float dt = softplusf_(small[(size_t)(tok0 + t) * 64 + 16 + head] + dtb);
        float cs = dt * aneg;
#pragma unroll
        for (int o = 1; o < 64; o <<= 1) { const float v = __shfl_up(cs, o); if (lane >= o) cs += v; }
        ((LAS float*)(gl + M2_ACUM))[t] = cs; ((LAS float*)(gl + M2_DTV))[t] = dt;
        if (lane == 63) ((LAS float*)(gl + M2_TOT))[wl] = cs;
    }
    __syncthreads();
    const float t0_ = ((const LAS float*)(gl + M2_TOT))[0], t1_ = ((const LAS float*)(gl + M2_TOT))[1], t2_ = ((const LAS float*)(gl + M2_TOT))[2], t3_ = ((const LAS float*)(gl + M2_TOT))[3];
    const float atot = t0_ + t1_ + t2_ + t3_;
    {
        const int px = tl & 63, tq = tl >> 6;
        float wx[4];
#pragma unroll
        for (int i = 0; i < 4; ++i) wx[i] = cw[i * 3072 + head * 64 + px];
        const float bx = cbias[head * 64 + px];
        const float offq = (tq == 3) ? t0_ + t1_ + t2_ : (tq == 2) ? t0_ + t1_ : (tq == 1) ? t0_ : 0.f;
        for (int c8 = 0; c8 < 8; ++c8) { const int tb = tq * 64 + c8 * 8;
            float xv[11];
#pragma unroll
            for (int k = 0; k < 11; ++k) { const int tt = tb - 3 + k; xv[k] = (s0 + tt >= 0) ? bf2f(Xb[(size_t)(tok0 + tt) * 1024 + px]) : 0.f; }
            unsigned a2[4]; float e2[2];
#pragma unroll
            for (int i = 0; i < 8; ++i) { const int t = tb + i;
                const float cv = bx + xv[i] * wx[0] + xv[i + 1] * wx[1] + xv[i + 2] * wx[2] + xv[i + 3] * wx[3];
                e2[i & 1] = siluf_(cv) * ((const LAS float*)(gl + M2_DTV))[t] * __expf(atot - offq - ((const LAS float*)(gl + M2_ACUM))[t]);
                if (i & 1) a2[i >> 1] = pk2(e2[0], e2[1]); }
            *(LAS u32x4*)(gl + M2_XD2 + px * 528 + tb * 2) = (u32x4){a2[0], a2[1], a2[2], a2[3]}; }
    }
#pragma unroll
    for (int i = 0; i < 8; ++i) { const int pid = tid + 512 * i, c8 = pid >> 8, t = pid & 255;
        const u32x4 v = *(const u32x4*)(BCc + (size_t)(tok0 + t) * 1024 + g * 128 + c8 * 8);
        LAS bf16_t* bt = (LAS bf16_t*)(lds + M2_BT) + (c8 * 8) * 264 + t;
#pragma unroll
        for (int e = 0; e < 4; ++e) { bt[(2 * e) * 264] = (bf16_t)(v[e] & 0xffffu); bt[(2 * e + 1) * 264] = (bf16_t)(v[e] >> 16); } }
    __syncthreads();
#pragma unroll
    for (int nbl = 0; nbl < 2; ++nbl)
#pragma unroll
        for (int pb = 0; pb < 4; ++pb) { const int nbk = 2 * wl + nbl;
            const f32x4 st = mm16<8>((f32x4){0.f, 0.f, 0.f, 0.f}, lds + M2_BT + nbk * 16 * 528, 528, gl + M2_XD2 + pb * 16 * 528, 528, lane);
            *(f32x4*)(states + ((size_t)(nbk * 4 + pb) * 64 + lane) * 4) = st; }
    if (tl == 0) ((float*)(ws + WS_DECS))[sc * 32 + head] = __expf(atot);
    __syncthreads();
}
DI void ssd_scan(const Params& p) {
    const int gid = blockIdx.x * 512 + opaque_tid();
    for (int it = gid; it < 131072; it += gridDim.x * 512) {
        const int chain = it >> 11, e = it & 2047, b = chain >> 5, head = chain & 31;
        f32x4* st = (f32x4*)(p.ws + WS_STS); const float* dec = (const float*)(p.ws + WS_DECS);
        f32x4 run = (f32x4){0.f, 0.f, 0.f, 0.f};
        for (int hb = 0; hb < 4; ++hb) {
            f32x4 u[8];
#pragma unroll
            for (int s = 0; s < 8; ++s) u[s] = st[(size_t)((b * 32 + hb * 8 + s) * 32 + head) * 2048 + e];
            asm volatile("" ::: "memory");
#pragma unroll
            for (int s = 0; s < 8; ++s) { const int un = (b * 32 + hb * 8 + s) * 32 + head; const float dc = dec[un];
                st[(size_t)un * 2048 + e] = run; run = run * dc + u[s]; }
        }
    }
}

typedef short v4i16_t __attribute__((ext_vector_type(4)));
DI s16x4 vtr(const LAS unsigned char* p) { return __builtin_bit_cast(s16x4, __builtin_amdgcn_ds_read_tr16_b64_v4i16((LAS v4i16_t*)p)); }
constexpr int A_K = 0, A_V = 69632, A_X = 0, A_Y = 65536, A_NG = 143360;
DI void attn_unit(const Params& p, int b, int h, int qb, float lam, float oscale, LAS unsigned char* lds) {
    const int tid = opaque_tid(), lane = tid & 63, w = __builtin_amdgcn_readfirstlane(tid >> 6), rg = w & 3, sub = w >> 2, q = lane & 31, hh = lane >> 5;
    bf16_t* Qd = (bf16_t*)(p.ws + WS_R + 4 * BLK); const bf16_t* Kd = (const bf16_t*)(p.ws + WS_R + 5 * BLK); const bf16_t* Vd = (const bf16_t*)(p.ws + WS_R + 6 * BLK);
    const int tok0 = b * SEQ + qb * 128;
    bf16x8 qf[4];
    { const bf16_t* qp = Qd + (size_t)(tok0 + rg * 32 + q) * 1024 + h * 128 + sub * 64 + hh * 8;
#pragma unroll
      for (int ks = 0; ks < 4; ++ks) qf[ks] = *(const bf16x8*)(qp + ks * 16); }
    const int NP = qb + 1;
    u32x4 kr[4], vr[4];
    const int prow = tid >> 4, pc16 = tid & 15;
#define ATT_LOAD(pr) do { _Pragma("unroll") for (int i_ = 0; i_ < 4; ++i_) { const size_t off_ = (size_t)(b * SEQ + (pr) * 128 + prow + 32 * i_) * 1024 + h * 128 + pc16 * 8; \
        kr[i_] = *(const u32x4*)(Kd + off_); vr[i_] = *(const u32x4*)(Vd + off_); } } while (0)
#define ATT_STORE(buf) do { _Pragma("unroll") for (int i_ = 0; i_ < 4; ++i_) { \
        *(LAS u32x4*)(lds + A_K + (buf) * 34816 + (prow + 32 * i_) * 272 + pc16 * 16) = kr[i_]; *(LAS u32x4*)(lds + A_V + (buf) * 36864 + (prow + 32 * i_) * 288 + pc16 * 16) = vr[i_]; } } while (0)
    f32x16 o[4];
#pragma unroll
    for (int db = 0; db < 4; ++db)
#pragma unroll
        for (int i = 0; i < 16; ++i) o[db][i] = 0.f;
    float m_run = -1e30f, l_run = 0.f;
    const float C2 = 0.18033688011112042f;
    ATT_LOAD(0); ATT_STORE(0); if (NP > 1) ATT_LOAD(1);
    __syncthreads();
    const int i16 = lane & 15, blk = (lane >> 4) & 1;
    for (int pr = 0; pr < NP; ++pr) {
        if (pr + 1 < NP) ATT_STORE((pr + 1) & 1);
        if (pr + 2 < NP) ATT_LOAD(pr + 2);
      for (int hf = 0; hf < 2; ++hf) {
        const int t = 2 * pr + hf;
        if (t <= 2 * qb + (rg >> 1)) {
            const LAS unsigned char* Kb = lds + A_K + (pr & 1) * 34816 + hf * 64 * 272; const LAS unsigned char* Vb = lds + A_V + (pr & 1) * 36864 + hf * 64 * 288;
            f32x16 s0, s1;
#pragma unroll
            for (int i = 0; i < 16; ++i) { s0[i] = 0.f; s1[i] = 0.f; }
#pragma unroll
            for (int ks = 0; ks < 4; ++ks) { const LAS unsigned char* kp = Kb + q * 272 + (sub * 64 + ks * 16 + hh * 8) * 2;
                s0 = mfma32(*(const LAS bf16x8*)kp, qf[ks], s0); s1 = mfma32(*(const LAS bf16x8*)(kp + 32 * 272), qf[ks], s1); }
            float mx = fmaxf(s0[0], s1[0]);
#pragma unroll
            for (int i = 1; i < 16; ++i) mx = fmaxf(mx, fmaxf(s0[i], s1[i]));
            mx = fmaxf(mx, __shfl_xor(mx, 32));
            const float m_new = fmaxf(m_run, mx), negm = -m_new * C2;
            if (__any(m_new > m_run)) {
                const float alpha = __builtin_amdgcn_exp2f((m_run - m_new) * C2);
                l_run *= alpha;
#pragma unroll
                for (int db = 0; db < 4; ++db)
#pragma unroll
                    for (int i = 0; i < 16; ++i) o[db][i] *= alpha;
            }
            float sum = 0.f;
#pragma unroll
            for (int i = 0; i < 16; ++i) { s0[i] = __builtin_amdgcn_exp2f(fmaf(s0[i], C2, negm)); s1[i] = __builtin_amdgcn_exp2f(fmaf(s1[i], C2, negm)); sum += s0[i] + s1[i]; }
            l_run += sum; m_run = m_new;
            bf16x8 pf[2][2];
#pragma unroll
            for (int s = 0; s < 2; ++s) {
                pf[0][s] = __builtin_bit_cast(bf16x8, (u32x4){pk2(s0[8 * s], s0[8 * s + 1]), pk2(s0[8 * s + 2], s0[8 * s + 3]), pk2(s0[8 * s + 4], s0[8 * s + 5]), pk2(s0[8 * s + 6], s0[8 * s + 7])});
                pf[1][s] = __builtin_bit_cast(bf16x8, (u32x4){pk2(s1[8 * s], s1[8 * s + 1]), pk2(s1[8 * s + 2], s1[8 * s + 3]), pk2(s1[8 * s + 4], s1[8 * s + 5]), pk2(s1[8 * s + 6], s1[8 * s + 7])}); }
#pragma unroll
            for (int kb = 0; kb < 2; ++kb)
#pragma unroll
                for (int s = 0; s < 2; ++s) { const LAS unsigned char* vp = Vb + (32 * kb + 16 * s + 4 * hh + (i16 >> 2)) * 288 + blk * 32 + (i16 & 3) * 8;
#pragma unroll
                    for (int db = 0; db < 4; ++db) { const s16x4 lo = vtr(vp + db * 64), hi = vtr(vp + db * 64 + 8 * 288);
                        const bf16x8 vf = (bf16x8){lo[0], lo[1], lo[2], lo[3], hi[0], hi[1], hi[2], hi[3]};
                        o[db] = mfma32(vf, pf[kb][s], o[db]); } }
        }
      }
        __syncthreads();
    }
#undef ATT_LOAD
#undef ATT_STORE
    const float l_tot = l_run + __shfl_xor(l_run, 32);
    LAS float* X = (LAS float*)(lds + A_X) + rg * 4096;
    if (sub == 1) { const float inv = lam / l_tot;
#pragma unroll
        for (int db = 0; db < 4; ++db)
#pragma unroll
            for (int i = 0; i < 16; ++i) X[(db * 16 + i) * 64 + lane] = o[db][i] * inv; }
    __syncthreads();
    if (sub == 0) { const float inv = 1.f / l_tot; float ss = 0.f;
#pragma unroll
        for (int db = 0; db < 4; ++db)
#pragma unroll
            for (int i = 0; i < 16; ++i) { const float v = o[db][i] * inv - X[(db * 16 + i) * 64 + lane]; o[db][i] = v; ss += v * v; }
        ss += __shfl_xor(ss, 32);
        const float rs = rsqrtf(ss * (1.f / 128.f) + 1e-5f) * oscale;
        LAS bf16_t* Y = (LAS bf16_t*)(lds + A_Y) + rg * (32 * 136);
        const LAS float* ngl = (const LAS float*)(lds + A_NG);
#pragma unroll
        for (int db = 0; db < 4; ++db)
#pragma unroll
            for (int i = 0; i < 16; ++i) { const int dv = 32 * db + crow(i, hh); Y[q * 136 + dv] = f2bf(o[db][i] * rs * ngl[dv]); }
        asm volatile("s_waitcnt lgkmcnt(0)" ::: "memory");
#pragma unroll
        for (int k = 0; k < 8; ++k) { const int piece = lane + 64 * k, row = piece >> 4, c16 = piece & 15;
            const u32x4 v = *(const LAS u32x4*)((const LAS unsigned char*)Y + row * 272 + c16 * 16);
            *(u32x4*)(Qd + (size_t)(tok0 + rg * 32 + row) * 1024 + h * 128 + c16 * 8) = v; }
    }
    __syncthreads();
}
DI void attn_phase(const Params& p, int l, LAS unsigned char* lds, int vcu) {
    const int tid = opaque_tid();
    float d1 = 0.f, d2 = 0.f;
    for (int i = 0; i < 64; ++i) { d1 += p.in[14][l * 64 + i] * p.in[15][l * 64 + i]; d2 += p.in[16][l * 64 + i] * p.in[17][l * 64 + i]; }
    const float lambda_init = (l == 0) ? 0.2f : 0.35550906759096934f;
    const float lam = expf(d1) - expf(d2) + lambda_init;
    if (tid < 128) ((LAS float*)(lds + A_NG))[tid] = p.in[18][l * 128 + tid];
    __syncthreads();
    for (int i = 0; i < 4; ++i)
        for (int vc = vcu; vc < 256; vc += gridDim.x) {
            const int bh = vc >> 4, s = vc & 15; const int qb = (i == 0) ? s : (i == 1) ? 31 - s : (i == 2) ? 32 + s : 63 - s;
            attn_unit(p, bh >> 3, bh & 7, qb, lam, 1.f - lambda_init, lds);
        }
}

DI void final_norm(const Params& p) {
    const float* rowsq = (const float*)(p.ws + WS_ROWSQ) + 4 * T; const float* g = p.in[26];
    const int gt = blockIdx.x * 512 + opaque_tid(), NTH = gridDim.x * 512;
    for (int i0 = gt; i0 < T * 256; i0 += 4 * NTH) {
        f32x4 v[4];
#pragma unroll
        for (int k = 0; k < 4; ++k) { const int i = i0 + k * NTH; if (i < T * 256) v[k] = *(const f32x4*)(p.out + (size_t)(i >> 8) * 1024 + (i & 255) * 4); }
        asm volatile("" ::: "memory");
#pragma unroll
        for (int k = 0; k < 4; ++k) { const int i = i0 + k * NTH; if (i < T * 256) { const int row = i >> 8, c = (i & 255) * 4;
            const float rs = rsqrtf(rowsq[row] * (1.f / 1024.f) + EPS); const f32x4 gv = *(const f32x4*)(g + c);
            *(f32x4*)(p.out + (size_t)row * 1024 + c) = v[k] * rs * gv; } }
    }
}


DI void gemv2(float* out, int ldo, const float* in, int ldi, const float* W, int ldw, int K, int N, int kchunk) {
    const int tid = opaque_tid(), lane = tid & 63, wave = __builtin_amdgcn_readfirstlane(tid >> 6);
    const int gw = blockIdx.x * 8 + wave, NGW = gridDim.x * 8, nstrip = (N + 63) / 64, nk = K / 128;
    for (int job = gw; job < nstrip * nk; job += NGW) {
        const int strip = job % nstrip, kq = job / nstrip, col = strip * 64 + lane; const bool ok = col < N;
        const float* wp = W + (size_t)(kq * 128) * ldw + (ok ? col : 0);
        const float* i0 = in + kq * 128; const float* i1 = in + ldi + kq * 128;
        float a0 = 0.f, a1 = 0.f;
        for (int kk = 0; kk < 2; ++kk) {
            const float h0 = i0[kk * 64 + lane], h1 = i1[kk * 64 + lane];
#pragma unroll
            for (int k = 0; k < 64; ++k) { const float wv = wp[(size_t)(kk * 64 + k) * ldw];
                a0 += __uint_as_float(__builtin_amdgcn_readlane(__float_as_uint(h0), k)) * wv; a1 += __uint_as_float(__builtin_amdgcn_readlane(__float_as_uint(h1), k)) * wv; }
        }
        if (ok) { atomicAdd(out + col, a0); atomicAdd(out + ldo + col, a1); }
    }
}
DI void side_init(const Params& p) {
    const int tid = opaque_tid(), lane = tid & 63, wave = __builtin_amdgcn_readfirstlane(tid >> 6);
    const int gt = blockIdx.x * 512 + tid, NTH = gridDim.x * 512, gw = blockIdx.x * 8 + wave, NGW = gridDim.x * 8;
    float* z = (float*)(p.ws + SB_PROJ);
    for (int i = gt; i < (int)((SB_END - SB_PROJ) / 4); i += NTH) z[i] = 0.f;
    float* hn = (float*)(p.ws + SB_HN);
    for (int r = gw; r < 128; r += NGW) { const int row = (r >> 6) * SEQ + (r & 63);
        const f32x4* xr = (const f32x4*)(p.in[0] + (size_t)row * 1024) + lane; f32x4 v[4]; float s2 = 0.f;
#pragma unroll
        for (int j = 0; j < 4; ++j) { v[j] = xr[64 * j]; s2 += v[j][0] * v[j][0] + v[j][1] * v[j][1] + v[j][2] * v[j][2] + v[j][3] * v[j][3]; }
        const float rs = rsqrtf(wave_sum(s2) * (1.f / 1024.f) + EPS);
#pragma unroll
        for (int j = 0; j < 4; ++j) { const f32x4 g = *((const f32x4*)p.in[2] + lane + 64 * j); *((f32x4*)(hn + (size_t)r * 1024) + lane + 64 * j) = v[j] * rs * g; } }
}
DI void side_kv(const Params& p) {
    const int tid = opaque_tid(), lane = tid & 63, wave = __builtin_amdgcn_readfirstlane(tid >> 6);
    const int gw = blockIdx.x * 8 + wave, NGW = gridDim.x * 8;
    const float* hn = (const float*)(p.ws + SB_HN); float* kv = (float*)(p.ws + SB_KV);
    for (int job = gw; job < 4096; job += NGW) {
        const int strip = job & 31, grp = (job >> 5) & 15, kq = job >> 9, col = strip * 64 + lane;
        const float* wp = p.in[3] + (size_t)(kq * 128) * INC + 9264 + col; const float* hp = hn + (size_t)(grp * 8) * 1024 + kq * 128;
        float a[8];
#pragma unroll
        for (int t = 0; t < 8; ++t) a[t] = 0.f;
        for (int kk = 0; kk < 2; ++kk) {
            float h[8];
#pragma unroll
            for (int t = 0; t < 8; ++t) h[t] = hp[t * 1024 + kk * 64 + lane];
#pragma unroll 16
            for (int k = 0; k < 64; ++k) { const float wv = wp[(size_t)(kk * 64 + k) * INC];
#pragma unroll
                for (int t = 0; t < 8; ++t) a[t] += __uint_as_float(__builtin_amdgcn_readlane(__float_as_uint(h[t]), k)) * wv; }
        }
#pragma unroll
        for (int t = 0; t < 8; ++t) atomicAdd(kv + (size_t)(grp * 8 + t) * 2048 + col, a[t]);
    }
}
DI void rope_cs(int pos, int i, float& cs, float& sn) {
    const double cf[8] = {0.15915494309189535, 0.03086376340470123, 0.005985185712713705, 0.001160663641240061, 0.00022507907903927653, 4.364795279280289e-05, 8.464330808241401e-06, 1.6414262627950345e-06};
    double c = cf[0];
#pragma unroll
    for (int q = 1; q < 8; ++q) c = (i == q) ? cf[q] : c;
    double rv = (double)pos * c; rv -= floor(rv); const float fr = (float)rv; sn = __builtin_amdgcn_sinf(fr); cs = __builtin_amdgcn_cosf(fr);
}
DI float wave_max(float v) {
#pragma unroll
    for (int o = 1; o < 64; o <<= 1) v = fmaxf(v, __shfl_xor(v, o));
    return v;
}
DI void side_mixers(const Params& p, int b, LAS unsigned char* lds) {
    const int tid = opaque_tid(), lane = tid & 63, w = __builtin_amdgcn_readfirstlane(tid >> 6);
    const float* P = (const float*)(p.ws + SB_PROJ) + b * 14384; float* Y = (float*)(p.ws + SB_Y) + b * 4096; float* KV = (float*)(p.ws + SB_KV) + (size_t)b * 64 * 2048;
    LAS float* cx = (LAS float*)lds; LAS float* ypre = cx + 3072; LAS float* lg = ypre + 2048; LAS float* pr = lg + 1024; LAS float* red = pr + 1024; LAS float* qr = red + 64;
    const int* pos = (const int*)p.in[1] + b * SEQ;
    __syncthreads();
    if (w < 4) { float qk = P[w * 128 + lane] * P[512 + w * 128 + lane] + P[w * 128 + 64 + lane] * P[512 + w * 128 + 64 + lane]; float vv = 0.f;
#pragma unroll
        for (int k = 0; k < 4; ++k) { const float v = P[1024 + w * 256 + k * 64 + lane]; vv += v * v; }
        qk = wave_sum(qk); vv = wave_sum(vv);
        if (lane == 0) { red[w] = qk * 0.08838834764831845f; red[4 + w] = vv * (1.f / 256.f); } }
    for (int c = tid; c < 3072; c += 512) cx[c] = siluf_(p.in[9][c] + p.in[8][3 * 3072 + c] * P[5136 + c]);
    if (tid < 32) red[8 + tid] = softplusf_(P[8208 + tid] + p.in[10][tid]);
    __syncthreads();
    for (int i = tid; i < 1024; i += 512) { const int h = i >> 8; const float p00 = red[h], o = p00 * P[1024 + i];
        Y[i] = o * rsqrtf(p00 * p00 * red[4 + h] + EPS) * p.in[7][i & 255] * siluf_(P[2064 + i]); }
    if (w < 4) { float cb = cx[2560 + w * 128 + lane] * cx[2048 + w * 128 + lane] + cx[2560 + w * 128 + 64 + lane] * cx[2048 + w * 128 + 64 + lane]; cb = wave_sum(cb); if (lane == 0) red[40 + w] = cb; }
    __syncthreads();
    for (int i = tid; i < 2048; i += 512) { const int head = i >> 6; ypre[i] = (red[40 + (head >> 3)] * red[8 + head] + p.in[12][head]) * cx[i] * siluf_(P[3088 + i]); }
    __syncthreads();
    if (w < 4) { float ss = 0.f;
#pragma unroll
        for (int k = 0; k < 8; ++k) { const float v = ypre[w * 512 + k * 64 + lane]; ss += v * v; }
        ss = wave_sum(ss); if (lane == 0) red[44 + w] = rsqrtf(ss * (1.f / 512.f) + EPS); }
    __syncthreads();
    for (int i = tid; i < 2048; i += 512) Y[1024 + i] = ypre[i] * red[44 + (i >> 9)] * p.in[13][i];
    for (int i = tid; i < 1024; i += 512) { const int d = i & 63; float v = P[8240 + i];
        if (d < 16) { float cs, sn; rope_cs(pos[0], d & 7, cs, sn); const float o = (d < 8) ? P[8240 + i + 8] : P[8240 + i - 8]; v = (d < 8) ? v * cs - o * sn : v * cs + o * sn; }
        qr[i] = v; }
    {
        float k1[16], k2[16];
#pragma unroll
        for (int q = 0; q < 16; ++q) { const int it = tid + 512 * q, j = it >> 7, hs = (it >> 3) & 15, d = it & 7; const float* kp = KV + (size_t)j * 2048 + hs * 64 + d; k1[q] = kp[0]; k2[q] = kp[8]; }
        asm volatile("" ::: "memory");
#pragma unroll
        for (int q = 0; q < 16; ++q) { const int it = tid + 512 * q, j = it >> 7, hs = (it >> 3) & 15, d = it & 7; float cs, sn; rope_cs(pos[j], d, cs, sn);
            float* kp = KV + (size_t)j * 2048 + hs * 64 + d; kp[0] = k1[q] * cs - k2[q] * sn; kp[8] = k2[q] * cs + k1[q] * sn; }
    }
    __threadfence_block();
    __syncthreads();
    for (int i = tid; i < 1024; i += 512) { const int hs = i >> 6, j = i & 63; const f32x4* kp = (const f32x4*)(KV + (size_t)j * 2048 + hs * 64); float sacc = 0.f;
#pragma unroll
        for (int d4 = 0; d4 < 16; ++d4) { const f32x4 kv4 = kp[d4]; sacc += qr[hs * 64 + 4 * d4] * kv4[0] + qr[hs * 64 + 4 * d4 + 1] * kv4[1] + qr[hs * 64 + 4 * d4 + 2] * kv4[2] + qr[hs * 64 + 4 * d4 + 3] * kv4[3]; }
        lg[i] = sacc * 0.125f; }
    __syncthreads();
#pragma unroll
    for (int rr = 0; rr < 2; ++rr) { const int row = 2 * w + rr; const float x = lg[row * 64 + lane]; const float m = wave_max(x); const float e = expf(x - m); const float sum = wave_sum(e); pr[row * 64 + lane] = e / sum; }
    __syncthreads();
    float d1 = 0.f, d2 = 0.f;
    for (int i = 0; i < 64; ++i) { d1 += p.in[14][i] * p.in[15][i]; d2 += p.in[16][i] * p.in[17][i]; }
    const float lam = expf(d1) - expf(d2) + 0.2f;
    for (int i = tid; i < 1024; i += 512) { const int h = i >> 7; float o = 0.f;
#pragma unroll 16
        for (int j = 0; j < 64; ++j) o += (pr[(2 * h) * 64 + j] - lam * pr[(2 * h + 1) * 64 + j]) * KV[(size_t)j * 2048 + 1024 + i];
        ypre[i] = o; }
    __syncthreads();
    { const float v0 = ypre[w * 128 + lane], v1 = ypre[w * 128 + 64 + lane]; const float ss = wave_sum(v0 * v0 + v1 * v1); if (lane == 0) red[48 + w] = rsqrtf(ss * (1.f / 128.f) + 1e-5f) * 0.8f; }
    __syncthreads();
    for (int i = tid; i < 1024; i += 512) Y[3072 + i] = ypre[i] * red[48 + (i >> 7)] * p.in[18][i & 127];
    float* G = (float*)(p.ws + SB_GATE) + b * 3072;
    for (int i = tid; i < 3072; i += 512) G[i] = sigmoidf_(P[11312 + i] + p.in[4][i]);
    __syncthreads();
}
DI void side_glue(const Params& p, int step, int b, LAS unsigned char* lds) {
    const int tid = opaque_tid(); unsigned char* ws = p.ws; LAS float* red = (LAS float*)lds;
    if (step == 4) {
        const float* G = (const float*)(ws + SB_GATE) + b * 3072; const float* BR = (const float*)(ws + SB_BR) + b * 3072;
        for (int c = tid; c < 1024; c += 512) { ((float*)(ws + SB_MIX))[b * 1024 + c] = G[c] * BR[c] + G[1024 + c] * BR[1024 + c] + G[2048 + c] * BR[2048 + c];
            ((float*)(ws + SB_XM))[b * 1024 + c] = p.in[0][(size_t)b * SEQ * 1024 + c]; }
    } else if (step == 6 || step == 100) {
        const float* src = (const float*)(ws + (step == 6 ? SB_XM : SB_X1)) + b * 1024; float* dst = (float*)(ws + (step == 6 ? SB_H2 : SB_HN1)) + b * 1024;
        const float* g = step == 6 ? p.in[23] : p.in[2] + 1024;
        __syncthreads();
        float s2 = 0.f; for (int c = tid; c < 1024; c += 512) s2 += src[c] * src[c];
        s2 = wave_sum(s2); if ((tid & 63) == 0) red[tid >> 6] = s2;
        __syncthreads();
        float tot = 0.f; for (int w = 0; w < 8; ++w) tot += red[w];
        const float rs = rsqrtf(tot * (1.f / 1024.f) + EPS);
        for (int c = tid; c < 1024; c += 512) dst[c] = src[c] * rs * g[c];
        if (step == 100) { const size_t row = (size_t)b * SEQ; bf16_t* xb = (bf16_t*)(ws + WS_XB);
            for (int c = tid; c < 1024; c += 512) { p.out[row * 1024 + c] = src[c]; xb[row * 1024 + c] = f2bf(src[c]); }
            if (tid == 0) ((float*)(ws + WS_ROWSQ))[2 * T + row] = tot; }
        __syncthreads();
    } else if (step == 8) {
        const float* up = (const float*)(ws + SB_UP) + b * 4096; float* hh = (float*)(ws + SB_HH) + b * 4096;
        for (int c = tid; c < 4096; c += 512) { const float r = fmaxf(up[c], 0.f); hh[c] = r * r; }
        for (int c = tid; c < 1024; c += 512) ((float*)(ws + SB_X1))[b * 1024 + c] = ((const float*)(ws + SB_XM))[b * 1024 + c];
    }
}
DI void side_phase(const Params& p, int l, int k, LAS unsigned char* lds) {
    unsigned char* ws = p.ws; const int bid = blockIdx.x;
    if (l == 0) {
        if (k == 0) side_init(p);
        else if (k == 1) { gemv2((float*)(ws + SB_PROJ), 14384, (const float*)(ws + SB_HN), 64 * 1024, p.in[3], INC, 1024, INC, 128); side_kv(p); }
        else if (k == 2) { if (bid < 2) side_mixers(p, bid, lds); }
        else if (k == 3) { float* br = (float*)(ws + SB_BR); const float* y = (const float*)(ws + SB_Y);
            gemv2(br, 3072, y, 4096, p.in[19], 1024, 1024, 1024, 128); gemv2(br + 1024, 3072, y + 1024, 4096, p.in[20], 1024, 2048, 1024, 128); gemv2(br + 2048, 3072, y + 3072, 4096, p.in[21], 1024, 1024, 1024, 128); }
        else if (k == 4) { if (bid < 2) side_glue(p, 4, bid, lds); }
        else if (k == 5) gemv2((float*)(ws + SB_XM), 1024, (const float*)(ws + SB_MIX), 1024, p.in[22], 1024, 1024, 1024, 128);
        else if (k == 6) { if (bid < 2) side_glue(p, 6, bid, lds); }
        else if (k == 7) gemv2((float*)(ws + SB_UP), 4096, (const float*)(ws + SB_H2), 1024, p.in[24], 4096, 1024, 4096, 128);
        else if (k == 8) { if (bid < 2) side_glue(p, 8, bid, lds); }
        else if (k == 9) gemv2((float*)(ws + SB_X1), 1024, (const float*)(ws + SB_HH), 4096, p.in[25], 1024, 4096, 1024, 128);
    } else {
        if (k == 0) { if (bid < 2) side_glue(p, 100, bid, lds); }
        else if (k == 1) gemv2((float*)(ws + SB_QK1), 1024, (const float*)(ws + SB_HN1), 1024, p.in[3] + (size_t)1024 * INC, INC, 1024, 1024, 128);
    }
}


DI void grid_bar(unsigned* ctr, unsigned target) {
    asm volatile("s_waitcnt vmcnt(0)" ::: "memory");
    __syncthreads();
    if (threadIdx.x == 0) {
        __builtin_amdgcn_fence(__ATOMIC_RELEASE, "agent");
        asm volatile("s_waitcnt vmcnt(0)" ::: "memory");
        __hip_atomic_fetch_add(ctr, 1u, __ATOMIC_RELAXED, __HIP_MEMORY_SCOPE_AGENT);
        while (__hip_atomic_load(ctr, __ATOMIC_RELAXED, __HIP_MEMORY_SCOPE_AGENT) < target) __builtin_amdgcn_s_sleep(8);
        __builtin_amdgcn_fence(__ATOMIC_ACQUIRE, "agent");
        asm volatile("s_waitcnt vmcnt(0)" ::: "memory");
    }
    __syncthreads();
}


#define XB_TMO      128
#define XB_XCNT(j)  (256  + 64 * (j))
#define XB_XSUB(j)  (1280 + 64 * (j))
#define XB_XGEN(j)  (2304 + 64 * (j))
#define XB_TOP      3328
#define XB_TOPGEN   3392
#define XCD_BAR_WORDS 3456
#define XB_SPIN_CAP (1u << 22)
DI unsigned xb_ld(unsigned* p)              { return __hip_atomic_load(p, __ATOMIC_RELAXED, __HIP_MEMORY_SCOPE_AGENT); }
DI unsigned xb_add(unsigned* p, unsigned v) { return __hip_atomic_fetch_add(p, v, __ATOMIC_RELAXED, __HIP_MEMORY_SCOPE_AGENT); }
DI unsigned xb_xcc_id() { return (unsigned)__builtin_amdgcn_s_getreg((3 << 11) | 20) & 0xFu; }
#define XB_SPIN(cond, bar) do { unsigned _sp = 0; while (cond) { __builtin_amdgcn_s_sleep(1); \
    if ((++_sp & 255u) == 0u) { if (xb_ld(&(bar)[XB_TMO])) break; if (_sp > XB_SPIN_CAP) { atomicAdd(&(bar)[XB_TMO], 1u); break; } } } } while (0)
DI void xcd_barrier_complete(unsigned* bar, unsigned x, unsigned& nloc, unsigned& nx) {
    const unsigned G = gridDim.x;
    unsigned sum, cnt, mine, sp = 0u;
    for (;;) {
        sum = 0u; cnt = 0u; mine = 0u;
#pragma unroll
        for (unsigned j = 0; j < 16; ++j) { const unsigned c = xb_ld(&bar[XB_XCNT(j)]); sum += c; cnt += (c > 0u) ? 1u : 0u; mine = (j == x) ? c : mine; }
        if (sum == G) break;
        __builtin_amdgcn_s_sleep(1);
        if ((++sp & 255u) == 0u) { if (xb_ld(&bar[XB_TMO])) break; if (sp > XB_SPIN_CAP) { atomicAdd(&bar[XB_TMO], 1u); break; } }
    }
    nloc = mine > 0u ? mine : 1u; nx = cnt > 0u ? cnt : 1u;
}
DI void xcd_barrier(unsigned* bar, volatile LAS unsigned* st) {
    asm volatile("s_waitcnt vmcnt(0)" ::: "memory");
    __syncthreads();
    if (threadIdx.x == 0) {
        const unsigned x = xb_xcc_id();
        __builtin_amdgcn_s_waitcnt(0);
        unsigned nloc = st[0], nx = st[1];
        if (nloc == 0u) { xcd_barrier_complete(bar, x, nloc, nx); st[0] = nloc; st[1] = nx; }
        const unsigned old = xb_add(&bar[XB_XSUB(x)], 1u);
        const unsigned gen = old / nloc;
        if (old + 1u == (gen + 1u) * nloc) {
            __builtin_amdgcn_fence(__ATOMIC_RELEASE, "agent");
            asm volatile("s_waitcnt vmcnt(0)" ::: "memory");
            const unsigned og = xb_add(&bar[XB_TOP], 1u);
            const unsigned tg = og / nx;
            if (og + 1u == (tg + 1u) * nx) xb_add(&bar[XB_TOPGEN], 1u);
            else XB_SPIN(xb_ld(&bar[XB_TOPGEN]) == tg, bar);
            __builtin_amdgcn_fence(__ATOMIC_ACQUIRE, "agent");
            xb_add(&bar[XB_XGEN(x)], 1u);
            asm volatile("s_waitcnt vmcnt(0)" ::: "memory");
        } else {
            XB_SPIN(xb_ld(&bar[XB_XGEN(x)]) == gen, bar);
            __builtin_amdgcn_fence(__ATOMIC_ACQUIRE, "agent");
            asm volatile("s_waitcnt vmcnt(0)" ::: "memory");
        }
    }
    __syncthreads();
}

constexpr int NPHASE = 31, PPL = 15;
#ifndef PH_MASK
#define PH_MASK 0xFFFFFFFFu
#endif
#define EN(k_) ((PH_MASK >> (k_)) & 1u)
constexpr int LDS_BYTES = 147456;
template <bool COOP> __global__ void __launch_bounds__(512, 2) mk(Params p) {
    extern __shared__ __attribute__((aligned(16))) unsigned char lds_raw[];
    LAS unsigned char* lds = (LAS unsigned char*)lds_raw;
    unsigned char* ws = p.ws;
    float* rowsq = (float*)(ws + WS_ROWSQ);
    bf16_t* xb = (bf16_t*)(ws + WS_XB); bf16_t* mixb = (bf16_t*)(ws + WS_MIXB); bf16_t* R = (bf16_t*)(ws + WS_R);
    const unsigned char* wt = ws + WS_WT;
    const int G = gridDim.x, bid = blockIdx.x;
    volatile LAS unsigned* xst = (volatile LAS unsigned*)(lds + LDS_BYTES - 16);
    if (threadIdx.x == 0) { xst[0] = 0u; xst[1] = 0u; (void)xb_add((unsigned*)(ws + WS_BAR) + XB_XCNT(xb_xcc_id()), 1u); }
    __syncthreads();
    const int vcu = (G % 8 == 0) ? (bid % 8) * (G / 8) + bid / 8 : bid;
    for (int ph = p.ph_lo; ph < p.ph_hi; ++ph) {
        if (ph == 30) { final_norm(p); }
        else {
            const int l = ph / PPL, k = ph % PPL;
            if (EN(0) && k == 0) phase_prep(p, l, lds);
            else if (k == 1 || k == 6) {
                const bool gd = (k == 1);
                pg8::Gemm g{xb, (const bf16_t*)(wt + (gd ? WT_GD : WT_S)), T, gd ? 8448 : 6144, 1024, 1024, 1024};
                pg8::StaticOrder S; S.init(T, g.N, G, bid);
                EpiIn E{R, rowsq + (2 * l) * T, (float*)(ws + WS_SMALL), gd ? 32 : -1, gd ? 3 : 5, gd ? 7 : -1,
                        p.in[4] + l * 3072 + (gd ? 0 : 1024), p.in[4] + l * 3072 + 2048};
                pg8::gemm_phase(lds, g, S, E);
            }
            else if (EN(2) && k == 2) { rope_pass(p); for (int un = vcu; un < 256; un += G) gla_unit<1>(p, l, un, lds); }
            else if (EN(3) && k == 3) { gla_scan(p); attn_phase(p, l, lds, vcu); }
            else if (EN(4) && k == 4) { for (int un = vcu; un < 256; un += G) gla_unit<3>(p, l, un, lds); }
            else if (k == 5 || k == 11) {
                const int nrun = (k == 5) ? 2 : 4;
                for (int r = 0; r < nrun; ++r) {
                    pg8::Gemm g; EpiMix E;
                    if (k == 5) {
                        g = pg8::Gemm{R + (size_t)(r == 0 ? 2 : 4) * (BLK / 2), (const bf16_t*)(wt + (r == 0 ? WT_GLA : WT_DIFF)), T, 1024, 1024, 1024, 1024};
                        E = EpiMix{mixb, R + (size_t)(r == 0 ? 3 : 7) * (BLK / 2), nullptr, 0, r == 0 ? 1 : 0};
                    } else {
                        g = pg8::Gemm{R + (size_t)(r >> 1) * (BLK / 2) + (r & 1) * 512, (const bf16_t*)(wt + WT_SSM) + r * 512, T, 1024, 512, 1024, 2048};
                        E = EpiMix{mixb, R + (size_t)5 * (BLK / 2), (const float*)(ws + WS_SSQ), r, 0};
                    }
                    pg8::StaticOrder S; S.init(T, 1024, G, bid);
                    pg8::gemm_phase(lds, g, S, E);
                }
            }
            else if (k == 7) { conv_bc(p, l); }
            else if (k == 8) { for (int un = vcu; un < 1024; un += G) ssd_local2(p, l, un, lds); }
            else if (k == 9) { ssd_scan(p); }
            else if (k == 10) { for (int un = vcu; un < 1024; un += G) ssd_unit2(p, l, un, lds); }
            else if (k == 12 || k == 14) {
                const bool dn = (k == 14);
                pg8::Gemm g{dn ? R : mixb, (const bf16_t*)(wt + (dn ? WT_DOWN : WT_OUT)), T, 1024, dn ? 4096 : 1024, dn ? 4096 : 1024, dn ? 4096 : 1024};
                pg8::StaticOrder S; S.init(T, 1024, G, bid);
                EpiRes E{(l == 0 && !dn) ? p.in[0] : p.out, p.out, xb, rowsq + (2 * l + (dn ? 2 : 1)) * T};
                pg8::gemm_phase(lds, g, S, E);
            }
            else if (k == 13) {
                pg8::Gemm g{xb, (const bf16_t*)(wt + WT_UP), T, 4096, 1024, 1024, 1024};
                pg8::StaticOrder S; S.init(T, 4096, G, bid);
                EpiUp E{R, rowsq + (2 * l + 1) * T};
                pg8::gemm_phase(lds, g, S, E);
            }
        }
        if (ph < 30) side_phase(p, ph / PPL, ph % PPL, lds);
        if (COOP) { if (ph + 1 < p.ph_hi) { if (p.ph_hi < 0) cg::this_grid().sync();
            xcd_barrier((unsigned*)(ws + WS_BAR), xst); } }
    }
}

extern "C" void kernel_launch(void* const* d_in, const int* in_sizes, int n_in, void* d_out, int out_size, void* d_ws, size_t ws_size, hipStream_t stream) {
    static int grid = 0;
    if (grid == 0) {
        if (n_in != 27 || out_size != T * 1024 || ws_size < WS_END) { fprintf(stderr, "kernel_launch: unexpected shapes/ws (n_in %d out %d ws %zu need %zu)\n", n_in, out_size, ws_size, (size_t)WS_END); grid = -1; return; }
        int dev = 0, cus = 0, per_cu = 0;
        (void)hipGetDevice(&dev); (void)hipDeviceGetAttribute(&cus, hipDeviceAttributeMultiprocessorCount, dev);
        (void)hipFuncSetAttribute((const void*)mk<true>, hipFuncAttributeMaxDynamicSharedMemorySize, LDS_BYTES);
        (void)hipOccupancyMaxActiveBlocksPerMultiprocessor(&per_cu, (const void*)mk<true>, 512, LDS_BYTES);
        if (per_cu < 1) fprintf(stderr, "kernel_launch: occupancy query says %d blocks/CU\n", per_cu);
        (void)hipGetLastError();
        grid = cus;
    }
    if (grid < 0) return;
    Params p{};
    for (int i = 0; i < 27; ++i) p.in[i] = (const float*)d_in[i];
    p.out = (float*)d_out; p.ws = (unsigned char*)d_ws;
    p.ph_lo = 0; p.ph_hi = NPHASE;
    (void)hipMemsetAsync((unsigned char*)d_ws + WS_BAR, 0, 16384, stream);
    void* args[] = {&p};
    hipError_t e = hipLaunchCooperativeKernel((const void*)mk<true>, dim3(grid), dim3(512), args, LDS_BYTES, stream);
    if (e != hipSuccess) fprintf(stderr, "cooperative launch failed: %s (grid %d)\n", hipGetErrorString(e), grid);
}
```
